# Optimizing an MI355X kernel written in HIP

```python
import math
import jax, jax.numpy as jnp
from jax import lax
import numpy as np

D_MODEL = 1024
BATCH = 4
SEQ = 8192
DEPTH = 2

HEAD_DIM = 64
ROPE_THETA = 10000.0
NORM_EPS = 1e-6
NEG_INF = -1e30
D_FF = 4 * D_MODEL
Q_BLOCK = 128
MAX_POS_OFFSET = 4096

MLA_HEADS = 8
MLA_Q_RANK = 384
MLA_KV_RANK = 256
MLA_NOPE = 64
MLA_ROPE = 32
MLA_V = 64

DIL_CONFIGS = ((128, 1), (512, 4), (2048, 16))
DIL_GROUPS = len(DIL_CONFIGS)
DIL_HEADS = 4

DIFF_HEADS = 4
DIFF_DIM = 64

MOBA_HEADS = 8
MOBA_BLOCK = 256
MOBA_TOPK = 3
MOBA_Q_CHUNK = 32

N_EVEN = (DEPTH + 1) // 2
N_ODD = DEPTH // 2

EVEN_IN = MLA_Q_RANK + MLA_KV_RANK + MLA_ROPE + 3 * DIL_GROUPS * DIL_HEADS * HEAD_DIM
EVEN_OUT = MLA_HEADS * MLA_V + DIL_HEADS * HEAD_DIM
ODD_IN = 3 * DIFF_HEADS * 2 * DIFF_DIM + 3 * MOBA_HEADS * HEAD_DIM
ODD_OUT = DIFF_HEADS * 2 * DIFF_DIM + MOBA_HEADS * HEAD_DIM

kernel_name = "hybrid_mla_dilated_diff_moba_adaln"


def rms_norm(x, w):
    xf = x.astype(jnp.float32)
    y = xf * lax.rsqrt(jnp.mean(xf * xf, axis=-1, keepdims=True) + NORM_EPS)
    return (y * w.astype(jnp.float32)).astype(x.dtype)


def apply_rope(x, positions):
    half = x.shape[-1] // 2
    inv_freq = ROPE_THETA ** (-jnp.arange(half, dtype=jnp.float32) / half)
    ang = positions.astype(jnp.float32)[:, :, None] * inv_freq
    bshape = ang.shape[:2] + (1,) * (x.ndim - 3) + (half,)
    cos = jnp.cos(ang).reshape(bshape)
    sin = jnp.sin(ang).reshape(bshape)
    xf = x.astype(jnp.float32)
    x1, x2 = xf[..., :half], xf[..., half:]
    return jnp.concatenate([x1 * cos - x2 * sin, x2 * cos + x1 * sin], axis=-1).astype(x.dtype)


def dense_causal_attention(q, k, v):
    b, s, h, dk = q.shape
    nq = s // Q_BLOCK
    scale = dk ** -0.5
    qb = q.reshape(b, nq, Q_BLOCK, h, dk).transpose(1, 0, 2, 3, 4)
    kpos = jnp.arange(s)

    def one_block(args):
        i, qi = args
        sc = jnp.einsum('bqhd,bkhd->bhqk', qi, k, preferred_element_type=jnp.float32) * scale
        qpos = i * Q_BLOCK + jnp.arange(Q_BLOCK)
        sc = jnp.where(qpos[:, None] >= kpos[None, :], sc, NEG_INF)
        p = jax.nn.softmax(sc, axis=-1)
        return jnp.einsum('bhqk,bkhe->bqhe', p.astype(v.dtype), v)

    out = lax.map(one_block, (jnp.arange(nq), qb))
    return out.transpose(1, 0, 2, 3, 4).reshape(b, s, h, v.shape[-1])


def diff_causal_attention(q, k, v, lam):
    b, s, h, _, d = q.shape
    nq = s // Q_BLOCK
    scale = d ** -0.5
    qb = q.reshape(b, nq, Q_BLOCK, h, 2, d).transpose(1, 0, 2, 3, 4, 5)
    kpos = jnp.arange(s)

    def one_block(args):
        i, qi = args
        sc = jnp.einsum('bqhmd,bkhmd->bmhqk', qi, k, preferred_element_type=jnp.float32) * scale
        qpos = i * Q_BLOCK + jnp.arange(Q_BLOCK)
        sc = jnp.where(qpos[:, None] >= kpos[None, :], sc, NEG_INF)
        p = jax.nn.softmax(sc, axis=-1)
        pd = p[:, 0] - lam * p[:, 1]
        return jnp.einsum('bhqk,bkhe->bqhe', pd.astype(v.dtype), v)

    out = lax.map(one_block, (jnp.arange(nq), qb))
    return out.transpose(1, 0, 2, 3, 4).reshape(b, s, h, v.shape[-1])


def sliding_window_lse(q, k, v, window):
    n, l, h, d = q.shape
    blk = window
    lp = -(-l // blk) * blk
    pad = ((0, 0), (0, lp - l), (0, 0), (0, 0))
    q, k, v = jnp.pad(q, pad), jnp.pad(k, pad), jnp.pad(v, pad)
    nb = lp // blk
    qb = q.reshape(n, nb, blk, h, d)
    kb = k.reshape(n, nb, blk, h, d)
    vb = v.reshape(n, nb, blk, h, d)
    prev_pad = ((0, 0), (1, 0), (0, 0), (0, 0), (0, 0))
    kk = jnp.concatenate([jnp.pad(kb[:, :-1], prev_pad), kb], axis=2)
    vv = jnp.concatenate([jnp.pad(vb[:, :-1], prev_pad), vb], axis=2)
    sc = jnp.einsum('nbqhd,nbkhd->nbhqk', qb, kk, preferred_element_type=jnp.float32) * d ** -0.5
    qloc = jnp.arange(blk) + blk
    kloc = jnp.arange(2 * blk)
    rel = qloc[:, None] - kloc[None, :]
    band = (rel >= 0) & (rel <= window)
    kabs = jnp.arange(nb)[:, None, None] * blk + kloc[None, None, :] - blk
    mask = band[None] & (kabs >= 0)
    sc = jnp.where(mask[None, :, None], sc, NEG_INF)
    lse = jax.nn.logsumexp(sc, axis=-1)
    p = jnp.exp(sc - lse[..., None])
    out = jnp.einsum('nbhqk,nbkhd->nbqhd', p.astype(v.dtype), vv).reshape(n, lp, h, d)[:, :l]
    lse = lse.transpose(0, 1, 3, 2).reshape(n, lp, h)[:, :l]
    return out, lse


def dilated_group(q, k, v, window, dilation):
    b, s, h, d = q.shape
    m = s // dilation

    def split(t):
        return t.reshape(b, m, dilation, h, d).transpose(0, 2, 1, 3, 4).reshape(b * dilation, m, h, d)

    out, lse = sliding_window_lse(split(q), split(k), split(v), window // dilation)
    out = out.reshape(b, dilation, m, h, d).transpose(0, 2, 1, 3, 4).reshape(b, s, h, d)
    lse = lse.reshape(b, dilation, m, h).transpose(0, 2, 1, 3).reshape(b, s, h)
    return out, lse


def dilated_mixture(q, k, v):
    outs, lses = [], []
    for g, (w, r) in enumerate(DIL_CONFIGS):
        o, l = dilated_group(q[:, :, g], k[:, :, g], v[:, :, g], w, r)
        outs.append(o)
        lses.append(l)
    alpha = jax.nn.softmax(jnp.stack(lses), axis=0)
    out = jnp.sum(alpha[..., None] * jnp.stack(outs).astype(jnp.float32), axis=0)
    return out.astype(q.dtype)


def moba_attention(q, k, v):
    b, s, h, d = q.shape
    blk = MOBA_BLOCK
    sp = -(-s // blk) * blk
    nb = sp // blk
    scale = d ** -0.5
    pad = ((0, 0), (0, sp - s), (0, 0), (0, 0))
    qp, kp, vp = jnp.pad(q, pad), jnp.pad(k, pad), jnp.pad(v, pad)
    qb = qp.reshape(b, nb, blk, h, d)
    kb = kp.reshape(b, nb, blk, h, d)
    vb = vp.reshape(b, nb, blk, h, d)

    s_own = jnp.einsum('bnqhd,bnkhd->bnhqk', qb, kb, preferred_element_type=jnp.float32) * scale
    s_own = jnp.where(jnp.tril(jnp.ones((blk, blk), dtype=bool)), s_own, NEG_INF)
    lse_own = jax.nn.logsumexp(s_own, axis=-1)
    o_own = jnp.einsum('bnhqk,bnkhd->bnqhd', jnp.exp(s_own - lse_own[..., None]).astype(v.dtype), vb)
    o_own = o_own.reshape(b, sp, h, d)[:, :s].astype(jnp.float32)
    lse_own = lse_own.transpose(0, 1, 3, 2).reshape(b, sp, h)[:, :s]

    kmean = jnp.mean(kb.astype(jnp.float32), axis=2)
    gate = jnp.einsum('bshd,bnhd->bhsn', q.astype(jnp.float32), kmean)
    qblk = jnp.arange(s) // blk
    past = jnp.arange(nb)[None, :] < qblk[:, None]
    gate = jnp.where(past, gate, NEG_INF)
    n_sel = min(MOBA_TOPK, nb)
    _, idx = lax.top_k(gate, n_sel)
    valid = idx < qblk[None, None, :, None]

    kbh = kb.transpose(0, 3, 1, 2, 4)
    vbh = vb.transpose(0, 3, 1, 2, 4)
    nc = s // MOBA_Q_CHUNK
    qc_all = q.transpose(0, 2, 1, 3).reshape(b, h, nc, MOBA_Q_CHUNK, d).transpose(2, 0, 1, 3, 4)
    ic_all = idx.reshape(b, h, nc, MOBA_Q_CHUNK, n_sel).transpose(2, 0, 1, 3, 4)
    vc_all = valid.reshape(b, h, nc, MOBA_Q_CHUNK, n_sel).transpose(2, 0, 1, 3, 4)
    bidx = jnp.arange(b)[:, None, None, None]
    hidx = jnp.arange(h)[None, :, None, None]

    def chunk(args):
        qc, ic, vc = args
        kg = kbh[bidx, hidx, ic]
        vg = vbh[bidx, hidx, ic]
        sc = jnp.einsum('bhqd,bhqjkd->bhqjk', qc, kg, preferred_element_type=jnp.float32) * scale
        sc = jnp.where(vc[..., None], sc, NEG_INF).reshape(b, h, MOBA_Q_CHUNK, n_sel * blk)
        lse = jax.nn.logsumexp(sc, axis=-1)
        p = jnp.exp(sc - lse[..., None]).reshape(b, h, MOBA_Q_CHUNK, n_sel, blk)
        o = jnp.einsum('bhqjk,bhqjkd->bhqd', p.astype(vg.dtype), vg)
        return o, lse

    o_sel, lse_sel = lax.map(chunk, (qc_all, ic_all, vc_all))
    o_sel = o_sel.transpose(1, 0, 3, 2, 4).reshape(b, s, h, d).astype(jnp.float32)
    lse_sel = lse_sel.transpose(1, 0, 3, 2).reshape(b, s, h)

    lse_tot = jnp.logaddexp(lse_own, lse_sel)
    out = (jnp.exp(lse_own - lse_tot)[..., None] * o_own
           + jnp.exp(lse_sel - lse_tot)[..., None] * o_sel)
    return out.astype(q.dtype)


def even_mixer(h, positions, w_in, w_out, q_lat_norm, kv_lat_norm, w_uq, w_ukv,
               mla_qn, mla_kn, dil_qn, dil_kn):
    b, s, _ = h.shape
    u = h @ w_in
    o1 = MLA_Q_RANK
    o2 = o1 + MLA_KV_RANK
    o3 = o2 + MLA_ROPE
    c_q, c_kv, k_r, u_dil = u[..., :o1], u[..., o1:o2], u[..., o2:o3], u[..., o3:]

    q = jnp.einsum('bsr,rhd->bshd', rms_norm(c_q, q_lat_norm), w_uq)
    kv = jnp.einsum('bsr,rhd->bshd', rms_norm(c_kv, kv_lat_norm), w_ukv)
    k_nope, v_a = kv[..., :MLA_NOPE], kv[..., MLA_NOPE:]
    k_rope = jnp.broadcast_to(k_r[:, :, None, :], (b, s, MLA_HEADS, MLA_ROPE))
    k = jnp.concatenate([k_nope, k_rope], axis=-1)
    q, k = rms_norm(q, mla_qn), rms_norm(k, mla_kn)
    q = jnp.concatenate([q[..., :MLA_NOPE], apply_rope(q[..., MLA_NOPE:], positions)], axis=-1)
    k = jnp.concatenate([k[..., :MLA_NOPE], apply_rope(k[..., MLA_NOPE:], positions)], axis=-1)
    o_a = dense_causal_attention(q, k, v_a)

    qkv = u_dil.reshape(b, s, 3, DIL_GROUPS, DIL_HEADS, HEAD_DIM)
    qd = apply_rope(rms_norm(qkv[:, :, 0], dil_qn), positions)
    kd = apply_rope(rms_norm(qkv[:, :, 1], dil_kn), positions)
    o_b = dilated_mixture(qd, kd, qkv[:, :, 2])

    o = jnp.concatenate([o_a.reshape(b, s, -1), o_b.reshape(b, s, -1)], axis=-1)
    return o @ w_out


def odd_mixer(h, positions, w_in, w_out, diff_qn, diff_kn, diff_lambda, diff_subln,
              moba_qn, moba_kn, lam_init):
    b, s, _ = h.shape
    u = h @ w_in
    nqk = DIFF_HEADS * 2 * DIFF_DIM

    qc = u[..., :nqk].reshape(b, s, DIFF_HEADS, 2, DIFF_DIM)
    kc = u[..., nqk:2 * nqk].reshape(b, s, DIFF_HEADS, 2, DIFF_DIM)
    vc = u[..., 2 * nqk:3 * nqk].reshape(b, s, DIFF_HEADS, 2 * DIFF_DIM)
    qc = apply_rope(rms_norm(qc, diff_qn), positions)
    kc = apply_rope(rms_norm(kc, diff_kn), positions)
    lv = diff_lambda.astype(jnp.float32)
    lam = jnp.exp(jnp.sum(lv[0] * lv[1])) - jnp.exp(jnp.sum(lv[2] * lv[3])) + lam_init
    o_c = diff_causal_attention(qc, kc, vc, lam)
    o_c = rms_norm(o_c, diff_subln) * (1.0 - lam_init)

    m = u[..., 3 * nqk:].reshape(b, s, 3, MOBA_HEADS, HEAD_DIM)
    qm = apply_rope(rms_norm(m[:, :, 0], moba_qn), positions)
    km = apply_rope(rms_norm(m[:, :, 1], moba_kn), positions)
    o_d = moba_attention(qm, km, m[:, :, 2])

    o = jnp.concatenate([o_c.reshape(b, s, -1), o_d.reshape(b, s, -1)], axis=-1)
    return o @ w_out


def squared_relu_mlp(h, w1, w2):
    a = jax.nn.relu(h @ w1)
    return (a * a) @ w2


def modulate(xn, shift, scale):
    return xn * (1.0 + scale[:, None, :]) + shift[:, None, :]


def setup_inputs(seed: int = 0) -> dict:
    key = jax.random.key(seed)
    ks = jax.random.split(key, 27)
    f32 = jnp.float32

    def nrm(k, shape, scale):
        return jax.random.normal(k, shape, f32) * scale

    def gain(k, shape):
        return 1.0 + 0.1 * jax.random.normal(k, shape, f32)

    offset = jax.random.randint(ks[2], (BATCH, 1), 0, MAX_POS_OFFSET, dtype=jnp.int32)
    positions = offset + jnp.arange(SEQ, dtype=jnp.int32)[None, :]
    return {
        "x": nrm(ks[0], (BATCH, SEQ, D_MODEL), 1.0),
        "c": nrm(ks[1], (BATCH, D_MODEL), 1.0),
        "positions": positions,
        "ada_w": nrm(ks[3], (DEPTH, D_MODEL, 6 * D_MODEL), 0.5 * D_MODEL ** -0.5),
        "ada_b": nrm(ks[4], (DEPTH, 6 * D_MODEL), 0.02),
        "norm_mix": gain(ks[5], (DEPTH, D_MODEL)),
        "norm_mlp": gain(ks[6], (DEPTH, D_MODEL)),
        "mlp_w1": nrm(ks[7], (DEPTH, D_MODEL, D_FF), D_MODEL ** -0.5),
        "mlp_w2": nrm(ks[8], (DEPTH, D_FF, D_MODEL), D_FF ** -0.5),
        "even_w_in": nrm(ks[9], (N_EVEN, D_MODEL, EVEN_IN), D_MODEL ** -0.5),
        "even_w_out": nrm(ks[10], (N_EVEN, EVEN_OUT, D_MODEL), EVEN_OUT ** -0.5),
        "mla_q_lat_norm": gain(ks[11], (N_EVEN, MLA_Q_RANK)),
        "mla_kv_lat_norm": gain(ks[12], (N_EVEN, MLA_KV_RANK)),
        "mla_w_uq": nrm(ks[13], (N_EVEN, MLA_Q_RANK, MLA_HEADS, MLA_NOPE + MLA_ROPE), MLA_Q_RANK ** -0.5),
        "mla_w_ukv": nrm(ks[14], (N_EVEN, MLA_KV_RANK, MLA_HEADS, MLA_NOPE + MLA_V), MLA_KV_RANK ** -0.5),
        "mla_q_norm": gain(ks[15], (N_EVEN, MLA_NOPE + MLA_ROPE)),
        "mla_k_norm": gain(ks[16], (N_EVEN, MLA_NOPE + MLA_ROPE)),
        "dil_q_norm": gain(ks[17], (N_EVEN, HEAD_DIM)),
        "dil_k_norm": gain(ks[18], (N_EVEN, HEAD_DIM)),
        "odd_w_in": nrm(ks[19], (N_ODD, D_MODEL, ODD_IN), D_MODEL ** -0.5),
        "odd_w_out": nrm(ks[20], (N_ODD, ODD_OUT, D_MODEL), ODD_OUT ** -0.5),
        "diff_q_norm": gain(ks[21], (N_ODD, DIFF_DIM)),
        "diff_k_norm": gain(ks[22], (N_ODD, DIFF_DIM)),
        "diff_lambda": nrm(ks[23], (N_ODD, 4, DIFF_DIM), 0.1),
        "diff_subln": gain(ks[24], (N_ODD, 2 * DIFF_DIM)),
        "moba_q_norm": gain(ks[25], (N_ODD, HEAD_DIM)),
        "moba_k_norm": gain(ks[26], (N_ODD, HEAD_DIM)),
    }


def reference(x, c, positions, ada_w, ada_b, norm_mix, norm_mlp, mlp_w1, mlp_w2,
              even_w_in, even_w_out, mla_q_lat_norm, mla_kv_lat_norm, mla_w_uq, mla_w_ukv,
              mla_q_norm, mla_k_norm, dil_q_norm, dil_k_norm,
              odd_w_in, odd_w_out, diff_q_norm, diff_k_norm, diff_lambda, diff_subln,
              moba_q_norm, moba_k_norm):
    cond = jax.nn.silu(c.astype(jnp.float32)).astype(x.dtype)
    for layer in range(DEPTH):
        mod = cond @ ada_w[layer] + ada_b[layer]
        sh1, sc1, g1, sh2, sc2, g2 = jnp.split(mod, 6, axis=-1)
        h = modulate(rms_norm(x, norm_mix[layer]), sh1, sc1)
        i = layer // 2
        if layer % 2 == 0:
            y = even_mixer(h, positions, even_w_in[i], even_w_out[i], mla_q_lat_norm[i],
                           mla_kv_lat_norm[i], mla_w_uq[i], mla_w_ukv[i], mla_q_norm[i],
                           mla_k_norm[i], dil_q_norm[i], dil_k_norm[i])
        else:
            lam_init = 0.8 - 0.6 * math.exp(-0.3 * layer)
            y = odd_mixer(h, positions, odd_w_in[i], odd_w_out[i], diff_q_norm[i], diff_k_norm[i],
                          diff_lambda[i], diff_subln[i], moba_q_norm[i], moba_k_norm[i], lam_init)
        x = x + g1[:, None, :] * y
        h = modulate(rms_norm(x, norm_mlp[layer]), sh2, sc2)
        x = x + g2[:, None, :] * squared_relu_mlp(h, mlp_w1[layer], mlp_w2[layer])
    return x
```

```cpp
#include <hip/hip_runtime.h>
#include <hip/hip_cooperative_groups.h>
#include <stdint.h>
#include <cstdio>
#include <cmath>
namespace cg = cooperative_groups;

#ifndef MK_COOP
#define MK_COOP 1
#endif

typedef unsigned short bfu;
typedef __attribute__((ext_vector_type(8))) short bf16x8;
typedef __attribute__((ext_vector_type(4))) short s16x4;
typedef short v4i16_t __attribute__((ext_vector_type(4)));
typedef __attribute__((ext_vector_type(16))) float f32x16;
typedef __attribute__((ext_vector_type(4))) float f32x4;
typedef __attribute__((ext_vector_type(2))) float f32x2;
typedef __attribute__((ext_vector_type(4))) unsigned u32x4;
typedef __attribute__((ext_vector_type(2))) unsigned u32x2;
typedef __attribute__((ext_vector_type(2))) __bf16 bf2_t;
typedef __attribute__((address_space(3))) const char* lds_cptr;

#define DI __device__ __forceinline__
#define MFMA(a, b, c) __builtin_amdgcn_mfma_f32_32x32x16_bf16((a), (b), (c), 0, 0, 0)

constexpr int T = 32768, SEQ = 8192;
constexpr float EPS = 1e-6f;
constexpr float LOG2E = 1.4426950408889634f;
constexpr float SC_MLA = 0.10206207261596577f * LOG2E;
constexpr float SC_64 = 0.125f * LOG2E;
constexpr float LAM_INIT = 0.35550906759096926f;
constexpr int NPH = 21;

constexpr size_t MiB = 1048576;
constexpr size_t OFF_WIN0 = 0, OFF_WIN1 = 6 * MiB, OFF_W1_0 = 12 * MiB, OFF_W1_1 = 20 * MiB, OFF_W2_0 = 28 * MiB, OFF_W2_1 = 36 * MiB,
                 OFF_WOUT0 = 44 * MiB, OFF_WOUT1 = 46 * MiB, OFF_WUQ = 48 * MiB, OFF_WUKV = 49 * MiB, OFF_MODP = 50 * MiB, OFF_MOD = 52 * MiB,
                 OFF_ROPE64 = 53 * MiB, OFF_ROPE32 = 61 * MiB, OFF_KPART = 65 * MiB, OFF_CTR = 66 * MiB,
                 OFF_HBUF = 72 * MiB, OFF_OBUF = 136 * MiB, OFF_UBUF = 200 * MiB, OFF_DBUF = 392 * MiB, WS_END = 456 * MiB;

struct Params {
    const float *x, *c; const int* pos;
    const float *ada_w, *ada_b, *norm_mix, *norm_mlp, *w1, *w2, *e_win, *e_wout, *qlat, *kvlat, *wuq, *wukv, *mla_qn, *mla_kn, *dil_qn, *dil_kn,
        *o_win, *o_wout, *diff_qn, *diff_kn, *diff_lam, *diff_subln, *moba_qn, *moba_kn;
    float* out; char* ws;
    float invf64[32]; float invf32[16];
    int phase_lo, phase_hi, coop, pad_;
};

DI unsigned pk2(float a, float b) { f32x2 v = {a, b}; bf2_t r = __builtin_convertvector(v, bf2_t); return __builtin_bit_cast(unsigned, r); }
DI float bflo(unsigned u) { return __uint_as_float(u << 16); }
DI float bfhi(unsigned u) { return __uint_as_float(u & 0xffff0000u); }
DI float wave_sum(float v) {
#pragma unroll
    for (int o = 32; o; o >>= 1) v += __shfl_xor(v, o);
    return v; }
DI s16x4 vtr(lds_cptr p) { return __builtin_bit_cast(s16x4, __builtin_amdgcn_ds_read_tr16_b64_v4i16((__attribute__((address_space(3))) v4i16_t*)p)); }

DI void tr_tile(const float* __restrict__ src, int K, int N, bfu* __restrict__ dst, const float* __restrict__ kscale, int it, float* tl) {
    const int nkt = K >> 6; const int kt = it % nkt, nt = it / nkt; const int tid = threadIdx.x;
#pragma unroll
    for (int rr = 0; rr < 4; ++rr) {
        const int kl = rr * 16 + (tid >> 4), k = kt * 64 + kl, nl = (tid & 15) * 4, n = nt * 64 + nl;
        float4 v = make_float4(0.f, 0.f, 0.f, 0.f);
        if (n < N) v = *(const float4*)(src + (size_t)k * N + n);
        if (kscale) { const float s = kscale[k]; v.x *= s; v.y *= s; v.z *= s; v.w *= s; }
        tl[kl * 65 + nl] = v.x; tl[kl * 65 + nl + 1] = v.y; tl[kl * 65 + nl + 2] = v.z; tl[kl * 65 + nl + 3] = v.w;
    }
    __syncthreads();
    {
        const int nl = tid >> 2, kc = (tid & 3) * 16;
        unsigned w[8];
#pragma unroll
        for (int i = 0; i < 8; ++i) w[i] = pk2(tl[(kc + 2 * i) * 65 + nl], tl[(kc + 2 * i + 1) * 65 + nl]);
        bfu* d = dst + (size_t)(nt * 64 + nl) * K + kt * 64 + kc;
        *(u32x4*)d = (u32x4){w[0], w[1], w[2], w[3]};
        *(u32x4*)(d + 8) = (u32x4){w[4], w[5], w[6], w[7]};
    }
    __syncthreads();
}
DI void tr_matrix(const float* src, int K, int N, int Npad, bfu* dst, const float* kscale, float* tl) {
    const int nit = (K >> 6) * (Npad >> 6);
    for (int it = blockIdx.x; it < nit; it += gridDim.x) tr_tile(src, K, N, dst, kscale, it, tl);
}

DI void phase_prep(const Params& p, char* smem) {
    float* tl = (float*)smem;
    char* ws = p.ws;
    if (blockIdx.x == 0 && threadIdx.x < 4) ((int*)(ws + OFF_CTR))[threadIdx.x] = 0;
    tr_matrix(p.e_win, 1024, 2976, 3072, (bfu*)(ws + OFF_WIN0), nullptr, tl);
    tr_matrix(p.o_win, 1024, 3072, 3072, (bfu*)(ws + OFF_WIN1), nullptr, tl);
    tr_matrix(p.w1, 1024, 4096, 4096, (bfu*)(ws + OFF_W1_0), nullptr, tl);
    tr_matrix(p.w1 + (size_t)1024 * 4096, 1024, 4096, 4096, (bfu*)(ws + OFF_W1_1), nullptr, tl);
    tr_matrix(p.w2, 4096, 1024, 1024, (bfu*)(ws + OFF_W2_0), nullptr, tl);
    tr_matrix(p.w2 + (size_t)1024 * 4096, 4096, 1024, 1024, (bfu*)(ws + OFF_W2_1), nullptr, tl);
    tr_matrix(p.e_wout, 768, 1024, 1024, (bfu*)(ws + OFF_WOUT0), nullptr, tl);
    tr_matrix(p.o_wout, 1024, 1024, 1024, (bfu*)(ws + OFF_WOUT1), nullptr, tl);
    tr_matrix(p.wuq, 384, 768, 768, (bfu*)(ws + OFF_WUQ), p.qlat, tl);
    tr_matrix(p.wukv, 256, 1024, 1024, (bfu*)(ws + OFF_WUKV), p.kvlat, tl);
    {
        float2* r64 = (float2*)(ws + OFF_ROPE64); float2* r32 = (float2*)(ws + OFF_ROPE32);
        for (int idx = blockIdx.x * 256 + threadIdx.x; idx < T * 48; idx += gridDim.x * 256) {
            const int t = idx / 48, i = idx % 48;
            const float invf = (i < 32) ? p.invf64[i] : p.invf32[i - 32];
            const float a = (float)p.pos[t] * invf;
            double rev = (double)a * 0.15915494309189535; rev -= floor(rev);
            const double y = (rev > 0.5 ? rev - 1.0 : rev) * 6.283185307179586;
            const double y2 = y * y; double s = 1.0, c = 1.0;
#pragma unroll
            for (int k = 15; k >= 1; --k) { s = 1.0 - s * y2 * (1.0 / (double)((2 * k) * (2 * k + 1))); c = 1.0 - c * y2 * (1.0 / (double)((2 * k - 1) * (2 * k))); }
            s *= y;
            const float2 o = make_float2((float)c, (float)s);
            if (i < 32) r64[(size_t)t * 32 + i] = o; else r32[(size_t)t * 16 + (i - 32)] = o;
        }
    }
    {
        float* sl = (float*)smem; float* modp = (float*)(ws + OFF_MODP);
        for (int it = blockIdx.x; it < 2 * 24 * 8; it += gridDim.x) {
            const int l = it / 192, cc = (it % 192) / 8, kc = it % 8;
            __syncthreads();
            for (int i = threadIdx.x; i < 512; i += 256) { const int b = i >> 7, kk = i & 127; const float cv = p.c[b * 1024 + kc * 128 + kk]; sl[i] = cv / (1.f + __expf(-cv)); }
            __syncthreads();
            const int j = cc * 256 + threadIdx.x;
            const float* w = p.ada_w + ((size_t)l * 1024 + kc * 128) * 6144 + j;
            float a0 = 0.f, a1 = 0.f, a2 = 0.f, a3 = 0.f;
#pragma unroll 8
            for (int kk = 0; kk < 128; ++kk) { const float wv = w[(size_t)kk * 6144]; a0 += sl[kk] * wv; a1 += sl[128 + kk] * wv; a2 += sl[256 + kk] * wv; a3 += sl[384 + kk] * wv; }
            float* o = modp + (size_t)((l * 8 + kc) * 4) * 6144 + j;
            o[0] = a0; o[6144] = a1; o[2 * 6144] = a2; o[3 * 6144] = a3;
        }
        __syncthreads();
    }
}

DI void phase_modfin(const Params& p) {
    const float* modp = (const float*)(p.ws + OFF_MODP); float* mod = (float*)(p.ws + OFF_MOD);
    for (int idx = blockIdx.x * 256 + threadIdx.x; idx < 2 * 4 * 6144; idx += gridDim.x * 256) {
        const int l = idx / 24576, rem = idx % 24576, j = rem % 6144;
        float s = p.ada_b[l * 6144 + j];
#pragma unroll
        for (int kc = 0; kc < 8; ++kc) s += modp[(size_t)((l * 8 + kc) * 4) * 6144 + rem];
        mod[idx] = s;
    }
}

DI void phase_normmod(const float* xs, const float* __restrict__ nw, const float* __restrict__ mod, int sh_off, bfu* __restrict__ hb) {
    const int lane = threadIdx.x & 63, gw = blockIdx.x * 4 + (threadIdx.x >> 6), nwv = gridDim.x * 4;
    for (int t = gw; t < T; t += nwv) {
        const int b = t >> 13; const float* xr = xs + (size_t)t * 1024;
        float4 v[4]; float ss = 0.f;
#pragma unroll
        for (int i = 0; i < 4; ++i) { v[i] = *(const float4*)(xr + (i * 64 + lane) * 4); ss += v[i].x * v[i].x + v[i].y * v[i].y + v[i].z * v[i].z + v[i].w * v[i].w; }
        ss = wave_sum(ss);
        const float rinv = rsqrtf(ss * (1.f / 1024.f) + EPS);
        const float* mb = mod + b * 6144 + sh_off;
#pragma unroll
        for (int i = 0; i < 4; ++i) {
            const int col = (i * 64 + lane) * 4;
            const float4 w = *(const float4*)(nw + col), sh = *(const float4*)(mb + col), sc = *(const float4*)(mb + 1024 + col);
            const float o0 = v[i].x * rinv * w.x * (1.f + sc.x) + sh.x, o1 = v[i].y * rinv * w.y * (1.f + sc.y) + sh.y;
            const float o2 = v[i].z * rinv * w.z * (1.f + sc.z) + sh.z, o3 = v[i].w * rinv * w.w * (1.f + sc.w) + sh.w;
            *(u32x2*)(hb + (size_t)t * 1024 + col) = (u32x2){pk2(o0, o1), pk2(o2, o3)};
        }
    }
}

template <int EPI>
DI void gemm_tile(const bfu* __restrict__ A, int lda, const bfu* __restrict__ Bt, int K, int m0, int n0, int N,
                  bfu* Cb, int ldc, const float* resid, float* outf, const float* __restrict__ gate, char* smem) {
    bfu* As = (bfu*)smem; bfu* Bs = As + 128 * 72;
    const int tid = threadIdx.x, lane = tid & 63, wid = tid >> 6, l32 = lane & 31, hi = lane >> 5;
    const int wm = wid & 1, wn = wid >> 1;
    f32x16 acc[4][2];
#pragma unroll
    for (int nb = 0; nb < 4; ++nb)
#pragma unroll
        for (int mb = 0; mb < 2; ++mb)
#pragma unroll
            for (int r = 0; r < 16; ++r) acc[nb][mb][r] = 0.f;
    const bfu* Ag = A + (size_t)(m0 + (tid >> 3)) * lda + (tid & 7) * 8;
    const bfu* Bg = Bt + (size_t)(n0 + (tid >> 3)) * K + (tid & 7) * 8;
    u32x4 ra[4], rb[8];
#pragma unroll
    for (int i = 0; i < 4; ++i) ra[i] = *(const u32x4*)(Ag + (size_t)(32 * i) * lda);
#pragma unroll
    for (int i = 0; i < 8; ++i) rb[i] = *(const u32x4*)(Bg + (size_t)(32 * i) * K);
    const int nk = K >> 6;
    bfu* Asw = As + (tid >> 3) * 72 + (tid & 7) * 8; bfu* Bsw = Bs + (tid >> 3) * 72 + (tid & 7) * 8;
    const bfu* Asr = As + (wm * 64 + l32) * 72 + hi * 8; const bfu* Bsr = Bs + (wn * 128 + l32) * 72 + hi * 8;
    for (int kt = 0; kt < nk; ++kt) {
        __syncthreads();
#pragma unroll
        for (int i = 0; i < 4; ++i) *(u32x4*)(Asw + 32 * i * 72) = ra[i];
#pragma unroll
        for (int i = 0; i < 8; ++i) *(u32x4*)(Bsw + 32 * i * 72) = rb[i];
        __syncthreads();
        if (kt + 1 < nk) {
            const int ko = (kt + 1) * 64;
#pragma unroll
            for (int i = 0; i < 4; ++i) ra[i] = *(const u32x4*)(Ag + (size_t)(32 * i) * lda + ko);
#pragma unroll
            for (int i = 0; i < 8; ++i) rb[i] = *(const u32x4*)(Bg + (size_t)(32 * i) * K + ko);
        }
#pragma unroll
        for (int k16 = 0; k16 < 4; ++k16) {
            bf16x8 af[2], bfr[4];
#pragma unroll
            for (int mb = 0; mb < 2; ++mb) af[mb] = *(const bf16x8*)(Asr + mb * 32 * 72 + k16 * 16);
#pragma unroll
            for (int nb = 0; nb < 4; ++nb) bfr[nb] = *(const bf16x8*)(Bsr + nb * 32 * 72 + k16 * 16);
#pragma unroll
            for (int nb = 0; nb < 4; ++nb)
#pragma unroll
                for (int mb = 0; mb < 2; ++mb) acc[nb][mb] = MFMA(bfr[nb], af[mb], acc[nb][mb]);
        }
    }
#pragma unroll
    for (int nb = 0; nb < 4; ++nb)
#pragma unroll
        for (int mb = 0; mb < 2; ++mb) {
            const int m = m0 + wm * 64 + mb * 32 + l32;
#pragma unroll
            for (int i = 0; i < 4; ++i) {
                const int n = n0 + wn * 128 + nb * 32 + 8 * i + 4 * hi;
                float v0 = acc[nb][mb][4 * i], v1 = acc[nb][mb][4 * i + 1], v2 = acc[nb][mb][4 * i + 2], v3 = acc[nb][mb][4 * i + 3];
                if (n < N) {
                    if (EPI == 2) {
                        const int b = m >> 13;
                        const float4 g = *(const float4*)(gate + b * 6144 + n);
                        const float4 r = *(const float4*)(resid + (size_t)m * 1024 + n);
                        float4 o; o.x = r.x + g.x * v0; o.y = r.y + g.y * v1; o.z = r.z + g.z * v2; o.w = r.w + g.w * v3;
                        *(float4*)(outf + (size_t)m * 1024 + n) = o;
                    } else {
                        if (EPI == 1) { v0 = fmaxf(v0, 0.f); v1 = fmaxf(v1, 0.f); v2 = fmaxf(v2, 0.f); v3 = fmaxf(v3, 0.f); v0 *= v0; v1 *= v1; v2 *= v2; v3 *= v3; }
                        *(u32x2*)(Cb + (size_t)m * ldc + n) = (u32x2){pk2(v0, v1), pk2(v2, v3)};
                    }
                }
            }
        }
}

template <int EPI>
DI void phase_gemm(const bfu* A, int lda, const bfu* Bt, int K, int N, int ntn, bfu* Cb, int ldc, const float* resid, float* outf, const float* gate, char* smem) {
    const int ntiles = 256 * ntn;
    for (int tile = blockIdx.x; tile < ntiles; tile += gridDim.x) {
        const int mt = tile / ntn, nt = tile % ntn;
        gemm_tile<EPI>(A, lda, Bt, K, mt * 128, nt * 256, N, Cb, ldc, resid, outf, gate, smem);
    }
}

DI void headnorm64(bfu* hp, const float* __restrict__ w, const float2* __restrict__ cs, float scale, int j, bool acc_on, f32x4& ka1, f32x4& ka2) {
    const u32x2 a = *(const u32x2*)(hp + 4 * j), b = *(const u32x2*)(hp + 32 + 4 * j);
    float x1[4] = {bflo(a[0]), bfhi(a[0]), bflo(a[1]), bfhi(a[1])}, x2[4] = {bflo(b[0]), bfhi(b[0]), bflo(b[1]), bfhi(b[1])};
    float ss = 0.f;
#pragma unroll
    for (int e = 0; e < 4; ++e) ss += x1[e] * x1[e] + x2[e] * x2[e];
    ss += __shfl_xor(ss, 1); ss += __shfl_xor(ss, 2); ss += __shfl_xor(ss, 4);
    const float r = rsqrtf(ss * (1.f / 64.f) + EPS);
    const float4 w1 = *(const float4*)(w + 4 * j), w2 = *(const float4*)(w + 32 + 4 * j);
    const float wa[4] = {w1.x, w1.y, w1.z, w1.w}, wb[4] = {w2.x, w2.y, w2.z, w2.w};
    float o1[4], o2[4];
#pragma unroll
    for (int e = 0; e < 4; ++e) {
        const float y1 = x1[e] * r * wa[e], y2 = x2[e] * r * wb[e]; const float2 c = cs[4 * j + e];
        o1[e] = y1 * c.x - y2 * c.y; o2[e] = y2 * c.x + y1 * c.y;
    }
    if (acc_on) {
#pragma unroll
        for (int e = 0; e < 4; ++e) { ka1[e] += o1[e]; ka2[e] += o2[e]; }
    }
    *(u32x2*)(hp + 4 * j) = (u32x2){pk2(o1[0] * scale, o1[1] * scale), pk2(o1[2] * scale, o1[3] * scale)};
    *(u32x2*)(hp + 32 + 4 * j) = (u32x2){pk2(o2[0] * scale, o2[1] * scale), pk2(o2[2] * scale, o2[3] * scale)};
}

DI float sq4(u32x2 a) { const float x0 = bflo(a[0]), x1 = bfhi(a[0]), x2 = bflo(a[1]), x3 = bfhi(a[1]); return x0 * x0 + x1 * x1 + x2 * x2 + x3 * x3; }

DI void mla_head(u32x4 nv, unsigned x1, unsigned x2, float rn, float rr, const float* __restrict__ wn, int j, float2 csA, float2 csB, float scale, bfu* dst) {
    float f[8] = {bflo(nv[0]) * rn, bfhi(nv[0]) * rn, bflo(nv[1]) * rn, bfhi(nv[1]) * rn, bflo(nv[2]) * rn, bfhi(nv[2]) * rn, bflo(nv[3]) * rn, bfhi(nv[3]) * rn};
    const float a0 = bflo(x1) * rr, a1 = bfhi(x1) * rr, b0 = bflo(x2) * rr, b1 = bfhi(x2) * rr;
    float ss = a0 * a0 + a1 * a1 + b0 * b0 + b1 * b1;
#pragma unroll
    for (int e = 0; e < 8; ++e) ss += f[e] * f[e];
    ss += __shfl_xor(ss, 1); ss += __shfl_xor(ss, 2); ss += __shfl_xor(ss, 4);
    const float r = rsqrtf(ss * (1.f / 96.f) + EPS) * scale;
    const float4 wA = *(const float4*)(wn + 8 * j), wB = *(const float4*)(wn + 8 * j + 4);
    const float wv[8] = {wA.x, wA.y, wA.z, wA.w, wB.x, wB.y, wB.z, wB.w};
#pragma unroll
    for (int e = 0; e < 8; ++e) f[e] *= r * wv[e];
    *(u32x4*)(dst + 8 * j) = (u32x4){pk2(f[0], f[1]), pk2(f[2], f[3]), pk2(f[4], f[5]), pk2(f[6], f[7])};
    const float y10 = a0 * r * wn[64 + 2 * j], y11 = a1 * r * wn[65 + 2 * j], y20 = b0 * r * wn[80 + 2 * j], y21 = b1 * r * wn[81 + 2 * j];
    *(unsigned*)(dst + 64 + 2 * j) = pk2(y10 * csA.x - y20 * csA.y, y11 * csB.x - y21 * csB.y);
    *(unsigned*)(dst + 80 + 2 * j) = pk2(y20 * csA.x + y10 * csA.y, y21 * csB.x + y11 * csB.y);
}

DI void phase_post_even(const Params& p) {
    char* ws = p.ws;
    bfu* ubuf = (bfu*)(ws + OFF_UBUF); const bfu* qraw = (const bfu*)(ws + OFF_HBUF); const bfu* kvraw = (const bfu*)(ws + OFF_OBUF);
    bfu* Qa = (bfu*)p.out; bfu* Ka = Qa + (size_t)T * 768; bfu* Va = Ka + (size_t)T * 768;
    const float2* r64 = (const float2*)(ws + OFF_ROPE64); const float2* r32 = (const float2*)(ws + OFF_ROPE32);
    const int lane = threadIdx.x & 63, gw = blockIdx.x * 4 + (threadIdx.x >> 6), nwv = gridDim.x * 4;
    const int h = lane >> 3, j = lane & 7;
    for (int t = gw; t < T; t += nwv) {
        bfu* ur = ubuf + (size_t)t * 3072;
        float ssq = sq4(*(const u32x2*)(ur + lane * 4));
        if (lane < 32) ssq += sq4(*(const u32x2*)(ur + 256 + lane * 4));
        float sskv = sq4(*(const u32x2*)(ur + 384 + lane * 4));
        ssq = wave_sum(ssq); sskv = wave_sum(sskv);
        const float rq = rsqrtf(ssq * (1.f / 384.f) + EPS), rkv = rsqrtf(sskv * (1.f / 256.f) + EPS);
        const float2 csA = r32[(size_t)t * 16 + 2 * j], csB = r32[(size_t)t * 16 + 2 * j + 1];
        {
            const bfu* qr = qraw + (size_t)t * 768 + h * 96;
            mla_head(*(const u32x4*)(qr + 8 * j), *(const unsigned*)(qr + 64 + 2 * j), *(const unsigned*)(qr + 80 + 2 * j), rq, rq, p.mla_qn, j, csA, csB, SC_MLA, Qa + (size_t)t * 768 + h * 96);
        }
        {
            const bfu* kr = kvraw + (size_t)t * 1024 + h * 128;
            mla_head(*(const u32x4*)(kr + 8 * j), *(const unsigned*)(ur + 640 + 2 * j), *(const unsigned*)(ur + 656 + 2 * j), rkv, 1.f, p.mla_kn, j, csA, csB, 1.f, Ka + (size_t)t * 768 + h * 96);
            const u32x4 vv = *(const u32x4*)(kr + 64 + 8 * j);
            *(u32x4*)(Va + (size_t)t * 512 + h * 64 + 8 * j) = (u32x4){pk2(bflo(vv[0]) * rkv, bfhi(vv[0]) * rkv), pk2(bflo(vv[1]) * rkv, bfhi(vv[1]) * rkv),
                                                                      pk2(bflo(vv[2]) * rkv, bfhi(vv[2]) * rkv), pk2(bflo(vv[3]) * rkv, bfhi(vv[3]) * rkv)};
        }
        f32x4 d1, d2;
#pragma unroll
        for (int rd = 0; rd < 3; ++rd) {
            const int hh = rd * 8 + h, which = hh / 12, gh = hh % 12;
            headnorm64(ur + 672 + which * 768 + gh * 64, which ? p.dil_kn : p.dil_qn, r64 + (size_t)t * 32, which ? 1.f : SC_64, j, false, d1, d2);
        }
    }
}

DI void phase_post_odd(const Params& p, char* smem) {
    char* ws = p.ws;
    bfu* ubuf = (bfu*)(ws + OFF_UBUF); const float2* r64 = (const float2*)(ws + OFF_ROPE64); float* kpart = (float*)(ws + OFF_KPART);
    const int tid = threadIdx.x, lane = tid & 63, wid = tid >> 6, h = lane >> 3, j = lane & 7;
    float* red = (float*)smem;
    for (int it = blockIdx.x; it < T / 64; it += gridDim.x) {
        f32x4 ka1 = {0.f, 0.f, 0.f, 0.f}, ka2 = {0.f, 0.f, 0.f, 0.f}, d1, d2;
        for (int tt = 0; tt < 16; ++tt) {
            const int t = it * 64 + wid * 16 + tt;
            bfu* ur = ubuf + (size_t)t * 3072; const float2* cs = r64 + (size_t)t * 32;
            headnorm64(ur + h * 64, p.diff_qn, cs, SC_64, j, false, d1, d2);
            headnorm64(ur + 512 + h * 64, p.diff_kn, cs, 1.f, j, false, d1, d2);
            headnorm64(ur + 1536 + h * 64, p.moba_qn, cs, SC_64, j, false, d1, d2);
            headnorm64(ur + 2048 + h * 64, p.moba_kn, cs, 1.f, j, true, ka1, ka2);
        }
        __syncthreads();
#pragma unroll
        for (int e = 0; e < 4; ++e) { red[(wid * 64 + lane) * 8 + e] = ka1[e]; red[(wid * 64 + lane) * 8 + 4 + e] = ka2[e]; }
        __syncthreads();
        for (int o = tid; o < 512; o += 256) {
            const int hh = o >> 6, d = o & 63, jj = (d & 31) >> 2, e = (d & 3) + ((d >> 5) << 2), ln = hh * 8 + jj;
            kpart[(size_t)it * 512 + o] = red[(0 * 64 + ln) * 8 + e] + red[(1 * 64 + ln) * 8 + e] + red[(2 * 64 + ln) * 8 + e] + red[(3 * 64 + ln) * 8 + e];
        }
    }
    __syncthreads();
}

DI void phase_dil_merge(const Params& p) {
    const bfu* dil_o = (const bfu*)(p.ws + OFF_HBUF); const float* dil_lse = (const float*)(p.ws + OFF_HBUF + 48 * MiB);
    bfu* obuf = (bfu*)(p.ws + OFF_OBUF);
    for (int idx = blockIdx.x * 256 + threadIdx.x; idx < T * 64; idx += gridDim.x * 256) {
        const int t = idx >> 6, r = idx & 63, h = r >> 4, jj = r & 15;
        const float l0 = dil_lse[(size_t)t * 12 + h], l1 = dil_lse[(size_t)t * 12 + 4 + h], l2 = dil_lse[(size_t)t * 12 + 8 + h];
        const float mx = fmaxf(l0, fmaxf(l1, l2));
        float w0 = exp2f(l0 - mx), w1 = exp2f(l1 - mx), w2 = exp2f(l2 - mx); const float inv = 1.f / (w0 + w1 + w2); w0 *= inv; w1 *= inv; w2 *= inv;
        const u32x2 a = *(const u32x2*)(dil_o + (size_t)t * 768 + h * 64 + 4 * jj), b = *(const u32x2*)(dil_o + (size_t)t * 768 + (4 + h) * 64 + 4 * jj),
                    c = *(const u32x2*)(dil_o + (size_t)t * 768 + (8 + h) * 64 + 4 * jj);
        const float o0 = w0 * bflo(a[0]) + w1 * bflo(b[0]) + w2 * bflo(c[0]), o1 = w0 * bfhi(a[0]) + w1 * bfhi(b[0]) + w2 * bfhi(c[0]);
        const float o2 = w0 * bflo(a[1]) + w1 * bflo(b[1]) + w2 * bflo(c[1]), o3 = w0 * bfhi(a[1]) + w1 * bfhi(b[1]) + w2 * bfhi(c[1]);
        *(u32x2*)(obuf + (size_t)t * 768 + 512 + h * 64 + 4 * jj) = (u32x2){pk2(o0, o1), pk2(o2, o3)};
    }
}

DI void phase_diff_combine(const Params& p) {
    const bfu* dbuf = (const bfu*)(p.ws + OFF_DBUF); bfu* obuf = (bfu*)(p.ws + OFF_OBUF);
    const int lane = threadIdx.x & 63, gw = blockIdx.x * 4 + (threadIdx.x >> 6), nwv = gridDim.x * 4;
    float lam;
    {
        const float sa = wave_sum(p.diff_lam[lane] * p.diff_lam[64 + lane]), sb = wave_sum(p.diff_lam[128 + lane] * p.diff_lam[192 + lane]);
        lam = expf(sa) - expf(sb) + LAM_INIT;
    }
    const int h = lane >> 4, jj = lane & 15;
    const float4 sA = *(const float4*)(p.diff_subln + 8 * jj), sB = *(const float4*)(p.diff_subln + 8 * jj + 4);
    const float sw[8] = {sA.x, sA.y, sA.z, sA.w, sB.x, sB.y, sB.z, sB.w};
    for (int t = gw; t < T; t += nwv) {
        const u32x4 a = *(const u32x4*)(dbuf + (size_t)t * 1024 + (2 * h) * 128 + 8 * jj), b = *(const u32x4*)(dbuf + (size_t)t * 1024 + (2 * h + 1) * 128 + 8 * jj);
        float d[8];
#pragma unroll
        for (int e = 0; e < 4; ++e) { d[2 * e] = bflo(a[e]) - lam * bflo(b[e]); d[2 * e + 1] = bfhi(a[e]) - lam * bfhi(b[e]); }
        float ss = 0.f;
#pragma unroll
        for (int e = 0; e < 8; ++e) ss += d[e] * d[e];
        ss += __shfl_xor(ss, 1); ss += __shfl_xor(ss, 2); ss += __shfl_xor(ss, 4); ss += __shfl_xor(ss, 8);
        const float r = rsqrtf(ss * (1.f / 128.f) + EPS) * (1.f - LAM_INIT);
#pragma unroll
        for (int e = 0; e < 8; ++e) d[e] *= r * sw[e];
        *(u32x4*)(obuf + (size_t)t * 1024 + h * 128 + 8 * jj) = (u32x4){pk2(d[0], d[1]), pk2(d[2], d[3]), pk2(d[4], d[5]), pk2(d[6], d[7])};
    }
}

struct Top3 { float v0, v1, v2; int i0, i1, i2; };
DI Top3 top3_ins(Top3 t, float v, int i) {
    const bool g0 = (v > t.v0) || (v == t.v0 && i < t.i0), g1 = (v > t.v1) || (v == t.v1 && i < t.i1), g2 = (v > t.v2) || (v == t.v2 && i < t.i2);
    Top3 r;
    r.v2 = g1 ? t.v1 : (g2 ? v : t.v2); r.i2 = g1 ? t.i1 : (g2 ? i : t.i2);
    r.v1 = g0 ? t.v0 : (g1 ? v : t.v1); r.i1 = g0 ? t.i0 : (g1 ? i : t.i1);
    r.v0 = g0 ? v : t.v0; r.i0 = g0 ? i : t.i0;
    return r;
}

template <int DK, int DV, int MODE>
DI void attn_item(const bfu* __restrict__ Qp, int qp, const bfu* __restrict__ Kp, int kp, const bfu* __restrict__ Vp, int vp,
                  long rowbase, int rs, int q0, bfu* __restrict__ Op, int op, float* __restrict__ lsep, int lsest,
                  const float* __restrict__ kpart, char* smem) {
    constexpr int KPT = DK + 8, KCH = DK / 8, VCH = DV / 8, NKL = 64 * KCH / 256, NVL = 64 * VCH / 256, NDV = DV / 32, ND0 = DK / 16;
    bfu* Ks = (bfu*)smem; bfu* Vs = Ks + 64 * KPT;
    short* tlist = (short*)(Vs + 64 * DV);
    int* misc = (int*)(tlist + 192);
    float* km = (float*)(misc + 4);
    unsigned* selm = (unsigned*)(km + 2048);
    float* cand = (float*)(selm + 128);
    const int tid = threadIdx.x, lane = tid & 63, wid = tid >> 6, l32 = lane & 31, hi = lane >> 5;
    const int qstep = q0 + wid * 32 + l32;
    unsigned mysel = 0;
    if (MODE == 2) {
        const int nb = q0 >> 8;
        for (int idx = tid; idx < nb * 64; idx += 256) {
            const int blk = idx >> 6, d = idx & 63; const float* kq = kpart + (size_t)(blk * 4) * 512 + d;
            km[idx] = (kq[0] + kq[512] + kq[1024] + kq[1536]) * (1.f / 256.f);
        }
        if (tid == 0) misc[1] = 0;
        __syncthreads();
        {
            const int qq = tid & 127, hf = tid >> 7;
            const bfu* qr = Qp + (size_t)(rowbase + q0 + qq) * qp;
            float qv[64];
#pragma unroll
            for (int c8 = 0; c8 < 8; ++c8) {
                const u32x4 w = *(const u32x4*)(qr + c8 * 8);
#pragma unroll
                for (int e = 0; e < 4; ++e) { qv[c8 * 8 + 2 * e] = bflo(w[e]); qv[c8 * 8 + 2 * e + 1] = bfhi(w[e]); }
            }
            Top3 tp; tp.v0 = -3e38f; tp.v1 = -3e38f; tp.v2 = -3e38f; tp.i0 = 64; tp.i1 = 64; tp.i2 = 64;
            for (int blk = hf; blk < nb; blk += 2) {
                float g = 0.f;
#pragma unroll
                for (int d = 0; d < 64; ++d) g += qv[d] * km[blk * 64 + d];
                tp = top3_ins(tp, g, blk);
            }
            cand[tid * 6 + 0] = tp.v0; cand[tid * 6 + 1] = tp.v1; cand[tid * 6 + 2] = tp.v2;
            cand[tid * 6 + 3] = __int_as_float(tp.i0); cand[tid * 6 + 4] = __int_as_float(tp.i1); cand[tid * 6 + 5] = __int_as_float(tp.i2);
        }
        __syncthreads();
        if (tid < 128) {
            Top3 tp; tp.v0 = cand[tid * 6]; tp.v1 = cand[tid * 6 + 1]; tp.v2 = cand[tid * 6 + 2];
            tp.i0 = __float_as_int(cand[tid * 6 + 3]); tp.i1 = __float_as_int(cand[tid * 6 + 4]); tp.i2 = __float_as_int(cand[tid * 6 + 5]);
            const int o = (tid + 128) * 6;
#pragma unroll
            for (int e = 0; e < 3; ++e) { const int ii = __float_as_int(cand[o + 3 + e]); tp = top3_ins(tp, cand[o + e], ii); }
            unsigned mk = 0;
            if (tp.i0 < 32) mk |= 1u << tp.i0;
            if (tp.i1 < 32) mk |= 1u << tp.i1;
            if (tp.i2 < 32) mk |= 1u << tp.i2;
            selm[tid] = mk;
            atomicOr((unsigned*)&misc[1], mk);
        }
        __syncthreads();
        mysel = selm[wid * 32 + l32];
    }
    if (MODE == 0) { const int last = (q0 >> 6) + 1; for (int jx = tid; jx <= last; jx += 256) tlist[jx] = (short)jx; if (tid == 0) misc[0] = last + 1; }
    if (MODE == 1) { const int last = (q0 >> 6) + 1, first = (q0 >> 6) >= 2 ? (q0 >> 6) - 2 : 0; if (tid == 0) { int n = 0; for (int jx = first; jx <= last; ++jx) tlist[n++] = (short)jx; misc[0] = n; } }
    if (MODE == 2) {
        if (tid == 0) {
            const unsigned om = (unsigned)misc[1]; const int nb = q0 >> 8; int n = 0;
            for (int blk = 0; blk < nb; ++blk) if ((om >> blk) & 1u) { tlist[n++] = (short)(blk * 4); tlist[n++] = (short)(blk * 4 + 1); tlist[n++] = (short)(blk * 4 + 2); tlist[n++] = (short)(blk * 4 + 3); }
            for (int jx = nb * 4; jx <= (q0 >> 6) + 1; ++jx) tlist[n++] = (short)jx;
            misc[0] = n;
        }
    }
    __syncthreads();
    const int nt = misc[0];
    bf16x8 qf[ND0];
    {
        const bfu* qr = Qp + (size_t)(rowbase + (long)qstep * rs) * qp + hi * 8;
#pragma unroll
        for (int d0 = 0; d0 < ND0; ++d0) qf[d0] = *(const bf16x8*)(qr + d0 * 16);
    }
    float m = -1e30f, l = 0.f;
    f32x16 o[NDV];
#pragma unroll
    for (int dvb = 0; dvb < NDV; ++dvb)
#pragma unroll
        for (int r = 0; r < 16; ++r) o[dvb][r] = 0.f;
    int krow[NKL], kch[NKL], vrow[NVL], vch[NVL];
#pragma unroll
    for (int i = 0; i < NKL; ++i) { const int id = tid + 256 * i; krow[i] = id / KCH; kch[i] = id % KCH; }
#pragma unroll
    for (int i = 0; i < NVL; ++i) { const int id = tid + 256 * i; vrow[i] = id / VCH; vch[i] = id % VCH; }
    u32x4 rk[NKL], rv[NVL];
    int jn = tlist[0];
#pragma unroll
    for (int i = 0; i < NKL; ++i) rk[i] = *(const u32x4*)(Kp + (size_t)(rowbase + (long)(jn * 64 + krow[i]) * rs) * kp + kch[i] * 8);
#pragma unroll
    for (int i = 0; i < NVL; ++i) rv[i] = *(const u32x4*)(Vp + (size_t)(rowbase + (long)(jn * 64 + vrow[i]) * rs) * vp + vch[i] * 8);
    const lds_cptr vb = (lds_cptr)Vs + ((lane >> 4) & 1) * 32 + (lane & 3) * 8 + (4 * hi + ((lane & 15) >> 2)) * 64;
    const bfu* ksr = Ks + l32 * KPT + hi * 8;
    for (int it = 0; it < nt; ++it) {
        __syncthreads();
#pragma unroll
        for (int i = 0; i < NKL; ++i) *(u32x4*)(Ks + krow[i] * KPT + kch[i] * 8) = rk[i];
#pragma unroll
        for (int i = 0; i < NVL; ++i) *(u32x4*)(Vs + (vch[i] >> 2) * 2048 + vrow[i] * 32 + (vch[i] & 3) * 8) = rv[i];
        __syncthreads();
        const int jc = jn;
        if (it + 1 < nt) {
            jn = tlist[it + 1];
#pragma unroll
            for (int i = 0; i < NKL; ++i) rk[i] = *(const u32x4*)(Kp + (size_t)(rowbase + (long)(jn * 64 + krow[i]) * rs) * kp + kch[i] * 8);
#pragma unroll
            for (int i = 0; i < NVL; ++i) rv[i] = *(const u32x4*)(Vp + (size_t)(rowbase + (long)(jn * 64 + vrow[i]) * rs) * vp + vch[i] * 8);
        }
        f32x16 s0, s1;
#pragma unroll
        for (int r = 0; r < 16; ++r) { s0[r] = 0.f; s1[r] = 0.f; }
#pragma unroll
        for (int d0 = 0; d0 < ND0; ++d0) {
            const bf16x8 k0 = *(const bf16x8*)(ksr + d0 * 16), k1 = *(const bf16x8*)(ksr + 32 * KPT + d0 * 16);
            s0 = MFMA(k0, qf[d0], s0); s1 = MFMA(k1, qf[d0], s1);
        }
        const int kbase = jc * 64 + 4 * hi;
        if (MODE == 1) {
#pragma unroll
            for (int r = 0; r < 16; ++r) {
                const int dd = qstep - (kbase + (r & 3) + 8 * (r >> 2));
                if (dd < 0 || dd > 128) s0[r] = -INFINITY;
                if (dd - 32 < 0 || dd - 32 > 128) s1[r] = -INFINITY;
            }
        } else {
            if (jc * 64 + 63 > q0) {
#pragma unroll
                for (int r = 0; r < 16; ++r) {
                    const int ks = kbase + (r & 3) + 8 * (r >> 2);
                    if (ks > qstep) s0[r] = -INFINITY;
                    if (ks + 32 > qstep) s1[r] = -INFINITY;
                }
            }
            if (MODE == 2) {
                const int blk = jc >> 2;
                if (blk < (q0 >> 8) && !((mysel >> blk) & 1u)) {
#pragma unroll
                    for (int r = 0; r < 16; ++r) { s0[r] = -INFINITY; s1[r] = -INFINITY; }
                }
            }
        }
        float mx = fmaxf(s0[0], s1[0]);
#pragma unroll
        for (int r = 1; r < 16; ++r) mx = fmaxf(mx, fmaxf(s0[r], s1[r]));
        mx = fmaxf(mx, __shfl_xor(mx, 32));
        const float mnew = fmaxf(m, mx);
        const float alpha = __builtin_amdgcn_exp2f(m - mnew);
        m = mnew;
        float ps = 0.f;
#pragma unroll
        for (int r = 0; r < 16; ++r) { s0[r] = __builtin_amdgcn_exp2f(s0[r] - mnew); s1[r] = __builtin_amdgcn_exp2f(s1[r] - mnew); ps += s0[r] + s1[r]; }
        l = l * alpha + ps;
#pragma unroll
        for (int dvb = 0; dvb < NDV; ++dvb)
#pragma unroll
            for (int r = 0; r < 16; ++r) o[dvb][r] *= alpha;
        bf16x8 pf[4];
        pf[0] = __builtin_bit_cast(bf16x8, (u32x4){pk2(s0[0], s0[1]), pk2(s0[2], s0[3]), pk2(s0[4], s0[5]), pk2(s0[6], s0[7])});
        pf[1] = __builtin_bit_cast(bf16x8, (u32x4){pk2(s0[8], s0[9]), pk2(s0[10], s0[11]), pk2(s0[12], s0[13]), pk2(s0[14], s0[15])});
        pf[2] = __builtin_bit_cast(bf16x8, (u32x4){pk2(s1[0], s1[1]), pk2(s1[2], s1[3]), pk2(s1[4], s1[5]), pk2(s1[6], s1[7])});
        pf[3] = __builtin_bit_cast(bf16x8, (u32x4){pk2(s1[8], s1[9]), pk2(s1[10], s1[11]), pk2(s1[12], s1[13]), pk2(s1[14], s1[15])});
#pragma unroll
        for (int s = 0; s < 4; ++s)
#pragma unroll
            for (int dvb = 0; dvb < NDV; ++dvb) {
                const s16x4 lo = vtr(vb + dvb * 4096 + s * 1024), hh = vtr(vb + dvb * 4096 + s * 1024 + 512);
                const bf16x8 vf = (bf16x8){lo[0], lo[1], lo[2], lo[3], hh[0], hh[1], hh[2], hh[3]};
                o[dvb] = MFMA(vf, pf[s], o[dvb]);
            }
    }
    l += __shfl_xor(l, 32);
    const float inv = 1.f / l;
    const size_t tok = (size_t)(rowbase + (long)qstep * rs);
#pragma unroll
    for (int dvb = 0; dvb < NDV; ++dvb)
#pragma unroll
        for (int i = 0; i < 4; ++i) {
            const int dv = dvb * 32 + 8 * i + 4 * hi;
            *(u32x2*)(Op + tok * op + dv) = (u32x2){pk2(o[dvb][4 * i] * inv, o[dvb][4 * i + 1] * inv), pk2(o[dvb][4 * i + 2] * inv, o[dvb][4 * i + 3] * inv)};
        }
    if (MODE == 1) { if (hi == 0) lsep[tok * lsest] = m + __builtin_amdgcn_logf(l); }
}

DI void phase_attn_even(const Params& p, char* smem, int* s_item) {
    char* ws = p.ws;
    const bfu* ubuf = (const bfu*)(ws + OFF_UBUF);
    const bfu* Qa = (const bfu*)p.out; const bfu* Ka = Qa + (size_t)T * 768; const bfu* Va = Ka + (size_t)T * 768;
    bfu* obuf = (bfu*)(ws + OFF_OBUF); bfu* dil_o = (bfu*)(ws + OFF_HBUF); float* dil_lse = (float*)(ws + OFF_HBUF + 48 * MiB);
    int* ctr = (int*)(ws + OFF_CTR);
    const int total = 2048 + 3072;
    while (true) {
        __syncthreads();
        if (threadIdx.x == 0) *s_item = atomicAdd(ctr, 1);
        __syncthreads();
        const int i = *s_item;
        if (i >= total) break;
        if (i < 2048) {
            const int qt = 63 - (i >> 5), bh = i & 31, b = bh >> 3, h = bh & 7;
            attn_item<96, 64, 0>(Qa + h * 96, 768, Ka + h * 96, 768, Va + h * 64, 512, (long)b * SEQ, 1, qt * 128, obuf + h * 64, 768, nullptr, 0, nullptr, smem);
        } else {
            const int i2 = i - 2048, g = i2 >> 10, r2 = i2 & 1023, h = r2 & 3, b = (r2 >> 2) & 3, qi = r2 >> 4;
            const int rr = (g == 0) ? 1 : (g == 1 ? 4 : 16), tpc = 64 / rr, cls = qi / tpc, st = qi % tpc;
            const int gh = g * 4 + h;
            attn_item<64, 64, 1>(ubuf + 672 + gh * 64, 3072, ubuf + 672 + 768 + gh * 64, 3072, ubuf + 672 + 1536 + gh * 64, 3072, (long)b * SEQ + cls, rr, st * 128,
                                 dil_o + gh * 64, 768, dil_lse + gh, 12, nullptr, smem);
        }
    }
}
DI void phase_attn_odd(const Params& p, char* smem, int* s_item) {
    char* ws = p.ws;
    const bfu* ubuf = (const bfu*)(ws + OFF_UBUF);
    bfu* obuf = (bfu*)(ws + OFF_OBUF); bfu* dbuf = (bfu*)(ws + OFF_DBUF); const float* kpart = (const float*)(ws + OFF_KPART);
    int* ctr = (int*)(ws + OFF_CTR) + 1;
    const int total = 4096;
    while (true) {
        __syncthreads();
        if (threadIdx.x == 0) *s_item = atomicAdd(ctr, 1);
        __syncthreads();
        const int i = *s_item;
        if (i >= total) break;
        const int qt = 63 - (i >> 6), kind = (i >> 5) & 1, bh = i & 31, b = bh >> 3, hh = bh & 7;
        if (kind == 0) {
            attn_item<64, 128, 0>(ubuf + hh * 64, 3072, ubuf + 512 + hh * 64, 3072, ubuf + 1024 + (hh >> 1) * 128, 3072, (long)b * SEQ, 1, qt * 128,
                                  dbuf + hh * 128, 1024, nullptr, 0, nullptr, smem);
        } else {
            attn_item<64, 64, 2>(ubuf + 1536 + hh * 64, 3072, ubuf + 2048 + hh * 64, 3072, ubuf + 2560 + hh * 64, 3072, (long)b * SEQ, 1, qt * 128,
                                 obuf + 512 + hh * 64, 1024, nullptr, 0, kpart + (size_t)b * (32 * 4 * 512) + hh * 64, smem);
        }
    }
}

#define PHASE_BEGIN(k) if (p.phase_lo <= (k) && (k) < p.phase_hi) {
#define PHASE_END(k) if (p.coop && (k) + 1 < p.phase_hi) cg::this_grid().sync(); }
__global__ void __launch_bounds__(256, 2) mega(Params p) {
    __shared__ __attribute__((aligned(16))) char smem[55296];
    __shared__ int s_item;
    char* ws = p.ws;
    bfu* hbuf = (bfu*)(ws + OFF_HBUF); bfu* obuf = (bfu*)(ws + OFF_OBUF); bfu* ubuf = (bfu*)(ws + OFF_UBUF); bfu* hid = ubuf;
    const float* mod0 = (const float*)(ws + OFF_MOD); const float* mod1 = mod0 + 4 * 6144;
    PHASE_BEGIN(0) phase_prep(p, smem); PHASE_END(0)
    PHASE_BEGIN(1) phase_modfin(p); PHASE_END(1)
    PHASE_BEGIN(2) phase_normmod(p.x, p.norm_mix, mod0, 0, hbuf); PHASE_END(2)
    PHASE_BEGIN(3) phase_gemm<0>(hbuf, 1024, (const bfu*)(ws + OFF_WIN0), 1024, 2976, 12, ubuf, 3072, nullptr, nullptr, nullptr, smem); PHASE_END(3)
    PHASE_BEGIN(4)
            for (int tile = blockIdx.x; tile < 256 * 7; tile += gridDim.x) {
                const int mt = tile / 7, nt = tile % 7;
                if (nt < 3) gemm_tile<0>(ubuf, 3072, (const bfu*)(ws + OFF_WUQ), 384, mt * 128, nt * 256, 768, hbuf, 768, nullptr, nullptr, nullptr, smem);
                else gemm_tile<0>(ubuf + 384, 3072, (const bfu*)(ws + OFF_WUKV), 256, mt * 128, (nt - 3) * 256, 1024, obuf, 1024, nullptr, nullptr, nullptr, smem);
            }
    PHASE_END(4)
    PHASE_BEGIN(5) phase_post_even(p); PHASE_END(5)
    PHASE_BEGIN(6) phase_attn_even(p, smem, &s_item); PHASE_END(6)
    PHASE_BEGIN(7) phase_dil_merge(p); PHASE_END(7)
    PHASE_BEGIN(8) phase_gemm<2>(obuf, 768, (const bfu*)(ws + OFF_WOUT0), 768, 1024, 4, nullptr, 0, p.x, p.out, mod0 + 2048, smem); PHASE_END(8)
    PHASE_BEGIN(9) phase_normmod(p.out, p.norm_mlp, mod0, 3072, hbuf); PHASE_END(9)
    PHASE_BEGIN(10) phase_gemm<1>(hbuf, 1024, (const bfu*)(ws + OFF_W1_0), 1024, 4096, 16, hid, 4096, nullptr, nullptr, nullptr, smem); PHASE_END(10)
    PHASE_BEGIN(11) phase_gemm<2>(hid, 4096, (const bfu*)(ws + OFF_W2_0), 4096, 1024, 4, nullptr, 0, p.out, p.out, mod0 + 5120, smem); PHASE_END(11)
    PHASE_BEGIN(12) phase_normmod(p.out, p.norm_mix + 1024, mod1, 0, hbuf); PHASE_END(12)
    PHASE_BEGIN(13) phase_gemm<0>(hbuf, 1024, (const bfu*)(ws + OFF_WIN1), 1024, 3072, 12, ubuf, 3072, nullptr, nullptr, nullptr, smem); PHASE_END(13)
    PHASE_BEGIN(14) phase_post_odd(p, smem); PHASE_END(14)
    PHASE_BEGIN(15) phase_attn_odd(p, smem, &s_item); PHASE_END(15)
    PHASE_BEGIN(16) phase_diff_combine(p); PHASE_END(16)
    PHASE_BEGIN(17) phase_gemm<2>(obuf, 1024, (const bfu*)(ws + OFF_WOUT1), 1024, 1024, 4, nullptr, 0, p.out, p.out, mod1 + 2048, smem); PHASE_END(17)
    PHASE_BEGIN(18) phase_normmod(p.out, p.norm_mlp + 1024, mod1, 3072, hbuf); PHASE_END(18)
    PHASE_BEGIN(19) phase_gemm<1>(hbuf, 1024, (const bfu*)(ws + OFF_W1_1), 1024, 4096, 16, hid, 4096, nullptr, nullptr, nullptr, smem); PHASE_END(19)
    PHASE_BEGIN(20) phase_gemm<2>(hid, 4096, (const bfu*)(ws + OFF_W2_1), 4096, 1024, 4, nullptr, 0, p.out, p.out, mod1 + 5120, smem); PHASE_END(20)
}

extern "C" void kernel_launch(void* const* d_in, const int* in_sizes, int n_in, void* d_out, int out_size, void* d_ws, size_t ws_size, hipStream_t stream) {
    static int grid_blocks = 0;
    if (!grid_blocks) {
        int dev = 0, cus = 0, per_cu = 0;
        hipGetDevice(&dev);
        hipDeviceGetAttribute(&cus, hipDeviceAttributeMultiprocessorCount, dev);
        hipOccupancyMaxActiveBlocksPerMultiprocessor(&per_cu, mega, 256, 0);
        if (per_cu < 1) per_cu = 1;
        if (per_cu > 2) per_cu = 2;
        grid_blocks = cus * per_cu;
    }
    if (ws_size < WS_END) fprintf(stderr, "workspace too small: %zu < %zu\n", ws_size, (size_t)WS_END);
    Params p{};
    p.x = (const float*)d_in[0]; p.c = (const float*)d_in[1]; p.pos = (const int*)d_in[2];
    p.ada_w = (const float*)d_in[3]; p.ada_b = (const float*)d_in[4]; p.norm_mix = (const float*)d_in[5]; p.norm_mlp = (const float*)d_in[6];
    p.w1 = (const float*)d_in[7]; p.w2 = (const float*)d_in[8]; p.e_win = (const float*)d_in[9]; p.e_wout = (const float*)d_in[10];
    p.qlat = (const float*)d_in[11]; p.kvlat = (const float*)d_in[12]; p.wuq = (const float*)d_in[13]; p.wukv = (const float*)d_in[14];
    p.mla_qn = (const float*)d_in[15]; p.mla_kn = (const float*)d_in[16]; p.dil_qn = (const float*)d_in[17]; p.dil_kn = (const float*)d_in[18];
    p.o_win = (const float*)d_in[19]; p.o_wout = (const float*)d_in[20]; p.diff_qn = (const float*)d_in[21]; p.diff_kn = (const float*)d_in[22];
    p.diff_lam = (const float*)d_in[23]; p.diff_subln = (const float*)d_in[24]; p.moba_qn = (const float*)d_in[25]; p.moba_kn = (const float*)d_in[26];
    p.out = (float*)d_out; p.ws = (char*)d_ws;
    for (int i = 0; i < 32; ++i) p.invf64[i] = (float)pow(10000.0, -(double)i / 32.0);
    for (int i = 0; i < 16; ++i) p.invf32[i] = (float)pow(10000.0, -(double)i / 16.0);
#if MK_COOP
    p.phase_lo = 0; p.phase_hi = NPH; p.coop = 1;
    void* args[] = {&p};
    hipError_t e = hipLaunchCooperativeKernel((void*)mega, dim3(grid_blocks), dim3(256), args, 0, stream);
    if (e != hipSuccess) fprintf(stderr, "cooperative launch failed: %s (grid %d)\n", hipGetErrorString(e), grid_blocks);
#else
    for (int ph = 0; ph < NPH; ++ph) {
        p.phase_lo = ph; p.phase_hi = ph + 1; p.coop = 0;
        hipLaunchKernelGGL(mega, dim3(grid_blocks), dim3(256), 0, stream, p);
    }
#endif
}
```

```cpp
#include <hip/hip_runtime.h>
#include <hip/hip_cooperative_groups.h>
#include <stdint.h>
#include <cstdio>
#include <cmath>
namespace cg = cooperative_groups;

#ifndef MK_COOP
#define MK_COOP 1
#endif

typedef unsigned short bfu;
typedef __attribute__((ext_vector_type(8))) short bf16x8;
typedef __attribute__((ext_vector_type(4))) short s16x4;
typedef short v4i16_t __attribute__((ext_vector_type(4)));
typedef __attribute__((ext_vector_type(16))) float f32x16;
typedef __attribute__((ext_vector_type(4))) float f32x4;
typedef __attribute__((ext_vector_type(2))) float f32x2;
typedef __attribute__((ext_vector_type(4))) unsigned u32x4;
typedef __attribute__((ext_vector_type(2))) unsigned u32x2;
typedef __attribute__((ext_vector_type(2))) __bf16 bf2_t;
typedef __attribute__((address_space(3))) const char* lds_cptr;

#define DI __device__ __forceinline__
#define MFMA(a, b, c) __builtin_amdgcn_mfma_f32_32x32x16_bf16((a), (b), (c), 0, 0, 0)

constexpr int T = 32768, SEQ = 8192;
constexpr float EPS = 1e-6f;
constexpr float LOG2E = 1.4426950408889634f;
constexpr float SC_MLA = 0.10206207261596577f * LOG2E;
constexpr float SC_64 = 0.125f * LOG2E;
constexpr float LAM_INIT = 0.35550906759096926f;
constexpr int NPH = 21;
constexpr int NT = 512, NW = 8;
constexpr int DYN_LDS = 2 * 512 * 72 * 2;

constexpr size_t MiB = 1048576;
constexpr size_t OFF_WIN0 = 0, OFF_WIN1 = 6 * MiB, OFF_W1_0 = 12 * MiB, OFF_W1_1 = 20 * MiB, OFF_W2_0 = 28 * MiB, OFF_W2_1 = 36 * MiB,
                 OFF_WOUT0 = 44 * MiB, OFF_WOUT1 = 46 * MiB, OFF_WUQ = 48 * MiB, OFF_WUKV = 49 * MiB, OFF_MODP = 50 * MiB, OFF_MOD = 52 * MiB,
                 OFF_ROPE64 = 53 * MiB, OFF_ROPE32 = 61 * MiB, OFF_KPART = 65 * MiB, OFF_CTR = 66 * MiB,
                 OFF_HBUF = 72 * MiB, OFF_OBUF = 136 * MiB, OFF_UBUF = 200 * MiB, OFF_DBUF = 392 * MiB, WS_END = 456 * MiB;

struct Params {
    const float *x, *c; const int* pos;
    const float *ada_w, *ada_b, *norm_mix, *norm_mlp, *w1, *w2, *e_win, *e_wout, *qlat, *kvlat, *wuq, *wukv, *mla_qn, *mla_kn, *dil_qn, *dil_kn,
        *o_win, *o_wout, *diff_qn, *diff_kn, *diff_lam, *diff_subln, *moba_qn, *moba_kn;
    float* out; char* ws;
    float invf64[32]; float invf32[16];
    int phase_lo, phase_hi, coop, pad_;
};

DI unsigned pk2(float a, float b) { f32x2 v = {a, b}; bf2_t r = __builtin_convertvector(v, bf2_t); return __builtin_bit_cast(unsigned, r); }
DI float bflo(unsigned u) { return __uint_as_float(u << 16); }
DI float bfhi(unsigned u) { return __uint_as_float(u & 0xffff0000u); }
DI float wave_sum(float v) {
#pragma unroll
    for (int o = 32; o; o >>= 1) v += __shfl_xor(v, o);
    return v; }
DI s16x4 vtr(lds_cptr p) { return __builtin_bit_cast(s16x4, __builtin_amdgcn_ds_read_tr16_b64_v4i16((__attribute__((address_space(3))) v4i16_t*)p)); }

DI void tr_tile(const float* __restrict__ src, int K, int N, bfu* __restrict__ dst, const float* __restrict__ kscale, int it, float* tl) {
    const int nkt = K >> 6; const int kt = it % nkt, nt = it / nkt; const int tid = threadIdx.x;
#pragma unroll
    for (int rr = 0; rr < 2; ++rr) {
        const int kl = rr * 32 + (tid >> 4), k = kt * 64 + kl, nl = (tid & 15) * 4, n = nt * 64 + nl;
        float4 v = make_float4(0.f, 0.f, 0.f, 0.f);
        if (n < N) v = *(const float4*)(src + (size_t)k * N + n);
        if (kscale) { const float sc = kscale[k]; v.x *= sc; v.y *= sc; v.z *= sc; v.w *= sc; }
        tl[kl * 65 + nl] = v.x; tl[kl * 65 + nl + 1] = v.y; tl[kl * 65 + nl + 2] = v.z; tl[kl * 65 + nl + 3] = v.w;
    }
    __syncthreads();
    {
        const int nl = tid >> 3, kc = (tid & 7) * 8;
        unsigned w[4];
#pragma unroll
        for (int i = 0; i < 4; ++i) w[i] = pk2(tl[(kc + 2 * i) * 65 + nl], tl[(kc + 2 * i + 1) * 65 + nl]);
        bfu* d = dst + (size_t)(nt * 64 + nl) * K + kt * 64 + kc;
        *(u32x4*)d = (u32x4){w[0], w[1], w[2], w[3]};
    }
    __syncthreads();
}
DI void tr_matrix(const float* src, int K, int N, int Npad, bfu* dst, const float* kscale, float* tl) {
    const int nit = (K >> 6) * (Npad >> 6);
    for (int it = blockIdx.x; it < nit; it += gridDim.x) tr_tile(src, K, N, dst, kscale, it, tl);
}

DI void phase_prep(const Params& p, char* smem) {
    float* tl = (float*)smem;
    char* ws = p.ws;
    if (blockIdx.x == 0 && threadIdx.x < 4) ((int*)(ws + OFF_CTR))[threadIdx.x] = 0;
    tr_matrix(p.e_win, 1024, 2976, 3072, (bfu*)(ws + OFF_WIN0), nullptr, tl);
    tr_matrix(p.o_win, 1024, 3072, 3072, (bfu*)(ws + OFF_WIN1), nullptr, tl);
    tr_matrix(p.w1, 1024, 4096, 4096, (bfu*)(ws + OFF_W1_0), nullptr, tl);
    tr_matrix(p.w1 + (size_t)1024 * 4096, 1024, 4096, 4096, (bfu*)(ws + OFF_W1_1), nullptr, tl);
    tr_matrix(p.w2, 4096, 1024, 1024, (bfu*)(ws + OFF_W2_0), nullptr, tl);
    tr_matrix(p.w2 + (size_t)1024 * 4096, 4096, 1024, 1024, (bfu*)(ws + OFF_W2_1), nullptr, tl);
    tr_matrix(p.e_wout, 768, 1024, 1024, (bfu*)(ws + OFF_WOUT0), nullptr, tl);
    tr_matrix(p.o_wout, 1024, 1024, 1024, (bfu*)(ws + OFF_WOUT1), nullptr, tl);
    tr_matrix(p.wuq, 384, 768, 768, (bfu*)(ws + OFF_WUQ), p.qlat, tl);
    tr_matrix(p.wukv, 256, 1024, 1024, (bfu*)(ws + OFF_WUKV), p.kvlat, tl);
    {
        float2* r64 = (float2*)(ws + OFF_ROPE64); float2* r32 = (float2*)(ws + OFF_ROPE32);
        for (int idx = blockIdx.x * NT + threadIdx.x; idx < T * 48; idx += gridDim.x * NT) {
            const int t = idx / 48, i = idx % 48;
            const float invf = (i < 32) ? p.invf64[i] : p.invf32[i - 32];
            const float a = (float)p.pos[t] * invf;
            double rev = (double)a * 0.15915494309189535; rev -= floor(rev);
            const double y = (rev > 0.5 ? rev - 1.0 : rev) * 6.283185307179586;
            const double y2 = y * y; double s = 1.0, c = 1.0;
#pragma unroll
            for (int k = 15; k >= 1; --k) { s = 1.0 - s * y2 * (1.0 / (double)((2 * k) * (2 * k + 1))); c = 1.0 - c * y2 * (1.0 / (double)((2 * k - 1) * (2 * k))); }
            s *= y;
            const float2 o = make_float2((float)c, (float)s);
            if (i < 32) r64[(size_t)t * 32 + i] = o; else r32[(size_t)t * 16 + (i - 32)] = o;
        }
    }
    {
        float* sl = (float*)smem; float* modp = (float*)(ws + OFF_MODP);
        for (int it = blockIdx.x; it < 2 * 12 * 8; it += gridDim.x) {
            const int l = it / 96, cc = (it % 96) / 8, kc = it % 8;
            __syncthreads();
            { const int i = threadIdx.x, b = i >> 7, kk = i & 127; const float cv = p.c[b * 1024 + kc * 128 + kk]; sl[i] = cv / (1.f + __expf(-cv)); }
            __syncthreads();
            const int j = cc * 512 + threadIdx.x;
            const float* w = p.ada_w + ((size_t)l * 1024 + kc * 128) * 6144 + j;
            float a0 = 0.f, a1 = 0.f, a2 = 0.f, a3 = 0.f;
#pragma unroll 8
            for (int kk = 0; kk < 128; ++kk) { const float wv = w[(size_t)kk * 6144]; a0 += sl[kk] * wv; a1 += sl[128 + kk] * wv; a2 += sl[256 + kk] * wv; a3 += sl[384 + kk] * wv; }
            float* o = modp + (size_t)((l * 8 + kc) * 4) * 6144 + j;
            o[0] = a0; o[6144] = a1; o[2 * 6144] = a2; o[3 * 6144] = a3;
        }
        __syncthreads();
    }
}

DI void phase_modfin(const Params& p) {
    const float* modp = (const float*)(p.ws + OFF_MODP); float* mod = (float*)(p.ws + OFF_MOD);
    for (int idx = blockIdx.x * NT + threadIdx.x; idx < 2 * 4 * 6144; idx += gridDim.x * NT) {
        const int l = idx / 24576, rem = idx % 24576, j = rem % 6144;
        float s = p.ada_b[l * 6144 + j];
#pragma unroll
        for (int kc = 0; kc < 8; ++kc) s += modp[(size_t)((l * 8 + kc) * 4) * 6144 + rem];
        mod[idx] = s;
    }
}

DI void phase_normmod(const float* xs, const float* __restrict__ nw, const float* __restrict__ mod, int sh_off, bfu* __restrict__ hb) {
    const int lane = threadIdx.x & 63, gw = blockIdx.x * NW + (threadIdx.x >> 6), nwv = gridDim.x * NW;
    for (int t = gw; t < T; t += nwv) {
        const int b = t >> 13; const float* xr = xs + (size_t)t * 1024;
        float4 v[4]; float ss = 0.f;
#pragma unroll
        for (int i = 0; i < 4; ++i) { v[i] = *(const float4*)(xr + (i * 64 + lane) * 4); ss += v[i].x * v[i].x + v[i].y * v[i].y + v[i].z * v[i].z + v[i].w * v[i].w; }
        ss = wave_sum(ss);
        const float rinv = rsqrtf(ss * (1.f / 1024.f) + EPS);
        const float* mb = mod + b * 6144 + sh_off;
#pragma unroll
        for (int i = 0; i < 4; ++i) {
            const int col = (i * 64 + lane) * 4;
            const float4 w = *(const float4*)(nw + col), sh = *(const float4*)(mb + col), sc = *(const float4*)(mb + 1024 + col);
            const float o0 = v[i].x * rinv * w.x * (1.f + sc.x) + sh.x, o1 = v[i].y * rinv * w.y * (1.f + sc.y) + sh.y;
            const float o2 = v[i].z * rinv * w.z * (1.f + sc.z) + sh.z, o3 = v[i].w * rinv * w.w * (1.f + sc.w) + sh.w;
            *(u32x2*)(hb + (size_t)t * 1024 + col) = (u32x2){pk2(o0, o1), pk2(o2, o3)};
        }
    }
}

template <int EPI>
DI void gemm_tile(const bfu* __restrict__ A, int lda, const bfu* __restrict__ Bt, int K, int m0, int n0, int N,
                  bfu* Cb, int ldc, const float* resid, float* outf, const float* __restrict__ gate, char* smem) {
    constexpr int STG = 512 * 72;
    bfu* S0 = (bfu*)smem;
    const int tid = threadIdx.x, lane = tid & 63, wid = tid >> 6, l32 = lane & 31, hi = lane >> 5;
    const int wm = wid & 3, wn = wid >> 2;
    f32x16 acc[4][2];
#pragma unroll
    for (int nb = 0; nb < 4; ++nb)
#pragma unroll
        for (int mb = 0; mb < 2; ++mb)
#pragma unroll
            for (int r = 0; r < 16; ++r) acc[nb][mb][r] = 0.f;
    const bfu* Ag = A + (size_t)(m0 + (tid >> 3)) * lda + (tid & 7) * 8;
    const bfu* Bg = Bt + (size_t)(n0 + (tid >> 3)) * K + (tid & 7) * 8;
    u32x4 ra[4], rb[4];
#pragma unroll
    for (int i = 0; i < 4; ++i) { ra[i] = *(const u32x4*)(Ag + (size_t)(64 * i) * lda); rb[i] = *(const u32x4*)(Bg + (size_t)(64 * i) * K); }
    const int nk = K >> 6;
    const int wofs = (tid >> 3) * 72 + (tid & 7) * 8;
    const int arofs = (wm * 64 + l32) * 72 + hi * 8, brofs = 256 * 72 + (wn * 128 + l32) * 72 + hi * 8;
    __syncthreads();
#pragma unroll
    for (int i = 0; i < 4; ++i) { *(u32x4*)(S0 + wofs + 64 * i * 72) = ra[i]; *(u32x4*)(S0 + 256 * 72 + wofs + 64 * i * 72) = rb[i]; }
    if (nk > 1) {
#pragma unroll
        for (int i = 0; i < 4; ++i) { ra[i] = *(const u32x4*)(Ag + (size_t)(64 * i) * lda + 64); rb[i] = *(const u32x4*)(Bg + (size_t)(64 * i) * K + 64); }
    }
    __syncthreads();
    for (int kt = 0; kt < nk; ++kt) {
        const bfu* Sc = S0 + (kt & 1) * STG; bfu* Sn = S0 + ((kt & 1) ^ 1) * STG;
        if (kt + 1 < nk) {
#pragma unroll
            for (int i = 0; i < 4; ++i) { *(u32x4*)(Sn + wofs + 64 * i * 72) = ra[i]; *(u32x4*)(Sn + 256 * 72 + wofs + 64 * i * 72) = rb[i]; }
        }
        if (kt + 2 < nk) {
            const int ko = (kt + 2) * 64;
#pragma unroll
            for (int i = 0; i < 4; ++i) { ra[i] = *(const u32x4*)(Ag + (size_t)(64 * i) * lda + ko); rb[i] = *(const u32x4*)(Bg + (size_t)(64 * i) * K + ko); }
        }
#pragma unroll
        for (int k16 = 0; k16 < 4; ++k16) {
            bf16x8 af[2], bfr[4];
#pragma unroll
            for (int mb = 0; mb < 2; ++mb) af[mb] = *(const bf16x8*)(Sc + arofs + mb * 32 * 72 + k16 * 16);
#pragma unroll
            for (int nb = 0; nb < 4; ++nb) bfr[nb] = *(const bf16x8*)(Sc + brofs + nb * 32 * 72 + k16 * 16);
#pragma unroll
            for (int nb = 0; nb < 4; ++nb)
#pragma unroll
                for (int mb = 0; mb < 2; ++mb) acc[nb][mb] = MFMA(bfr[nb], af[mb], acc[nb][mb]);
        }
        __syncthreads();
    }
#pragma unroll
    for (int nb = 0; nb < 4; ++nb)
#pragma unroll
        for (int mb = 0; mb < 2; ++mb) {
            const int m = m0 + wm * 64 + mb * 32 + l32;
#pragma unroll
            for (int i = 0; i < 4; ++i) {
                const int n = n0 + wn * 128 + nb * 32 + 8 * i + 4 * hi;
                float v0 = acc[nb][mb][4 * i], v1 = acc[nb][mb][4 * i + 1], v2 = acc[nb][mb][4 * i + 2], v3 = acc[nb][mb][4 * i + 3];
                if (n < N) {
                    if (EPI == 2) {
                        const int b = m >> 13;
                        const float4 g = *(const float4*)(gate + b * 6144 + n);
                        const float4 r = *(const float4*)(resid + (size_t)m * 1024 + n);
                        float4 o; o.x = r.x + g.x * v0; o.y = r.y + g.y * v1; o.z = r.z + g.z * v2; o.w = r.w + g.w * v3;
                        *(float4*)(outf + (size_t)m * 1024 + n) = o;
                    } else {
                        if (EPI == 1) { v0 = fmaxf(v0, 0.f); v1 = fmaxf(v1, 0.f); v2 = fmaxf(v2, 0.f); v3 = fmaxf(v3, 0.f); v0 *= v0; v1 *= v1; v2 *= v2; v3 *= v3; }
                        *(u32x2*)(Cb + (size_t)m * ldc + n) = (u32x2){pk2(v0, v1), pk2(v2, v3)};
                    }
                }
            }
        }
}

template <int EPI>
DI void phase_gemm(const bfu* A, int lda, const bfu* Bt, int K, int N, int ntn, bfu* Cb, int ldc, const float* resid, float* outf, const float* gate, char* smem) {
    const int ntiles = 128 * ntn;
    for (int tile = blockIdx.x; tile < ntiles; tile += gridDim.x) {
        const int mt = tile / ntn, nt = tile % ntn;
        gemm_tile<EPI>(A, lda, Bt, K, mt * 256, nt * 256, N, Cb, ldc, resid, outf, gate, smem);
    }
}

DI void headnorm64(bfu* hp, const float* __restrict__ w, const float2* __restrict__ cs, float scale, int j, bool acc_on, f32x4& ka1, f32x4& ka2) {
    const u32x2 a = *(const u32x2*)(hp + 4 * j), b = *(const u32x2*)(hp + 32 + 4 * j);
    float x1[4] = {bflo(a[0]), bfhi(a[0]), bflo(a[1]), bfhi(a[1])}, x2[4] = {bflo(b[0]), bfhi(b[0]), bflo(b[1]), bfhi(b[1])};
    float ss = 0.f;
#pragma unroll
    for (int e = 0; e < 4; ++e) ss += x1[e] * x1[e] + x2[e] * x2[e];
    ss += __shfl_xor(ss, 1); ss += __shfl_xor(ss, 2); ss += __shfl_xor(ss, 4);
    const float r = rsqrtf(ss * (1.f / 64.f) + EPS);
    const float4 w1 = *(const float4*)(w + 4 * j), w2 = *(const float4*)(w + 32 + 4 * j);
    const float wa[4] = {w1.x, w1.y, w1.z, w1.w}, wb[4] = {w2.x, w2.y, w2.z, w2.w};
    float o1[4], o2[4];
#pragma unroll
    for (int e = 0; e < 4; ++e) {
        const float y1 = x1[e] * r * wa[e], y2 = x2[e] * r * wb[e]; const float2 c = cs[4 * j + e];
        o1[e] = y1 * c.x - y2 * c.y; o2[e] = y2 * c.x + y1 * c.y;
    }
    if (acc_on) {
#pragma unroll
        for (int e = 0; e < 4; ++e) { ka1[e] += o1[e]; ka2[e] += o2[e]; }
    }
    *(u32x2*)(hp + 4 * j) = (u32x2){pk2(o1[0] * scale, o1[1] * scale), pk2(o1[2] * scale, o1[3] * scale)};
    *(u32x2*)(hp + 32 + 4 * j) = (u32x2){pk2(o2[0] * scale, o2[1] * scale), pk2(o2[2] * scale, o2[3] * scale)};
}

DI float sq4(u32x2 a) { const float x0 = bflo(a[0]), x1 = bfhi(a[0]), x2 = bflo(a[1]), x3 = bfhi(a[1]); return x0 * x0 + x1 * x1 + x2 * x2 + x3 * x3; }

DI void mla_head(u32x4 nv, unsigned x1, unsigned x2, float rn, float rr, const float* __restrict__ wn, int j, float2 csA, float2 csB, float scale, bfu* dst) {
    float f[8] = {bflo(nv[0]) * rn, bfhi(nv[0]) * rn, bflo(nv[1]) * rn, bfhi(nv[1]) * rn, bflo(nv[2]) * rn, bfhi(nv[2]) * rn, bflo(nv[3]) * rn, bfhi(nv[3]) * rn};
    const float a0 = bflo(x1) * rr, a1 = bfhi(x1) * rr, b0 = bflo(x2) * rr, b1 = bfhi(x2) * rr;
    float ss = a0 * a0 + a1 * a1 + b0 * b0 + b1 * b1;
#pragma unroll
    for (int e = 0; e < 8; ++e) ss += f[e] * f[e];
    ss += __shfl_xor(ss, 1); ss += __shfl_xor(ss, 2); ss += __shfl_xor(ss, 4);
    const float r = rsqrtf(ss * (1.f / 96.f) + EPS) * scale;
    const float4 wA = *(const float4*)(wn + 8 * j), wB = *(const float4*)(wn + 8 * j + 4);
    const float wv[8] = {wA.x, wA.y, wA.z, wA.w, wB.x, wB.y, wB.z, wB.w};
#pragma unroll
    for (int e = 0; e < 8; ++e) f[e] *= r * wv[e];
    *(u32x4*)(dst + 8 * j) = (u32x4){pk2(f[0], f[1]), pk2(f[2], f[3]), pk2(f[4], f[5]), pk2(f[6], f[7])};
    const float y10 = a0 * r * wn[64 + 2 * j], y11 = a1 * r * wn[65 + 2 * j], y20 = b0 * r * wn[80 + 2 * j], y21 = b1 * r * wn[81 + 2 * j];
    *(unsigned*)(dst + 64 + 2 * j) = pk2(y10 * csA.x - y20 * csA.y, y11 * csB.x - y21 * csB.y);
    *(unsigned*)(dst + 80 + 2 * j) = pk2(y20 * csA.x + y10 * csA.y, y21 * csB.x + y11 * csB.y);
}

DI void phase_post_even(const Params& p) {
    char* ws = p.ws;
    bfu* ubuf = (bfu*)(ws + OFF_UBUF); const bfu* qraw = (const bfu*)(ws + OFF_HBUF); const bfu* kvraw = (const bfu*)(ws + OFF_OBUF);
    bfu* Qa = (bfu*)p.out; bfu* Ka = Qa + (size_t)T * 768; bfu* Va = Ka + (size_t)T * 768;
    const float2* r64 = (const float2*)(ws + OFF_ROPE64); const float2* r32 = (const float2*)(ws + OFF_ROPE32);
    const int lane = threadIdx.x & 63, gw = blockIdx.x * NW + (threadIdx.x >> 6), nwv = gridDim.x * NW;
    const int h = lane >> 3, j = lane & 7;
    for (int t = gw; t < T; t += nwv) {
        bfu* ur = ubuf + (size_t)t * 3072;
        float ssq = sq4(*(const u32x2*)(ur + lane * 4));
        if (lane < 32) ssq += sq4(*(const u32x2*)(ur + 256 + lane * 4));
        float sskv = sq4(*(const u32x2*)(ur + 384 + lane * 4));
        ssq = wave_sum(ssq); sskv = wave_sum(sskv);
        const float rq = rsqrtf(ssq * (1.f / 384.f) + EPS), rkv = rsqrtf(sskv * (1.f / 256.f) + EPS);
        const float2 csA = r32[(size_t)t * 16 + 2 * j], csB = r32[(size_t)t * 16 + 2 * j + 1];
        {
            const bfu* qr = qraw + (size_t)t * 768 + h * 96;
            mla_head(*(const u32x4*)(qr + 8 * j), *(const unsigned*)(qr + 64 + 2 * j), *(const unsigned*)(qr + 80 + 2 * j), rq, rq, p.mla_qn, j, csA, csB, SC_MLA, Qa + (size_t)t * 768 + h * 96);
        }
        {
            const bfu* kr = kvraw + (size_t)t * 1024 + h * 128;
            mla_head(*(const u32x4*)(kr + 8 * j), *(const unsigned*)(ur + 640 + 2 * j), *(const unsigned*)(ur + 656 + 2 * j), rkv, 1.f, p.mla_kn, j, csA, csB, 1.f, Ka + (size_t)t * 768 + h * 96);
            const u32x4 vv = *(const u32x4*)(kr + 64 + 8 * j);
            *(u32x4*)(Va + (size_t)t * 512 + h * 64 + 8 * j) = (u32x4){pk2(bflo(vv[0]) * rkv, bfhi(vv[0]) * rkv), pk2(bflo(vv[1]) * rkv, bfhi(vv[1]) * rkv),
                                                                      pk2(bflo(vv[2]) * rkv, bfhi(vv[2]) * rkv), pk2(bflo(vv[3]) * rkv, bfhi(vv[3]) * rkv)};
        }
        f32x4 d1, d2;
#pragma unroll
        for (int rd = 0; rd < 3; ++rd) {
            const int hh = rd * 8 + h, which = hh / 12, gh = hh % 12;
            headnorm64(ur + 672 + which * 768 + gh * 64, which ? p.dil_kn : p.dil_qn, r64 + (size_t)t * 32, which ? 1.f : SC_64, j, false, d1, d2);
        }
    }
}

DI void phase_post_odd(const Params& p, char* smem) {
    char* ws = p.ws;
    bfu* ubuf = (bfu*)(ws + OFF_UBUF); const float2* r64 = (const float2*)(ws + OFF_ROPE64); float* kpart = (float*)(ws + OFF_KPART);
    const int tid = threadIdx.x, lane = tid & 63, wid = tid >> 6, h = lane >> 3, j = lane & 7;
    float* red = (float*)smem;
    for (int it = blockIdx.x; it < T / 64; it += gridDim.x) {
        f32x4 ka1 = {0.f, 0.f, 0.f, 0.f}, ka2 = {0.f, 0.f, 0.f, 0.f}, d1, d2;
        for (int tt = 0; tt < 8; ++tt) {
            const int t = it * 64 + wid * 8 + tt;
            bfu* ur = ubuf + (size_t)t * 3072; const float2* cs = r64 + (size_t)t * 32;
            headnorm64(ur + h * 64, p.diff_qn, cs, SC_64, j, false, d1, d2);
            headnorm64(ur + 512 + h * 64, p.diff_kn, cs, 1.f, j, false, d1, d2);
            headnorm64(ur + 1536 + h * 64, p.moba_qn, cs, SC_64, j, false, d1, d2);
            headnorm64(ur + 2048 + h * 64, p.moba_kn, cs, 1.f, j, true, ka1, ka2);
        }
        __syncthreads();
#pragma unroll
        for (int e = 0; e < 4; ++e) { red[(wid * 64 + lane) * 8 + e] = ka1[e]; red[(wid * 64 + lane) * 8 + 4 + e] = ka2[e]; }
        __syncthreads();
        {
            const int o = tid, hh = o >> 6, d = o & 63, jj = (d & 31) >> 2, e = (d & 3) + ((d >> 5) << 2), ln = hh * 8 + jj;
            float sum = 0.f;
#pragma unroll
            for (int w = 0; w < NW; ++w) sum += red[(w * 64 + ln) * 8 + e];
            kpart[(size_t)it * 512 + o] = sum;
        }
    }
    __syncthreads();
}

DI void phase_dil_merge(const Params& p) {
    const bfu* dil_o = (const bfu*)(p.ws + OFF_HBUF); const float* dil_lse = (const float*)(p.ws + OFF_HBUF + 48 * MiB);
    bfu* obuf = (bfu*)(p.ws + OFF_OBUF);
    for (int idx = blockIdx.x * NT + threadIdx.x; idx < T * 64; idx += gridDim.x * NT) {
        const int t = idx >> 6, r = idx & 63, h = r >> 4, jj = r & 15;
        const float l0 = dil_lse[(size_t)t * 12 + h], l1 = dil_lse[(size_t)t * 12 + 4 + h], l2 = dil_lse[(size_t)t * 12 + 8 + h];
        const float mx = fmaxf(l0, fmaxf(l1, l2));
        float w0 = exp2f(l0 - mx), w1 = exp2f(l1 - mx), w2 = exp2f(l2 - mx); const float inv = 1.f / (w0 + w1 + w2); w0 *= inv; w1 *= inv; w2 *= inv;
        const u32x2 a = *(const u32x2*)(dil_o + (size_t)t * 768 + h * 64 + 4 * jj), b = *(const u32x2*)(dil_o + (size_t)t * 768 + (4 + h) * 64 + 4 * jj),
                    c = *(const u32x2*)(dil_o + (size_t)t * 768 + (8 + h) * 64 + 4 * jj);
        const float o0 = w0 * bflo(a[0]) + w1 * bflo(b[0]) + w2 * bflo(c[0]), o1 = w0 * bfhi(a[0]) + w1 * bfhi(b[0]) + w2 * bfhi(c[0]);
        const float o2 = w0 * bflo(a[1]) + w1 * bflo(b[1]) + w2 * bflo(c[1]), o3 = w0 * bfhi(a[1]) + w1 * bfhi(b[1]) + w2 * bfhi(c[1]);
        *(u32x2*)(obuf + (size_t)t * 768 + 512 + h * 64 + 4 * jj) = (u32x2){pk2(o0, o1), pk2(o2, o3)};
    }
}

DI void phase_diff_combine(const Params& p) {
    const bfu* dbuf = (const bfu*)(p.ws + OFF_DBUF); bfu* obuf = (bfu*)(p.ws + OFF_OBUF);
    const int lane = threadIdx.x & 63, gw = blockIdx.x * NW + (threadIdx.x >> 6), nwv = gridDim.x * NW;
    float lam;
    {
        const float sa = wave_sum(p.diff_lam[lane] * p.diff_lam[64 + lane]), sb = wave_sum(p.diff_lam[128 + lane] * p.diff_lam[192 + lane]);
        lam = expf(sa) - expf(sb) + LAM_INIT;
    }
    const int h = lane >> 4, jj = lane & 15;
    const float4 sA = *(const float4*)(p.diff_subln + 8 * jj), sB = *(const float4*)(p.diff_subln + 8 * jj + 4);
    const float sw[8] = {sA.x, sA.y, sA.z, sA.w, sB.x, sB.y, sB.z, sB.w};
    for (int t = gw; t < T; t += nwv) {
        const u32x4 a = *(const u32x4*)(dbuf + (size_t)t * 1024 + (2 * h) * 128 + 8 * jj), b = *(const u32x4*)(dbuf + (size_t)t * 1024 + (2 * h + 1) * 128 + 8 * jj);
        float d[8];
#pragma unroll
        for (int e = 0; e < 4; ++e) { d[2 * e] = bflo(a[e]) - lam * bflo(b[e]); d[2 * e + 1] = bfhi(a[e]) - lam * bfhi(b[e]); }
        float ss = 0.f;
#pragma unroll
        for (int e = 0; e < 8; ++e) ss += d[e] * d[e];
        ss += __shfl_xor(ss, 1); ss += __shfl_xor(ss, 2); ss += __shfl_xor(ss, 4); ss += __shfl_xor(ss, 8);
        const float r = rsqrtf(ss * (1.f / 128.f) + EPS) * (1.f - LAM_INIT);
#pragma unroll
        for (int e = 0; e < 8; ++e) d[e] *= r * sw[e];
        *(u32x4*)(obuf + (size_t)t * 1024 + h * 128 + 8 * jj) = (u32x4){pk2(d[0], d[1]), pk2(d[2], d[3]), pk2(d[4], d[5]), pk2(d[6], d[7])};
    }
}

struct Top3 { float v0, v1, v2; int i0, i1, i2; };
DI Top3 top3_ins(Top3 t, float v, int i) {
    const bool g0 = (v > t.v0) || (v == t.v0 && i < t.i0), g1 = (v > t.v1) || (v == t.v1 && i < t.i1), g2 = (v > t.v2) || (v == t.v2 && i < t.i2);
    Top3 r;
    r.v2 = g1 ? t.v1 : (g2 ? v : t.v2); r.i2 = g1 ? t.i1 : (g2 ? i : t.i2);
    r.v1 = g0 ? t.v0 : (g1 ? v : t.v1); r.i1 = g0 ? t.i0 : (g1 ? i : t.i1);
    r.v0 = g0 ? v : t.v0; r.i0 = g0 ? i : t.i0;
    return r;
}

template <int DK, int DV, int MODE>
DI void attn_item(const bfu* __restrict__ Qp, int qp, const bfu* __restrict__ Kp, int kp, const bfu* __restrict__ Vp, int vp,
                  long rowbase, int rs, int q0, bfu* __restrict__ Op, int op, float* __restrict__ lsep, int lsest,
                  const float* __restrict__ kpart, char* smem) {
    constexpr int KPT = DK + 8, KCH = DK / 8, VCH = DV / 8, NKL = (64 * KCH + NT - 1) / NT, NVL = 64 * VCH / NT, NDV = DV / 32, ND0 = DK / 16;
    constexpr int KST = 64 * KPT, VST = 64 * DV;
    bfu* Ks = (bfu*)smem; bfu* Vs = Ks + 2 * KST;
    short* tlist = (short*)(Vs + 2 * VST);
    int* misc = (int*)(tlist + 192);
    float* km = (float*)(misc + 4);
    unsigned* selm = (unsigned*)(km + 2048);
    float* cand = (float*)(selm + 256);
    const int tid = threadIdx.x, lane = tid & 63, wid = tid >> 6, l32 = lane & 31, hi = lane >> 5;
    const int qw = q0 + wid * 32, qstep = qw + l32;
    unsigned mysel = 0;
    if (MODE == 2) {
        const int nb = q0 >> 8;
        for (int idx = tid; idx < nb * 64; idx += NT) {
            const int blk = idx >> 6, d = idx & 63; const float* kq = kpart + (size_t)(blk * 4) * 512 + d;
            km[idx] = (kq[0] + kq[512] + kq[1024] + kq[1536]) * (1.f / 256.f);
        }
        if (tid == 0) misc[1] = 0;
        __syncthreads();
        {
            const int qq = tid & 255, hf = tid >> 8;
            const bfu* qr = Qp + (size_t)(rowbase + q0 + qq) * qp;
            float qv[64];
#pragma unroll
            for (int c8 = 0; c8 < 8; ++c8) {
                const u32x4 w = *(const u32x4*)(qr + c8 * 8);
#pragma unroll
                for (int e = 0; e < 4; ++e) { qv[c8 * 8 + 2 * e] = bflo(w[e]); qv[c8 * 8 + 2 * e + 1] = bfhi(w[e]); }
            }
            Top3 tp; tp.v0 = -3e38f; tp.v1 = -3e38f; tp.v2 = -3e38f; tp.i0 = 64; tp.i1 = 64; tp.i2 = 64;
            for (int blk = hf; blk < nb; blk += 2) {
                float g = 0.f;
#pragma unroll
                for (int d = 0; d < 64; ++d) g += qv[d] * km[blk * 64 + d];
                tp = top3_ins(tp, g, blk);
            }
            cand[tid * 6 + 0] = tp.v0; cand[tid * 6 + 1] = tp.v1; cand[tid * 6 + 2] = tp.v2;
            cand[tid * 6 + 3] = __int_as_float(tp.i0); cand[tid * 6 + 4] = __int_as_float(tp.i1); cand[tid * 6 + 5] = __int_as_float(tp.i2);
        }
        __syncthreads();
        if (tid < 256) {
            Top3 tp; tp.v0 = cand[tid * 6]; tp.v1 = cand[tid * 6 + 1]; tp.v2 = cand[tid * 6 + 2];
            tp.i0 = __float_as_int(cand[tid * 6 + 3]); tp.i1 = __float_as_int(cand[tid * 6 + 4]); tp.i2 = __float_as_int(cand[tid * 6 + 5]);
            const int o = (tid + 256) * 6;
#pragma unroll
            for (int e = 0; e < 3; ++e) { const int ii = __float_as_int(cand[o + 3 + e]); tp = top3_ins(tp, cand[o + e], ii); }
            unsigned mk = 0;
            if (tp.i0 < 32) mk |= 1u << tp.i0;
            if (tp.i1 < 32) mk |= 1u << tp.i1;
            if (tp.i2 < 32) mk |= 1u << tp.i2;
            selm[tid] = mk;
            atomicOr((unsigned*)&misc[1], mk);
        }
        __syncthreads();
        mysel = selm[wid * 32 + l32];
    }
    if (MODE == 0) { const int last = (q0 >> 6) + 3; for (int jx = tid; jx <= last; jx += NT) tlist[jx] = (short)jx; if (tid == 0) misc[0] = last + 1; }
    if (MODE == 1) { const int last = (q0 >> 6) + 3, first = (q0 >> 6) >= 2 ? (q0 >> 6) - 2 : 0; if (tid == 0) { int n = 0; for (int jx = first; jx <= last; ++jx) tlist[n++] = (short)jx; misc[0] = n; } }
    if (MODE == 2) {
        if (tid == 0) {
            const unsigned om = (unsigned)misc[1]; const int nb = q0 >> 8; int n = 0;
            for (int blk = 0; blk < nb; ++blk) if ((om >> blk) & 1u) { tlist[n++] = (short)(blk * 4); tlist[n++] = (short)(blk * 4 + 1); tlist[n++] = (short)(blk * 4 + 2); tlist[n++] = (short)(blk * 4 + 3); }
            for (int jx = nb * 4; jx <= nb * 4 + 3; ++jx) tlist[n++] = (short)jx;
            misc[0] = n;
        }
    }
    __syncthreads();
    const int nt = misc[0];
    bf16x8 qf[ND0];
    {
        const bfu* qr = Qp + (size_t)(rowbase + (long)qstep * rs) * qp + hi * 8;
#pragma unroll
        for (int d0 = 0; d0 < ND0; ++d0) qf[d0] = *(const bf16x8*)(qr + d0 * 16);
    }
    float m = 0.f, l = 0.f; bool started = false;
    f32x16 o[NDV];
#pragma unroll
    for (int dvb = 0; dvb < NDV; ++dvb)
#pragma unroll
        for (int r = 0; r < 16; ++r) o[dvb][r] = 0.f;
    int krow[NKL], kch[NKL], vrow[NVL], vch[NVL];
#pragma unroll
    for (int i = 0; i < NKL; ++i) { const int id = tid + NT * i; krow[i] = id / KCH; kch[i] = id % KCH; }
#pragma unroll
    for (int i = 0; i < NVL; ++i) { const int id = tid + NT * i; vrow[i] = id / VCH; vch[i] = id % VCH; }
    u32x4 rk[NKL], rv[NVL];
#define ATT_LOAD(JJ) do { const int j_ = (JJ); \
    _Pragma("unroll") for (int i = 0; i < NKL; ++i) if (tid + NT * i < 64 * KCH) rk[i] = *(const u32x4*)(Kp + (size_t)(rowbase + (long)(j_ * 64 + krow[i]) * rs) * kp + kch[i] * 8); \
    _Pragma("unroll") for (int i = 0; i < NVL; ++i) rv[i] = *(const u32x4*)(Vp + (size_t)(rowbase + (long)(j_ * 64 + vrow[i]) * rs) * vp + vch[i] * 8); } while (0)
#define ATT_STORE(ST) do { bfu* ks_ = Ks + (ST) * KST; bfu* vs_ = Vs + (ST) * VST; \
    _Pragma("unroll") for (int i = 0; i < NKL; ++i) if (tid + NT * i < 64 * KCH) *(u32x4*)(ks_ + krow[i] * KPT + kch[i] * 8) = rk[i]; \
    _Pragma("unroll") for (int i = 0; i < NVL; ++i) *(u32x4*)(vs_ + (vch[i] >> 2) * 2048 + vrow[i] * 32 + (vch[i] & 3) * 8) = rv[i]; } while (0)
    ATT_LOAD(tlist[0]);
    ATT_STORE(0);
    if (nt > 1) ATT_LOAD(tlist[1]);
    __syncthreads();
    const lds_cptr vb0 = (lds_cptr)Vs + ((lane >> 4) & 1) * 32 + (lane & 3) * 8 + (4 * hi + ((lane & 15) >> 2)) * 64;
    const bfu* ksr0 = Ks + l32 * KPT + hi * 8;
    for (int it = 0; it < nt; ++it) {
        const int cur = it & 1;
        const int jc = tlist[it];
        if (it + 1 < nt) ATT_STORE(cur ^ 1);
        if (it + 2 < nt) ATT_LOAD(tlist[it + 2]);
        bool need;
        if (MODE == 1) need = (jc * 64 <= qw + 31) && (jc * 64 + 63 >= qw - 128);
        else {
            need = (jc * 64 <= qw + 31);
            if (MODE == 2) { const int blk = jc >> 2; if (blk < (q0 >> 8)) need = __any((mysel >> blk) & 1u) != 0; }
        }
        if (need) {
            const bfu* ksr = ksr0 + cur * KST; const lds_cptr vb = vb0 + cur * (VST * 2);
            f32x16 s0, s1;
            const float negm = -m;
#pragma unroll
            for (int r = 0; r < 16; ++r) { s0[r] = negm; s1[r] = negm; }
#pragma unroll
            for (int d0 = 0; d0 < ND0; ++d0) {
                const bf16x8 k0 = *(const bf16x8*)(ksr + d0 * 16), k1 = *(const bf16x8*)(ksr + 32 * KPT + d0 * 16);
                s0 = MFMA(k0, qf[d0], s0); s1 = MFMA(k1, qf[d0], s1);
            }
            const int kbase = jc * 64 + 4 * hi;
            if (MODE == 1) {
#pragma unroll
                for (int r = 0; r < 16; ++r) {
                    const int dd = qstep - (kbase + (r & 3) + 8 * (r >> 2));
                    if (dd < 0 || dd > 128) s0[r] = -INFINITY;
                    if (dd - 32 < 0 || dd - 32 > 128) s1[r] = -INFINITY;
                }
            } else {
                if (jc * 64 + 63 > qw) {
#pragma unroll
                    for (int r = 0; r < 16; ++r) {
                        const int ks = kbase + (r & 3) + 8 * (r >> 2);
                        if (ks > qstep) s0[r] = -INFINITY;
                        if (ks + 32 > qstep) s1[r] = -INFINITY;
                    }
                }
                if (MODE == 2) {
                    const int blk = jc >> 2;
                    if (blk < (q0 >> 8) && !((mysel >> blk) & 1u)) {
#pragma unroll
                        for (int r = 0; r < 16; ++r) { s0[r] = -INFINITY; s1[r] = -INFINITY; }
                    }
                }
            }
            float mx = fmaxf(s0[0], s1[0]);
#pragma unroll
            for (int r = 1; r < 16; ++r) mx = fmaxf(mx, fmaxf(s0[r], s1[r]));
            mx = fmaxf(mx, __shfl_xor(mx, 32));
            if (!started || __any(mx > 8.f)) {
                float delta = started ? fmaxf(mx, 0.f) : mx;
                if (!(delta > -1e30f)) delta = 0.f;
                m += delta;
                const float alpha = __builtin_amdgcn_exp2f(-delta);
                l *= alpha;
#pragma unroll
                for (int r = 0; r < 16; ++r) { s0[r] -= delta; s1[r] -= delta; }
#pragma unroll
                for (int dvb = 0; dvb < NDV; ++dvb)
#pragma unroll
                    for (int r = 0; r < 16; ++r) o[dvb][r] *= alpha;
                started = true;
            }
            float ps = 0.f;
#pragma unroll
            for (int r = 0; r < 16; ++r) { s0[r] = __builtin_amdgcn_exp2f(s0[r]); s1[r] = __builtin_amdgcn_exp2f(s1[r]); ps += s0[r] + s1[r]; }
            l += ps;
            bf16x8 pf[4];
            pf[0] = __builtin_bit_cast(bf16x8, (u32x4){pk2(s0[0], s0[1]), pk2(s0[2], s0[3]), pk2(s0[4], s0[5]), pk2(s0[6], s0[7])});
            pf[1] = __builtin_bit_cast(bf16x8, (u32x4){pk2(s0[8], s0[9]), pk2(s0[10], s0[11]), pk2(s0[12], s0[13]), pk2(s0[14], s0[15])});
            pf[2] = __builtin_bit_cast(bf16x8, (u32x4){pk2(s1[0], s1[1]), pk2(s1[2], s1[3]), pk2(s1[4], s1[5]), pk2(s1[6], s1[7])});
            pf[3] = __builtin_bit_cast(bf16x8, (u32x4){pk2(s1[8], s1[9]), pk2(s1[10], s1[11]), pk2(s1[12], s1[13]), pk2(s1[14], s1[15])});
#pragma unroll
            for (int sx = 0; sx < 4; ++sx)
#pragma unroll
                for (int dvb = 0; dvb < NDV; ++dvb) {
                    const s16x4 lo = vtr(vb + dvb * 4096 + sx * 1024), hh = vtr(vb + dvb * 4096 + sx * 1024 + 512);
                    const bf16x8 vf = (bf16x8){lo[0], lo[1], lo[2], lo[3], hh[0], hh[1], hh[2], hh[3]};
                    o[dvb] = MFMA(vf, pf[sx], o[dvb]);
                }
        }
        __syncthreads();
    }
#undef ATT_LOAD
#undef ATT_STORE
    l += __shfl_xor(l, 32);
    const float inv = 1.f / l;
    const size_t tok = (size_t)(rowbase + (long)qstep * rs);
#pragma unroll
    for (int dvb = 0; dvb < NDV; ++dvb)
#pragma unroll
        for (int i = 0; i < 4; ++i) {
            const int dv = dvb * 32 + 8 * i + 4 * hi;
            *(u32x2*)(Op + tok * op + dv) = (u32x2){pk2(o[dvb][4 * i] * inv, o[dvb][4 * i + 1] * inv), pk2(o[dvb][4 * i + 2] * inv, o[dvb][4 * i + 3] * inv)};
        }
    if (MODE == 1) { if (hi == 0) lsep[tok * lsest] = m + __builtin_amdgcn_logf(l); }
}

DI void phase_attn_even(const Params& p, char* smem, int* s_item, int rep) {
    char* ws = p.ws;
    const bfu* ubuf = (const bfu*)(ws + OFF_UBUF);
    const bfu* Qa = (const bfu*)p.out; const bfu* Ka = Qa + (size_t)T * 768; const bfu* Va = Ka + (size_t)T * 768;
    bfu* obuf = (bfu*)(ws + OFF_OBUF); bfu* dil_o = (bfu*)(ws + OFF_HBUF); float* dil_lse = (float*)(ws + OFF_HBUF + 48 * MiB);
    int* ctr = (int*)(ws + OFF_CTR) + 2 * rep;
    const int total = 1024 + 1536;
    while (true) {
        __syncthreads();
        if (threadIdx.x == 0) *s_item = atomicAdd(ctr, 1);
        __syncthreads();
        const int i = *s_item;
        if (i >= total) break;
        if (i < 1024) {
            const int qt = 31 - (i >> 5), bh = i & 31, b = bh >> 3, h = bh & 7;
            attn_item<96, 64, 0>(Qa + h * 96, 768, Ka + h * 96, 768, Va + h * 64, 512, (long)b * SEQ, 1, qt * 256, obuf + h * 64, 768, nullptr, 0, nullptr, smem);
        } else {
            const int i2 = i - 1024, g = i2 >> 9, r2 = i2 & 511, h = r2 & 3, b = (r2 >> 2) & 3, qi = r2 >> 4;
            const int rr = (g == 0) ? 1 : (g == 1 ? 4 : 16), tpc = 32 / rr, cls = qi / tpc, st = qi % tpc;
            const int gh = g * 4 + h;
            attn_item<64, 64, 1>(ubuf + 672 + gh * 64, 3072, ubuf + 672 + 768 + gh * 64, 3072, ubuf + 672 + 1536 + gh * 64, 3072, (long)b * SEQ + cls, rr, st * 256,
                                 dil_o + gh * 64, 768, dil_lse + gh, 12, nullptr, smem);
        }
    }
}
DI void phase_attn_odd(const Params& p, char* smem, int* s_item, int rep) {
    char* ws = p.ws;
    const bfu* ubuf = (const bfu*)(ws + OFF_UBUF);
    bfu* obuf = (bfu*)(ws + OFF_OBUF); bfu* dbuf = (bfu*)(ws + OFF_DBUF); const float* kpart = (const float*)(ws + OFF_KPART);
    int* ctr = (int*)(ws + OFF_CTR) + 1 + 2 * rep;
    const int total = 2048;
    while (true) {
        __syncthreads();
        if (threadIdx.x == 0) *s_item = atomicAdd(ctr, 1);
        __syncthreads();
        const int i = *s_item;
        if (i >= total) break;
        const int qt = 31 - (i >> 6), kind = (i >> 5) & 1, bh = i & 31, b = bh >> 3, hh = bh & 7;
        if (kind == 0) {
            attn_item<64, 128, 0>(ubuf + hh * 64, 3072, ubuf + 512 + hh * 64, 3072, ubuf + 1024 + (hh >> 1) * 128, 3072, (long)b * SEQ, 1, qt * 256,
                                  dbuf + hh * 128, 1024, nullptr, 0, nullptr, smem);
        } else {
            attn_item<64, 64, 2>(ubuf + 1536 + hh * 64, 3072, ubuf + 2048 + hh * 64, 3072, ubuf + 2560 + hh * 64, 3072, (long)b * SEQ, 1, qt * 256,
                                 obuf + 512 + hh * 64, 1024, nullptr, 0, kpart + (size_t)b * (32 * 4 * 512) + hh * 64, smem);
        }
    }
}

#define XB_TMO      128
#define XB_XCNT(j)  (256  + 64 * (j))
#define XB_XSUB(j)  (1280 + 64 * (j))
#define XB_XGEN(j)  (2304 + 64 * (j))
#define XB_TOP      3328
#define XB_TOPGEN   3392
#define XCD_BAR_WORDS 3456
#define XB_SPIN_CAP (1u << 18)
#define LAS __attribute__((address_space(3)))

__device__ __forceinline__ unsigned xb_ld(unsigned* p)              { return __hip_atomic_load(p, __ATOMIC_RELAXED, __HIP_MEMORY_SCOPE_AGENT); }
__device__ __forceinline__ unsigned xb_add(unsigned* p, unsigned v) { return __hip_atomic_fetch_add(p, v, __ATOMIC_RELAXED, __HIP_MEMORY_SCOPE_AGENT); }
__device__ __forceinline__ unsigned xb_xcc_id() { return (unsigned)__builtin_amdgcn_s_getreg((3 << 11) | 20) & 0xFu; }
#define XB_SPIN(cond, bar) do { unsigned _sp = 0; while (cond) { __builtin_amdgcn_s_sleep(1); \
    if ((++_sp & 255u) == 0u) { if (xb_ld(&(bar)[XB_TMO])) break; if (_sp > XB_SPIN_CAP) { atomicAdd(&(bar)[XB_TMO], 1u); break; } } } } while (0)

struct XcdBarrier {
    unsigned* bar; unsigned x;
    volatile LAS unsigned* st;
};

__device__ __forceinline__ XcdBarrier xcd_barrier_post(unsigned* bar, volatile LAS unsigned* st) {
    XcdBarrier b; b.bar = bar; b.x = xb_xcc_id(); b.st = st;
    if (threadIdx.x == 0) (void)xb_add(&bar[XB_XCNT(b.x)], 1u);
    return b;
}
__device__ __forceinline__ void xcd_barrier_complete(unsigned* bar, unsigned x, unsigned& nloc, unsigned& nx) {
    const unsigned G = gridDim.x * gridDim.y * gridDim.z;
    unsigned sum, cnt, mine, sp = 0u;
    for (;;) {
        sum = 0u; cnt = 0u; mine = 0u;
#pragma unroll
        for (unsigned j = 0; j < 16; ++j) { const unsigned c = xb_ld(&bar[XB_XCNT(j)]); sum += c; cnt += (c > 0u) ? 1u : 0u; mine = (j == x) ? c : mine; }
        if (sum == G) break;
        __builtin_amdgcn_s_sleep(1);
        if ((++sp & 255u) == 0u) { if (xb_ld(&bar[XB_TMO])) break; if (sp > XB_SPIN_CAP) { atomicAdd(&bar[XB_TMO], 1u); break; } }
    }
    nloc = mine > 0u ? mine : 1u; nx = cnt > 0u ? cnt : 1u;
}

__device__ __forceinline__ void xcd_barrier(const XcdBarrier& b) {
    asm volatile("s_waitcnt vmcnt(0)" ::: "memory");
    __syncthreads();
    if (threadIdx.x == 0) {
        unsigned* bar = b.bar;
        __builtin_amdgcn_s_waitcnt(0);
        unsigned nloc = b.st[0], nx = b.st[1];
        if (nloc == 0u) { xcd_barrier_complete(bar, b.x, nloc, nx); b.st[0] = nloc; b.st[1] = nx; }
        const unsigned old = xb_add(&bar[XB_XSUB(b.x)], 1u);
        const unsigned gen = old / nloc;
        if (old + 1u == (gen + 1u) * nloc) {
            __builtin_amdgcn_fence(__ATOMIC_RELEASE, "agent");
            asm volatile("s_waitcnt vmcnt(0)" ::: "memory");
            const unsigned og = xb_add(&bar[XB_TOP], 1u);
            const unsigned tg = og / nx;
            if (og + 1u == (tg + 1u) * nx) xb_add(&bar[XB_TOPGEN], 1u);
            else XB_SPIN(xb_ld(&bar[XB_TOPGEN]) == tg, bar);
            __builtin_amdgcn_fence(__ATOMIC_ACQUIRE, "agent");
            xb_add(&bar[XB_XGEN(b.x)], 1u);
            asm volatile("s_waitcnt vmcnt(0)" ::: "memory");
        } else {
            XB_SPIN(xb_ld(&bar[XB_XGEN(b.x)]) == gen, bar);
            __builtin_amdgcn_fence(__ATOMIC_ACQUIRE, "agent");
            asm volatile("s_waitcnt vmcnt(0)" ::: "memory");
        }
    }
    __syncthreads();
}

#ifndef MK_REPMASK
#define MK_REPMASK 0u
#endif
#define PHASE_BEGIN(k) if (p.phase_lo <= (k) && (k) < p.phase_hi) { for (int rep_ = 0; rep_ < (((MK_REPMASK >> (k)) & 1u) ? 2 : 1); ++rep_) {
#define PHASE_MID(k) if (rep_ == 0 && ((MK_REPMASK >> (k)) & 1u)) xcd_barrier(xb); }
#define PHASE_END(k) PHASE_MID(k) if (p.coop && (k) + 1 < p.phase_hi) xcd_barrier(xb); }
__global__ void __launch_bounds__(512) mega(Params p) {
    extern __shared__ __attribute__((aligned(16))) char smem[];
    __shared__ int s_item;
    __shared__ uint4 xb_words;
    char* ws = p.ws;
    if (threadIdx.x == 0) xb_words = make_uint4(0u, 0u, 0u, 0u);
    __syncthreads();
    XcdBarrier xb = xcd_barrier_post((unsigned*)(ws + OFF_CTR + 4096), (volatile LAS unsigned*)&xb_words);
    bfu* hbuf = (bfu*)(ws + OFF_HBUF); bfu* obuf = (bfu*)(ws + OFF_OBUF); bfu* ubuf = (bfu*)(ws + OFF_UBUF); bfu* hid = ubuf;
    const float* mod0 = (const float*)(ws + OFF_MOD); const float* mod1 = mod0 + 4 * 6144;
    PHASE_BEGIN(0) phase_prep(p, smem); PHASE_END(0)
    PHASE_BEGIN(1) phase_modfin(p); PHASE_END(1)
    PHASE_BEGIN(2) phase_normmod(p.x, p.norm_mix, mod0, 0, hbuf); PHASE_END(2)
    PHASE_BEGIN(3) phase_gemm<0>(hbuf, 1024, (const bfu*)(ws + OFF_WIN0), 1024, 2976, 12, ubuf, 3072, nullptr, nullptr, nullptr, smem); PHASE_END(3)
    PHASE_BEGIN(4)
            for (int tile = blockIdx.x; tile < 128 * 7; tile += gridDim.x) {
                const int mt = tile / 7, nt = tile % 7;
                if (nt < 3) gemm_tile<0>(ubuf, 3072, (const bfu*)(ws + OFF_WUQ), 384, mt * 256, nt * 256, 768, hbuf, 768, nullptr, nullptr, nullptr, smem);
                else gemm_tile<0>(ubuf + 384, 3072, (const bfu*)(ws + OFF_WUKV), 256, mt * 256, (nt - 3) * 256, 1024, obuf, 1024, nullptr, nullptr, nullptr, smem);
            }
    PHASE_END(4)
    PHASE_BEGIN(5) phase_post_even(p); PHASE_END(5)
    PHASE_BEGIN(6) phase_attn_even(p, smem, &s_item, rep_); PHASE_END(6)
    PHASE_BEGIN(7) phase_dil_merge(p); PHASE_END(7)
    PHASE_BEGIN(8) phase_gemm<2>(obuf, 768, (const bfu*)(ws + OFF_WOUT0), 768, 1024, 4, nullptr, 0, p.x, p.out, mod0 + 2048, smem); PHASE_END(8)
    PHASE_BEGIN(9) phase_normmod(p.out, p.norm_mlp, mod0, 3072, hbuf); PHASE_END(9)
    PHASE_BEGIN(10) phase_gemm<1>(hbuf, 1024, (const bfu*)(ws + OFF_W1_0), 1024, 4096, 16, hid, 4096, nullptr, nullptr, nullptr, smem); PHASE_END(10)
    PHASE_BEGIN(11) phase_gemm<2>(hid, 4096, (const bfu*)(ws + OFF_W2_0), 4096, 1024, 4, nullptr, 0, p.out, p.out, mod0 + 5120, smem); PHASE_END(11)
    PHASE_BEGIN(12) phase_normmod(p.out, p.norm_mix + 1024, mod1, 0, hbuf); PHASE_END(12)
    PHASE_BEGIN(13) phase_gemm<0>(hbuf, 1024, (const bfu*)(ws + OFF_WIN1), 1024, 3072, 12, ubuf, 3072, nullptr, nullptr, nullptr, smem); PHASE_END(13)
    PHASE_BEGIN(14) phase_post_odd(p, smem); PHASE_END(14)
    PHASE_BEGIN(15) phase_attn_odd(p, smem, &s_item, rep_); PHASE_END(15)
    PHASE_BEGIN(16) phase_diff_combine(p); PHASE_END(16)
    PHASE_BEGIN(17) phase_gemm<2>(obuf, 1024, (const bfu*)(ws + OFF_WOUT1), 1024, 1024, 4, nullptr, 0, p.out, p.out, mod1 + 2048, smem); PHASE_END(17)
    PHASE_BEGIN(18) phase_normmod(p.out, p.norm_mlp + 1024, mod1, 3072, hbuf); PHASE_END(18)
    PHASE_BEGIN(19) phase_gemm<1>(hbuf, 1024, (const bfu*)(ws + OFF_W1_1), 1024, 4096, 16, hid, 4096, nullptr, nullptr, nullptr, smem); PHASE_END(19)
    PHASE_BEGIN(20) phase_gemm<2>(hid, 4096, (const bfu*)(ws + OFF_W2_1), 4096, 1024, 4, nullptr, 0, p.out, p.out, mod1 + 5120, smem); PHASE_END(20)
    if (p.coop == 2) cg::this_grid().sync();
}

extern "C" void kernel_launch(void* const* d_in, const int* in_sizes, int n_in, void* d_out, int out_size, void* d_ws, size_t ws_size, hipStream_t stream) {
    static int grid_blocks = 0;
    if (!grid_blocks) {
        int dev = 0, cus = 0, per_cu = 0;
        (void)hipGetDevice(&dev);
        (void)hipDeviceGetAttribute(&cus, hipDeviceAttributeMultiprocessorCount, dev);
        (void)hipFuncSetAttribute((const void*)mega, hipFuncAttributeMaxDynamicSharedMemorySize, DYN_LDS);
        (void)hipOccupancyMaxActiveBlocksPerMultiprocessor(&per_cu, mega, NT, DYN_LDS);
        if (per_cu != 1) per_cu = 1;
        grid_blocks = cus * per_cu;
    }
    if (ws_size < WS_END) fprintf(stderr, "workspace too small: %zu < %zu\n", ws_size, (size_t)WS_END);
    Params p{};
    p.x = (const float*)d_in[0]; p.c = (const float*)d_in[1]; p.pos = (const int*)d_in[2];
    p.ada_w = (const float*)d_in[3]; p.ada_b = (const float*)d_in[4]; p.norm_mix = (const float*)d_in[5]; p.norm_mlp = (const float*)d_in[6];
    p.w1 = (const float*)d_in[7]; p.w2 = (const float*)d_in[8]; p.e_win = (const float*)d_in[9]; p.e_wout = (const float*)d_in[10];
    p.qlat = (const float*)d_in[11]; p.kvlat = (const float*)d_in[12]; p.wuq = (const float*)d_in[13]; p.wukv = (const float*)d_in[14];
    p.mla_qn = (const float*)d_in[15]; p.mla_kn = (const float*)d_in[16]; p.dil_qn = (const float*)d_in[17]; p.dil_kn = (const float*)d_in[18];
    p.o_win = (const float*)d_in[19]; p.o_wout = (const float*)d_in[20]; p.diff_qn = (const float*)d_in[21]; p.diff_kn = (const float*)d_in[22];
    p.diff_lam = (const float*)d_in[23]; p.diff_subln = (const float*)d_in[24]; p.moba_qn = (const float*)d_in[25]; p.moba_kn = (const float*)d_in[26];
    p.out = (float*)d_out; p.ws = (char*)d_ws;
    for (int i = 0; i < 32; ++i) p.invf64[i] = (float)pow(10000.0, -(double)i / 32.0);
    for (int i = 0; i < 16; ++i) p.invf32[i] = (float)pow(10000.0, -(double)i / 16.0);
    (void)hipMemsetAsync((char*)d_ws + OFF_CTR, 0, 32768, stream);
#if MK_COOP
    p.phase_lo = 0; p.phase_hi = NPH; p.coop = 1;
    void* args[] = {&p};
    hipError_t e = hipLaunchCooperativeKernel((void*)mega, dim3(grid_blocks), dim3(NT), args, DYN_LDS, stream);
    if (e != hipSuccess) fprintf(stderr, "cooperative launch failed: %s (grid %d)\n", hipGetErrorString(e), grid_blocks);
#else
    for (int ph = 0; ph < NPH; ++ph) {
        p.phase_lo = ph; p.phase_hi = ph + 1; p.coop = 0;
        hipLaunchKernelGGL(mega, dim3(grid_blocks), dim3(NT), DYN_LDS, stream, p);
    }
#endif
}
```

```cpp
#include <hip/hip_runtime.h>
#include <hip/hip_cooperative_groups.h>
#include <stdint.h>
#include <cstdio>
#include <cmath>
namespace cg = cooperative_groups;

#ifndef MK_COOP
#define MK_COOP 1
#endif

typedef unsigned short bfu;
typedef __attribute__((ext_vector_type(8))) short bf16x8;
typedef __attribute__((ext_vector_type(4))) short s16x4;
typedef short v4i16_t __attribute__((ext_vector_type(4)));
typedef __attribute__((ext_vector_type(16))) float f32x16;
typedef __attribute__((ext_vector_type(4))) float f32x4;
typedef __attribute__((ext_vector_type(2))) float f32x2;
typedef __attribute__((ext_vector_type(4))) unsigned u32x4;
typedef __attribute__((ext_vector_type(2))) unsigned u32x2;
typedef __attribute__((ext_vector_type(2))) __bf16 bf2_t;
typedef __attribute__((address_space(3))) const char* lds_cptr;

#define DI __device__ __forceinline__
#define MFMA(a, b, c) __builtin_amdgcn_mfma_f32_32x32x16_bf16((a), (b), (c), 0, 0, 0)

constexpr int T = 32768, SEQ = 8192;
constexpr float EPS = 1e-6f;
constexpr float LOG2E = 1.4426950408889634f;
constexpr float SC_MLA = 0.10206207261596577f * LOG2E;
constexpr float SC_64 = 0.125f * LOG2E;
constexpr float LAM_INIT = 0.35550906759096926f;
constexpr int NPH = 21;
constexpr int NT = 512, NW = 8;
constexpr int DYN_LDS = 2 * 512 * 72 * 2;

constexpr size_t MiB = 1048576;
constexpr size_t OFF_WIN0 = 0, OFF_WIN1 = 6 * MiB, OFF_W1_0 = 12 * MiB, OFF_W1_1 = 20 * MiB, OFF_W2_0 = 28 * MiB, OFF_W2_1 = 36 * MiB,
                 OFF_WOUT0 = 44 * MiB, OFF_WOUT1 = 46 * MiB, OFF_WUQ = 48 * MiB, OFF_WUKV = 49 * MiB, OFF_MODP = 50 * MiB, OFF_MOD = 52 * MiB,
                 OFF_ROPE64 = 53 * MiB, OFF_ROPE32 = 61 * MiB, OFF_KPART = 65 * MiB, OFF_CTR = 66 * MiB,
                 OFF_HBUF = 72 * MiB, OFF_OBUF = 136 * MiB, OFF_UBUF = 200 * MiB, OFF_DBUF = 392 * MiB, WS_END = 456 * MiB;

struct Params {
    const float *x, *c; const int* pos;
    const float *ada_w, *ada_b, *norm_mix, *norm_mlp, *w1, *w2, *e_win, *e_wout, *qlat, *kvlat, *wuq, *wukv, *mla_qn, *mla_kn, *dil_qn, *dil_kn,
        *o_win, *o_wout, *diff_qn, *diff_kn, *diff_lam, *diff_subln, *moba_qn, *moba_kn;
    float* out; char* ws;
    float invf64[32]; float invf32[16];
    int phase_lo, phase_hi, coop, pad_;
};

DI unsigned pk2(float a, float b) { f32x2 v = {a, b}; bf2_t r = __builtin_convertvector(v, bf2_t); return __builtin_bit_cast(unsigned, r); }
DI float bflo(unsigned u) { return __uint_as_float(u << 16); }
DI float bfhi(unsigned u) { return __uint_as_float(u & 0xffff0000u); }
DI float wave_sum(float v) {
#pragma unroll
    for (int o = 32; o; o >>= 1) v += __shfl_xor(v, o);
    return v; }
DI s16x4 vtr(lds_cptr p) { return __builtin_bit_cast(s16x4, __builtin_amdgcn_ds_read_tr16_b64_v4i16((__attribute__((address_space(3))) v4i16_t*)p)); }

DI void tr_tile(const float* __restrict__ src, int K, int N, bfu* __restrict__ dst, const float* __restrict__ kscale, int it, float* tl) {
    const int nkt = K >> 6; const int kt = it % nkt, nt = it / nkt; const int tid = threadIdx.x;
#pragma unroll
    for (int rr = 0; rr < 2; ++rr) {
        const int kl = rr * 32 + (tid >> 4), k = kt * 64 + kl, nl = (tid & 15) * 4, n = nt * 64 + nl;
        float4 v = make_float4(0.f, 0.f, 0.f, 0.f);
        if (n < N) v = *(const float4*)(src + (size_t)k * N + n);
        if (kscale) { const float sc = kscale[k]; v.x *= sc; v.y *= sc; v.z *= sc; v.w *= sc; }
        tl[kl * 65 + nl] = v.x; tl[kl * 65 + nl + 1] = v.y; tl[kl * 65 + nl + 2] = v.z; tl[kl * 65 + nl + 3] = v.w;
    }
    __syncthreads();
    {
        const int nl = tid >> 3, kc = (tid & 7) * 8;
        unsigned w[4];
#pragma unroll
        for (int i = 0; i < 4; ++i) w[i] = pk2(tl[(kc + 2 * i) * 65 + nl], tl[(kc + 2 * i + 1) * 65 + nl]);
        bfu* d = dst + (size_t)(nt * 64 + nl) * K + kt * 64 + kc;
        *(u32x4*)d = (u32x4){w[0], w[1], w[2], w[3]};
    }
    __syncthreads();
}
DI void tr_matrix(const float* src, int K, int N, int Npad, bfu* dst, const float* kscale, float* tl) {
    const int nit = (K >> 6) * (Npad >> 6);
    for (int it = blockIdx.x; it < nit; it += gridDim.x) tr_tile(src, K, N, dst, kscale, it, tl);
}

DI void phase_prep(const Params& p, char* smem) {
    float* tl = (float*)smem;
    char* ws = p.ws;
    if (blockIdx.x == 0 && threadIdx.x < 4) ((int*)(ws + OFF_CTR))[threadIdx.x] = 0;
    tr_matrix(p.e_win, 1024, 2976, 3072, (bfu*)(ws + OFF_WIN0), nullptr, tl);
    tr_matrix(p.o_win, 1024, 3072, 3072, (bfu*)(ws + OFF_WIN1), nullptr, tl);
    tr_matrix(p.w1, 1024, 4096, 4096, (bfu*)(ws + OFF_W1_0), nullptr, tl);
    tr_matrix(p.w1 + (size_t)1024 * 4096, 1024, 4096, 4096, (bfu*)(ws + OFF_W1_1), nullptr, tl);
    tr_matrix(p.w2, 4096, 1024, 1024, (bfu*)(ws + OFF_W2_0), nullptr, tl);
    tr_matrix(p.w2 + (size_t)1024 * 4096, 4096, 1024, 1024, (bfu*)(ws + OFF_W2_1), nullptr, tl);
    tr_matrix(p.e_wout, 768, 1024, 1024, (bfu*)(ws + OFF_WOUT0), nullptr, tl);
    tr_matrix(p.o_wout, 1024, 1024, 1024, (bfu*)(ws + OFF_WOUT1), nullptr, tl);
    tr_matrix(p.wuq, 384, 768, 768, (bfu*)(ws + OFF_WUQ), p.qlat, tl);
    tr_matrix(p.wukv, 256, 1024, 1024, (bfu*)(ws + OFF_WUKV), p.kvlat, tl);
    {
        float2* r64 = (float2*)(ws + OFF_ROPE64); float2* r32 = (float2*)(ws + OFF_ROPE32);
        for (int idx = blockIdx.x * NT + threadIdx.x; idx < T * 48; idx += gridDim.x * NT) {
            const int t = idx / 48, i = idx % 48;
            const float invf = (i < 32) ? p.invf64[i] : p.invf32[i - 32];
            const float a = (float)p.pos[t] * invf;
            double rev = (double)a * 0.15915494309189535; rev -= floor(rev);
            const double y = (rev > 0.5 ? rev - 1.0 : rev) * 6.283185307179586;
            const double y2 = y * y; double s = 1.0, c = 1.0;
#pragma unroll
            for (int k = 15; k >= 1; --k) { s = 1.0 - s * y2 * (1.0 / (double)((2 * k) * (2 * k + 1))); c = 1.0 - c * y2 * (1.0 / (double)((2 * k - 1) * (2 * k))); }
            s *= y;
            const float2 o = make_float2((float)c, (float)s);
            if (i < 32) r64[(size_t)t * 32 + i] = o; else r32[(size_t)t * 16 + (i - 32)] = o;
        }
    }
    {
        float* sl = (float*)smem; float* modp = (float*)(ws + OFF_MODP);
        for (int it = blockIdx.x; it < 2 * 12 * 8; it += gridDim.x) {
            const int l = it / 96, cc = (it % 96) / 8, kc = it % 8;
            __syncthreads();
            { const int i = threadIdx.x, b = i >> 7, kk = i & 127; const float cv = p.c[b * 1024 + kc * 128 + kk]; sl[i] = cv / (1.f + __expf(-cv)); }
            __syncthreads();
            const int j = cc * 512 + threadIdx.x;
            const float* w = p.ada_w + ((size_t)l * 1024 + kc * 128) * 6144 + j;
            float a0 = 0.f, a1 = 0.f, a2 = 0.f, a3 = 0.f;
#pragma unroll 8
            for (int kk = 0; kk < 128; ++kk) { const float wv = w[(size_t)kk * 6144]; a0 += sl[kk] * wv; a1 += sl[128 + kk] * wv; a2 += sl[256 + kk] * wv; a3 += sl[384 + kk] * wv; }
            float* o = modp + (size_t)((l * 8 + kc) * 4) * 6144 + j;
            o[0] = a0; o[6144] = a1; o[2 * 6144] = a2; o[3 * 6144] = a3;
        }
        __syncthreads();
    }
}

DI void phase_modfin(const Params& p) {
    const float* modp = (const float*)(p.ws + OFF_MODP); float* mod = (float*)(p.ws + OFF_MOD);
    for (int idx = blockIdx.x * NT + threadIdx.x; idx < 2 * 4 * 6144; idx += gridDim.x * NT) {
        const int l = idx / 24576, rem = idx % 24576, j = rem % 6144;
        float s = p.ada_b[l * 6144 + j];
#pragma unroll
        for (int kc = 0; kc < 8; ++kc) s += modp[(size_t)((l * 8 + kc) * 4) * 6144 + rem];
        mod[idx] = s;
    }
}

DI void phase_normmod(const float* xs, const float* __restrict__ nw, const float* __restrict__ mod, int sh_off, bfu* __restrict__ hb) {
    const int lane = threadIdx.x & 63, gw = blockIdx.x * NW + (threadIdx.x >> 6), nwv = gridDim.x * NW;
    for (int t = gw; t < T; t += nwv) {
        const int b = t >> 13; const float* xr = xs + (size_t)t * 1024;
        float4 v[4]; float ss = 0.f;
#pragma unroll
        for (int i = 0; i < 4; ++i) { v[i] = *(const float4*)(xr + (i * 64 + lane) * 4); ss += v[i].x * v[i].x + v[i].y * v[i].y + v[i].z * v[i].z + v[i].w * v[i].w; }
        ss = wave_sum(ss);
        const float rinv = rsqrtf(ss * (1.f / 1024.f) + EPS);
        const float* mb = mod + b * 6144 + sh_off;
#pragma unroll
        for (int i = 0; i < 4; ++i) {
            const int col = (i * 64 + lane) * 4;
            const float4 w = *(const float4*)(nw + col), sh = *(const float4*)(mb + col), sc = *(const float4*)(mb + 1024 + col);
            const float o0 = v[i].x * rinv * w.x * (1.f + sc.x) + sh.x, o1 = v[i].y * rinv * w.y * (1.f + sc.y) + sh.y;
            const float o2 = v[i].z * rinv * w.z * (1.f + sc.z) + sh.z, o3 = v[i].w * rinv * w.w * (1.f + sc.w) + sh.w;
            *(u32x2*)(hb + (size_t)t * 1024 + col) = (u32x2){pk2(o0, o1), pk2(o2, o3)};
        }
    }
}

template <int EPI>
DI void gemm_tile(const bfu* __restrict__ A, int lda, const bfu* __restrict__ Bt, int K, int m0, int n0, int N,
                  bfu* Cb, int ldc, const float* resid, float* outf, const float* __restrict__ gate, char* smem) {
    constexpr int STG = 512 * 72;
    bfu* S0 = (bfu*)smem;
    const int tid = threadIdx.x, lane = tid & 63, wid = tid >> 6, l32 = lane & 31, hi = lane >> 5;
    const int wm = wid & 3, wn = wid >> 2;
    f32x16 acc[4][2];
#pragma unroll
    for (int nb = 0; nb < 4; ++nb)
#pragma unroll
        for (int mb = 0; mb < 2; ++mb)
#pragma unroll
            for (int r = 0; r < 16; ++r) acc[nb][mb][r] = 0.f;
    const bfu* Ag = A + (size_t)(m0 + (tid >> 3)) * lda + (tid & 7) * 8;
    const bfu* Bg = Bt + (size_t)(n0 + (tid >> 3)) * K + (tid & 7) * 8;
    u32x4 ra[4], rb[4];
#pragma unroll
    for (int i = 0; i < 4; ++i) { ra[i] = *(const u32x4*)(Ag + (size_t)(64 * i) * lda); rb[i] = *(const u32x4*)(Bg + (size_t)(64 * i) * K); }
    const int nk = K >> 6;
    const int wofs = (tid >> 3) * 72 + (tid & 7) * 8;
    const int arofs = (wm * 64 + l32) * 72 + hi * 8, brofs = 256 * 72 + (wn * 128 + l32) * 72 + hi * 8;
    __syncthreads();
#pragma unroll
    for (int i = 0; i < 4; ++i) { *(u32x4*)(S0 + wofs + 64 * i * 72) = ra[i]; *(u32x4*)(S0 + 256 * 72 + wofs + 64 * i * 72) = rb[i]; }
    if (nk > 1) {
#pragma unroll
        for (int i = 0; i < 4; ++i) { ra[i] = *(const u32x4*)(Ag + (size_t)(64 * i) * lda + 64); rb[i] = *(const u32x4*)(Bg + (size_t)(64 * i) * K + 64); }
    }
    __syncthreads();
#pragma unroll 1
    for (int kt = 0; kt < nk; ++kt) {
        const bfu* Sc = S0 + (kt & 1) * STG; bfu* Sn = S0 + ((kt & 1) ^ 1) * STG;
        if (kt + 1 < nk) {
#pragma unroll
            for (int i = 0; i < 4; ++i) { *(u32x4*)(Sn + wofs + 64 * i * 72) = ra[i]; *(u32x4*)(Sn + 256 * 72 + wofs + 64 * i * 72) = rb[i]; }
        }
        __builtin_amdgcn_sched_barrier(0);
        if (kt + 2 < nk) {
            const int ko = (kt + 2) * 64;
#pragma unroll
            for (int i = 0; i < 4; ++i) { ra[i] = *(const u32x4*)(Ag + (size_t)(64 * i) * lda + ko); rb[i] = *(const u32x4*)(Bg + (size_t)(64 * i) * K + ko); }
        }
        __builtin_amdgcn_sched_barrier(0);
#pragma unroll
        for (int k16 = 0; k16 < 4; ++k16) {
            bf16x8 af[2], bfr[4];
#pragma unroll
            for (int mb = 0; mb < 2; ++mb) af[mb] = *(const bf16x8*)(Sc + arofs + mb * 32 * 72 + k16 * 16);
#pragma unroll
            for (int nb = 0; nb < 4; ++nb) bfr[nb] = *(const bf16x8*)(Sc + brofs + nb * 32 * 72 + k16 * 16);
#pragma unroll
            for (int nb = 0; nb < 4; ++nb)
#pragma unroll
                for (int mb = 0; mb < 2; ++mb) acc[nb][mb] = MFMA(bfr[nb], af[mb], acc[nb][mb]);
        }
        __syncthreads();
    }
    if (EPI != 2) {
        constexpr int CP = 264;
        bfu* Cs = (bfu*)smem;
#pragma unroll
        for (int nb = 0; nb < 4; ++nb)
#pragma unroll
            for (int mb = 0; mb < 2; ++mb) {
                const int row = wm * 64 + mb * 32 + l32;
#pragma unroll
                for (int i = 0; i < 4; ++i) {
                    const int col = wn * 128 + nb * 32 + 8 * i + 4 * hi;
                    float v0 = acc[nb][mb][4 * i], v1 = acc[nb][mb][4 * i + 1], v2 = acc[nb][mb][4 * i + 2], v3 = acc[nb][mb][4 * i + 3];
                    if (EPI == 1) { v0 = fmaxf(v0, 0.f); v1 = fmaxf(v1, 0.f); v2 = fmaxf(v2, 0.f); v3 = fmaxf(v3, 0.f); v0 *= v0; v1 *= v1; v2 *= v2; v3 *= v3; }
                    *(u32x2*)(Cs + row * CP + col) = (u32x2){pk2(v0, v1), pk2(v2, v3)};
                }
            }
        __syncthreads();
        const int c8 = (tid & 31) * 8, n = n0 + c8;
#pragma unroll 1
        for (int ps = 0; ps < 16; ++ps) {
            const int row = ps * 16 + (tid >> 5);
            const u32x4 v = *(const u32x4*)(Cs + row * CP + c8);
            if (n < N) *(u32x4*)(Cb + (size_t)(m0 + row) * ldc + n) = v;
        }
        __syncthreads();
    } else {
        constexpr int CPF = 132;
        float* Cs = (float*)smem;
#pragma unroll
        for (int p2 = 0; p2 < 2; ++p2) {
#pragma unroll
            for (int nbl = 0; nbl < 2; ++nbl)
#pragma unroll
                for (int mb = 0; mb < 2; ++mb) {
                    const int row = wm * 64 + mb * 32 + l32;
#pragma unroll
                    for (int i = 0; i < 4; ++i) {
                        const int col = wn * 64 + nbl * 32 + 8 * i + 4 * hi;
                        *(f32x4*)(Cs + row * CPF + col) = (f32x4){acc[2 * p2 + nbl][mb][4 * i], acc[2 * p2 + nbl][mb][4 * i + 1], acc[2 * p2 + nbl][mb][4 * i + 2], acc[2 * p2 + nbl][mb][4 * i + 3]};
                    }
                }
            __syncthreads();
            const int cl = (tid & 31) * 4;
            const int n = n0 + (cl >> 6) * 128 + (2 * p2 + ((cl >> 5) & 1)) * 32 + (cl & 31);
#pragma unroll 1
            for (int ps = 0; ps < 16; ++ps) {
                const int row = ps * 16 + (tid >> 5), m = m0 + row, b = m >> 13;
                const f32x4 v = *(const f32x4*)(Cs + row * CPF + cl);
                const float4 g = *(const float4*)(gate + b * 6144 + n);
                const float4 r = *(const float4*)(resid + (size_t)m * 1024 + n);
                float4 o; o.x = r.x + g.x * v[0]; o.y = r.y + g.y * v[1]; o.z = r.z + g.z * v[2]; o.w = r.w + g.w * v[3];
                *(float4*)(outf + (size_t)m * 1024 + n) = o;
            }
            __syncthreads();
        }
    }
}

DI bool gemm_map(int round, int nsn, int nwt, int& mt, int& nt) {
    const int x = blockIdx.x & 7, li = blockIdx.x >> 3;
    const int st = round * 8 + x;
    if (st >= 16 * nsn || (li >> 3) >= nwt) return false;
    const int sm = st / nsn, sn = st % nsn;
    mt = sm * 8 + (li & 7); nt = sn * nwt + (li >> 3);
    return true;
}
template <int EPI>
DI void phase_gemm(const bfu* A, int lda, const bfu* Bt, int K, int N, int ntn, bfu* Cb, int ldc, const float* resid, float* outf, const float* gate, char* smem) {
    const bool xcd = (gridDim.x == 256);
    const int nwt = (ntn % 4 == 0) ? 4 : ntn, nsn = ntn / nwt;
    const int rounds = xcd ? 2 * nsn : (128 * ntn + (int)gridDim.x - 1) / (int)gridDim.x;
    for (int r = 0; r < rounds; ++r) {
        int mt = 0, nt = 0; bool ok;
        if (xcd) ok = gemm_map(r, nsn, nwt, mt, nt);
        else { const int tile = r * gridDim.x + blockIdx.x; ok = tile < 128 * ntn; mt = tile / ntn; nt = tile % ntn; }
        if (ok) gemm_tile<EPI>(A, lda, Bt, K, mt * 256, nt * 256, N, Cb, ldc, resid, outf, gate, smem);
    }
}


#ifndef MK_PROBE
#define MK_PROBE 0
#endif
#if MK_PROBE
template <int VAR>
DI void gemm_probe(const bfu* __restrict__ A, int lda, const bfu* __restrict__ Bt, int K, int m0, int n0, float* sinkp, int sink, char* smem) {
    constexpr int STG = 512 * 72;
    bfu* S0 = (bfu*)smem;
    const int tid = threadIdx.x, lane = tid & 63, wid = tid >> 6, l32 = lane & 31, hi = lane >> 5;
    const int wm = wid & 3, wn = wid >> 2;
    f32x16 acc[4][2];
#pragma unroll
    for (int nb = 0; nb < 4; ++nb)
#pragma unroll
        for (int mb = 0; mb < 2; ++mb)
#pragma unroll
            for (int r = 0; r < 16; ++r) acc[nb][mb][r] = 0.f;
    const bfu* Ag = A + (size_t)(m0 + (tid >> 3)) * lda + (tid & 7) * 8;
    const bfu* Bg = Bt + (size_t)(n0 + (tid >> 3)) * K + (tid & 7) * 8;
    u32x4 ra[4], rb[4];
#pragma unroll
    for (int i = 0; i < 4; ++i) { ra[i] = *(const u32x4*)(Ag + (size_t)(64 * i) * lda); rb[i] = *(const u32x4*)(Bg + (size_t)(64 * i) * K); }
    const int nk = K >> 6;
    const int wofs = (tid >> 3) * 72 + (tid & 7) * 8;
    const int arofs = (wm * 64 + l32) * 72 + hi * 8, brofs = 256 * 72 + (wn * 128 + l32) * 72 + hi * 8;
    __syncthreads();
#pragma unroll
    for (int i = 0; i < 4; ++i) { *(u32x4*)(S0 + wofs + 64 * i * 72) = ra[i]; *(u32x4*)(S0 + 256 * 72 + wofs + 64 * i * 72) = rb[i]; }
    __syncthreads();
#pragma unroll 1
    for (int kt = 0; kt < nk; ++kt) {
        const bfu* Sc = S0 + (kt & 1) * STG; bfu* Sn = S0 + ((kt & 1) ^ 1) * STG;
        if (VAR != 2 && kt + 1 < nk) {
#pragma unroll
            for (int i = 0; i < 4; ++i) { *(u32x4*)(Sn + wofs + 64 * i * 72) = ra[i]; *(u32x4*)(Sn + 256 * 72 + wofs + 64 * i * 72) = rb[i]; }
        }
        __builtin_amdgcn_sched_barrier(0);
        if (VAR != 1 && VAR != 2 && kt + 2 < nk) {
            const int ko = (kt + 2) * 64;
#pragma unroll
            for (int i = 0; i < 4; ++i) { ra[i] = *(const u32x4*)(Ag + (size_t)(64 * i) * lda + ko); rb[i] = *(const u32x4*)(Bg + (size_t)(64 * i) * K + ko); }
        }
        __builtin_amdgcn_sched_barrier(0);
        if (VAR == 3) {
            bf16x8 af[2], bfr[4];
#pragma unroll
            for (int mb = 0; mb < 2; ++mb) af[mb] = *(const bf16x8*)(Sc + arofs + mb * 32 * 72);
#pragma unroll
            for (int nb = 0; nb < 4; ++nb) bfr[nb] = *(const bf16x8*)(Sc + brofs + nb * 32 * 72);
#pragma unroll
            for (int k16 = 0; k16 < 4; ++k16)
#pragma unroll
                for (int nb = 0; nb < 4; ++nb)
#pragma unroll
                    for (int mb = 0; mb < 2; ++mb) acc[nb][mb] = MFMA(bfr[nb], af[mb], acc[nb][mb]);
        } else {
#pragma unroll
            for (int k16 = 0; k16 < 4; ++k16) {
                bf16x8 af[2], bfr[4];
#pragma unroll
                for (int mb = 0; mb < 2; ++mb) af[mb] = *(const bf16x8*)(Sc + arofs + mb * 32 * 72 + k16 * 16);
#pragma unroll
                for (int nb = 0; nb < 4; ++nb) bfr[nb] = *(const bf16x8*)(Sc + brofs + nb * 32 * 72 + k16 * 16);
#pragma unroll
                for (int nb = 0; nb < 4; ++nb)
#pragma unroll
                    for (int mb = 0; mb < 2; ++mb) acc[nb][mb] = MFMA(bfr[nb], af[mb], acc[nb][mb]);
            }
        }
        __syncthreads();
    }
    if (sink) {
#pragma unroll
        for (int nb = 0; nb < 4; ++nb)
#pragma unroll
            for (int mb = 0; mb < 2; ++mb)
#pragma unroll
                for (int r = 0; r < 16; ++r) sinkp[tid * 128 + (nb * 2 + mb) * 16 + r] = acc[nb][mb][r];
    }
}
template <int VAR>
DI void phase_gemm_probe(const bfu* A, const bfu* Bt, float* sinkp, int sink, char* smem) {
    for (int r = 0; r < 6; ++r) { int mt, nt; if (gemm_map(r, 3, 4, mt, nt)) gemm_probe<VAR>(A, 1024, Bt, 1024, mt * 256, nt * 256, sinkp, sink, smem); }
}
#endif

DI void headnorm64(bfu* hp, const float* __restrict__ w, const float2* __restrict__ cs, float scale, int j, bool acc_on, f32x4& ka1, f32x4& ka2) {
    const u32x2 a = *(const u32x2*)(hp + 4 * j), b = *(const u32x2*)(hp + 32 + 4 * j);
    float x1[4] = {bflo(a[0]), bfhi(a[0]), bflo(a[1]), bfhi(a[1])}, x2[4] = {bflo(b[0]), bfhi(b[0]), bflo(b[1]), bfhi(b[1])};
    float ss = 0.f;
#pragma unroll
    for (int e = 0; e < 4; ++e) ss += x1[e] * x1[e] + x2[e] * x2[e];
    ss += __shfl_xor(ss, 1); ss += __shfl_xor(ss, 2); ss += __shfl_xor(ss, 4);
    const float r = rsqrtf(ss * (1.f / 64.f) + EPS);
    const float4 w1 = *(const float4*)(w + 4 * j), w2 = *(const float4*)(w + 32 + 4 * j);
    const float wa[4] = {w1.x, w1.y, w1.z, w1.w}, wb[4] = {w2.x, w2.y, w2.z, w2.w};
    float o1[4], o2[4];
#pragma unroll
    for (int e = 0; e < 4; ++e) {
        const float y1 = x1[e] * r * wa[e], y2 = x2[e] * r * wb[e]; const float2 c = cs[4 * j + e];
        o1[e] = y1 * c.x - y2 * c.y; o2[e] = y2 * c.x + y1 * c.y;
    }
    if (acc_on) {
#pragma unroll
        for (int e = 0; e < 4; ++e) { ka1[e] += o1[e]; ka2[e] += o2[e]; }
    }
    *(u32x2*)(hp + 4 * j) = (u32x2){pk2(o1[0] * scale, o1[1] * scale), pk2(o1[2] * scale, o1[3] * scale)};
    *(u32x2*)(hp + 32 + 4 * j) = (u32x2){pk2(o2[0] * scale, o2[1] * scale), pk2(o2[2] * scale, o2[3] * scale)};
}

DI float sq4(u32x2 a) { const float x0 = bflo(a[0]), x1 = bfhi(a[0]), x2 = bflo(a[1]), x3 = bfhi(a[1]); return x0 * x0 + x1 * x1 + x2 * x2 + x3 * x3; }

DI void mla_head(u32x4 nv, unsigned x1, unsigned x2, float rn, float rr, const float* __restrict__ wn, int j, float2 csA, float2 csB, float scale, bfu* dst) {
    float f[8] = {bflo(nv[0]) * rn, bfhi(nv[0]) * rn, bflo(nv[1]) * rn, bfhi(nv[1]) * rn, bflo(nv[2]) * rn, bfhi(nv[2]) * rn, bflo(nv[3]) * rn, bfhi(nv[3]) * rn};
    const float a0 = bflo(x1) * rr, a1 = bfhi(x1) * rr, b0 = bflo(x2) * rr, b1 = bfhi(x2) * rr;
    float ss = a0 * a0 + a1 * a1 + b0 * b0 + b1 * b1;
#pragma unroll
    for (int e = 0; e < 8; ++e) ss += f[e] * f[e];
    ss += __shfl_xor(ss, 1); ss += __shfl_xor(ss, 2); ss += __shfl_xor(ss, 4);
    const float r = rsqrtf(ss * (1.f / 96.f) + EPS) * scale;
    const float4 wA = *(const float4*)(wn + 8 * j), wB = *(const float4*)(wn + 8 * j + 4);
    const float wv[8] = {wA.x, wA.y, wA.z, wA.w, wB.x, wB.y, wB.z, wB.w};
#pragma unroll
    for (int e = 0; e < 8; ++e) f[e] *= r * wv[e];
    *(u32x4*)(dst + 8 * j) = (u32x4){pk2(f[0], f[1]), pk2(f[2], f[3]), pk2(f[4], f[5]), pk2(f[6], f[7])};
    const float y10 = a0 * r * wn[64 + 2 * j], y11 = a1 * r * wn[65 + 2 * j], y20 = b0 * r * wn[80 + 2 * j], y21 = b1 * r * wn[81 + 2 * j];
    *(unsigned*)(dst + 64 + 2 * j) = pk2(y10 * csA.x - y20 * csA.y, y11 * csB.x - y21 * csB.y);
    *(unsigned*)(dst + 80 + 2 * j) = pk2(y20 * csA.x + y10 * csA.y, y21 * csB.x + y11 * csB.y);
}

DI void phase_post_even(const Params& p) {
    char* ws = p.ws;
    bfu* ubuf = (bfu*)(ws + OFF_UBUF); const bfu* qraw = (const bfu*)(ws + OFF_HBUF); const bfu* kvraw = (const bfu*)(ws + OFF_OBUF);
    bfu* Qa = (bfu*)p.out; bfu* Ka = Qa + (size_t)T * 768; bfu* Va = Ka + (size_t)T * 768;
    const float2* r64 = (const float2*)(ws + OFF_ROPE64); const float2* r32 = (const float2*)(ws + OFF_ROPE32);
    const int lane = threadIdx.x & 63, gw = blockIdx.x * NW + (threadIdx.x >> 6), nwv = gridDim.x * NW;
    const int h = lane >> 3, j = lane & 7;
    for (int t = gw; t < T; t += nwv) {
        bfu* ur = ubuf + (size_t)t * 3072;
        float ssq = sq4(*(const u32x2*)(ur + lane * 4));
        if (lane < 32) ssq += sq4(*(const u32x2*)(ur + 256 + lane * 4));
        float sskv = sq4(*(const u32x2*)(ur + 384 + lane * 4));
        ssq = wave_sum(ssq); sskv = wave_sum(sskv);
        const float rq = rsqrtf(ssq * (1.f / 384.f) + EPS), rkv = rsqrtf(sskv * (1.f / 256.f) + EPS);
        const float2 csA = r32[(size_t)t * 16 + 2 * j], csB = r32[(size_t)t * 16 + 2 * j + 1];
        {
            const bfu* qr = qraw + (size_t)t * 768 + h * 96;
            mla_head(*(const u32x4*)(qr + 8 * j), *(const unsigned*)(qr + 64 + 2 * j), *(const unsigned*)(qr + 80 + 2 * j), rq, rq, p.mla_qn, j, csA, csB, SC_MLA, Qa + (size_t)t * 768 + h * 96);
        }
        {
            const bfu* kr = kvraw + (size_t)t * 1024 + h * 128;
            mla_head(*(const u32x4*)(kr + 8 * j), *(const unsigned*)(ur + 640 + 2 * j), *(const unsigned*)(ur + 656 + 2 * j), rkv, 1.f, p.mla_kn, j, csA, csB, 1.f, Ka + (size_t)t * 768 + h * 96);
            const u32x4 vv = *(const u32x4*)(kr + 64 + 8 * j);
            *(u32x4*)(Va + (size_t)t * 512 + h * 64 + 8 * j) = (u32x4){pk2(bflo(vv[0]) * rkv, bfhi(vv[0]) * rkv), pk2(bflo(vv[1]) * rkv, bfhi(vv[1]) * rkv),
                                                                      pk2(bflo(vv[2]) * rkv, bfhi(vv[2]) * rkv), pk2(bflo(vv[3]) * rkv, bfhi(vv[3]) * rkv)};
        }
        f32x4 d1, d2;
#pragma unroll
        for (int rd = 0; rd < 3; ++rd) {
            const int hh = rd * 8 + h, which = hh / 12, gh = hh % 12;
            headnorm64(ur + 672 + which * 768 + gh * 64, which ? p.dil_kn : p.dil_qn, r64 + (size_t)t * 32, which ? 1.f : SC_64, j, false, d1, d2);
        }
    }
}

DI void phase_post_odd(const Params& p, char* smem) {
    char* ws = p.ws;
    bfu* ubuf = (bfu*)(ws + OFF_UBUF); const float2* r64 = (const float2*)(ws + OFF_ROPE64); float* kpart = (float*)(ws + OFF_KPART);
    const int tid = threadIdx.x, lane = tid & 63, wid = tid >> 6, h = lane >> 3, j = lane & 7;
    float* red = (float*)smem;
    for (int it = blockIdx.x; it < T / 64; it += gridDim.x) {
        f32x4 ka1 = {0.f, 0.f, 0.f, 0.f}, ka2 = {0.f, 0.f, 0.f, 0.f}, d1, d2;
        for (int tt = 0; tt < 8; ++tt) {
            const int t = it * 64 + wid * 8 + tt;
            bfu* ur = ubuf + (size_t)t * 3072; const float2* cs = r64 + (size_t)t * 32;
            headnorm64(ur + h * 64, p.diff_qn, cs, SC_64, j, false, d1, d2);
            headnorm64(ur + 512 + h * 64, p.diff_kn, cs, 1.f, j, false, d1, d2);
            headnorm64(ur + 1536 + h * 64, p.moba_qn, cs, SC_64, j, false, d1, d2);
            headnorm64(ur + 2048 + h * 64, p.moba_kn, cs, 1.f, j, true, ka1, ka2);
        }
        __syncthreads();
#pragma unroll
        for (int e = 0; e < 4; ++e) { red[(wid * 64 + lane) * 8 + e] = ka1[e]; red[(wid * 64 + lane) * 8 + 4 + e] = ka2[e]; }
        __syncthreads();
        {
            const int o = tid, hh = o >> 6, d = o & 63, jj = (d & 31) >> 2, e = (d & 3) + ((d >> 5) << 2), ln = hh * 8 + jj;
            float sum = 0.f;
#pragma unroll
            for (int w = 0; w < NW; ++w) sum += red[(w * 64 + ln) * 8 + e];
            kpart[(size_t)it * 512 + o] = sum;
        }
    }
    __syncthreads();
}

DI void phase_dil_merge(const Params& p) {
    const bfu* dil_o = (const bfu*)(p.ws + OFF_HBUF); const float* dil_lse = (const float*)(p.ws + OFF_HBUF + 48 * MiB);
    bfu* obuf = (bfu*)(p.ws + OFF_OBUF);
    for (int idx = blockIdx.x * NT + threadIdx.x; idx < T * 64; idx += gridDim.x * NT) {
        const int t = idx >> 6, r = idx & 63, h = r >> 4, jj = r & 15;
        const float l0 = dil_lse[(size_t)t * 12 + h], l1 = dil_lse[(size_t)t * 12 + 4 + h], l2 = dil_lse[(size_t)t * 12 + 8 + h];
        const float mx = fmaxf(l0, fmaxf(l1, l2));
        float w0 = exp2f(l0 - mx), w1 = exp2f(l1 - mx), w2 = exp2f(l2 - mx); const float inv = 1.f / (w0 + w1 + w2); w0 *= inv; w1 *= inv; w2 *= inv;
        const u32x2 a = *(const u32x2*)(dil_o + (size_t)t * 768 + h * 64 + 4 * jj), b = *(const u32x2*)(dil_o + (size_t)t * 768 + (4 + h) * 64 + 4 * jj),
                    c = *(const u32x2*)(dil_o + (size_t)t * 768 + (8 + h) * 64 + 4 * jj);
        const float o0 = w0 * bflo(a[0]) + w1 * bflo(b[0]) + w2 * bflo(c[0]), o1 = w0 * bfhi(a[0]) + w1 * bfhi(b[0]) + w2 * bfhi(c[0]);
        const float o2 = w0 * bflo(a[1]) + w1 * bflo(b[1]) + w2 * bflo(c[1]), o3 = w0 * bfhi(a[1]) + w1 * bfhi(b[1]) + w2 * bfhi(c[1]);
        *(u32x2*)(obuf + (size_t)t * 768 + 512 + h * 64 + 4 * jj) = (u32x2){pk2(o0, o1), pk2(o2, o3)};
    }
}

DI void phase_diff_combine(const Params& p) {
    const bfu* dbuf = (const bfu*)(p.ws + OFF_DBUF); bfu* obuf = (bfu*)(p.ws + OFF_OBUF);
    const int lane = threadIdx.x & 63, gw = blockIdx.x * NW + (threadIdx.x >> 6), nwv = gridDim.x * NW;
    float lam;
    {
        const float sa = wave_sum(p.diff_lam[lane] * p.diff_lam[64 + lane]), sb = wave_sum(p.diff_lam[128 + lane] * p.diff_lam[192 + lane]);
        lam = expf(sa) - expf(sb) + LAM_INIT;
    }
    const int h = lane >> 4, jj = lane & 15;
    const float4 sA = *(const float4*)(p.diff_subln + 8 * jj), sB = *(const float4*)(p.diff_subln + 8 * jj + 4);
    const float sw[8] = {sA.x, sA.y, sA.z, sA.w, sB.x, sB.y, sB.z, sB.w};
    for (int t = gw; t < T; t += nwv) {
        const u32x4 a = *(const u32x4*)(dbuf + (size_t)t * 1024 + (2 * h) * 128 + 8 * jj), b = *(const u32x4*)(dbuf + (size_t)t * 1024 + (2 * h + 1) * 128 + 8 * jj);
        float d[8];
#pragma unroll
        for (int e = 0; e < 4; ++e) { d[2 * e] = bflo(a[e]) - lam * bflo(b[e]); d[2 * e + 1] = bfhi(a[e]) - lam * bfhi(b[e]); }
        float ss = 0.f;
#pragma unroll
        for (int e = 0; e < 8; ++e) ss += d[e] * d[e];
        ss += __shfl_xor(ss, 1); ss += __shfl_xor(ss, 2); ss += __shfl_xor(ss, 4); ss += __shfl_xor(ss, 8);
        const float r = rsqrtf(ss * (1.f / 128.f) + EPS) * (1.f - LAM_INIT);
#pragma unroll
        for (int e = 0; e < 8; ++e) d[e] *= r * sw[e];
        *(u32x4*)(obuf + (size_t)t * 1024 + h * 128 + 8 * jj) = (u32x4){pk2(d[0], d[1]), pk2(d[2], d[3]), pk2(d[4], d[5]), pk2(d[6], d[7])};
    }
}

struct Top3 { float v0, v1, v2; int i0, i1, i2; };
DI Top3 top3_ins(Top3 t, float v, int i) {
    const bool g0 = (v > t.v0) || (v == t.v0 && i < t.i0), g1 = (v > t.v1) || (v == t.v1 && i < t.i1), g2 = (v > t.v2) || (v == t.v2 && i < t.i2);
    Top3 r;
    r.v2 = g1 ? t.v1 : (g2 ? v : t.v2); r.i2 = g1 ? t.i1 : (g2 ? i : t.i2);
    r.v1 = g0 ? t.v0 : (g1 ? v : t.v1); r.i1 = g0 ? t.i0 : (g1 ? i : t.i1);
    r.v0 = g0 ? v : t.v0; r.i0 = g0 ? i : t.i0;
    return r;
}

template <int DK, int DV, int MODE>
DI void attn_item(const bfu* __restrict__ Qp, int qp, const bfu* __restrict__ Kp, int kp, const bfu* __restrict__ Vp, int vp,
                  long rowbase, int rs, int q0, bfu* __restrict__ Op, int op, float* __restrict__ lsep, int lsest,
                  const float* __restrict__ kpart, char* smem) {
    constexpr int KPT = DK + 8, KCH = DK / 8, VCH = DV / 8, NKL = (64 * KCH + NT - 1) / NT, NVL = 64 * VCH / NT, NDV = DV / 32, ND0 = DK / 16;
    constexpr int KST = 64 * KPT, VST = 64 * DV;
    bfu* Ks = (bfu*)smem; bfu* Vs = Ks + 2 * KST;
    short* tlist = (short*)(Vs + 2 * VST);
    int* misc = (int*)(tlist + 192);
    float* km = (float*)(misc + 4);
    unsigned* selm = (unsigned*)(km + 2048);
    float* cand = (float*)(selm + 256);
    const int tid = threadIdx.x, lane = tid & 63, wid = tid >> 6, l32 = lane & 31, hi = lane >> 5;
    const int qw = q0 + wid * 32, qstep = qw + l32;
    unsigned mysel = 0;
    if (MODE == 2) {
        const int nb = q0 >> 8;
        for (int idx = tid; idx < nb * 64; idx += NT) {
            const int blk = idx >> 6, d = idx & 63; const float* kq = kpart + (size_t)(blk * 4) * 512 + d;
            km[idx] = (kq[0] + kq[512] + kq[1024] + kq[1536]) * (1.f / 256.f);
        }
        if (tid == 0) misc[1] = 0;
        __syncthreads();
        {
            const int qq = tid & 255, hf = tid >> 8;
            const bfu* qr = Qp + (size_t)(rowbase + q0 + qq) * qp;
            float qv[64];
#pragma unroll
            for (int c8 = 0; c8 < 8; ++c8) {
                const u32x4 w = *(const u32x4*)(qr + c8 * 8);
#pragma unroll
                for (int e = 0; e < 4; ++e) { qv[c8 * 8 + 2 * e] = bflo(w[e]); qv[c8 * 8 + 2 * e + 1] = bfhi(w[e]); }
            }
            Top3 tp; tp.v0 = -3e38f; tp.v1 = -3e38f; tp.v2 = -3e38f; tp.i0 = 64; tp.i1 = 64; tp.i2 = 64;
            for (int blk = hf; blk < nb; blk += 2) {
                float g = 0.f;
#pragma unroll
                for (int d = 0; d < 64; ++d) g += qv[d] * km[blk * 64 + d];
                tp = top3_ins(tp, g, blk);
            }
            cand[tid * 6 + 0] = tp.v0; cand[tid * 6 + 1] = tp.v1; cand[tid * 6 + 2] = tp.v2;
            cand[tid * 6 + 3] = __int_as_float(tp.i0); cand[tid * 6 + 4] = __int_as_float(tp.i1); cand[tid * 6 + 5] = __int_as_float(tp.i2);
        }
        __syncthreads();
        if (tid < 256) {
            Top3 tp; tp.v0 = cand[tid * 6]; tp.v1 = cand[tid * 6 + 1]; tp.v2 = cand[tid * 6 + 2];
            tp.i0 = __float_as_int(cand[tid * 6 + 3]); tp.i1 = __float_as_int(cand[tid * 6 + 4]); tp.i2 = __float_as_int(cand[tid * 6 + 5]);
            const int o = (tid + 256) * 6;
#pragma unroll
            for (int e = 0; e < 3; ++e) { const int ii = __float_as_int(cand[o + 3 + e]); tp = top3_ins(tp, cand[o + e], ii); }
            unsigned mk = 0;
            if (tp.i0 < 32) mk |= 1u << tp.i0;
            if (tp.i1 < 32) mk |= 1u << tp.i1;
            if (tp.i2 < 32) mk |= 1u << tp.i2;
            selm[tid] = mk;
            atomicOr((unsigned*)&misc[1], mk);
        }
        __syncthreads();
        mysel = selm[wid * 32 + l32];
    }
    if (MODE == 0) { const int last = (q0 >> 6) + 3; for (int jx = tid; jx <= last; jx += NT) tlist[jx] = (short)jx; if (tid == 0) misc[0] = last + 1; }
    if (MODE == 1) { const int last = (q0 >> 6) + 3, first = (q0 >> 6) >= 2 ? (q0 >> 6) - 2 : 0; if (tid == 0) { int n = 0; for (int jx = first; jx <= last; ++jx) tlist[n++] = (short)jx; misc[0] = n; } }
    if (MODE == 2) {
        if (tid == 0) {
            const unsigned om = (unsigned)misc[1]; const int nb = q0 >> 8; int n = 0;
            for (int blk = 0; blk < nb; ++blk) if ((om >> blk) & 1u) { tlist[n++] = (short)(blk * 4); tlist[n++] = (short)(blk * 4 + 1); tlist[n++] = (short)(blk * 4 + 2); tlist[n++] = (short)(blk * 4 + 3); }
            for (int jx = nb * 4; jx <= nb * 4 + 3; ++jx) tlist[n++] = (short)jx;
            misc[0] = n;
        }
    }
    __syncthreads();
    const int nt = misc[0];
    bf16x8 qf[ND0];
    {
        const bfu* qr = Qp + (size_t)(rowbase + (long)qstep * rs) * qp + hi * 8;
#pragma unroll
        for (int d0 = 0; d0 < ND0; ++d0) qf[d0] = *(const bf16x8*)(qr + d0 * 16);
    }
    float m = 0.f, l = 0.f; bool started = false;
    f32x16 o[NDV];
#pragma unroll
    for (int dvb = 0; dvb < NDV; ++dvb)
#pragma unroll
        for (int r = 0; r < 16; ++r) o[dvb][r] = 0.f;
    int krow[NKL], kch[NKL], vrow[NVL], vch[NVL];
#pragma unroll
    for (int i = 0; i < NKL; ++i) { const int id = tid + NT * i; krow[i] = id / KCH; kch[i] = id % KCH; }
#pragma unroll
    for (int i = 0; i < NVL; ++i) { const int id = tid + NT * i; vrow[i] = id / VCH; vch[i] = id % VCH; }
    u32x4 rk[NKL], rv[NVL];
#define ATT_LOAD(JJ) do { const int j_ = (JJ); \
    _Pragma("unroll") for (int i = 0; i < NKL; ++i) if (tid + NT * i < 64 * KCH) rk[i] = *(const u32x4*)(Kp + (size_t)(rowbase + (long)(j_ * 64 + krow[i]) * rs) * kp + kch[i] * 8); \
    _Pragma("unroll") for (int i = 0; i < NVL; ++i) rv[i] = *(const u32x4*)(Vp + (size_t)(rowbase + (long)(j_ * 64 + vrow[i]) * rs) * vp + vch[i] * 8); } while (0)
#define ATT_STORE(ST) do { bfu* ks_ = Ks + (ST) * KST; bfu* vs_ = Vs + (ST) * VST; \
    _Pragma("unroll") for (int i = 0; i < NKL; ++i) if (tid + NT * i < 64 * KCH) *(u32x4*)(ks_ + krow[i] * KPT + kch[i] * 8) = rk[i]; \
    _Pragma("unroll") for (int i = 0; i < NVL; ++i) *(u32x4*)(vs_ + (vch[i] >> 2) * 2048 + vrow[i] * 32 + (vch[i] & 3) * 8) = rv[i]; } while (0)
    ATT_LOAD(tlist[0]);
    ATT_STORE(0);
    if (nt > 1) ATT_LOAD(tlist[1]);
    __syncthreads();
    const lds_cptr vb0 = (lds_cptr)Vs + ((lane >> 4) & 1) * 32 + (lane & 3) * 8 + (4 * hi + ((lane & 15) >> 2)) * 64;
    const bfu* ksr0 = Ks + l32 * KPT + hi * 8;
    for (int it = 0; it < nt; ++it) {
        const int cur = it & 1;
        const int jc = tlist[it];
        if (it + 1 < nt) ATT_STORE(cur ^ 1);
        if (it + 2 < nt) ATT_LOAD(tlist[it + 2]);
        __builtin_amdgcn_sched_barrier(0);
        bool need;
        if (MODE == 1) need = (jc * 64 <= qw + 31) && (jc * 64 + 63 >= qw - 128);
        else {
            need = (jc * 64 <= qw + 31);
            if (MODE == 2) { const int blk = jc >> 2; if (blk < (q0 >> 8)) need = __any((mysel >> blk) & 1u) != 0; }
        }
        if (need) {
            const bfu* ksr = ksr0 + cur * KST; const lds_cptr vb = vb0 + cur * (VST * 2);
            f32x16 s0, s1;
            const float negm = -m;
#pragma unroll
            for (int r = 0; r < 16; ++r) { s0[r] = negm; s1[r] = negm; }
#pragma unroll
            for (int d0 = 0; d0 < ND0; ++d0) {
                const bf16x8 k0 = *(const bf16x8*)(ksr + d0 * 16), k1 = *(const bf16x8*)(ksr + 32 * KPT + d0 * 16);
                s0 = MFMA(k0, qf[d0], s0); s1 = MFMA(k1, qf[d0], s1);
            }
            const int kbase = jc * 64 + 4 * hi;
            if (MODE == 1) {
#pragma unroll
                for (int r = 0; r < 16; ++r) {
                    const int dd = qstep - (kbase + (r & 3) + 8 * (r >> 2));
                    if (dd < 0 || dd > 128) s0[r] = -INFINITY;
                    if (dd - 32 < 0 || dd - 32 > 128) s1[r] = -INFINITY;
                }
            } else {
                if (jc * 64 + 63 > qw) {
#pragma unroll
                    for (int r = 0; r < 16; ++r) {
                        const int ks = kbase + (r & 3) + 8 * (r >> 2);
                        if (ks > qstep) s0[r] = -INFINITY;
                        if (ks + 32 > qstep) s1[r] = -INFINITY;
                    }
                }
                if (MODE == 2) {
                    const int blk = jc >> 2;
                    if (blk < (q0 >> 8) && !((mysel >> blk) & 1u)) {
#pragma unroll
                        for (int r = 0; r < 16; ++r) { s0[r] = -INFINITY; s1[r] = -INFINITY; }
                    }
                }
            }
            float mx = fmaxf(s0[0], s1[0]);
#pragma unroll
            for (int r = 1; r < 16; ++r) mx = fmaxf(mx, fmaxf(s0[r], s1[r]));
            mx = fmaxf(mx, __shfl_xor(mx, 32));
            if (!started || __any(mx > 8.f)) {
                float delta = started ? fmaxf(mx, 0.f) : mx;
                if (!(delta > -1e30f)) delta = 0.f;
                m += delta;
                const float alpha = __builtin_amdgcn_exp2f(-delta);
                l *= alpha;
#pragma unroll
                for (int r = 0; r < 16; ++r) { s0[r] -= delta; s1[r] -= delta; }
#pragma unroll
                for (int dvb = 0; dvb < NDV; ++dvb)
#pragma unroll
                    for (int r = 0; r < 16; ++r) o[dvb][r] *= alpha;
                started = true;
            }
            float ps = 0.f;
#pragma unroll
            for (int r = 0; r < 16; ++r) { s0[r] = __builtin_amdgcn_exp2f(s0[r]); s1[r] = __builtin_amdgcn_exp2f(s1[r]); ps += s0[r] + s1[r]; }
            l += ps;
            bf16x8 pf[4];
            pf[0] = __builtin_bit_cast(bf16x8, (u32x4){pk2(s0[0], s0[1]), pk2(s0[2], s0[3]), pk2(s0[4], s0[5]), pk2(s0[6], s0[7])});
            pf[1] = __builtin_bit_cast(bf16x8, (u32x4){pk2(s0[8], s0[9]), pk2(s0[10], s0[11]), pk2(s0[12], s0[13]), pk2(s0[14], s0[15])});
            pf[2] = __builtin_bit_cast(bf16x8, (u32x4){pk2(s1[0], s1[1]), pk2(s1[2], s1[3]), pk2(s1[4], s1[5]), pk2(s1[6], s1[7])});
            pf[3] = __builtin_bit_cast(bf16x8, (u32x4){pk2(s1[8], s1[9]), pk2(s1[10], s1[11]), pk2(s1[12], s1[13]), pk2(s1[14], s1[15])});
#pragma unroll
            for (int sx = 0; sx < 4; ++sx)
#pragma unroll
                for (int dvb = 0; dvb < NDV; ++dvb) {
                    const s16x4 lo = vtr(vb + dvb * 4096 + sx * 1024), hh = vtr(vb + dvb * 4096 + sx * 1024 + 512);
                    const bf16x8 vf = (bf16x8){lo[0], lo[1], lo[2], lo[3], hh[0], hh[1], hh[2], hh[3]};
                    o[dvb] = MFMA(vf, pf[sx], o[dvb]);
                }
        }
        __syncthreads();
    }
#undef ATT_LOAD
#undef ATT_STORE
    l += __shfl_xor(l, 32);
    const float inv = 1.f / l;
    const size_t tok = (size_t)(rowbase + (long)qstep * rs);
#pragma unroll
    for (int dvb = 0; dvb < NDV; ++dvb)
#pragma unroll
        for (int i = 0; i < 4; ++i) {
            const int dv = dvb * 32 + 8 * i + 4 * hi;
            *(u32x2*)(Op + tok * op + dv) = (u32x2){pk2(o[dvb][4 * i] * inv, o[dvb][4 * i + 1] * inv), pk2(o[dvb][4 * i + 2] * inv, o[dvb][4 * i + 3] * inv)};
        }
    if (MODE == 1) { if (hi == 0) lsep[tok * lsest] = m + __builtin_amdgcn_logf(l); }
}

DI void phase_attn_even(const Params& p, char* smem, int* s_item, int rep) {
    char* ws = p.ws;
    const bfu* ubuf = (const bfu*)(ws + OFF_UBUF);
    const bfu* Qa = (const bfu*)p.out; const bfu* Ka = Qa + (size_t)T * 768; const bfu* Va = Ka + (size_t)T * 768;
    bfu* obuf = (bfu*)(ws + OFF_OBUF); bfu* dil_o = (bfu*)(ws + OFF_HBUF); float* dil_lse = (float*)(ws + OFF_HBUF + 48 * MiB);
    const int nblk = gridDim.x;
    for (int it = blockIdx.x; it < 1024; it += nblk) {
        int bh, qt;
        if (nblk == 256) { const int x = blockIdx.x & 7, li = blockIdx.x >> 3, hs = it >> 8; bh = x + 8 * hs; qt = (hs & 1) ? li : 31 - li; }
        else { bh = it & 31; qt = 31 - (it >> 5); }
        const int b = bh >> 3, h = bh & 7;
        __syncthreads();
        attn_item<96, 64, 0>(Qa + h * 96, 768, Ka + h * 96, 768, Va + h * 64, 512, (long)b * SEQ, 1, qt * 256, obuf + h * 64, 768, nullptr, 0, nullptr, smem);
    }
    for (int i2 = blockIdx.x; i2 < 1536; i2 += nblk) {
        const int g = i2 >> 9, r2 = i2 & 511, h = r2 & 3, b = (r2 >> 2) & 3, qi = r2 >> 4;
        const int rr = (g == 0) ? 1 : (g == 1 ? 4 : 16), tpc = 32 / rr, cls = qi / tpc, st = qi % tpc;
        const int gh = g * 4 + h;
        __syncthreads();
        attn_item<64, 64, 1>(ubuf + 672 + gh * 64, 3072, ubuf + 672 + 768 + gh * 64, 3072, ubuf + 672 + 1536 + gh * 64, 3072, (long)b * SEQ + cls, rr, st * 256,
                             dil_o + gh * 64, 768, dil_lse + gh, 12, nullptr, smem);
    }
}
DI void phase_attn_odd(const Params& p, char* smem, int* s_item, int rep) {
    char* ws = p.ws;
    const bfu* ubuf = (const bfu*)(ws + OFF_UBUF);
    bfu* obuf = (bfu*)(ws + OFF_OBUF); bfu* dbuf = (bfu*)(ws + OFF_DBUF); const float* kpart = (const float*)(ws + OFF_KPART);
    const int nblk = gridDim.x;
    for (int it = blockIdx.x; it < 2048; it += nblk) {
        int bh, qt, kind;
        if (nblk == 256) { const int x = blockIdx.x & 7, li = blockIdx.x >> 3, hs = it >> 8; kind = hs >> 2; bh = x + 8 * (hs & 3); qt = (hs & 1) ? li : 31 - li; }
        else { kind = (it >> 5) & 1; bh = it & 31; qt = 31 - (it >> 6); }
        const int b = bh >> 3, hh = bh & 7;
        __syncthreads();
        if (kind == 0) {
            attn_item<64, 128, 0>(ubuf + hh * 64, 3072, ubuf + 512 + hh * 64, 3072, ubuf + 1024 + (hh >> 1) * 128, 3072, (long)b * SEQ, 1, qt * 256,
                                  dbuf + hh * 128, 1024, nullptr, 0, nullptr, smem);
        } else {
            attn_item<64, 64, 2>(ubuf + 1536 + hh * 64, 3072, ubuf + 2048 + hh * 64, 3072, ubuf + 2560 + hh * 64, 3072, (long)b * SEQ, 1, qt * 256,
                                 obuf + 512 + hh * 64, 1024, nullptr, 0, kpart + (size_t)b * (32 * 4 * 512) + hh * 64, smem);
        }
    }
}

#define XB_TMO      128
#define XB_XCNT(j)  (256  + 64 * (j))
#define XB_XSUB(j)  (1280 + 64 * (j))
#define XB_XGEN(j)  (2304 + 64 * (j))
#define XB_TOP      3328
#define XB_TOPGEN   3392
#define XCD_BAR_WORDS 3456
#define XB_SPIN_CAP (1u << 18)
#define LAS __attribute__((address_space(3)))

__device__ __forceinline__ unsigned xb_ld(unsigned* p)              { return __hip_atomic_load(p, __ATOMIC_RELAXED, __HIP_MEMORY_SCOPE_AGENT); }
__device__ __forceinline__ unsigned xb_add(unsigned* p, unsigned v) { return __hip_atomic_fetch_add(p, v, __ATOMIC_RELAXED, __HIP_MEMORY_SCOPE_AGENT); }
__device__ __forceinline__ unsigned xb_xcc_id() { return (unsigned)__builtin_amdgcn_s_getreg((3 << 11) | 20) & 0xFu; }
#define XB_SPIN(cond, bar) do { unsigned _sp = 0; while (cond) { __builtin_amdgcn_s_sleep(1); \
    if ((++_sp & 255u) == 0u) { if (xb_ld(&(bar)[XB_TMO])) break; if (_sp > XB_SPIN_CAP) { atomicAdd(&(bar)[XB_TMO], 1u); break; } } } } while (0)

struct XcdBarrier {
    unsigned* bar; unsigned x;
    volatile LAS unsigned* st;
};

__device__ __forceinline__ XcdBarrier xcd_barrier_post(unsigned* bar, volatile LAS unsigned* st) {
    XcdBarrier b; b.bar = bar; b.x = xb_xcc_id(); b.st = st;
    if (threadIdx.x == 0) (void)xb_add(&bar[XB_XCNT(b.x)], 1u);
    return b;
}
__device__ __forceinline__ void xcd_barrier_complete(unsigned* bar, unsigned x, unsigned& nloc, unsigned& nx) {
    const unsigned G = gridDim.x * gridDim.y * gridDim.z;
    unsigned sum, cnt, mine, sp = 0u;
    for (;;) {
        sum = 0u; cnt = 0u; mine = 0u;
#pragma unroll
        for (unsigned j = 0; j < 16; ++j) { const unsigned c = xb_ld(&bar[XB_XCNT(j)]); sum += c; cnt += (c > 0u) ? 1u : 0u; mine = (j == x) ? c : mine; }
        if (sum == G) break;
        __builtin_amdgcn_s_sleep(1);
        if ((++sp & 255u) == 0u) { if (xb_ld(&bar[XB_TMO])) break; if (sp > XB_SPIN_CAP) { atomicAdd(&bar[XB_TMO], 1u); break; } }
    }
    nloc = mine > 0u ? mine : 1u; nx = cnt > 0u ? cnt : 1u;
}

__device__ __forceinline__ void xcd_barrier(const XcdBarrier& b) {
    asm volatile("s_waitcnt vmcnt(0)" ::: "memory");
    __syncthreads();
    if (threadIdx.x == 0) {
        unsigned* bar = b.bar;
        __builtin_amdgcn_s_waitcnt(0);
        unsigned nloc = b.st[0], nx = b.st[1];
        if (nloc == 0u) { xcd_barrier_complete(bar, b.x, nloc, nx); b.st[0] = nloc; b.st[1] = nx; }
        const unsigned old = xb_add(&bar[XB_XSUB(b.x)], 1u);
        const unsigned gen = old / nloc;
        if (old + 1u == (gen + 1u) * nloc) {
            __builtin_amdgcn_fence(__ATOMIC_RELEASE, "agent");
            asm volatile("s_waitcnt vmcnt(0)" ::: "memory");
            const unsigned og = xb_add(&bar[XB_TOP], 1u);
            const unsigned tg = og / nx;
            if (og + 1u == (tg + 1u) * nx) xb_add(&bar[XB_TOPGEN], 1u);
            else XB_SPIN(xb_ld(&bar[XB_TOPGEN]) == tg, bar);
            __builtin_amdgcn_fence(__ATOMIC_ACQUIRE, "agent");
            xb_add(&bar[XB_XGEN(b.x)], 1u);
            asm volatile("s_waitcnt vmcnt(0)" ::: "memory");
        } else {
            XB_SPIN(xb_ld(&bar[XB_XGEN(b.x)]) == gen, bar);
            __builtin_amdgcn_fence(__ATOMIC_ACQUIRE, "agent");
            asm volatile("s_waitcnt vmcnt(0)" ::: "memory");
        }
    }
    __syncthreads();
}

#ifndef MK_REPMASK
#define MK_REPMASK 0u
#endif
#define PHASE_BEGIN(k) if (p.phase_lo <= (k) && (k) < p.phase_hi) { for (int rep_ = 0; rep_ < (((MK_REPMASK >> (k)) & 1u) ? 2 : 1); ++rep_) {
#define PHASE_MID(k) if (rep_ == 0 && ((MK_REPMASK >> (k)) & 1u)) xcd_barrier(xb); }
#define PHASE_END(k) PHASE_MID(k) if (p.coop && (k) + 1 < p.phase_hi) xcd_barrier(xb); }
__global__ void __launch_bounds__(512) mega(Params p) {
    extern __shared__ __attribute__((aligned(16))) char smem[];
    __shared__ int s_item;
    __shared__ uint4 xb_words;
    char* ws = p.ws;
    if (threadIdx.x == 0) xb_words = make_uint4(0u, 0u, 0u, 0u);
    __syncthreads();
    XcdBarrier xb = xcd_barrier_post((unsigned*)(ws + OFF_CTR + 4096), (volatile LAS unsigned*)&xb_words);
    bfu* hbuf = (bfu*)(ws + OFF_HBUF); bfu* obuf = (bfu*)(ws + OFF_OBUF); bfu* ubuf = (bfu*)(ws + OFF_UBUF); bfu* hid = ubuf;
    const float* mod0 = (const float*)(ws + OFF_MOD); const float* mod1 = mod0 + 4 * 6144;
    PHASE_BEGIN(0) phase_prep(p, smem); PHASE_END(0)
    PHASE_BEGIN(1) phase_modfin(p); PHASE_END(1)
    PHASE_BEGIN(2) phase_normmod(p.x, p.norm_mix, mod0, 0, hbuf); PHASE_END(2)
    PHASE_BEGIN(3) phase_gemm<0>(hbuf, 1024, (const bfu*)(ws + OFF_WIN0), 1024, 2976, 12, ubuf, 3072, nullptr, nullptr, nullptr, smem); PHASE_END(3)
#if MK_PROBE
    if (p.coop) { phase_gemm_probe<MK_PROBE - 1>(hbuf, (const bfu*)(ws + OFF_WIN0), (float*)(ws + OFF_DBUF), p.pad_, smem); xcd_barrier(xb); }
#endif
    PHASE_BEGIN(4)
            phase_gemm<0>(ubuf, 3072, (const bfu*)(ws + OFF_WUQ), 384, 768, 3, hbuf, 768, nullptr, nullptr, nullptr, smem);
            phase_gemm<0>(ubuf + 384, 3072, (const bfu*)(ws + OFF_WUKV), 256, 1024, 4, obuf, 1024, nullptr, nullptr, nullptr, smem);
    PHASE_END(4)
    PHASE_BEGIN(5) phase_post_even(p); PHASE_END(5)
    PHASE_BEGIN(6) phase_attn_even(p, smem, &s_item, rep_); PHASE_END(6)
    PHASE_BEGIN(7) phase_dil_merge(p); PHASE_END(7)
    PHASE_BEGIN(8) phase_gemm<2>(obuf, 768, (const bfu*)(ws + OFF_WOUT0), 768, 1024, 4, nullptr, 0, p.x, p.out, mod0 + 2048, smem); PHASE_END(8)
    PHASE_BEGIN(9) phase_normmod(p.out, p.norm_mlp, mod0, 3072, hbuf); PHASE_END(9)
    PHASE_BEGIN(10) phase_gemm<1>(hbuf, 1024, (const bfu*)(ws + OFF_W1_0), 1024, 4096, 16, hid, 4096, nullptr, nullptr, nullptr, smem); PHASE_END(10)
    PHASE_BEGIN(11) phase_gemm<2>(hid, 4096, (const bfu*)(ws + OFF_W2_0), 4096, 1024, 4, nullptr, 0, p.out, p.out, mod0 + 5120, smem); PHASE_END(11)
    PHASE_BEGIN(12) phase_normmod(p.out, p.norm_mix + 1024, mod1, 0, hbuf); PHASE_END(12)
    PHASE_BEGIN(13) phase_gemm<0>(hbuf, 1024, (const bfu*)(ws + OFF_WIN1), 1024, 3072, 12, ubuf, 3072, nullptr, nullptr, nullptr, smem); PHASE_END(13)
    PHASE_BEGIN(14) phase_post_odd(p, smem); PHASE_END(14)
    PHASE_BEGIN(15) phase_attn_odd(p, smem, &s_item, rep_); PHASE_END(15)
    PHASE_BEGIN(16) phase_diff_combine(p); PHASE_END(16)
    PHASE_BEGIN(17) phase_gemm<2>(obuf, 1024, (const bfu*)(ws + OFF_WOUT1), 1024, 1024, 4, nullptr, 0, p.out, p.out, mod1 + 2048, smem); PHASE_END(17)
    PHASE_BEGIN(18) phase_normmod(p.out, p.norm_mlp + 1024, mod1, 3072, hbuf); PHASE_END(18)
    PHASE_BEGIN(19) phase_gemm<1>(hbuf, 1024, (const bfu*)(ws + OFF_W1_1), 1024, 4096, 16, hid, 4096, nullptr, nullptr, nullptr, smem); PHASE_END(19)
    PHASE_BEGIN(20) phase_gemm<2>(hid, 4096, (const bfu*)(ws + OFF_W2_1), 4096, 1024, 4, nullptr, 0, p.out, p.out, mod1 + 5120, smem); PHASE_END(20)
    if (p.coop == 2) cg::this_grid().sync();
}

extern "C" void kernel_launch(void* const* d_in, const int* in_sizes, int n_in, void* d_out, int out_size, void* d_ws, size_t ws_size, hipStream_t stream) {
    static int grid_blocks = 0;
    if (!grid_blocks) {
        int dev = 0, cus = 0, per_cu = 0;
        (void)hipGetDevice(&dev);
        (void)hipDeviceGetAttribute(&cus, hipDeviceAttributeMultiprocessorCount, dev);
        (void)hipFuncSetAttribute((const void*)mega, hipFuncAttributeMaxDynamicSharedMemorySize, DYN_LDS);
        (void)hipOccupancyMaxActiveBlocksPerMultiprocessor(&per_cu, mega, NT, DYN_LDS);
        if (per_cu != 1) per_cu = 1;
        grid_blocks = cus * per_cu;
    }
    if (ws_size < WS_END) fprintf(stderr, "workspace too small: %zu < %zu\n", ws_size, (size_t)WS_END);
    Params p{};
    p.x = (const float*)d_in[0]; p.c = (const float*)d_in[1]; p.pos = (const int*)d_in[2];
    p.ada_w = (const float*)d_in[3]; p.ada_b = (const float*)d_in[4]; p.norm_mix = (const float*)d_in[5]; p.norm_mlp = (const float*)d_in[6];
    p.w1 = (const float*)d_in[7]; p.w2 = (const float*)d_in[8]; p.e_win = (const float*)d_in[9]; p.e_wout = (const float*)d_in[10];
    p.qlat = (const float*)d_in[11]; p.kvlat = (const float*)d_in[12]; p.wuq = (const float*)d_in[13]; p.wukv = (const float*)d_in[14];
    p.mla_qn = (const float*)d_in[15]; p.mla_kn = (const float*)d_in[16]; p.dil_qn = (const float*)d_in[17]; p.dil_kn = (const float*)d_in[18];
    p.o_win = (const float*)d_in[19]; p.o_wout = (const float*)d_in[20]; p.diff_qn = (const float*)d_in[21]; p.diff_kn = (const float*)d_in[22];
    p.diff_lam = (const float*)d_in[23]; p.diff_subln = (const float*)d_in[24]; p.moba_qn = (const float*)d_in[25]; p.moba_kn = (const float*)d_in[26];
    p.out = (float*)d_out; p.ws = (char*)d_ws;
    for (int i = 0; i < 32; ++i) p.invf64[i] = (float)pow(10000.0, -(double)i / 32.0);
    for (int i = 0; i < 16; ++i) p.invf32[i] = (float)pow(10000.0, -(double)i / 16.0);
    (void)hipMemsetAsync((char*)d_ws + OFF_CTR, 0, 32768, stream);
#if MK_COOP
    p.phase_lo = 0; p.phase_hi = NPH; p.coop = 1;
    void* args[] = {&p};
    hipError_t e = hipLaunchCooperativeKernel((void*)mega, dim3(grid_blocks), dim3(NT), args, DYN_LDS, stream);
    if (e != hipSuccess) fprintf(stderr, "cooperative launch failed: %s (grid %d)\n", hipGetErrorString(e), grid_blocks);
#else
    for (int ph = 0; ph < NPH; ++ph) {
        p.phase_lo = ph; p.phase_hi = ph + 1; p.coop = 0;
        hipLaunchKernelGGL(mega, dim3(grid_blocks), dim3(NT), DYN_LDS, stream, p);
    }
#endif
}
```

```cpp
#include <hip/hip_runtime.h>
#include <hip/hip_cooperative_groups.h>
#include <stdint.h>
#include <cstdio>
#include <cmath>
namespace cg = cooperative_groups;

#ifndef MK_COOP
#define MK_COOP 1
#endif

typedef unsigned short bfu;
typedef __attribute__((ext_vector_type(8))) short bf16x8;
typedef __attribute__((ext_vector_type(4))) short s16x4;
typedef short v4i16_t __attribute__((ext_vector_type(4)));
typedef __attribute__((ext_vector_type(16))) float f32x16;
typedef __attribute__((ext_vector_type(4))) float f32x4;
typedef __attribute__((ext_vector_type(2))) float f32x2;
typedef __attribute__((ext_vector_type(4))) unsigned u32x4;
typedef __attribute__((ext_vector_type(2))) unsigned u32x2;
typedef __attribute__((ext_vector_type(2))) __bf16 bf2_t;
typedef __attribute__((address_space(3))) const char* lds_cptr;

#define DI __device__ __forceinline__
#define MFMA(a, b, c) __builtin_amdgcn_mfma_f32_32x32x16_bf16((a), (b), (c), 0, 0, 0)

constexpr int T = 32768, SEQ = 8192;
constexpr float EPS = 1e-6f;
constexpr float LOG2E = 1.4426950408889634f;
constexpr float SC_MLA = 0.10206207261596577f * LOG2E;
constexpr float SC_64 = 0.125f * LOG2E;
constexpr float LAM_INIT = 0.35550906759096926f;
constexpr int NPH = 21;
constexpr int NT = 512, NW = 8;
constexpr int DYN_LDS = 2 * 512 * 72 * 2;

constexpr size_t MiB = 1048576;
constexpr size_t OFF_WIN0 = 0, OFF_WIN1 = 6 * MiB, OFF_W1_0 = 12 * MiB, OFF_W1_1 = 20 * MiB, OFF_W2_0 = 28 * MiB, OFF_W2_1 = 36 * MiB,
                 OFF_WOUT0 = 44 * MiB, OFF_WOUT1 = 46 * MiB, OFF_WUQ = 48 * MiB, OFF_WUKV = 49 * MiB, OFF_MODP = 50 * MiB, OFF_MOD = 52 * MiB,
                 OFF_ROPE64 = 53 * MiB, OFF_ROPE32 = 61 * MiB, OFF_KPART = 65 * MiB, OFF_CTR = 66 * MiB,
                 OFF_HBUF = 72 * MiB, OFF_OBUF = 136 * MiB, OFF_UBUF = 200 * MiB, OFF_DBUF = 392 * MiB, WS_END = 456 * MiB;

struct Params {
    const float *x, *c; const int* pos;
    const float *ada_w, *ada_b, *norm_mix, *norm_mlp, *w1, *w2, *e_win, *e_wout, *qlat, *kvlat, *wuq, *wukv, *mla_qn, *mla_kn, *dil_qn, *dil_kn,
        *o_win, *o_wout, *diff_qn, *diff_kn, *diff_lam, *diff_subln, *moba_qn, *moba_kn;
    float* out; char* ws;
    float invf64[32]; float invf32[16];
    int phase_lo, phase_hi, coop, pad_;
};

DI unsigned pk2(float a, float b) { f32x2 v = {a, b}; bf2_t r = __builtin_convertvector(v, bf2_t); return __builtin_bit_cast(unsigned, r); }
DI float bflo(unsigned u) { return __uint_as_float(u << 16); }
DI float bfhi(unsigned u) { return __uint_as_float(u & 0xffff0000u); }
DI float wave_sum(float v) {
#pragma unroll
    for (int o = 32; o; o >>= 1) v += __shfl_xor(v, o);
    return v; }
DI s16x4 vtr(lds_cptr p) { return __builtin_bit_cast(s16x4, __builtin_amdgcn_ds_read_tr16_b64_v4i16((__attribute__((address_space(3))) v4i16_t*)p)); }

DI void tr_tile(const float* __restrict__ src, int K, int N, bfu* __restrict__ dst, const float* __restrict__ kscale, int it, float* tl) {
    const int nkt = K >> 6; const int kt = it % nkt, nt = it / nkt; const int tid = threadIdx.x;
#pragma unroll
    for (int rr = 0; rr < 2; ++rr) {
        const int kl = rr * 32 + (tid >> 4), k = kt * 64 + kl, nl = (tid & 15) * 4, n = nt * 64 + nl;
        float4 v = make_float4(0.f, 0.f, 0.f, 0.f);
        if (n < N) v = *(const float4*)(src + (size_t)k * N + n);
        if (kscale) { const float sc = kscale[k]; v.x *= sc; v.y *= sc; v.z *= sc; v.w *= sc; }
        tl[kl * 65 + nl] = v.x; tl[kl * 65 + nl + 1] = v.y; tl[kl * 65 + nl + 2] = v.z; tl[kl * 65 + nl + 3] = v.w;
    }
    __syncthreads();
    {
        const int nl = tid >> 3, kc = (tid & 7) * 8;
        unsigned w[4];
#pragma unroll
        for (int i = 0; i < 4; ++i) w[i] = pk2(tl[(kc + 2 * i) * 65 + nl], tl[(kc + 2 * i + 1) * 65 + nl]);
        bfu* d = dst + (size_t)(nt * 64 + nl) * K + kt * 64 + kc;
        *(u32x4*)d = (u32x4){w[0], w[1], w[2], w[3]};
    }
    __syncthreads();
}
DI void tr_matrix(const float* src, int K, int N, int Npad, bfu* dst, const float* kscale, float* tl) {
    const int nit = (K >> 6) * (Npad >> 6);
    for (int it = blockIdx.x; it < nit; it += gridDim.x) tr_tile(src, K, N, dst, kscale, it, tl);
}

DI void phase_prep(const Params& p, char* smem) {
    float* tl = (float*)smem;
    char* ws = p.ws;
    if (blockIdx.x == 0 && threadIdx.x < 4) ((int*)(ws + OFF_CTR))[threadIdx.x] = 0;
    tr_matrix(p.e_win, 1024, 2976, 3072, (bfu*)(ws + OFF_WIN0), nullptr, tl);
    tr_matrix(p.o_win, 1024, 3072, 3072, (bfu*)(ws + OFF_WIN1), nullptr, tl);
    tr_matrix(p.w1, 1024, 4096, 4096, (bfu*)(ws + OFF_W1_0), nullptr, tl);
    tr_matrix(p.w1 + (size_t)1024 * 4096, 1024, 4096, 4096, (bfu*)(ws + OFF_W1_1), nullptr, tl);
    tr_matrix(p.w2, 4096, 1024, 1024, (bfu*)(ws + OFF_W2_0), nullptr, tl);
    tr_matrix(p.w2 + (size_t)1024 * 4096, 4096, 1024, 1024, (bfu*)(ws + OFF_W2_1), nullptr, tl);
    tr_matrix(p.e_wout, 768, 1024, 1024, (bfu*)(ws + OFF_WOUT0), nullptr, tl);
    tr_matrix(p.o_wout, 1024, 1024, 1024, (bfu*)(ws + OFF_WOUT1), nullptr, tl);
    tr_matrix(p.wuq, 384, 768, 768, (bfu*)(ws + OFF_WUQ), p.qlat, tl);
    tr_matrix(p.wukv, 256, 1024, 1024, (bfu*)(ws + OFF_WUKV), p.kvlat, tl);
    {
        float2* r64 = (float2*)(ws + OFF_ROPE64); float2* r32 = (float2*)(ws + OFF_ROPE32);
        for (int idx = blockIdx.x * NT + threadIdx.x; idx < T * 48; idx += gridDim.x * NT) {
            const int t = idx / 48, i = idx % 48;
            const float invf = (i < 32) ? p.invf64[i] : p.invf32[i - 32];
            const float a = (float)p.pos[t] * invf;
            double rev = (double)a * 0.15915494309189535; rev -= floor(rev);
            const double y = (rev > 0.5 ? rev - 1.0 : rev) * 6.283185307179586;
            const double y2 = y * y; double s = 1.0, c = 1.0;
#pragma unroll
            for (int k = 15; k >= 1; --k) { s = 1.0 - s * y2 * (1.0 / (double)((2 * k) * (2 * k + 1))); c = 1.0 - c * y2 * (1.0 / (double)((2 * k - 1) * (2 * k))); }
            s *= y;
            const float2 o = make_float2((float)c, (float)s);
            if (i < 32) r64[(size_t)t * 32 + i] = o; else r32[(size_t)t * 16 + (i - 32)] = o;
        }
    }
    {
        float* sl = (float*)smem; float* modp = (float*)(ws + OFF_MODP);
        for (int it = blockIdx.x; it < 2 * 12 * 8; it += gridDim.x) {
            const int l = it / 96, cc = (it % 96) / 8, kc = it % 8;
            __syncthreads();
            { const int i = threadIdx.x, b = i >> 7, kk = i & 127; const float cv = p.c[b * 1024 + kc * 128 + kk]; sl[i] = cv / (1.f + __expf(-cv)); }
            __syncthreads();
            const int j = cc * 512 + threadIdx.x;
            const float* w = p.ada_w + ((size_t)l * 1024 + kc * 128) * 6144 + j;
            float a0 = 0.f, a1 = 0.f, a2 = 0.f, a3 = 0.f;
#pragma unroll 8
            for (int kk = 0; kk < 128; ++kk) { const float wv = w[(size_t)kk * 6144]; a0 += sl[kk] * wv; a1 += sl[128 + kk] * wv; a2 += sl[256 + kk] * wv; a3 += sl[384 + kk] * wv; }
            float* o = modp + (size_t)((l * 8 + kc) * 4) * 6144 + j;
            o[0] = a0; o[6144] = a1; o[2 * 6144] = a2; o[3 * 6144] = a3;
        }
        __syncthreads();
    }
}

DI void phase_modfin(const Params& p) {
    const float* modp = (const float*)(p.ws + OFF_MODP); float* mod = (float*)(p.ws + OFF_MOD);
    for (int idx = blockIdx.x * NT + threadIdx.x; idx < 2 * 4 * 6144; idx += gridDim.x * NT) {
        const int l = idx / 24576, rem = idx % 24576, j = rem % 6144;
        float s = p.ada_b[l * 6144 + j];
#pragma unroll
        for (int kc = 0; kc < 8; ++kc) s += modp[(size_t)((l * 8 + kc) * 4) * 6144 + rem];
        mod[idx] = s;
    }
}

DI void phase_normmod(const float* xs, const float* __restrict__ nw, const float* __restrict__ mod, int sh_off, bfu* __restrict__ hb) {
    const int lane = threadIdx.x & 63, gw = blockIdx.x * NW + (threadIdx.x >> 6), nwv = gridDim.x * NW;
    for (int t = gw; t < T; t += nwv) {
        const int b = t >> 13; const float* xr = xs + (size_t)t * 1024;
        float4 v[4]; float ss = 0.f;
#pragma unroll
        for (int i = 0; i < 4; ++i) { v[i] = *(const float4*)(xr + (i * 64 + lane) * 4); ss += v[i].x * v[i].x + v[i].y * v[i].y + v[i].z * v[i].z + v[i].w * v[i].w; }
        ss = wave_sum(ss);
        const float rinv = rsqrtf(ss * (1.f / 1024.f) + EPS);
        const float* mb = mod + b * 6144 + sh_off;
#pragma unroll
        for (int i = 0; i < 4; ++i) {
            const int col = (i * 64 + lane) * 4;
            const float4 w = *(const float4*)(nw + col), sh = *(const float4*)(mb + col), sc = *(const float4*)(mb + 1024 + col);
            const float o0 = v[i].x * rinv * w.x * (1.f + sc.x) + sh.x, o1 = v[i].y * rinv * w.y * (1.f + sc.y) + sh.y;
            const float o2 = v[i].z * rinv * w.z * (1.f + sc.z) + sh.z, o3 = v[i].w * rinv * w.w * (1.f + sc.w) + sh.w;
            *(u32x2*)(hb + (size_t)t * 1024 + col) = (u32x2){pk2(o0, o1), pk2(o2, o3)};
        }
    }
}

template <int EPI>
DI void gemm_tile(const bfu* __restrict__ A, int lda, const bfu* __restrict__ Bt, int K, int m0, int n0, int N,
                  bfu* Cb, int ldc, const float* resid, float* outf, const float* __restrict__ gate, char* smem) {
    constexpr int STG = 512 * 72;
    bfu* S0 = (bfu*)smem;
    const int tid = threadIdx.x, lane = tid & 63, wid = tid >> 6, l32 = lane & 31, hi = lane >> 5;
    const int wm = wid & 3, wn = wid >> 2;
    f32x16 acc[4][2];
#pragma unroll
    for (int nb = 0; nb < 4; ++nb)
#pragma unroll
        for (int mb = 0; mb < 2; ++mb)
#pragma unroll
            for (int r = 0; r < 16; ++r) acc[nb][mb][r] = 0.f;
    const bfu* Ag = A + (size_t)(m0 + (tid >> 3)) * lda + (tid & 7) * 8;
    const bfu* Bg = Bt + (size_t)(n0 + (tid >> 3)) * K + (tid & 7) * 8;
    u32x4 ra[4], rb[4];
#pragma unroll
    for (int i = 0; i < 4; ++i) { ra[i] = *(const u32x4*)(Ag + (size_t)(64 * i) * lda); rb[i] = *(const u32x4*)(Bg + (size_t)(64 * i) * K); }
    const int nk = K >> 6;
    const int wofs = (tid >> 3) * 72 + (tid & 7) * 8;
    const int arofs = (wm * 64 + l32) * 72 + hi * 8, brofs = 256 * 72 + (wn * 128 + l32) * 72 + hi * 8;
    __syncthreads();
#pragma unroll
    for (int i = 0; i < 4; ++i) { *(u32x4*)(S0 + wofs + 64 * i * 72) = ra[i]; *(u32x4*)(S0 + 256 * 72 + wofs + 64 * i * 72) = rb[i]; }
    if (nk > 1) {
#pragma unroll
        for (int i = 0; i < 4; ++i) { ra[i] = *(const u32x4*)(Ag + (size_t)(64 * i) * lda + 64); rb[i] = *(const u32x4*)(Bg + (size_t)(64 * i) * K + 64); }
    }
    __syncthreads();
#pragma unroll 1
    for (int kt = 0; kt < nk; ++kt) {
        const bfu* Sc = S0 + (kt & 1) * STG; bfu* Sn = S0 + ((kt & 1) ^ 1) * STG;
        if (kt + 1 < nk) {
#pragma unroll
            for (int i = 0; i < 4; ++i) { *(u32x4*)(Sn + wofs + 64 * i * 72) = ra[i]; *(u32x4*)(Sn + 256 * 72 + wofs + 64 * i * 72) = rb[i]; }
        }
        __builtin_amdgcn_sched_barrier(0);
        if (kt + 2 < nk) {
            const int ko = (kt + 2) * 64;
#pragma unroll
            for (int i = 0; i < 4; ++i) { ra[i] = *(const u32x4*)(Ag + (size_t)(64 * i) * lda + ko); rb[i] = *(const u32x4*)(Bg + (size_t)(64 * i) * K + ko); }
        }
        __builtin_amdgcn_sched_barrier(0);
#pragma unroll
        for (int k16 = 0; k16 < 4; ++k16) {
            bf16x8 af[2], bfr[4];
#pragma unroll
            for (int mb = 0; mb < 2; ++mb) af[mb] = *(const bf16x8*)(Sc + arofs + mb * 32 * 72 + k16 * 16);
#pragma unroll
            for (int nb = 0; nb < 4; ++nb) bfr[nb] = *(const bf16x8*)(Sc + brofs + nb * 32 * 72 + k16 * 16);
#pragma unroll
            for (int nb = 0; nb < 4; ++nb)
#pragma unroll
                for (int mb = 0; mb < 2; ++mb) acc[nb][mb] = MFMA(bfr[nb], af[mb], acc[nb][mb]);
        }
        __syncthreads();
    }
    if (EPI != 2) {
        constexpr int CP = 264;
        bfu* Cs = (bfu*)smem;
#pragma unroll
        for (int nb = 0; nb < 4; ++nb)
#pragma unroll
            for (int mb = 0; mb < 2; ++mb) {
                const int row = wm * 64 + mb * 32 + l32;
#pragma unroll
                for (int i = 0; i < 4; ++i) {
                    const int col = wn * 128 + nb * 32 + 8 * i + 4 * hi;
                    float v0 = acc[nb][mb][4 * i], v1 = acc[nb][mb][4 * i + 1], v2 = acc[nb][mb][4 * i + 2], v3 = acc[nb][mb][4 * i + 3];
                    if (EPI == 1) { v0 = fmaxf(v0, 0.f); v1 = fmaxf(v1, 0.f); v2 = fmaxf(v2, 0.f); v3 = fmaxf(v3, 0.f); v0 *= v0; v1 *= v1; v2 *= v2; v3 *= v3; }
                    *(u32x2*)(Cs + row * CP + col) = (u32x2){pk2(v0, v1), pk2(v2, v3)};
                }
            }
        __syncthreads();
        const int c8 = (tid & 31) * 8, n = n0 + c8;
#pragma unroll 1
        for (int ps = 0; ps < 16; ++ps) {
            const int row = ps * 16 + (tid >> 5);
            const u32x4 v = *(const u32x4*)(Cs + row * CP + c8);
            if (n < N) *(u32x4*)(Cb + (size_t)(m0 + row) * ldc + n) = v;
        }
        __syncthreads();
    } else {
        constexpr int CPF = 132;
        float* Cs = (float*)smem;
#pragma unroll
        for (int p2 = 0; p2 < 2; ++p2) {
#pragma unroll
            for (int nbl = 0; nbl < 2; ++nbl)
#pragma unroll
                for (int mb = 0; mb < 2; ++mb) {
                    const int row = wm * 64 + mb * 32 + l32;
#pragma unroll
                    for (int i = 0; i < 4; ++i) {
                        const int col = wn * 64 + nbl * 32 + 8 * i + 4 * hi;
                        *(f32x4*)(Cs + row * CPF + col) = (f32x4){acc[2 * p2 + nbl][mb][4 * i], acc[2 * p2 + nbl][mb][4 * i + 1], acc[2 * p2 + nbl][mb][4 * i + 2], acc[2 * p2 + nbl][mb][4 * i + 3]};
                    }
                }
            __syncthreads();
            const int cl = (tid & 31) * 4;
            const int n = n0 + (cl >> 6) * 128 + (2 * p2 + ((cl >> 5) & 1)) * 32 + (cl & 31);
#pragma unroll 1
            for (int ps = 0; ps < 16; ++ps) {
                const int row = ps * 16 + (tid >> 5), m = m0 + row, b = m >> 13;
                const f32x4 v = *(const f32x4*)(Cs + row * CPF + cl);
                const float4 g = *(const float4*)(gate + b * 6144 + n);
                const float4 r = *(const float4*)(resid + (size_t)m * 1024 + n);
                float4 o; o.x = r.x + g.x * v[0]; o.y = r.y + g.y * v[1]; o.z = r.z + g.z * v[2]; o.w = r.w + g.w * v[3];
                *(float4*)(outf + (size_t)m * 1024 + n) = o;
            }
            __syncthreads();
        }
    }
}

DI bool gemm_map(int round, int nsn, int nwt, int& mt, int& nt) {
    const int x = blockIdx.x & 7, li = blockIdx.x >> 3;
    const int st = round * 8 + x;
    if (st >= 16 * nsn || (li >> 3) >= nwt) return false;
    const int sm = st / nsn, sn = st % nsn;
    mt = sm * 8 + (li & 7); nt = sn * nwt + (li >> 3);
    return true;
}
template <int EPI>
DI void phase_gemm(const bfu* A, int lda, const bfu* Bt, int K, int N, int ntn, bfu* Cb, int ldc, const float* resid, float* outf, const float* gate, char* smem) {
    const bool xcd = (gridDim.x == 256);
    const int nwt = (ntn % 4 == 0) ? 4 : ntn, nsn = ntn / nwt;
    const int rounds = xcd ? 2 * nsn : (128 * ntn + (int)gridDim.x - 1) / (int)gridDim.x;
    for (int r = 0; r < rounds; ++r) {
        int mt = 0, nt = 0; bool ok;
        if (xcd) ok = gemm_map(r, nsn, nwt, mt, nt);
        else { const int tile = r * gridDim.x + blockIdx.x; ok = tile < 128 * ntn; mt = tile / ntn; nt = tile % ntn; }
        if (ok) gemm_tile<EPI>(A, lda, Bt, K, mt * 256, nt * 256, N, Cb, ldc, resid, outf, gate, smem);
    }
}


#ifndef MK_PROBE
#define MK_PROBE 0
#endif
#if MK_PROBE
template <int VAR>
DI void gemm_probe(const bfu* __restrict__ A, int lda, const bfu* __restrict__ Bt, int K, int m0, int n0, float* sinkp, int sink, char* smem) {
    constexpr int STG = 512 * 72;
    bfu* S0 = (bfu*)smem;
    const int tid = threadIdx.x, lane = tid & 63, wid = tid >> 6, l32 = lane & 31, hi = lane >> 5;
    const int wm = wid & 3, wn = wid >> 2;
    f32x16 acc[4][2];
#pragma unroll
    for (int nb = 0; nb < 4; ++nb)
#pragma unroll
        for (int mb = 0; mb < 2; ++mb)
#pragma unroll
            for (int r = 0; r < 16; ++r) acc[nb][mb][r] = 0.f;
    const bfu* Ag = A + (size_t)(m0 + (tid >> 3)) * lda + (tid & 7) * 8;
    const bfu* Bg = Bt + (size_t)(n0 + (tid >> 3)) * K + (tid & 7) * 8;
    u32x4 ra[4], rb[4];
#pragma unroll
    for (int i = 0; i < 4; ++i) { ra[i] = *(const u32x4*)(Ag + (size_t)(64 * i) * lda); rb[i] = *(const u32x4*)(Bg + (size_t)(64 * i) * K); }
    const int nk = K >> 6;
    const int wofs = (tid >> 3) * 72 + (tid & 7) * 8;
    const int arofs = (wm * 64 + l32) * 72 + hi * 8, brofs = 256 * 72 + (wn * 128 + l32) * 72 + hi * 8;
    __syncthreads();
#pragma unroll
    for (int i = 0; i < 4; ++i) { *(u32x4*)(S0 + wofs + 64 * i * 72) = ra[i]; *(u32x4*)(S0 + 256 * 72 + wofs + 64 * i * 72) = rb[i]; }
    __syncthreads();
#pragma unroll 1
    for (int kt = 0; kt < nk; ++kt) {
        const bfu* Sc = S0 + (kt & 1) * STG; bfu* Sn = S0 + ((kt & 1) ^ 1) * STG;
        if (VAR != 2 && kt + 1 < nk) {
#pragma unroll
            for (int i = 0; i < 4; ++i) { *(u32x4*)(Sn + wofs + 64 * i * 72) = ra[i]; *(u32x4*)(Sn + 256 * 72 + wofs + 64 * i * 72) = rb[i]; }
        }
        __builtin_amdgcn_sched_barrier(0);
        if (VAR != 1 && VAR != 2 && kt + 2 < nk) {
            const int ko = (kt + 2) * 64;
#pragma unroll
            for (int i = 0; i < 4; ++i) { ra[i] = *(const u32x4*)(Ag + (size_t)(64 * i) * lda + ko); rb[i] = *(const u32x4*)(Bg + (size_t)(64 * i) * K + ko); }
        }
        __builtin_amdgcn_sched_barrier(0);
        if (VAR == 3) {
            bf16x8 af[2], bfr[4];
#pragma unroll
            for (int mb = 0; mb < 2; ++mb) af[mb] = *(const bf16x8*)(Sc + arofs + mb * 32 * 72);
#pragma unroll
            for (int nb = 0; nb < 4; ++nb) bfr[nb] = *(const bf16x8*)(Sc + brofs + nb * 32 * 72);
#pragma unroll
            for (int k16 = 0; k16 < 4; ++k16)
#pragma unroll
                for (int nb = 0; nb < 4; ++nb)
#pragma unroll
                    for (int mb = 0; mb < 2; ++mb) acc[nb][mb] = MFMA(bfr[nb], af[mb], acc[nb][mb]);
        } else {
#pragma unroll
            for (int k16 = 0; k16 < 4; ++k16) {
                bf16x8 af[2], bfr[4];
#pragma unroll
                for (int mb = 0; mb < 2; ++mb) af[mb] = *(const bf16x8*)(Sc + arofs + mb * 32 * 72 + k16 * 16);
#pragma unroll
                for (int nb = 0; nb < 4; ++nb) bfr[nb] = *(const bf16x8*)(Sc + brofs + nb * 32 * 72 + k16 * 16);
#pragma unroll
                for (int nb = 0; nb < 4; ++nb)
#pragma unroll
                    for (int mb = 0; mb < 2; ++mb) acc[nb][mb] = MFMA(bfr[nb], af[mb], acc[nb][mb]);
            }
        }
        __syncthreads();
    }
    if (sink) {
#pragma unroll
        for (int nb = 0; nb < 4; ++nb)
#pragma unroll
            for (int mb = 0; mb < 2; ++mb)
#pragma unroll
                for (int r = 0; r < 16; ++r) sinkp[tid * 128 + (nb * 2 + mb) * 16 + r] = acc[nb][mb][r];
    }
}
template <int VAR>
DI void phase_gemm_probe(const bfu* A, const bfu* Bt, float* sinkp, int sink, char* smem) {
    for (int r = 0; r < 6; ++r) { int mt, nt; if (gemm_map(r, 3, 4, mt, nt)) gemm_probe<VAR>(A, 1024, Bt, 1024, mt * 256, nt * 256, sinkp, sink, smem); }
}
#endif

DI void headnorm64(bfu* hp, const float* __restrict__ w, const float2* __restrict__ cs, float scale, int j, bool acc_on, f32x4& ka1, f32x4& ka2) {
    const u32x2 a = *(const u32x2*)(hp + 4 * j), b = *(const u32x2*)(hp + 32 + 4 * j);
    float x1[4] = {bflo(a[0]), bfhi(a[0]), bflo(a[1]), bfhi(a[1])}, x2[4] = {bflo(b[0]), bfhi(b[0]), bflo(b[1]), bfhi(b[1])};
    float ss = 0.f;
#pragma unroll
    for (int e = 0; e < 4; ++e) ss += x1[e] * x1[e] + x2[e] * x2[e];
    ss += __shfl_xor(ss, 1); ss += __shfl_xor(ss, 2); ss += __shfl_xor(ss, 4);
    const float r = rsqrtf(ss * (1.f / 64.f) + EPS);
    const float4 w1 = *(const float4*)(w + 4 * j), w2 = *(const float4*)(w + 32 + 4 * j);
    const float wa[4] = {w1.x, w1.y, w1.z, w1.w}, wb[4] = {w2.x, w2.y, w2.z, w2.w};
    float o1[4], o2[4];
#pragma unroll
    for (int e = 0; e < 4; ++e) {
        const float y1 = x1[e] * r * wa[e], y2 = x2[e] * r * wb[e]; const float2 c = cs[4 * j + e];
        o1[e] = y1 * c.x - y2 * c.y; o2[e] = y2 * c.x + y1 * c.y;
    }
    if (acc_on) {
#pragma unroll
        for (int e = 0; e < 4; ++e) { ka1[e] += o1[e]; ka2[e] += o2[e]; }
    }
    *(u32x2*)(hp + 4 * j) = (u32x2){pk2(o1[0] * scale, o1[1] * scale), pk2(o1[2] * scale, o1[3] * scale)};
    *(u32x2*)(hp + 32 + 4 * j) = (u32x2){pk2(o2[0] * scale, o2[1] * scale), pk2(o2[2] * scale, o2[3] * scale)};
}

DI float sq4(u32x2 a) { const float x0 = bflo(a[0]), x1 = bfhi(a[0]), x2 = bflo(a[1]), x3 = bfhi(a[1]); return x0 * x0 + x1 * x1 + x2 * x2 + x3 * x3; }

DI void mla_head(u32x4 nv, unsigned x1, unsigned x2, float rn, float rr, const float* __restrict__ wn, int j, float2 csA, float2 csB, float scale, bfu* dst) {
    float f[8] = {bflo(nv[0]) * rn, bfhi(nv[0]) * rn, bflo(nv[1]) * rn, bfhi(nv[1]) * rn, bflo(nv[2]) * rn, bfhi(nv[2]) * rn, bflo(nv[3]) * rn, bfhi(nv[3]) * rn};
    const float a0 = bflo(x1) * rr, a1 = bfhi(x1) * rr, b0 = bflo(x2) * rr, b1 = bfhi(x2) * rr;
    float ss = a0 * a0 + a1 * a1 + b0 * b0 + b1 * b1;
#pragma unroll
    for (int e = 0; e < 8; ++e) ss += f[e] * f[e];
    ss += __shfl_xor(ss, 1); ss += __shfl_xor(ss, 2); ss += __shfl_xor(ss, 4);
    const float r = rsqrtf(ss * (1.f / 96.f) + EPS) * scale;
    const float4 wA = *(const float4*)(wn + 8 * j), wB = *(const float4*)(wn + 8 * j + 4);
    const float wv[8] = {wA.x, wA.y, wA.z, wA.w, wB.x, wB.y, wB.z, wB.w};
#pragma unroll
    for (int e = 0; e < 8; ++e) f[e] *= r * wv[e];
    *(u32x4*)(dst + 8 * j) = (u32x4){pk2(f[0], f[1]), pk2(f[2], f[3]), pk2(f[4], f[5]), pk2(f[6], f[7])};
    const float y10 = a0 * r * wn[64 + 2 * j], y11 = a1 * r * wn[65 + 2 * j], y20 = b0 * r * wn[80 + 2 * j], y21 = b1 * r * wn[81 + 2 * j];
    *(unsigned*)(dst + 64 + 2 * j) = pk2(y10 * csA.x - y20 * csA.y, y11 * csB.x - y21 * csB.y);
    *(unsigned*)(dst + 80 + 2 * j) = pk2(y20 * csA.x + y10 * csA.y, y21 * csB.x + y11 * csB.y);
}

DI void phase_post_even(const Params& p) {
    char* ws = p.ws;
    bfu* ubuf = (bfu*)(ws + OFF_UBUF); const bfu* qraw = (const bfu*)(ws + OFF_HBUF); const bfu* kvraw = (const bfu*)(ws + OFF_OBUF);
    bfu* Qa = (bfu*)p.out; bfu* Ka = Qa + (size_t)T * 768; bfu* Va = Ka + (size_t)T * 768;
    const float2* r64 = (const float2*)(ws + OFF_ROPE64); const float2* r32 = (const float2*)(ws + OFF_ROPE32);
    const int lane = threadIdx.x & 63, gw = blockIdx.x * NW + (threadIdx.x >> 6), nwv = gridDim.x * NW;
    const int h = lane >> 3, j = lane & 7;
    for (int t = gw; t < T; t += nwv) {
        bfu* ur = ubuf + (size_t)t * 3072;
        float ssq = sq4(*(const u32x2*)(ur + lane * 4));
        if (lane < 32) ssq += sq4(*(const u32x2*)(ur + 256 + lane * 4));
        float sskv = sq4(*(const u32x2*)(ur + 384 + lane * 4));
        ssq = wave_sum(ssq); sskv = wave_sum(sskv);
        const float rq = rsqrtf(ssq * (1.f / 384.f) + EPS), rkv = rsqrtf(sskv * (1.f / 256.f) + EPS);
        const float2 csA = r32[(size_t)t * 16 + 2 * j], csB = r32[(size_t)t * 16 + 2 * j + 1];
        {
            const bfu* qr = qraw + (size_t)t * 768 + h * 96;
            mla_head(*(const u32x4*)(qr + 8 * j), *(const unsigned*)(qr + 64 + 2 * j), *(const unsigned*)(qr + 80 + 2 * j), rq, rq, p.mla_qn, j, csA, csB, SC_MLA, Qa + (size_t)t * 768 + h * 96);
        }
        {
            const bfu* kr = kvraw + (size_t)t * 1024 + h * 128;
            mla_head(*(const u32x4*)(kr + 8 * j), *(const unsigned*)(ur + 640 + 2 * j), *(const unsigned*)(ur + 656 + 2 * j), rkv, 1.f, p.mla_kn, j, csA, csB, 1.f, Ka + (size_t)t * 768 + h * 96);
            const u32x4 vv = *(const u32x4*)(kr + 64 + 8 * j);
            *(u32x4*)(Va + (size_t)t * 512 + h * 64 + 8 * j) = (u32x4){pk2(bflo(vv[0]) * rkv, bfhi(vv[0]) * rkv), pk2(bflo(vv[1]) * rkv, bfhi(vv[1]) * rkv),
                                                                      pk2(bflo(vv[2]) * rkv, bfhi(vv[2]) * rkv), pk2(bflo(vv[3]) * rkv, bfhi(vv[3]) * rkv)};
        }
        f32x4 d1, d2;
#pragma unroll
        for (int rd = 0; rd < 3; ++rd) {
            const int hh = rd * 8 + h, which = hh / 12, gh = hh % 12;
            headnorm64(ur + 672 + which * 768 + gh * 64, which ? p.dil_kn : p.dil_qn, r64 + (size_t)t * 32, which ? 1.f : SC_64, j, false, d1, d2);
        }
    }
}

DI void phase_post_odd(const Params& p, char* smem) {
    char* ws = p.ws;
    bfu* ubuf = (bfu*)(ws + OFF_UBUF); const float2* r64 = (const float2*)(ws + OFF_ROPE64); float* kpart = (float*)(ws + OFF_KPART);
    const int tid = threadIdx.x, lane = tid & 63, wid = tid >> 6, h = lane >> 3, j = lane & 7;
    float* red = (float*)smem;
    for (int it = blockIdx.x; it < T / 64; it += gridDim.x) {
        f32x4 ka1 = {0.f, 0.f, 0.f, 0.f}, ka2 = {0.f, 0.f, 0.f, 0.f}, d1, d2;
        for (int tt = 0; tt < 8; ++tt) {
            const int t = it * 64 + wid * 8 + tt;
            bfu* ur = ubuf + (size_t)t * 3072; const float2* cs = r64 + (size_t)t * 32;
            headnorm64(ur + h * 64, p.diff_qn, cs, SC_64, j, false, d1, d2);
            headnorm64(ur + 512 + h * 64, p.diff_kn, cs, 1.f, j, false, d1, d2);
            headnorm64(ur + 1536 + h * 64, p.moba_qn, cs, SC_64, j, false, d1, d2);
            headnorm64(ur + 2048 + h * 64, p.moba_kn, cs, 1.f, j, true, ka1, ka2);
        }
        __syncthreads();
#pragma unroll
        for (int e = 0; e < 4; ++e) { red[(wid * 64 + lane) * 8 + e] = ka1[e]; red[(wid * 64 + lane) * 8 + 4 + e] = ka2[e]; }
        __syncthreads();
        {
            const int o = tid, hh = o >> 6, d = o & 63, jj = (d & 31) >> 2, e = (d & 3) + ((d >> 5) << 2), ln = hh * 8 + jj;
            float sum = 0.f;
#pragma unroll
            for (int w = 0; w < NW; ++w) sum += red[(w * 64 + ln) * 8 + e];
            kpart[(size_t)it * 512 + o] = sum;
        }
    }
    __syncthreads();
}

DI void phase_dil_merge(const Params& p) {
    const bfu* dil_o = (const bfu*)(p.ws + OFF_HBUF); const float* dil_lse = (const float*)(p.ws + OFF_HBUF + 48 * MiB);
    bfu* obuf = (bfu*)(p.ws + OFF_OBUF);
    for (int idx = blockIdx.x * NT + threadIdx.x; idx < T * 64; idx += gridDim.x * NT) {
        const int t = idx >> 6, r = idx & 63, h = r >> 4, jj = r & 15;
        const float l0 = dil_lse[(size_t)t * 12 + h], l1 = dil_lse[(size_t)t * 12 + 4 + h], l2 = dil_lse[(size_t)t * 12 + 8 + h];
        const float mx = fmaxf(l0, fmaxf(l1, l2));
        float w0 = exp2f(l0 - mx), w1 = exp2f(l1 - mx), w2 = exp2f(l2 - mx); const float inv = 1.f / (w0 + w1 + w2); w0 *= inv; w1 *= inv; w2 *= inv;
        const u32x2 a = *(const u32x2*)(dil_o + (size_t)t * 768 + h * 64 + 4 * jj), b = *(const u32x2*)(dil_o + (size_t)t * 768 + (4 + h) * 64 + 4 * jj),
                    c = *(const u32x2*)(dil_o + (size_t)t * 768 + (8 + h) * 64 + 4 * jj);
        const float o0 = w0 * bflo(a[0]) + w1 * bflo(b[0]) + w2 * bflo(c[0]), o1 = w0 * bfhi(a[0]) + w1 * bfhi(b[0]) + w2 * bfhi(c[0]);
        const float o2 = w0 * bflo(a[1]) + w1 * bflo(b[1]) + w2 * bflo(c[1]), o3 = w0 * bfhi(a[1]) + w1 * bfhi(b[1]) + w2 * bfhi(c[1]);
        *(u32x2*)(obuf + (size_t)t * 768 + 512 + h * 64 + 4 * jj) = (u32x2){pk2(o0, o1), pk2(o2, o3)};
    }
}

DI void phase_diff_combine(const Params& p) {
    const bfu* dbuf = (const bfu*)(p.ws + OFF_DBUF); bfu* obuf = (bfu*)(p.ws + OFF_OBUF);
    const int lane = threadIdx.x & 63, gw = blockIdx.x * NW + (threadIdx.x >> 6), nwv = gridDim.x * NW;
    float lam;
    {
        const float sa = wave_sum(p.diff_lam[lane] * p.diff_lam[64 + lane]), sb = wave_sum(p.diff_lam[128 + lane] * p.diff_lam[192 + lane]);
        lam = expf(sa) - expf(sb) + LAM_INIT;
    }
    const int h = lane >> 4, jj = lane & 15;
    const float4 sA = *(const float4*)(p.diff_subln + 8 * jj), sB = *(const float4*)(p.diff_subln + 8 * jj + 4);
    const float sw[8] = {sA.x, sA.y, sA.z, sA.w, sB.x, sB.y, sB.z, sB.w};
    for (int t = gw; t < T; t += nwv) {
        const u32x4 a = *(const u32x4*)(dbuf + (size_t)t * 1024 + (2 * h) * 128 + 8 * jj), b = *(const u32x4*)(dbuf + (size_t)t * 1024 + (2 * h + 1) * 128 + 8 * jj);
        float d[8];
#pragma unroll
        for (int e = 0; e < 4; ++e) { d[2 * e] = bflo(a[e]) - lam * bflo(b[e]); d[2 * e + 1] = bfhi(a[e]) - lam * bfhi(b[e]); }
        float ss = 0.f;
#pragma unroll
        for (int e = 0; e < 8; ++e) ss += d[e] * d[e];
        ss += __shfl_xor(ss, 1); ss += __shfl_xor(ss, 2); ss += __shfl_xor(ss, 4); ss += __shfl_xor(ss, 8);
        const float r = rsqrtf(ss * (1.f / 128.f) + EPS) * (1.f - LAM_INIT);
#pragma unroll
        for (int e = 0; e < 8; ++e) d[e] *= r * sw[e];
        *(u32x4*)(obuf + (size_t)t * 1024 + h * 128 + 8 * jj) = (u32x4){pk2(d[0], d[1]), pk2(d[2], d[3]), pk2(d[4], d[5]), pk2(d[6], d[7])};
    }
}

struct Top3 { float v0, v1, v2; int i0, i1, i2; };
DI Top3 top3_ins(Top3 t, float v, int i) {
    const bool g0 = (v > t.v0) || (v == t.v0 && i < t.i0), g1 = (v > t.v1) || (v == t.v1 && i < t.i1), g2 = (v > t.v2) || (v == t.v2 && i < t.i2);
    Top3 r;
    r.v2 = g1 ? t.v1 : (g2 ? v : t.v2); r.i2 = g1 ? t.i1 : (g2 ? i : t.i2);
    r.v1 = g0 ? t.v0 : (g1 ? v : t.v1); r.i1 = g0 ? t.i0 : (g1 ? i : t.i1);
    r.v0 = g0 ? v : t.v0; r.i0 = g0 ? i : t.i0;
    return r;
}

template <int DK, int DV, int MODE>
DI void attn_item(const bfu* __restrict__ Qp, int qp, const bfu* __restrict__ Kp, int kp, const bfu* __restrict__ Vp, int vp,
                  long rowbase, int rs, int q0, bfu* __restrict__ Op, int op, float* __restrict__ lsep, int lsest,
                  const float* __restrict__ kpart, char* smem) {
    constexpr int KPT = DK + 8, KCH = DK / 8, VCH = DV / 8, NKL = (64 * KCH + NT - 1) / NT, NVL = 64 * VCH / NT, NDV = DV / 32, ND0 = DK / 16;
    constexpr int KST = 64 * KPT, VST = 64 * DV;
    bfu* Ks = (bfu*)smem; bfu* Vs = Ks + 2 * KST;
    short* tlist = (short*)(Vs + 2 * VST);
    int* misc = (int*)(tlist + 192);
    float* km = (float*)(misc + 4);
    unsigned* selm = (unsigned*)(km + 2048);
    float* cand = (float*)(selm + 256);
    const int tid = threadIdx.x, lane = tid & 63, wid = tid >> 6, l32 = lane & 31, hi = lane >> 5;
    const int qw = q0 + wid * 32, qstep = qw + l32;
    unsigned mysel = 0;
    if (MODE == 2) {
        const int nb = q0 >> 8;
        for (int idx = tid; idx < nb * 64; idx += NT) {
            const int blk = idx >> 6, d = idx & 63; const float* kq = kpart + (size_t)(blk * 4) * 512 + d;
            km[idx] = (kq[0] + kq[512] + kq[1024] + kq[1536]) * (1.f / 256.f);
        }
        if (tid == 0) misc[1] = 0;
        __syncthreads();
        {
            const int qq = tid & 255, hf = tid >> 8;
            const bfu* qr = Qp + (size_t)(rowbase + q0 + qq) * qp;
            float qv[64];
#pragma unroll
            for (int c8 = 0; c8 < 8; ++c8) {
                const u32x4 w = *(const u32x4*)(qr + c8 * 8);
#pragma unroll
                for (int e = 0; e < 4; ++e) { qv[c8 * 8 + 2 * e] = bflo(w[e]); qv[c8 * 8 + 2 * e + 1] = bfhi(w[e]); }
            }
            Top3 tp; tp.v0 = -3e38f; tp.v1 = -3e38f; tp.v2 = -3e38f; tp.i0 = 64; tp.i1 = 64; tp.i2 = 64;
            for (int blk = hf; blk < nb; blk += 2) {
                float g = 0.f;
#pragma unroll
                for (int d = 0; d < 64; ++d) g += qv[d] * km[blk * 64 + d];
                tp = top3_ins(tp, g, blk);
            }
            cand[tid * 6 + 0] = tp.v0; cand[tid * 6 + 1] = tp.v1; cand[tid * 6 + 2] = tp.v2;
            cand[tid * 6 + 3] = __int_as_float(tp.i0); cand[tid * 6 + 4] = __int_as_float(tp.i1); cand[tid * 6 + 5] = __int_as_float(tp.i2);
        }
        __syncthreads();
        if (tid < 256) {
            Top3 tp; tp.v0 = cand[tid * 6]; tp.v1 = cand[tid * 6 + 1]; tp.v2 = cand[tid * 6 + 2];
            tp.i0 = __float_as_int(cand[tid * 6 + 3]); tp.i1 = __float_as_int(cand[tid * 6 + 4]); tp.i2 = __float_as_int(cand[tid * 6 + 5]);
            const int o = (tid + 256) * 6;
#pragma unroll
            for (int e = 0; e < 3; ++e) { const int ii = __float_as_int(cand[o + 3 + e]); tp = top3_ins(tp, cand[o + e], ii); }
            unsigned mk = 0;
            if (tp.i0 < 32) mk |= 1u << tp.i0;
            if (tp.i1 < 32) mk |= 1u << tp.i1;
            if (tp.i2 < 32) mk |= 1u << tp.i2;
            selm[tid] = mk;
            atomicOr((unsigned*)&misc[1], mk);
        }
        __syncthreads();
        mysel = selm[wid * 32 + l32];
    }
    if (MODE == 0) { const int last = (q0 >> 6) + 3; for (int jx = tid; jx <= last; jx += NT) tlist[jx] = (short)jx; if (tid == 0) misc[0] = last + 1; }
    if (MODE == 1) { const int last = (q0 >> 6) + 3, first = (q0 >> 6) >= 2 ? (q0 >> 6) - 2 : 0; if (tid == 0) { int n = 0; for (int jx = first; jx <= last; ++jx) tlist[n++] = (short)jx; misc[0] = n; } }
    if (MODE == 2) {
        if (tid == 0) {
            const unsigned om = (unsigned)misc[1]; const int nb = q0 >> 8; int n = 0;
            for (int blk = 0; blk < nb; ++blk) if ((om >> blk) & 1u) { tlist[n++] = (short)(blk * 4); tlist[n++] = (short)(blk * 4 + 1); tlist[n++] = (short)(blk * 4 + 2); tlist[n++] = (short)(blk * 4 + 3); }
            for (int jx = nb * 4; jx <= nb * 4 + 3; ++jx) tlist[n++] = (short)jx;
            misc[0] = n;
        }
    }
    __syncthreads();
    const int nt = misc[0];
    bf16x8 qf[ND0];
    {
        const bfu* qr = Qp + (size_t)(rowbase + (long)qstep * rs) * qp + hi * 8;
#pragma unroll
        for (int d0 = 0; d0 < ND0; ++d0) qf[d0] = *(const bf16x8*)(qr + d0 * 16);
    }
    float m = 0.f, l = 0.f; bool anym = false;
    f32x16 o[NDV];
#pragma unroll
    for (int dvb = 0; dvb < NDV; ++dvb)
#pragma unroll
        for (int r = 0; r < 16; ++r) o[dvb][r] = 0.f;
    int krow[NKL], kch[NKL], vrow[NVL], vch[NVL];
#pragma unroll
    for (int i = 0; i < NKL; ++i) { const int id = tid + NT * i; krow[i] = id / KCH; kch[i] = id % KCH; }
#pragma unroll
    for (int i = 0; i < NVL; ++i) { const int id = tid + NT * i; vrow[i] = id / VCH; vch[i] = id % VCH; }
    u32x4 rk[NKL], rv[NVL];
#define ATT_LOAD(JJ) do { const int j_ = __builtin_amdgcn_readfirstlane((int)(JJ)); \
    _Pragma("unroll") for (int i = 0; i < NKL; ++i) if (tid + NT * i < 64 * KCH) rk[i] = *(const u32x4*)(Kp + (size_t)(rowbase + (long)(j_ * 64 + krow[i]) * rs) * kp + kch[i] * 8); \
    _Pragma("unroll") for (int i = 0; i < NVL; ++i) rv[i] = *(const u32x4*)(Vp + (size_t)(rowbase + (long)(j_ * 64 + vrow[i]) * rs) * vp + vch[i] * 8); } while (0)
#define ATT_STORE(ST) do { bfu* ks_ = Ks + (ST) * KST; bfu* vs_ = Vs + (ST) * VST; \
    _Pragma("unroll") for (int i = 0; i < NKL; ++i) if (tid + NT * i < 64 * KCH) *(u32x4*)(ks_ + krow[i] * KPT + kch[i] * 8) = rk[i]; \
    _Pragma("unroll") for (int i = 0; i < NVL; ++i) *(u32x4*)(vs_ + (vch[i] >> 2) * 2048 + vrow[i] * 32 + (vch[i] & 3) * 8) = rv[i]; } while (0)
    ATT_LOAD(tlist[0]);
    ATT_STORE(0);
    if (nt > 1) ATT_LOAD(tlist[1]);
    __syncthreads();
    const lds_cptr vb0 = (lds_cptr)Vs + ((lane >> 4) & 1) * 32 + (lane & 3) * 8 + (4 * hi + ((lane & 15) >> 2)) * 64;
    const bfu* ksr0 = Ks + l32 * KPT + hi * 8;
    for (int it = 0; it < nt; ++it) {
        const int cur = it & 1;
        const int jc = __builtin_amdgcn_readfirstlane((int)tlist[it]);
        if (it + 1 < nt) ATT_STORE(cur ^ 1);
        if (it + 2 < nt) ATT_LOAD(tlist[it + 2]);
        __builtin_amdgcn_sched_barrier(0);
        bool need;
        if (MODE == 1) need = (jc * 64 <= qw + 31) && (jc * 64 + 63 >= qw - 128);
        else {
            need = (jc * 64 <= qw + 31);
            if (MODE == 2) { const int blk = jc >> 2; if (blk < (q0 >> 8)) need = __any((mysel >> blk) & 1u) != 0; }
        }
        if (need) {
            const bfu* ksr = ksr0 + cur * KST; const lds_cptr vb = vb0 + cur * (VST * 2);
            f32x16 s0, s1;
#pragma unroll
            for (int r = 0; r < 16; ++r) { s0[r] = 0.f; s1[r] = 0.f; }
            {
                bf16x8 kf0[ND0], kf1[ND0];
#pragma unroll
                for (int d0 = 0; d0 < ND0; ++d0) { kf0[d0] = *(const bf16x8*)(ksr + d0 * 16); kf1[d0] = *(const bf16x8*)(ksr + 32 * KPT + d0 * 16); }
                __builtin_amdgcn_sched_barrier(0);
#pragma unroll
                for (int d0 = 0; d0 < ND0; ++d0) { s0 = MFMA(kf0[d0], qf[d0], s0); s1 = MFMA(kf1[d0], qf[d0], s1); }
            }
            const int kbase = jc * 64 + 4 * hi;
            if (MODE == 1) {
#pragma unroll
                for (int r = 0; r < 16; ++r) {
                    const int dd = qstep - (kbase + (r & 3) + 8 * (r >> 2));
                    if (dd < 0 || dd > 128) s0[r] = -INFINITY;
                    if (dd - 32 < 0 || dd - 32 > 128) s1[r] = -INFINITY;
                }
            } else {
                if (jc * 64 + 63 > qw) {
#pragma unroll
                    for (int r = 0; r < 16; ++r) {
                        const int ks = kbase + (r & 3) + 8 * (r >> 2);
                        if (ks > qstep) s0[r] = -INFINITY;
                        if (ks + 32 > qstep) s1[r] = -INFINITY;
                    }
                }
                if (MODE == 2) {
                    const int blk = jc >> 2;
                    if (blk < (q0 >> 8) && !((mysel >> blk) & 1u)) {
#pragma unroll
                        for (int r = 0; r < 16; ++r) { s0[r] = -INFINITY; s1[r] = -INFINITY; }
                    }
                }
            }
            float ps = 0.f;
#pragma unroll
            for (int r = 0; r < 16; ++r) { s0[r] = __builtin_amdgcn_exp2f(s0[r]); s1[r] = __builtin_amdgcn_exp2f(s1[r]); ps += s0[r] + s1[r]; }
            if (__builtin_expect(anym || __any(ps > 1e12f), 0)) {
                float mxp = fmaxf(s0[0], s1[0]);
#pragma unroll
                for (int r = 1; r < 16; ++r) mxp = fmaxf(mxp, fmaxf(s0[r], s1[r]));
                mxp = fmaxf(mxp, __shfl_xor(mxp, 32));
                const float e = (mxp > 0.f) ? (__builtin_amdgcn_logf(mxp) - m) : -1e30f;
                const float delta = (e > 24.f) ? floorf(e) : 0.f;
                m += delta;
                const float alpha = __builtin_amdgcn_exp2f(-delta), sc = __builtin_amdgcn_exp2f(-m);
                l *= alpha;
#pragma unroll
                for (int dvb = 0; dvb < NDV; ++dvb)
#pragma unroll
                    for (int r = 0; r < 16; ++r) o[dvb][r] *= alpha;
                ps = 0.f;
#pragma unroll
                for (int r = 0; r < 16; ++r) { s0[r] *= sc; s1[r] *= sc; ps += s0[r] + s1[r]; }
                anym = anym || (__any(m != 0.f) != 0);
            }
            l += ps;
            bf16x8 pf[4];
            pf[0] = __builtin_bit_cast(bf16x8, (u32x4){pk2(s0[0], s0[1]), pk2(s0[2], s0[3]), pk2(s0[4], s0[5]), pk2(s0[6], s0[7])});
            pf[1] = __builtin_bit_cast(bf16x8, (u32x4){pk2(s0[8], s0[9]), pk2(s0[10], s0[11]), pk2(s0[12], s0[13]), pk2(s0[14], s0[15])});
            pf[2] = __builtin_bit_cast(bf16x8, (u32x4){pk2(s1[0], s1[1]), pk2(s1[2], s1[3]), pk2(s1[4], s1[5]), pk2(s1[6], s1[7])});
            pf[3] = __builtin_bit_cast(bf16x8, (u32x4){pk2(s1[8], s1[9]), pk2(s1[10], s1[11]), pk2(s1[12], s1[13]), pk2(s1[14], s1[15])});
#pragma unroll
            for (int sx = 0; sx < 4; ++sx)
#pragma unroll
                for (int dvb = 0; dvb < NDV; ++dvb) {
                    const s16x4 lo = vtr(vb + dvb * 4096 + sx * 1024), hh = vtr(vb + dvb * 4096 + sx * 1024 + 512);
                    const bf16x8 vf = (bf16x8){lo[0], lo[1], lo[2], lo[3], hh[0], hh[1], hh[2], hh[3]};
                    o[dvb] = MFMA(vf, pf[sx], o[dvb]);
                }
        }
        __syncthreads();
    }
#undef ATT_LOAD
#undef ATT_STORE
    l += __shfl_xor(l, 32);
    const float inv = 1.f / l;
    const size_t tok = (size_t)(rowbase + (long)qstep * rs);
#pragma unroll
    for (int dvb = 0; dvb < NDV; ++dvb)
#pragma unroll
        for (int i = 0; i < 4; ++i) {
            const int dv = dvb * 32 + 8 * i + 4 * hi;
            *(u32x2*)(Op + tok * op + dv) = (u32x2){pk2(o[dvb][4 * i] * inv, o[dvb][4 * i + 1] * inv), pk2(o[dvb][4 * i + 2] * inv, o[dvb][4 * i + 3] * inv)};
        }
    if (MODE == 1) { if (hi == 0) lsep[tok * lsest] = m + __builtin_amdgcn_logf(l); }
}

DI void phase_attn_even(const Params& p, char* smem, int* s_item, int rep) {
    char* ws = p.ws;
    const bfu* ubuf = (const bfu*)(ws + OFF_UBUF);
    const bfu* Qa = (const bfu*)p.out; const bfu* Ka = Qa + (size_t)T * 768; const bfu* Va = Ka + (size_t)T * 768;
    bfu* obuf = (bfu*)(ws + OFF_OBUF); bfu* dil_o = (bfu*)(ws + OFF_HBUF); float* dil_lse = (float*)(ws + OFF_HBUF + 48 * MiB);
    const int nblk = gridDim.x;
    for (int it = blockIdx.x; it < 1024; it += nblk) {
        int bh, qt;
        if (nblk == 256) { const int x = blockIdx.x & 7, li = blockIdx.x >> 3, hs = it >> 8; bh = x + 8 * hs; qt = (hs & 1) ? li : 31 - li; }
        else { bh = it & 31; qt = 31 - (it >> 5); }
        const int b = bh >> 3, h = bh & 7;
        __syncthreads();
        attn_item<96, 64, 0>(Qa + h * 96, 768, Ka + h * 96, 768, Va + h * 64, 512, (long)b * SEQ, 1, qt * 256, obuf + h * 64, 768, nullptr, 0, nullptr, smem);
    }
    for (int i2 = blockIdx.x; i2 < 1536; i2 += nblk) {
        const int g = i2 >> 9, r2 = i2 & 511, h = r2 & 3, b = (r2 >> 2) & 3, qi = r2 >> 4;
        const int rr = (g == 0) ? 1 : (g == 1 ? 4 : 16), tpc = 32 / rr, cls = qi / tpc, st = qi % tpc;
        const int gh = g * 4 + h;
        __syncthreads();
        attn_item<64, 64, 1>(ubuf + 672 + gh * 64, 3072, ubuf + 672 + 768 + gh * 64, 3072, ubuf + 672 + 1536 + gh * 64, 3072, (long)b * SEQ + cls, rr, st * 256,
                             dil_o + gh * 64, 768, dil_lse + gh, 12, nullptr, smem);
    }
}
DI void phase_attn_odd(const Params& p, char* smem, int* s_item, int rep) {
    char* ws = p.ws;
    const bfu* ubuf = (const bfu*)(ws + OFF_UBUF);
    bfu* obuf = (bfu*)(ws + OFF_OBUF); bfu* dbuf = (bfu*)(ws + OFF_DBUF); const float* kpart = (const float*)(ws + OFF_KPART);
    const int nblk = gridDim.x;
    for (int it = blockIdx.x; it < 2048; it += nblk) {
        int bh, qt, kind;
        if (nblk == 256) { const int x = blockIdx.x & 7, li = blockIdx.x >> 3, hs = it >> 8; kind = hs >> 2; bh = x + 8 * (hs & 3); qt = (hs & 1) ? li : 31 - li; }
        else { kind = (it >> 5) & 1; bh = it & 31; qt = 31 - (it >> 6); }
        const int b = bh >> 3, hh = bh & 7;
        __syncthreads();
        if (kind == 0) {
            attn_item<64, 128, 0>(ubuf + hh * 64, 3072, ubuf + 512 + hh * 64, 3072, ubuf + 1024 + (hh >> 1) * 128, 3072, (long)b * SEQ, 1, qt * 256,
                                  dbuf + hh * 128, 1024, nullptr, 0, nullptr, smem);
        } else {
            attn_item<64, 64, 2>(ubuf + 1536 + hh * 64, 3072, ubuf + 2048 + hh * 64, 3072, ubuf + 2560 + hh * 64, 3072, (long)b * SEQ, 1, qt * 256,
                                 obuf + 512 + hh * 64, 1024, nullptr, 0, kpart + (size_t)b * (32 * 4 * 512) + hh * 64, smem);
        }
    }
}

#define XB_TMO      128
#define XB_XCNT(j)  (256  + 64 * (j))
#define XB_XSUB(j)  (1280 + 64 * (j))
#define XB_XGEN(j)  (2304 + 64 * (j))
#define XB_TOP      3328
#define XB_TOPGEN   3392
#define XCD_BAR_WORDS 3456
#define XB_SPIN_CAP (1u << 18)
#define LAS __attribute__((address_space(3)))

__device__ __forceinline__ unsigned xb_ld(unsigned* p)              { return __hip_atomic_load(p, __ATOMIC_RELAXED, __HIP_MEMORY_SCOPE_AGENT); }
__device__ __forceinline__ unsigned xb_add(unsigned* p, unsigned v) { return __hip_atomic_fetch_add(p, v, __ATOMIC_RELAXED, __HIP_MEMORY_SCOPE_AGENT); }
__device__ __forceinline__ unsigned xb_xcc_id() { return (unsigned)__builtin_amdgcn_s_getreg((3 << 11) | 20) & 0xFu; }
#define XB_SPIN(cond, bar) do { unsigned _sp = 0; while (cond) { __builtin_amdgcn_s_sleep(1); \
    if ((++_sp & 255u) == 0u) { if (xb_ld(&(bar)[XB_TMO])) break; if (_sp > XB_SPIN_CAP) { atomicAdd(&(bar)[XB_TMO], 1u); break; } } } } while (0)

struct XcdBarrier {
    unsigned* bar; unsigned x;
    volatile LAS unsigned* st;
};

__device__ __forceinline__ XcdBarrier xcd_barrier_post(unsigned* bar, volatile LAS unsigned* st) {
    XcdBarrier b; b.bar = bar; b.x = xb_xcc_id(); b.st = st;
    if (threadIdx.x == 0) (void)xb_add(&bar[XB_XCNT(b.x)], 1u);
    return b;
}
__device__ __forceinline__ void xcd_barrier_complete(unsigned* bar, unsigned x, unsigned& nloc, unsigned& nx) {
    const unsigned G = gridDim.x * gridDim.y * gridDim.z;
    unsigned sum, cnt, mine, sp = 0u;
    for (;;) {
        sum = 0u; cnt = 0u; mine = 0u;
#pragma unroll
        for (unsigned j = 0; j < 16; ++j) { const unsigned c = xb_ld(&bar[XB_XCNT(j)]); sum += c; cnt += (c > 0u) ? 1u : 0u; mine = (j == x) ? c : mine; }
        if (sum == G) break;
        __builtin_amdgcn_s_sleep(1);
        if ((++sp & 255u) == 0u) { if (xb_ld(&bar[XB_TMO])) break; if (sp > XB_SPIN_CAP) { atomicAdd(&bar[XB_TMO], 1u); break; } }
    }
    nloc = mine > 0u ? mine : 1u; nx = cnt > 0u ? cnt : 1u;
}

__device__ __forceinline__ void xcd_barrier(const XcdBarrier& b) {
    asm volatile("s_waitcnt vmcnt(0)" ::: "memory");
    __syncthreads();
    if (threadIdx.x == 0) {
        unsigned* bar = b.bar;
        __builtin_amdgcn_s_waitcnt(0);
        unsigned nloc = b.st[0], nx = b.st[1];
        if (nloc == 0u) { xcd_barrier_complete(bar, b.x, nloc, nx); b.st[0] = nloc; b.st[1] = nx; }
        const unsigned old = xb_add(&bar[XB_XSUB(b.x)], 1u);
        const unsigned gen = old / nloc;
        if (old + 1u == (gen + 1u) * nloc) {
            __builtin_amdgcn_fence(__ATOMIC_RELEASE, "agent");
            asm volatile("s_waitcnt vmcnt(0)" ::: "memory");
            const unsigned og = xb_add(&bar[XB_TOP], 1u);
            const unsigned tg = og / nx;
            if (og + 1u == (tg + 1u) * nx) xb_add(&bar[XB_TOPGEN], 1u);
            else XB_SPIN(xb_ld(&bar[XB_TOPGEN]) == tg, bar);
            __builtin_amdgcn_fence(__ATOMIC_ACQUIRE, "agent");
            xb_add(&bar[XB_XGEN(b.x)], 1u);
            asm volatile("s_waitcnt vmcnt(0)" ::: "memory");
        } else {
            XB_SPIN(xb_ld(&bar[XB_XGEN(b.x)]) == gen, bar);
            __builtin_amdgcn_fence(__ATOMIC_ACQUIRE, "agent");
            asm volatile("s_waitcnt vmcnt(0)" ::: "memory");
        }
    }
    __syncthreads();
}

#ifndef MK_REPMASK
#define MK_REPMASK 0u
#endif
#define PHASE_BEGIN(k) if (p.phase_lo <= (k) && (k) < p.phase_hi) { for (int rep_ = 0; rep_ < (((MK_REPMASK >> (k)) & 1u) ? 2 : 1); ++rep_) {
#define PHASE_MID(k) if (rep_ == 0 && ((MK_REPMASK >> (k)) & 1u)) xcd_barrier(xb); }
#define PHASE_END(k) PHASE_MID(k) if (p.coop && (k) + 1 < p.phase_hi) xcd_barrier(xb); }
__global__ void __launch_bounds__(512) mega(Params p) {
    extern __shared__ __attribute__((aligned(16))) char smem[];
    __shared__ int s_item;
    __shared__ uint4 xb_words;
    char* ws = p.ws;
    if (threadIdx.x == 0) xb_words = make_uint4(0u, 0u, 0u, 0u);
    __syncthreads();
    XcdBarrier xb = xcd_barrier_post((unsigned*)(ws + OFF_CTR + 4096), (volatile LAS unsigned*)&xb_words);
    bfu* hbuf = (bfu*)(ws + OFF_HBUF); bfu* obuf = (bfu*)(ws + OFF_OBUF); bfu* ubuf = (bfu*)(ws + OFF_UBUF); bfu* hid = ubuf;
    const float* mod0 = (const float*)(ws + OFF_MOD); const float* mod1 = mod0 + 4 * 6144;
    PHASE_BEGIN(0) phase_prep(p, smem); PHASE_END(0)
    PHASE_BEGIN(1) phase_modfin(p); PHASE_END(1)
    PHASE_BEGIN(2) phase_normmod(p.x, p.norm_mix, mod0, 0, hbuf); PHASE_END(2)
    PHASE_BEGIN(3) phase_gemm<0>(hbuf, 1024, (const bfu*)(ws + OFF_WIN0), 1024, 2976, 12, ubuf, 3072, nullptr, nullptr, nullptr, smem); PHASE_END(3)
#if MK_PROBE
    if (p.coop) { phase_gemm_probe<MK_PROBE - 1>(hbuf, (const bfu*)(ws + OFF_WIN0), (float*)(ws + OFF_DBUF), p.pad_, smem); xcd_barrier(xb); }
#endif
    PHASE_BEGIN(4)
            phase_gemm<0>(ubuf, 3072, (const bfu*)(ws + OFF_WUQ), 384, 768, 3, hbuf, 768, nullptr, nullptr, nullptr, smem);
            phase_gemm<0>(ubuf + 384, 3072, (const bfu*)(ws + OFF_WUKV), 256, 1024, 4, obuf, 1024, nullptr, nullptr, nullptr, smem);
    PHASE_END(4)
    PHASE_BEGIN(5) phase_post_even(p); PHASE_END(5)
    PHASE_BEGIN(6) phase_attn_even(p, smem, &s_item, rep_); PHASE_END(6)
    PHASE_BEGIN(7) phase_dil_merge(p); PHASE_END(7)
    PHASE_BEGIN(8) phase_gemm<2>(obuf, 768, (const bfu*)(ws + OFF_WOUT0), 768, 1024, 4, nullptr, 0, p.x, p.out, mod0 + 2048, smem); PHASE_END(8)
    PHASE_BEGIN(9) phase_normmod(p.out, p.norm_mlp, mod0, 3072, hbuf); PHASE_END(9)
    PHASE_BEGIN(10) phase_gemm<1>(hbuf, 1024, (const bfu*)(ws + OFF_W1_0), 1024, 4096, 16, hid, 4096, nullptr, nullptr, nullptr, smem); PHASE_END(10)
    PHASE_BEGIN(11) phase_gemm<2>(hid, 4096, (const bfu*)(ws + OFF_W2_0), 4096, 1024, 4, nullptr, 0, p.out, p.out, mod0 + 5120, smem); PHASE_END(11)
    PHASE_BEGIN(12) phase_normmod(p.out, p.norm_mix + 1024, mod1, 0, hbuf); PHASE_END(12)
    PHASE_BEGIN(13) phase_gemm<0>(hbuf, 1024, (const bfu*)(ws + OFF_WIN1), 1024, 3072, 12, ubuf, 3072, nullptr, nullptr, nullptr, smem); PHASE_END(13)
    PHASE_BEGIN(14) phase_post_odd(p, smem); PHASE_END(14)
    PHASE_BEGIN(15) phase_attn_odd(p, smem, &s_item, rep_); PHASE_END(15)
    PHASE_BEGIN(16) phase_diff_combine(p); PHASE_END(16)
    PHASE_BEGIN(17) phase_gemm<2>(obuf, 1024, (const bfu*)(ws + OFF_WOUT1), 1024, 1024, 4, nullptr, 0, p.out, p.out, mod1 + 2048, smem); PHASE_END(17)
    PHASE_BEGIN(18) phase_normmod(p.out, p.norm_mlp + 1024, mod1, 3072, hbuf); PHASE_END(18)
    PHASE_BEGIN(19) phase_gemm<1>(hbuf, 1024, (const bfu*)(ws + OFF_W1_1), 1024, 4096, 16, hid, 4096, nullptr, nullptr, nullptr, smem); PHASE_END(19)
    PHASE_BEGIN(20) phase_gemm<2>(hid, 4096, (const bfu*)(ws + OFF_W2_1), 4096, 1024, 4, nullptr, 0, p.out, p.out, mod1 + 5120, smem); PHASE_END(20)
    if (p.coop == 2) cg::this_grid().sync();
}

extern "C" void kernel_launch(void* const* d_in, const int* in_sizes, int n_in, void* d_out, int out_size, void* d_ws, size_t ws_size, hipStream_t stream) {
    static int grid_blocks = 0;
    if (!grid_blocks) {
        int dev = 0, cus = 0, per_cu = 0;
        (void)hipGetDevice(&dev);
        (void)hipDeviceGetAttribute(&cus, hipDeviceAttributeMultiprocessorCount, dev);
        (void)hipFuncSetAttribute((const void*)mega, hipFuncAttributeMaxDynamicSharedMemorySize, DYN_LDS);
        (void)hipOccupancyMaxActiveBlocksPerMultiprocessor(&per_cu, mega, NT, DYN_LDS);
        if (per_cu != 1) per_cu = 1;
        grid_blocks = cus * per_cu;
    }
    if (ws_size < WS_END) fprintf(stderr, "workspace too small: %zu < %zu\n", ws_size, (size_t)WS_END);
    Params p{};
    p.x = (const float*)d_in[0]; p.c = (const float*)d_in[1]; p.pos = (const int*)d_in[2];
    p.ada_w = (const float*)d_in[3]; p.ada_b = (const float*)d_in[4]; p.norm_mix = (const float*)d_in[5]; p.norm_mlp = (const float*)d_in[6];
    p.w1 = (const float*)d_in[7]; p.w2 = (const float*)d_in[8]; p.e_win = (const float*)d_in[9]; p.e_wout = (const float*)d_in[10];
    p.qlat = (const float*)d_in[11]; p.kvlat = (const float*)d_in[12]; p.wuq = (const float*)d_in[13]; p.wukv = (const float*)d_in[14];
    p.mla_qn = (const float*)d_in[15]; p.mla_kn = (const float*)d_in[16]; p.dil_qn = (const float*)d_in[17]; p.dil_kn = (const float*)d_in[18];
    p.o_win = (const float*)d_in[19]; p.o_wout = (const float*)d_in[20]; p.diff_qn = (const float*)d_in[21]; p.diff_kn = (const float*)d_in[22];
    p.diff_lam = (const float*)d_in[23]; p.diff_subln = (const float*)d_in[24]; p.moba_qn = (const float*)d_in[25]; p.moba_kn = (const float*)d_in[26];
    p.out = (float*)d_out; p.ws = (char*)d_ws;
    for (int i = 0; i < 32; ++i) p.invf64[i] = (float)pow(10000.0, -(double)i / 32.0);
    for (int i = 0; i < 16; ++i) p.invf32[i] = (float)pow(10000.0, -(double)i / 16.0);
    (void)hipMemsetAsync((char*)d_ws + OFF_CTR, 0, 32768, stream);
#if MK_COOP
    p.phase_lo = 0; p.phase_hi = NPH; p.coop = 1;
    void* args[] = {&p};
    hipError_t e = hipLaunchCooperativeKernel((void*)mega, dim3(grid_blocks), dim3(NT), args, DYN_LDS, stream);
    if (e != hipSuccess) fprintf(stderr, "cooperative launch failed: %s (grid %d)\n", hipGetErrorString(e), grid_blocks);
#else
    for (int ph = 0; ph < NPH; ++ph) {
        p.phase_lo = ph; p.phase_hi = ph + 1; p.coop = 0;
        hipLaunchKernelGGL(mega, dim3(grid_blocks), dim3(NT), DYN_LDS, stream, p);
    }
#endif
}
```

```cpp
#include <hip/hip_runtime.h>
#include <hip/hip_cooperative_groups.h>
#include <stdint.h>
#include <cstdio>
#include <cmath>
namespace cg = cooperative_groups;

#ifndef MK_COOP
#define MK_COOP 1
#endif

typedef unsigned short bfu;
typedef __attribute__((ext_vector_type(8))) short bf16x8;
typedef __attribute__((ext_vector_type(4))) short s16x4;
typedef short v4i16_t __attribute__((ext_vector_type(4)));
typedef __attribute__((ext_vector_type(16))) float f32x16;
typedef __attribute__((ext_vector_type(4))) float f32x4;
typedef __attribute__((ext_vector_type(2))) float f32x2;
typedef __attribute__((ext_vector_type(4))) unsigned u32x4;
typedef __attribute__((ext_vector_type(2))) unsigned u32x2;
typedef __attribute__((ext_vector_type(2))) __bf16 bf2_t;
typedef __attribute__((address_space(3))) const char* lds_cptr;

#define DI __device__ __forceinline__
#define MFMA(a, b, c) __builtin_amdgcn_mfma_f32_32x32x16_bf16((a), (b), (c), 0, 0, 0)

constexpr int T = 32768, SEQ = 8192;
constexpr float EPS = 1e-6f;
constexpr float LOG2E = 1.4426950408889634f;
constexpr float SC_MLA = 0.10206207261596577f * LOG2E;
constexpr float SC_64 = 0.125f * LOG2E;
constexpr float LAM_INIT = 0.35550906759096926f;
constexpr int NPH = 21;
constexpr int NT = 512, NW = 8;
constexpr int DYN_LDS = 2 * 512 * 72 * 2;

constexpr size_t MiB = 1048576;
constexpr size_t OFF_WIN0 = 0, OFF_WIN1 = 6 * MiB, OFF_W1_0 = 12 * MiB, OFF_W1_1 = 20 * MiB, OFF_W2_0 = 28 * MiB, OFF_W2_1 = 36 * MiB,
                 OFF_WOUT0 = 44 * MiB, OFF_WOUT1 = 46 * MiB, OFF_WUQ = 48 * MiB, OFF_WUKV = 49 * MiB, OFF_MODP = 50 * MiB, OFF_MOD = 52 * MiB,
                 OFF_ROPE64 = 53 * MiB, OFF_ROPE32 = 61 * MiB, OFF_KPART = 65 * MiB, OFF_CTR = 66 * MiB,
                 OFF_HBUF = 72 * MiB, OFF_OBUF = 136 * MiB, OFF_UBUF = 200 * MiB, OFF_DBUF = 392 * MiB,
                 OFF_PO2 = 456 * MiB, OFF_PLSE = 488 * MiB, OFF_SEG = 492 * MiB, OFF_CNT = 508 * MiB, WS_END = 509 * MiB;

struct Params {
    const float *x, *c; const int* pos;
    const float *ada_w, *ada_b, *norm_mix, *norm_mlp, *w1, *w2, *e_win, *e_wout, *qlat, *kvlat, *wuq, *wukv, *mla_qn, *mla_kn, *dil_qn, *dil_kn,
        *o_win, *o_wout, *diff_qn, *diff_kn, *diff_lam, *diff_subln, *moba_qn, *moba_kn;
    float* out; char* ws;
    float invf64[32]; float invf32[16];
    int phase_lo, phase_hi, coop, pad_;
};

DI unsigned pk2(float a, float b) { f32x2 v = {a, b}; bf2_t r = __builtin_convertvector(v, bf2_t); return __builtin_bit_cast(unsigned, r); }
DI float bflo(unsigned u) { return __uint_as_float(u << 16); }
DI float bfhi(unsigned u) { return __uint_as_float(u & 0xffff0000u); }
DI float wave_sum(float v) {
#pragma unroll
    for (int o = 32; o; o >>= 1) v += __shfl_xor(v, o);
    return v; }
DI s16x4 vtr(lds_cptr p) { return __builtin_bit_cast(s16x4, __builtin_amdgcn_ds_read_tr16_b64_v4i16((__attribute__((address_space(3))) v4i16_t*)p)); }

DI int hp_col(int n) { return (n & ~255) + 64 * ((n >> 5) & 3) + 32 * ((n >> 7) & 1) + (n & 31); }
DI void tr_tile(const float* __restrict__ src, int K, int N, bfu* __restrict__ dst, const float* __restrict__ kscale, int it, float* tl, int hperm) {
    const int nkt = K >> 6; const int kt = it % nkt, nt = it / nkt; const int tid = threadIdx.x;
#pragma unroll
    for (int rr = 0; rr < 2; ++rr) {
        const int kl = rr * 32 + (tid >> 4), k = kt * 64 + kl, nl = (tid & 15) * 4, n = nt * 64 + nl;
        float4 v = make_float4(0.f, 0.f, 0.f, 0.f);
        if (n < N) v = *(const float4*)(src + (size_t)k * N + (hperm ? hp_col(n) : n));
        if (kscale) { const float sc = kscale[k]; v.x *= sc; v.y *= sc; v.z *= sc; v.w *= sc; }
        tl[kl * 65 + nl] = v.x; tl[kl * 65 + nl + 1] = v.y; tl[kl * 65 + nl + 2] = v.z; tl[kl * 65 + nl + 3] = v.w;
    }
    __syncthreads();
    {
        const int nl = tid >> 3, kc = (tid & 7) * 8;
        unsigned w[4];
#pragma unroll
        for (int i = 0; i < 4; ++i) w[i] = pk2(tl[(kc + 2 * i) * 65 + nl], tl[(kc + 2 * i + 1) * 65 + nl]);
        bfu* d = dst + (size_t)(nt * 64 + nl) * K + kt * 64 + kc;
        *(u32x4*)d = (u32x4){w[0], w[1], w[2], w[3]};
    }
    __syncthreads();
}
DI void tr_matrix(const float* src, int K, int N, int Npad, bfu* dst, const float* kscale, float* tl, int hperm = 0) {
    const int nit = (K >> 6) * (Npad >> 6);
    for (int it = blockIdx.x; it < nit; it += gridDim.x) tr_tile(src, K, N, dst, kscale, it, tl, hperm);
}

DI void phase_prep(const Params& p, char* smem) {
    float* tl = (float*)smem;
    char* ws = p.ws;
    if (blockIdx.x == 0 && threadIdx.x < 4) ((int*)(ws + OFF_CTR))[threadIdx.x] = 0;
    tr_matrix(p.e_win, 1024, 2976, 3072, (bfu*)(ws + OFF_WIN0), nullptr, tl);
    tr_matrix(p.o_win, 1024, 3072, 3072, (bfu*)(ws + OFF_WIN1), nullptr, tl, 1);
    tr_matrix(p.w1, 1024, 4096, 4096, (bfu*)(ws + OFF_W1_0), nullptr, tl);
    tr_matrix(p.w1 + (size_t)1024 * 4096, 1024, 4096, 4096, (bfu*)(ws + OFF_W1_1), nullptr, tl);
    tr_matrix(p.w2, 4096, 1024, 1024, (bfu*)(ws + OFF_W2_0), nullptr, tl);
    tr_matrix(p.w2 + (size_t)1024 * 4096, 4096, 1024, 1024, (bfu*)(ws + OFF_W2_1), nullptr, tl);
    tr_matrix(p.e_wout, 768, 1024, 1024, (bfu*)(ws + OFF_WOUT0), nullptr, tl);
    tr_matrix(p.o_wout, 1024, 1024, 1024, (bfu*)(ws + OFF_WOUT1), nullptr, tl);
    tr_matrix(p.wuq, 384, 768, 768, (bfu*)(ws + OFF_WUQ), p.qlat, tl);
    tr_matrix(p.wukv, 256, 1024, 1024, (bfu*)(ws + OFF_WUKV), p.kvlat, tl);
    {
        float2* r64 = (float2*)(ws + OFF_ROPE64); float2* r32 = (float2*)(ws + OFF_ROPE32);
        for (int idx = blockIdx.x * NT + threadIdx.x; idx < T * 48; idx += gridDim.x * NT) {
            const int t = idx / 48, i = idx % 48;
            const float invf = (i < 32) ? p.invf64[i] : p.invf32[i - 32];
            const float a = (float)p.pos[t] * invf;
            double rev = (double)a * 0.15915494309189535; rev -= floor(rev);
            const double y = (rev > 0.5 ? rev - 1.0 : rev) * 6.283185307179586;
            const double y2 = y * y; double s = 1.0, c = 1.0;
#pragma unroll
            for (int k = 15; k >= 1; --k) { s = 1.0 - s * y2 * (1.0 / (double)((2 * k) * (2 * k + 1))); c = 1.0 - c * y2 * (1.0 / (double)((2 * k - 1) * (2 * k))); }
            s *= y;
            const float2 o = make_float2((float)c, (float)s);
            if (i < 32) r64[(size_t)t * 32 + i] = o; else r32[(size_t)t * 16 + (i - 32)] = o;
        }
    }
    {
        float* sl = (float*)smem; float* modp = (float*)(ws + OFF_MODP);
        for (int it = blockIdx.x; it < 2 * 12 * 8; it += gridDim.x) {
            const int l = it / 96, cc = (it % 96) / 8, kc = it % 8;
            __syncthreads();
            { const int i = threadIdx.x, b = i >> 7, kk = i & 127; const float cv = p.c[b * 1024 + kc * 128 + kk]; sl[i] = cv / (1.f + __expf(-cv)); }
            __syncthreads();
            const int j = cc * 512 + threadIdx.x;
            const float* w = p.ada_w + ((size_t)l * 1024 + kc * 128) * 6144 + j;
            float a0 = 0.f, a1 = 0.f, a2 = 0.f, a3 = 0.f;
#pragma unroll 8
            for (int kk = 0; kk < 128; ++kk) { const float wv = w[(size_t)kk * 6144]; a0 += sl[kk] * wv; a1 += sl[128 + kk] * wv; a2 += sl[256 + kk] * wv; a3 += sl[384 + kk] * wv; }
            float* o = modp + (size_t)((l * 8 + kc) * 4) * 6144 + j;
            o[0] = a0; o[6144] = a1; o[2 * 6144] = a2; o[3 * 6144] = a3;
        }
        __syncthreads();
    }
}

DI void phase_modfin(const Params& p) {
    const float* modp = (const float*)(p.ws + OFF_MODP); float* mod = (float*)(p.ws + OFF_MOD);
    for (int idx = blockIdx.x * NT + threadIdx.x; idx < 2 * 4 * 6144; idx += gridDim.x * NT) {
        const int l = idx / 24576, rem = idx % 24576, j = rem % 6144;
        float s = p.ada_b[l * 6144 + j];
#pragma unroll
        for (int kc = 0; kc < 8; ++kc) s += modp[(size_t)((l * 8 + kc) * 4) * 6144 + rem];
        mod[idx] = s;
    }
}

DI void phase_normmod(const float* xs, const float* __restrict__ nw, const float* __restrict__ mod, int sh_off, bfu* __restrict__ hb) {
    const int lane = threadIdx.x & 63, gw = blockIdx.x * NW + (threadIdx.x >> 6), nwv = gridDim.x * NW;
    for (int t = gw; t < T; t += nwv) {
        const int b = t >> 13; const float* xr = xs + (size_t)t * 1024;
        float4 v[4]; float ss = 0.f;
#pragma unroll
        for (int i = 0; i < 4; ++i) { v[i] = *(const float4*)(xr + (i * 64 + lane) * 4); ss += v[i].x * v[i].x + v[i].y * v[i].y + v[i].z * v[i].z + v[i].w * v[i].w; }
        ss = wave_sum(ss);
        const float rinv = rsqrtf(ss * (1.f / 1024.f) + EPS);
        const float* mb = mod + b * 6144 + sh_off;
#pragma unroll
        for (int i = 0; i < 4; ++i) {
            const int col = (i * 64 + lane) * 4;
            const float4 w = *(const float4*)(nw + col), sh = *(const float4*)(mb + col), sc = *(const float4*)(mb + 1024 + col);
            const float o0 = v[i].x * rinv * w.x * (1.f + sc.x) + sh.x, o1 = v[i].y * rinv * w.y * (1.f + sc.y) + sh.y;
            const float o2 = v[i].z * rinv * w.z * (1.f + sc.z) + sh.z, o3 = v[i].w * rinv * w.w * (1.f + sc.w) + sh.w;
            *(u32x2*)(hb + (size_t)t * 1024 + col) = (u32x2){pk2(o0, o1), pk2(o2, o3)};
        }
    }
}

template <int EPI>
DI void gemm_tile(const bfu* __restrict__ A, int lda, const bfu* __restrict__ Bt, int K, int m0, int n0, int N,
                  bfu* Cb, int ldc, const float* resid, float* outf, const float* __restrict__ gate, char* smem) {
    constexpr int STG = 512 * 72;
    bfu* S0 = (bfu*)smem;
    const int tid = threadIdx.x, lane = tid & 63, wid = tid >> 6, l32 = lane & 31, hi = lane >> 5;
    const int wm = wid & 3, wn = wid >> 2;
    f32x16 acc[4][2];
#pragma unroll
    for (int nb = 0; nb < 4; ++nb)
#pragma unroll
        for (int mb = 0; mb < 2; ++mb)
#pragma unroll
            for (int r = 0; r < 16; ++r) acc[nb][mb][r] = 0.f;
    const bfu* Ag = A + (size_t)(m0 + (tid >> 3)) * lda + (tid & 7) * 8;
    const bfu* Bg = Bt + (size_t)(n0 + (tid >> 3)) * K + (tid & 7) * 8;
    u32x4 ra[4], rb[4];
#pragma unroll
    for (int i = 0; i < 4; ++i) { ra[i] = *(const u32x4*)(Ag + (size_t)(64 * i) * lda); rb[i] = *(const u32x4*)(Bg + (size_t)(64 * i) * K); }
    const int nk = K >> 6;
    const int wofs = (tid >> 3) * 72 + (tid & 7) * 8;
    const int arofs = (wm * 64 + l32) * 72 + hi * 8, brofs = 256 * 72 + (wn * 128 + l32) * 72 + hi * 8;
    __syncthreads();
#pragma unroll
    for (int i = 0; i < 4; ++i) { *(u32x4*)(S0 + wofs + 64 * i * 72) = ra[i]; *(u32x4*)(S0 + 256 * 72 + wofs + 64 * i * 72) = rb[i]; }
    if (nk > 1) {
#pragma unroll
        for (int i = 0; i < 4; ++i) { ra[i] = *(const u32x4*)(Ag + (size_t)(64 * i) * lda + 64); rb[i] = *(const u32x4*)(Bg + (size_t)(64 * i) * K + 64); }
    }
    __syncthreads();
#pragma unroll 1
    for (int kt = 0; kt < nk; ++kt) {
        const bfu* Sc = S0 + (kt & 1) * STG; bfu* Sn = S0 + ((kt & 1) ^ 1) * STG;
        if (kt + 1 < nk) {
#pragma unroll
            for (int i = 0; i < 4; ++i) { *(u32x4*)(Sn + wofs + 64 * i * 72) = ra[i]; *(u32x4*)(Sn + 256 * 72 + wofs + 64 * i * 72) = rb[i]; }
        }
        __builtin_amdgcn_sched_barrier(0);
        if (kt + 2 < nk) {
            const int ko = (kt + 2) * 64;
#pragma unroll
            for (int i = 0; i < 4; ++i) { ra[i] = *(const u32x4*)(Ag + (size_t)(64 * i) * lda + ko); rb[i] = *(const u32x4*)(Bg + (size_t)(64 * i) * K + ko); }
        }
        __builtin_amdgcn_sched_barrier(0);
#pragma unroll
        for (int k16 = 0; k16 < 4; ++k16) {
            bf16x8 af[2], bfr[4];
#pragma unroll
            for (int mb = 0; mb < 2; ++mb) af[mb] = *(const bf16x8*)(Sc + arofs + mb * 32 * 72 + k16 * 16);
#pragma unroll
            for (int nb = 0; nb < 4; ++nb) bfr[nb] = *(const bf16x8*)(Sc + brofs + nb * 32 * 72 + k16 * 16);
#pragma unroll
            for (int nb = 0; nb < 4; ++nb)
#pragma unroll
                for (int mb = 0; mb < 2; ++mb) acc[nb][mb] = MFMA(bfr[nb], af[mb], acc[nb][mb]);
        }
        __syncthreads();
    }
    if (EPI != 2) {
        constexpr int CP = 264;
        bfu* Cs = (bfu*)smem;
#pragma unroll
        for (int nb = 0; nb < 4; ++nb)
#pragma unroll
            for (int mb = 0; mb < 2; ++mb) {
                const int row = wm * 64 + mb * 32 + l32;
#pragma unroll
                for (int i = 0; i < 4; ++i) {
                    const int col = wn * 128 + nb * 32 + 8 * i + 4 * hi;
                    float v0 = acc[nb][mb][4 * i], v1 = acc[nb][mb][4 * i + 1], v2 = acc[nb][mb][4 * i + 2], v3 = acc[nb][mb][4 * i + 3];
                    if (EPI == 1) { v0 = fmaxf(v0, 0.f); v1 = fmaxf(v1, 0.f); v2 = fmaxf(v2, 0.f); v3 = fmaxf(v3, 0.f); v0 *= v0; v1 *= v1; v2 *= v2; v3 *= v3; }
                    *(u32x2*)(Cs + row * CP + col) = (u32x2){pk2(v0, v1), pk2(v2, v3)};
                }
            }
        __syncthreads();
        const int c8 = (tid & 31) * 8, n = n0 + c8;
#pragma unroll 1
        for (int ps = 0; ps < 16; ++ps) {
            const int row = ps * 16 + (tid >> 5);
            const u32x4 v = *(const u32x4*)(Cs + row * CP + c8);
            if (n < N) *(u32x4*)(Cb + (size_t)(m0 + row) * ldc + n) = v;
        }
        __syncthreads();
    } else {
        constexpr int CPF = 132;
        float* Cs = (float*)smem;
#pragma unroll
        for (int p2 = 0; p2 < 2; ++p2) {
#pragma unroll
            for (int nbl = 0; nbl < 2; ++nbl)
#pragma unroll
                for (int mb = 0; mb < 2; ++mb) {
                    const int row = wm * 64 + mb * 32 + l32;
#pragma unroll
                    for (int i = 0; i < 4; ++i) {
                        const int col = wn * 64 + nbl * 32 + 8 * i + 4 * hi;
                        *(f32x4*)(Cs + row * CPF + col) = (f32x4){acc[2 * p2 + nbl][mb][4 * i], acc[2 * p2 + nbl][mb][4 * i + 1], acc[2 * p2 + nbl][mb][4 * i + 2], acc[2 * p2 + nbl][mb][4 * i + 3]};
                    }
                }
            __syncthreads();
            const int cl = (tid & 31) * 4;
            const int n = n0 + (cl >> 6) * 128 + (2 * p2 + ((cl >> 5) & 1)) * 32 + (cl & 31);
#pragma unroll 1
            for (int ps = 0; ps < 16; ++ps) {
                const int row = ps * 16 + (tid >> 5), m = m0 + row, b = m >> 13;
                const f32x4 v = *(const f32x4*)(Cs + row * CPF + cl);
                const float4 g = *(const float4*)(gate + b * 6144 + n);
                const float4 r = *(const float4*)(resid + (size_t)m * 1024 + n);
                float4 o; o.x = r.x + g.x * v[0]; o.y = r.y + g.y * v[1]; o.z = r.z + g.z * v[2]; o.w = r.w + g.w * v[3];
                *(float4*)(outf + (size_t)m * 1024 + n) = o;
            }
            __syncthreads();
        }
    }
}

DI bool gemm_map(int round, int nsn, int nwt, int& mt, int& nt) {
    const int x = blockIdx.x & 7, li = blockIdx.x >> 3;
    const int st = round * 8 + x;
    if (st >= 16 * nsn || (li >> 3) >= nwt) return false;
    const int sm = st / nsn, sn = st % nsn;
    mt = sm * 8 + (li & 7); nt = sn * nwt + (li >> 3);
    return true;
}
template <int EPI>
DI void phase_gemm(const bfu* A, int lda, const bfu* Bt, int K, int N, int ntn, bfu* Cb, int ldc, const float* resid, float* outf, const float* gate, char* smem) {
    const bool xcd = (gridDim.x == 256);
    const int nwt = (ntn % 4 == 0) ? 4 : ntn, nsn = ntn / nwt;
    const int rounds = xcd ? 2 * nsn : (128 * ntn + (int)gridDim.x - 1) / (int)gridDim.x;
    for (int r = 0; r < rounds; ++r) {
        int mt = 0, nt = 0; bool ok;
        if (xcd) ok = gemm_map(r, nsn, nwt, mt, nt);
        else { const int tile = r * gridDim.x + blockIdx.x; ok = tile < 128 * ntn; mt = tile / ntn; nt = tile % ntn; }
        if (ok) gemm_tile<EPI>(A, lda, Bt, K, mt * 256, nt * 256, N, Cb, ldc, resid, outf, gate, smem);
    }
}


namespace pg8 {
#define PG8_LAS __attribute__((address_space(3)))
typedef unsigned short bf16_t;
typedef short bf16x8 __attribute__((ext_vector_type(8)));
typedef float f32x4 __attribute__((ext_vector_type(4)));
typedef unsigned u32x4 __attribute__((ext_vector_type(4)));
constexpr int BM = 256, BK = 64, HALF = 128, HTB = HALF * BK * 2  , STAGE_BYTES = 8 * HTB, NXCD = 8, WGM = 8;

__host__ __device__ __forceinline__ int lds_byte(int r, int c) { const int st = (r >> 4) * 2 + (c >> 5), rr = r & 15, cc = c & 31, ob = rr * 64 + cc * 2; return st * 1024 + (ob ^ (((ob >> 9) & 1) << 5)); }
__host__ __device__ __forceinline__ void stage_rc(int b, int& R, int& C) { const int st = b / 1024, sb = b % 1024, swz = sb ^ (((sb >> 9) & 1) << 5); R = (st >> 1) * 16 + swz / 64; C = (st & 1) * 32 + (swz % 64) / 2; }
__host__ __device__ __forceinline__ int perm32(int rho) { const int n = rho >> 4, i = rho & 15; return 8 * (i >> 2) + 4 * n + (i & 3); }

struct Unit { int pm, pn; };
struct Gemm { const bf16_t* A; const bf16_t* Bt; int lda, K; };

template <class Epi, class Sched, bool STAMP = false>
__device__ __forceinline__ void gemm_phase(PG8_LAS unsigned char* lds, const Gemm g, const Sched& S, const Epi& E, unsigned long long* stamps) {
    const int tid = threadIdx.x, wid = __builtin_amdgcn_readfirstlane(tid >> 6), lane = tid & 63, wr = wid >> 2, wc = wid & 3, fr = lane & 15, fq = lane >> 4;
    const int K = g.K, nt = K / BK;
    int ts_lo = 0, ts_hi = 0, nts = 0; const unsigned long long rt_entry = STAMP ? (unsigned long long)wall_clock64() : 0ull;
#define PG8_STAMP() do { if (STAMP && wid == 0 && nts < 64) { const unsigned long long _c = (unsigned long long)clock64(); \
        ts_lo = (lane == nts) ? (int)(unsigned)_c : ts_lo; ts_hi = (lane == nts) ? (int)(unsigned)(_c >> 32) : ts_hi; ++nts; } } while (0)
    PG8_STAMP();
    unsigned voffA[2], voffB[2];
#pragma unroll
    for (int i = 0; i < 2; ++i) { int R, C; stage_rc(tid * 16 + i * 8192, R, C); const int Rb = Epi::PERM ? ((R & ~31) + perm32(R & 31)) : R;
        voffA[i] = (unsigned)(R * g.lda + C) * 2u; voffB[i] = (unsigned)(Rb * K + C) * 2u; }
    const size_t kstep = (size_t)(BK * 2);
    const size_t hstep = (size_t)HALF * K * 2, hstepA = (size_t)HALF * g.lda * 2;
    const size_t tstep = 2 * hstep, tstepA = 2 * hstepA;
    const unsigned ldsw = (unsigned)wid * 1024u;
    const int aoff = lds_byte(wr * 64 + fr, fq * 8), boff = lds_byte(wc * 32 + fr, fq * 8);
#define PG8_SA(b, h) (((b) * 2 + (h)) * HTB)
#define PG8_SB(b, h) ((4 + (b) * 2 + (h)) * HTB)
#define PG8_STAGE(bufoff, gbase, voff) do { _Pragma("unroll") for (int _i = 0; _i < 2; ++_i) \
        __builtin_amdgcn_global_load_lds((const unsigned*)((const char*)(gbase) + (voff)[_i]), (PG8_LAS unsigned*)(lds + (bufoff) + ldsw + _i * 8192), 16, 0, 0); } while (0)
#define PG8_LDA(dst, b, h) do { _Pragma("unroll") for (int m = 0; m < 4; ++m) _Pragma("unroll") for (int k = 0; k < 2; ++k) dst[m][k] = *(const PG8_LAS bf16x8*)(lds + PG8_SA(b, h) + aoff + m * 2048 + k * 1024); } while (0)
#define PG8_LDB(dst, b, h) do { _Pragma("unroll") for (int n = 0; n < 2; ++n) _Pragma("unroll") for (int k = 0; k < 2; ++k) dst[n][k] = *(const PG8_LAS bf16x8*)(lds + PG8_SB(b, h) + boff + n * 2048 + k * 1024); } while (0)
#define PG8_MMA(ai, bj, At, Bt) do { __builtin_amdgcn_s_setprio(1); _Pragma("unroll") for (int m = 0; m < 4; ++m) _Pragma("unroll") for (int n = 0; n < 2; ++n) _Pragma("unroll") for (int k = 0; k < 2; ++k) \
        acc[ai][bj][m][n] = __builtin_amdgcn_mfma_f32_16x16x32_bf16(Bt[n][k], At[m][k], acc[ai][bj][m][n], 0, 0, 0); __builtin_amdgcn_s_setprio(0); } while (0)
#define PG8_WAIT_V(n) asm volatile("s_waitcnt vmcnt(" #n ")" ::: "memory")
#define PG8_WAIT_L(n) asm volatile("s_waitcnt lgkmcnt(" #n ")" ::: "memory")
#define PG8_BAR __builtin_amdgcn_s_barrier()
#define PG8_SCHED __builtin_amdgcn_sched_barrier(0)
    Unit cur, nxt; int ui = 0;
    if (!S.next(0, cur)) return;
    f32x4 acc[2][2][4][2];
#pragma unroll
    for (int a = 0; a < 2; ++a)
#pragma unroll
        for (int b = 0; b < 2; ++b)
#pragma unroll
            for (int m = 0; m < 4; ++m)
#pragma unroll
                for (int n = 0; n < 2; ++n) acc[a][b][m][n] = (f32x4){0.f, 0.f, 0.f, 0.f};
    bf16x8 At[4][2], B0[2][2], B1[2][2];
    const char* cA = (const char*)g.A + (size_t)cur.pm * tstepA; const char* cB = (const char*)g.Bt + (size_t)cur.pn * tstep;
    S.a_ready(cur);
    PG8_STAGE(PG8_SB(0, 0), cB, voffB); PG8_STAGE(PG8_SA(0, 0), cA, voffA); PG8_STAGE(PG8_SB(0, 1), cB + hstep, voffB); PG8_STAGE(PG8_SA(0, 1), cA + hstepA, voffA);
    if (wr == 1) PG8_BAR;
    PG8_WAIT_V(4); PG8_BAR;
    PG8_STAGE(PG8_SB(1, 0), cB + kstep, voffB); PG8_STAGE(PG8_SA(1, 0), cA + kstep, voffA); PG8_STAGE(PG8_SB(1, 1), cB + hstep + kstep, voffB);
    PG8_WAIT_V(6); PG8_BAR;
    PG8_STAMP();
    for (;;) {
        const bool has_next = S.next(ui + 1, nxt);
        const char* nA = has_next ? (const char*)g.A + (size_t)nxt.pm * tstepA : cA; const char* nB = has_next ? (const char*)g.Bt + (size_t)nxt.pn * tstep : cB;
        for (int t = 0; t < nt; t += 2) {
            const bool last = (t == nt - 2);
            const char* a1 = cA + (size_t)(t + 1) * kstep;
            const char* a2 = last ? nA : cA + (size_t)(t + 2) * kstep; const char* b2 = last ? nB : cB + (size_t)(t + 2) * kstep;
            const char* a3 = a2 + kstep; const char* b3 = b2 + kstep;
            if (last && has_next) S.a_ready(nxt);
            PG8_LDB(B0, 0, 0); PG8_SCHED; PG8_LDA(At, 0, 0); PG8_STAGE(PG8_SA(1, 1), a1 + hstepA, voffA);
            PG8_WAIT_L(8); PG8_BAR; PG8_WAIT_L(0); PG8_MMA(0, 0, At, B0); PG8_BAR; PG8_SCHED;
            PG8_LDB(B1, 0, 1); PG8_STAGE(PG8_SB(0, 0), b2, voffB);
            PG8_BAR; PG8_WAIT_L(0); PG8_MMA(0, 1, At, B1); PG8_BAR;
            PG8_LDA(At, 0, 1); PG8_STAGE(PG8_SA(0, 0), a2, voffA);
            PG8_BAR; PG8_WAIT_L(0); PG8_MMA(1, 0, At, B0); PG8_BAR; PG8_SCHED;
            PG8_STAGE(PG8_SB(0, 1), b2 + hstep, voffB);
            PG8_WAIT_V(6); PG8_BAR; PG8_MMA(1, 1, At, B1); PG8_BAR;
            PG8_LDB(B0, 1, 0); PG8_SCHED; PG8_LDA(At, 1, 0); PG8_STAGE(PG8_SA(0, 1), a2 + hstepA, voffA);
            PG8_WAIT_L(8); PG8_BAR; PG8_WAIT_L(0); PG8_MMA(0, 0, At, B0); PG8_BAR; PG8_SCHED;
            PG8_LDB(B1, 1, 1); PG8_STAGE(PG8_SB(1, 0), b3, voffB);
            PG8_BAR; PG8_WAIT_L(0); PG8_MMA(0, 1, At, B1); PG8_BAR;
            PG8_LDA(At, 1, 1); PG8_STAGE(PG8_SA(1, 0), a3, voffA);
            PG8_BAR; PG8_WAIT_L(0); PG8_MMA(1, 0, At, B0); PG8_BAR; PG8_SCHED;
            PG8_STAGE(PG8_SB(1, 1), b3 + hstep, voffB);
            PG8_WAIT_V(6); PG8_BAR; PG8_MMA(1, 1, At, B1); PG8_BAR;
        }
        PG8_STAMP();
        if constexpr (!Epi::AFTER_DRAIN) { E(acc, cur, wr, wc, fr, fq); S.done(cur); }
        PG8_STAMP();
        if (!has_next) break;
#pragma unroll
        for (int a = 0; a < 2; ++a)
#pragma unroll
            for (int b = 0; b < 2; ++b)
#pragma unroll
                for (int m = 0; m < 4; ++m)
#pragma unroll
                    for (int n = 0; n < 2; ++n) acc[a][b][m][n] = (f32x4){0.f, 0.f, 0.f, 0.f};
        cur = nxt; cA = nA; cB = nB; ++ui;
    }
    PG8_WAIT_V(0);
    if (wr == 0) PG8_BAR;
    PG8_BAR;
    if constexpr (Epi::AFTER_DRAIN) { E.fused(acc, cur, wr, wc, fr, fq, lds, wid, lane); S.done(cur); }
    PG8_STAMP();
    if (STAMP && wid == 0) { stamps[lane] = lane < nts ? (((unsigned long long)(unsigned)ts_hi << 32) | (unsigned)ts_lo) : 0ull;
        if (lane == 62) stamps[62] = rt_entry; if (lane == 63) stamps[63] = (unsigned long long)wall_clock64(); }
#undef PG8_STAMP
#undef PG8_SA
#undef PG8_SB
#undef PG8_STAGE
#undef PG8_LDA
#undef PG8_LDB
#undef PG8_MMA
#undef PG8_WAIT_V
#undef PG8_WAIT_L
#undef PG8_BAR
#undef PG8_SCHED
}
}

struct XcdOrder {
    int nsn, nwt, ntn;
    DI bool next(int i, pg8::Unit& u) const {
        int mt, nt;
        if (gridDim.x == 256) { if (!gemm_map(i, nsn, nwt, mt, nt)) return false; }
        else { const int tile = i * (int)gridDim.x + (int)blockIdx.x; if (tile >= 128 * ntn) return false; mt = tile / ntn; nt = tile % ntn; }
        u.pm = mt; u.pn = nt; return true;
    }
    DI void a_ready(const pg8::Unit&) const {}
    DI void done(const pg8::Unit&) const {}
};
template <int ACT> struct EpiOutBf16 {
    static constexpr bool PERM = true, AFTER_DRAIN = false;
    bfu* O; int ldc, N;
    DI void operator()(const pg8::f32x4 (&acc)[2][2][4][2], const pg8::Unit& u, int wr, int wc, int fr, int fq) const {
        const int row0 = u.pm * 256 + wr * 64 + fr, col0 = u.pn * 256 + wc * 32 + 8 * fq;
#pragma unroll
        for (int ai = 0; ai < 2; ++ai)
#pragma unroll
            for (int m = 0; m < 4; ++m) {
                bfu* rowp = O + (size_t)(row0 + ai * 128 + m * 16) * ldc + col0;
#pragma unroll
                for (int bj = 0; bj < 2; ++bj) {
                    pg8::f32x4 v0 = acc[ai][bj][m][0], v1 = acc[ai][bj][m][1];
                    if (ACT == 1) {
#pragma unroll
                        for (int j = 0; j < 4; ++j) { const float a = fmaxf(v0[j], 0.f), b = fmaxf(v1[j], 0.f); v0[j] = a * a; v1[j] = b * b; }
                    }
                    if (col0 + bj * 128 < N) *(u32x4*)(rowp + bj * 128) = (u32x4){pk2(v0[0], v0[1]), pk2(v0[2], v0[3]), pk2(v1[0], v1[1]), pk2(v1[2], v1[3])};
                }
            }
    }
};
struct EpiResid {
    static constexpr bool PERM = false, AFTER_DRAIN = false;
    const float* resid; float* out; const float* gate;
    DI void operator()(const pg8::f32x4 (&acc)[2][2][4][2], const pg8::Unit& u, int wr, int wc, int fr, int fq) const {
        const int row0 = u.pm * 256 + wr * 64 + fr, col0 = u.pn * 256 + wc * 32 + 4 * fq;
        const float* gb = gate + ((u.pm * 256) >> 13) * 6144 + col0;
        pg8::f32x4 gv[2][2];
#pragma unroll
        for (int bj = 0; bj < 2; ++bj)
#pragma unroll
            for (int n = 0; n < 2; ++n) gv[bj][n] = *(const pg8::f32x4*)(gb + bj * 128 + n * 16);
#pragma unroll
        for (int ai = 0; ai < 2; ++ai)
#pragma unroll
            for (int m = 0; m < 4; ++m) {
                const size_t ro = (size_t)(row0 + ai * 128 + m * 16) * 1024 + col0;
#pragma unroll
                for (int bj = 0; bj < 2; ++bj)
#pragma unroll
                    for (int n = 0; n < 2; ++n) {
                        const pg8::f32x4 r = *(const pg8::f32x4*)(resid + ro + bj * 128 + n * 16);
                        *(pg8::f32x4*)(out + ro + bj * 128 + n * 16) = r + gv[bj][n] * acc[ai][bj][m][n];
                    }
            }
    }
};
template <int EPI>
DI void phase_gemm8(const bfu* A, int lda, const bfu* Bt, int K, int N, int ntn, bfu* Cb, int ldc, const float* resid, float* outf, const float* gate, char* smem) {
    pg8::Gemm g; g.A = A; g.Bt = Bt; g.lda = lda; g.K = K;
    XcdOrder S; S.ntn = ntn; S.nwt = (ntn % 4 == 0) ? 4 : ntn; S.nsn = ntn / S.nwt;
    __syncthreads();
    if (EPI == 2) { EpiResid E; E.resid = resid; E.out = outf; E.gate = gate; pg8::gemm_phase<EpiResid, XcdOrder, false>((PG8_LAS unsigned char*)smem, g, S, E, nullptr); }
    else { EpiOutBf16<EPI> E; E.O = Cb; E.ldc = ldc; E.N = N; pg8::gemm_phase<EpiOutBf16<EPI>, XcdOrder, false>((PG8_LAS unsigned char*)smem, g, S, E, nullptr); }
    __syncthreads();
}


struct EpiHeads {
    static constexpr bool PERM = true, AFTER_DRAIN = false;
    bfu* O; const float2* rope; const float *w_dq, *w_dk, *w_mq, *w_mk; float* kpart;
    DI void operator()(const pg8::f32x4 (&acc)[2][2][4][2], const pg8::Unit& u, int wr, int wc, int fr, int fq) const {
        const int pn = u.pn;
        const int kind = (pn < 2) ? 1 : (pn < 4) ? 2 : (pn < 6) ? 0 : (pn < 8) ? 3 : (pn < 10) ? 4 : 0;
        const float scale = (kind == 1 || kind == 3) ? SC_64 : 1.f;
        const int colbase = pn * 256 + wc * 64 + 8 * fq;
        float wa[8], wb[8];
#pragma unroll
        for (int e = 0; e < 8; ++e) {
            const int d = 8 * fq + e;
            const float a1 = w_dq[d], a2 = w_dk[d], a3 = w_mq[d], a4 = w_mk[d], b1 = w_dq[32 + d], b2 = w_dk[32 + d], b3 = w_mq[32 + d], b4 = w_mk[32 + d];
            wa[e] = ((kind == 1) ? a1 : (kind == 2) ? a2 : (kind == 3) ? a3 : a4) * scale;
            wb[e] = ((kind == 1) ? b1 : (kind == 2) ? b2 : (kind == 3) ? b3 : b4) * scale;
        }
#pragma unroll
        for (int ai = 0; ai < 2; ++ai) {
            float ks1[8], ks2[8];
#pragma unroll
            for (int e = 0; e < 8; ++e) { ks1[e] = 0.f; ks2[e] = 0.f; }
#pragma unroll
            for (int m = 0; m < 4; ++m) {
                const int row = u.pm * 256 + ai * 128 + wr * 64 + m * 16 + fr;
                float x1[8], x2[8];
#pragma unroll
                for (int e = 0; e < 8; ++e) { x1[e] = acc[ai][0][m][e >> 2][e & 3]; x2[e] = acc[ai][1][m][e >> 2][e & 3]; }
                if (kind) {
                    float ss = 0.f;
#pragma unroll
                    for (int e = 0; e < 8; ++e) ss += x1[e] * x1[e] + x2[e] * x2[e];
                    ss += __shfl_xor(ss, 16); ss += __shfl_xor(ss, 32);
                    const float r = rsqrtf(ss * (1.f / 64.f) + EPS);
                    const float4* cp = (const float4*)(rope + (size_t)row * 32 + 8 * fq);
#pragma unroll
                    for (int e2 = 0; e2 < 4; ++e2) {
                        const float4 cs = cp[e2];
                        {   const int e = 2 * e2; const float y1 = x1[e] * r * wa[e], y2 = x2[e] * r * wb[e];
                            x1[e] = y1 * cs.x - y2 * cs.y; x2[e] = y2 * cs.x + y1 * cs.y; }
                        {   const int e = 2 * e2 + 1; const float y1 = x1[e] * r * wa[e], y2 = x2[e] * r * wb[e];
                            x1[e] = y1 * cs.z - y2 * cs.w; x2[e] = y2 * cs.z + y1 * cs.w; }
                    }
                    if (kind == 4) {
#pragma unroll
                        for (int e = 0; e < 8; ++e) { ks1[e] += x1[e]; ks2[e] += x2[e]; }
                    }
                }
                bfu* rowp = O + (size_t)row * 3072 + colbase;
                *(u32x4*)rowp = (u32x4){pk2(x1[0], x1[1]), pk2(x1[2], x1[3]), pk2(x1[4], x1[5]), pk2(x1[6], x1[7])};
                *(u32x4*)(rowp + 32) = (u32x4){pk2(x2[0], x2[1]), pk2(x2[2], x2[3]), pk2(x2[4], x2[5]), pk2(x2[6], x2[7])};
            }
            if (kind == 4) {
#pragma unroll
                for (int e = 0; e < 8; ++e) {
                    float a = ks1[e], b = ks2[e];
                    a += __shfl_xor(a, 1); a += __shfl_xor(a, 2); a += __shfl_xor(a, 4); a += __shfl_xor(a, 8);
                    b += __shfl_xor(b, 1); b += __shfl_xor(b, 2); b += __shfl_xor(b, 4); b += __shfl_xor(b, 8);
                    ks1[e] = a; ks2[e] = b;
                }
                if (fr == 0) {
                    float* kp = kpart + (size_t)(4 * u.pm + 2 * ai + wr) * 512 + ((pn - 8) * 4 + wc) * 64 + 8 * fq;
#pragma unroll
                    for (int e = 0; e < 8; ++e) { kp[e] = ks1[e]; kp[32 + e] = ks2[e]; }
                }
            }
        }
    }
};
DI void phase_gemm_heads(const Params& p, const bfu* A, const bfu* Bt, bfu* O, char* smem) {
    pg8::Gemm g; g.A = A; g.Bt = Bt; g.lda = 1024; g.K = 1024;
    XcdOrder S; S.ntn = 12; S.nwt = 4; S.nsn = 3;
    EpiHeads E; E.O = O; E.rope = (const float2*)(p.ws + OFF_ROPE64); E.w_dq = p.diff_qn; E.w_dk = p.diff_kn; E.w_mq = p.moba_qn; E.w_mk = p.moba_kn;
    E.kpart = (float*)(p.ws + OFF_KPART);
    __syncthreads();
    pg8::gemm_phase<EpiHeads, XcdOrder, false>((PG8_LAS unsigned char*)smem, g, S, E, nullptr);
    __syncthreads();
}

#ifndef MK_PROBE
#define MK_PROBE 0
#endif
#if MK_PROBE
template <int VAR>
DI void gemm_probe(const bfu* __restrict__ A, int lda, const bfu* __restrict__ Bt, int K, int m0, int n0, float* sinkp, int sink, char* smem) {
    constexpr int STG = 512 * 72;
    bfu* S0 = (bfu*)smem;
    const int tid = threadIdx.x, lane = tid & 63, wid = tid >> 6, l32 = lane & 31, hi = lane >> 5;
    const int wm = wid & 3, wn = wid >> 2;
    f32x16 acc[4][2];
#pragma unroll
    for (int nb = 0; nb < 4; ++nb)
#pragma unroll
        for (int mb = 0; mb < 2; ++mb)
#pragma unroll
            for (int r = 0; r < 16; ++r) acc[nb][mb][r] = 0.f;
    const bfu* Ag = A + (size_t)(m0 + (tid >> 3)) * lda + (tid & 7) * 8;
    const bfu* Bg = Bt + (size_t)(n0 + (tid >> 3)) * K + (tid & 7) * 8;
    u32x4 ra[4], rb[4];
#pragma unroll
    for (int i = 0; i < 4; ++i) { ra[i] = *(const u32x4*)(Ag + (size_t)(64 * i) * lda); rb[i] = *(const u32x4*)(Bg + (size_t)(64 * i) * K); }
    const int nk = K >> 6;
    const int wofs = (tid >> 3) * 72 + (tid & 7) * 8;
    const int arofs = (wm * 64 + l32) * 72 + hi * 8, brofs = 256 * 72 + (wn * 128 + l32) * 72 + hi * 8;
    __syncthreads();
#pragma unroll
    for (int i = 0; i < 4; ++i) { *(u32x4*)(S0 + wofs + 64 * i * 72) = ra[i]; *(u32x4*)(S0 + 256 * 72 + wofs + 64 * i * 72) = rb[i]; }
    __syncthreads();
#pragma unroll 1
    for (int kt = 0; kt < nk; ++kt) {
        const bfu* Sc = S0 + (kt & 1) * STG; bfu* Sn = S0 + ((kt & 1) ^ 1) * STG;
        if (VAR != 2 && kt + 1 < nk) {
#pragma unroll
            for (int i = 0; i < 4; ++i) { *(u32x4*)(Sn + wofs + 64 * i * 72) = ra[i]; *(u32x4*)(Sn + 256 * 72 + wofs + 64 * i * 72) = rb[i]; }
        }
        __builtin_amdgcn_sched_barrier(0);
        if (VAR != 1 && VAR != 2 && kt + 2 < nk) {
            const int ko = (kt + 2) * 64;
#pragma unroll
            for (int i = 0; i < 4; ++i) { ra[i] = *(const u32x4*)(Ag + (size_t)(64 * i) * lda + ko); rb[i] = *(const u32x4*)(Bg + (size_t)(64 * i) * K + ko); }
        }
        __builtin_amdgcn_sched_barrier(0);
        if (VAR == 3) {
            bf16x8 af[2], bfr[4];
#pragma unroll
            for (int mb = 0; mb < 2; ++mb) af[mb] = *(const bf16x8*)(Sc + arofs + mb * 32 * 72);
#pragma unroll
            for (int nb = 0; nb < 4; ++nb) bfr[nb] = *(const bf16x8*)(Sc + brofs + nb * 32 * 72);
#pragma unroll
            for (int k16 = 0; k16 < 4; ++k16)
#pragma unroll
                for (int nb = 0; nb < 4; ++nb)
#pragma unroll
                    for (int mb = 0; mb < 2; ++mb) acc[nb][mb] = MFMA(bfr[nb], af[mb], acc[nb][mb]);
        } else {
#pragma unroll
            for (int k16 = 0; k16 < 4; ++k16) {
                bf16x8 af[2], bfr[4];
#pragma unroll
                for (int mb = 0; mb < 2; ++mb) af[mb] = *(const bf16x8*)(Sc + arofs + mb * 32 * 72 + k16 * 16);
#pragma unroll
                for (int nb = 0; nb < 4; ++nb) bfr[nb] = *(const bf16x8*)(Sc + brofs + nb * 32 * 72 + k16 * 16);
#pragma unroll
                for (int nb = 0; nb < 4; ++nb)
#pragma unroll
                    for (int mb = 0; mb < 2; ++mb) acc[nb][mb] = MFMA(bfr[nb], af[mb], acc[nb][mb]);
            }
        }
        __syncthreads();
    }
    if (sink) {
#pragma unroll
        for (int nb = 0; nb < 4; ++nb)
#pragma unroll
            for (int mb = 0; mb < 2; ++mb)
#pragma unroll
                for (int r = 0; r < 16; ++r) sinkp[tid * 128 + (nb * 2 + mb) * 16 + r] = acc[nb][mb][r];
    }
}
template <int VAR>
DI void phase_gemm_probe(const bfu* A, const bfu* Bt, float* sinkp, int sink, char* smem) {
    for (int r = 0; r < 6; ++r) { int mt, nt; if (gemm_map(r, 3, 4, mt, nt)) gemm_probe<VAR>(A, 1024, Bt, 1024, mt * 256, nt * 256, sinkp, sink, smem); }
}
#endif

DI void headnorm64(bfu* hp, const float* __restrict__ w, const float2* __restrict__ cs, float scale, int j, bool acc_on, f32x4& ka1, f32x4& ka2) {
    const u32x2 a = *(const u32x2*)(hp + 4 * j), b = *(const u32x2*)(hp + 32 + 4 * j);
    float x1[4] = {bflo(a[0]), bfhi(a[0]), bflo(a[1]), bfhi(a[1])}, x2[4] = {bflo(b[0]), bfhi(b[0]), bflo(b[1]), bfhi(b[1])};
    float ss = 0.f;
#pragma unroll
    for (int e = 0; e < 4; ++e) ss += x1[e] * x1[e] + x2[e] * x2[e];
    ss += __shfl_xor(ss, 1); ss += __shfl_xor(ss, 2); ss += __shfl_xor(ss, 4);
    const float r = rsqrtf(ss * (1.f / 64.f) + EPS);
    const float4 w1 = *(const float4*)(w + 4 * j), w2 = *(const float4*)(w + 32 + 4 * j);
    const float wa[4] = {w1.x, w1.y, w1.z, w1.w}, wb[4] = {w2.x, w2.y, w2.z, w2.w};
    float o1[4], o2[4];
#pragma unroll
    for (int e = 0; e < 4; ++e) {
        const float y1 = x1[e] * r * wa[e], y2 = x2[e] * r * wb[e]; const float2 c = cs[4 * j + e];
        o1[e] = y1 * c.x - y2 * c.y; o2[e] = y2 * c.x + y1 * c.y;
    }
    if (acc_on) {
#pragma unroll
        for (int e = 0; e < 4; ++e) { ka1[e] += o1[e]; ka2[e] += o2[e]; }
    }
    *(u32x2*)(hp + 4 * j) = (u32x2){pk2(o1[0] * scale, o1[1] * scale), pk2(o1[2] * scale, o1[3] * scale)};
    *(u32x2*)(hp + 32 + 4 * j) = (u32x2){pk2(o2[0] * scale, o2[1] * scale), pk2(o2[2] * scale, o2[3] * scale)};
}

DI float sq4(u32x2 a) { const float x0 = bflo(a[0]), x1 = bfhi(a[0]), x2 = bflo(a[1]), x3 = bfhi(a[1]); return x0 * x0 + x1 * x1 + x2 * x2 + x3 * x3; }

DI void mla_head(u32x4 nv, unsigned x1, unsigned x2, float rn, float rr, const float* __restrict__ wn, int j, float2 csA, float2 csB, float scale, bfu* dst) {
    float f[8] = {bflo(nv[0]) * rn, bfhi(nv[0]) * rn, bflo(nv[1]) * rn, bfhi(nv[1]) * rn, bflo(nv[2]) * rn, bfhi(nv[2]) * rn, bflo(nv[3]) * rn, bfhi(nv[3]) * rn};
    const float a0 = bflo(x1) * rr, a1 = bfhi(x1) * rr, b0 = bflo(x2) * rr, b1 = bfhi(x2) * rr;
    float ss = a0 * a0 + a1 * a1 + b0 * b0 + b1 * b1;
#pragma unroll
    for (int e = 0; e < 8; ++e) ss += f[e] * f[e];
    ss += __shfl_xor(ss, 1); ss += __shfl_xor(ss, 2); ss += __shfl_xor(ss, 4);
    const float r = rsqrtf(ss * (1.f / 96.f) + EPS) * scale;
    const float4 wA = *(const float4*)(wn + 8 * j), wB = *(const float4*)(wn + 8 * j + 4);
    const float wv[8] = {wA.x, wA.y, wA.z, wA.w, wB.x, wB.y, wB.z, wB.w};
#pragma unroll
    for (int e = 0; e < 8; ++e) f[e] *= r * wv[e];
    *(u32x4*)(dst + 8 * j) = (u32x4){pk2(f[0], f[1]), pk2(f[2], f[3]), pk2(f[4], f[5]), pk2(f[6], f[7])};
    const float y10 = a0 * r * wn[64 + 2 * j], y11 = a1 * r * wn[65 + 2 * j], y20 = b0 * r * wn[80 + 2 * j], y21 = b1 * r * wn[81 + 2 * j];
    *(unsigned*)(dst + 64 + 2 * j) = pk2(y10 * csA.x - y20 * csA.y, y11 * csB.x - y21 * csB.y);
    *(unsigned*)(dst + 80 + 2 * j) = pk2(y20 * csA.x + y10 * csA.y, y21 * csB.x + y11 * csB.y);
}

DI void phase_post_even(const Params& p) {
    char* ws = p.ws;
    bfu* ubuf = (bfu*)(ws + OFF_UBUF); const bfu* qraw = (const bfu*)(ws + OFF_HBUF); const bfu* kvraw = (const bfu*)(ws + OFF_OBUF);
    bfu* Qa = (bfu*)p.out; bfu* Ka = Qa + (size_t)T * 768; bfu* Va = Ka + (size_t)T * 768;
    const float2* r64 = (const float2*)(ws + OFF_ROPE64); const float2* r32 = (const float2*)(ws + OFF_ROPE32);
    const int lane = threadIdx.x & 63, gw = blockIdx.x * NW + (threadIdx.x >> 6), nwv = gridDim.x * NW;
    const int h = lane >> 3, j = lane & 7;
    for (int t = gw; t < T; t += nwv) {
        bfu* ur = ubuf + (size_t)t * 3072;
        float ssq = sq4(*(const u32x2*)(ur + lane * 4));
        if (lane < 32) ssq += sq4(*(const u32x2*)(ur + 256 + lane * 4));
        float sskv = sq4(*(const u32x2*)(ur + 384 + lane * 4));
        ssq = wave_sum(ssq); sskv = wave_sum(sskv);
        const float rq = rsqrtf(ssq * (1.f / 384.f) + EPS), rkv = rsqrtf(sskv * (1.f / 256.f) + EPS);
        const float2 csA = r32[(size_t)t * 16 + 2 * j], csB = r32[(size_t)t * 16 + 2 * j + 1];
        {
            const bfu* qr = qraw + (size_t)t * 768 + h * 96;
            mla_head(*(const u32x4*)(qr + 8 * j), *(const unsigned*)(qr + 64 + 2 * j), *(const unsigned*)(qr + 80 + 2 * j), rq, rq, p.mla_qn, j, csA, csB, SC_MLA, Qa + (size_t)t * 768 + h * 96);
        }
        {
            const bfu* kr = kvraw + (size_t)t * 1024 + h * 128;
            mla_head(*(const u32x4*)(kr + 8 * j), *(const unsigned*)(ur + 640 + 2 * j), *(const unsigned*)(ur + 656 + 2 * j), rkv, 1.f, p.mla_kn, j, csA, csB, 1.f, Ka + (size_t)t * 768 + h * 96);
            const u32x4 vv = *(const u32x4*)(kr + 64 + 8 * j);
            *(u32x4*)(Va + (size_t)t * 512 + h * 64 + 8 * j) = (u32x4){pk2(bflo(vv[0]) * rkv, bfhi(vv[0]) * rkv), pk2(bflo(vv[1]) * rkv, bfhi(vv[1]) * rkv),
                                                                      pk2(bflo(vv[2]) * rkv, bfhi(vv[2]) * rkv), pk2(bflo(vv[3]) * rkv, bfhi(vv[3]) * rkv)};
        }
        f32x4 d1, d2;
#pragma unroll
        for (int rd = 0; rd < 3; ++rd) {
            const int hh = rd * 8 + h, which = hh / 12, gh = hh % 12;
            headnorm64(ur + 672 + which * 768 + gh * 64, which ? p.dil_kn : p.dil_qn, r64 + (size_t)t * 32, which ? 1.f : SC_64, j, false, d1, d2);
        }
    }
}

DI void phase_post_odd(const Params& p, char* smem) {
    char* ws = p.ws;
    bfu* ubuf = (bfu*)(ws + OFF_UBUF); const float2* r64 = (const float2*)(ws + OFF_ROPE64); float* kpart = (float*)(ws + OFF_KPART);
    const int tid = threadIdx.x, lane = tid & 63, wid = tid >> 6, h = lane >> 3, j = lane & 7;
    float* red = (float*)smem;
    for (int it = blockIdx.x; it < T / 64; it += gridDim.x) {
        f32x4 ka1 = {0.f, 0.f, 0.f, 0.f}, ka2 = {0.f, 0.f, 0.f, 0.f}, d1, d2;
        for (int tt = 0; tt < 8; ++tt) {
            const int t = it * 64 + wid * 8 + tt;
            bfu* ur = ubuf + (size_t)t * 3072; const float2* cs = r64 + (size_t)t * 32;
            headnorm64(ur + h * 64, p.diff_qn, cs, SC_64, j, false, d1, d2);
            headnorm64(ur + 512 + h * 64, p.diff_kn, cs, 1.f, j, false, d1, d2);
            headnorm64(ur + 1536 + h * 64, p.moba_qn, cs, SC_64, j, false, d1, d2);
            headnorm64(ur + 2048 + h * 64, p.moba_kn, cs, 1.f, j, true, ka1, ka2);
        }
        __syncthreads();
#pragma unroll
        for (int e = 0; e < 4; ++e) { red[(wid * 64 + lane) * 8 + e] = ka1[e]; red[(wid * 64 + lane) * 8 + 4 + e] = ka2[e]; }
        __syncthreads();
        {
            const int o = tid, hh = o >> 6, d = o & 63, jj = (d & 31) >> 2, e = (d & 3) + ((d >> 5) << 2), ln = hh * 8 + jj;
            float sum = 0.f;
#pragma unroll
            for (int w = 0; w < NW; ++w) sum += red[(w * 64 + ln) * 8 + e];
            kpart[(size_t)it * 512 + o] = sum;
        }
    }
    __syncthreads();
}

DI void phase_dil_merge(const Params& p) {
    const bfu* dil_o = (const bfu*)(p.ws + OFF_HBUF); const float* dil_lse = (const float*)(p.ws + OFF_HBUF + 48 * MiB);
    bfu* obuf = (bfu*)(p.ws + OFF_OBUF);
    for (int idx = blockIdx.x * NT + threadIdx.x; idx < T * 64; idx += gridDim.x * NT) {
        const int t = idx >> 6, r = idx & 63, h = r >> 4, jj = r & 15;
        const float l0 = dil_lse[(size_t)t * 12 + h], l1 = dil_lse[(size_t)t * 12 + 4 + h], l2 = dil_lse[(size_t)t * 12 + 8 + h];
        const float mx = fmaxf(l0, fmaxf(l1, l2));
        float w0 = exp2f(l0 - mx), w1 = exp2f(l1 - mx), w2 = exp2f(l2 - mx); const float inv = 1.f / (w0 + w1 + w2); w0 *= inv; w1 *= inv; w2 *= inv;
        const u32x2 a = *(const u32x2*)(dil_o + (size_t)t * 768 + h * 64 + 4 * jj), b = *(const u32x2*)(dil_o + (size_t)t * 768 + (4 + h) * 64 + 4 * jj),
                    c = *(const u32x2*)(dil_o + (size_t)t * 768 + (8 + h) * 64 + 4 * jj);
        const float o0 = w0 * bflo(a[0]) + w1 * bflo(b[0]) + w2 * bflo(c[0]), o1 = w0 * bfhi(a[0]) + w1 * bfhi(b[0]) + w2 * bfhi(c[0]);
        const float o2 = w0 * bflo(a[1]) + w1 * bflo(b[1]) + w2 * bflo(c[1]), o3 = w0 * bfhi(a[1]) + w1 * bfhi(b[1]) + w2 * bfhi(c[1]);
        *(u32x2*)(obuf + (size_t)t * 768 + 512 + h * 64 + 4 * jj) = (u32x2){pk2(o0, o1), pk2(o2, o3)};
    }
}

DI void phase_diff_combine(const Params& p) {
    const bfu* dbuf = (const bfu*)(p.ws + OFF_DBUF); bfu* obuf = (bfu*)(p.ws + OFF_OBUF);
    const int lane = threadIdx.x & 63, gw = blockIdx.x * NW + (threadIdx.x >> 6), nwv = gridDim.x * NW;
    float lam;
    {
        const float sa = wave_sum(p.diff_lam[lane] * p.diff_lam[64 + lane]), sb = wave_sum(p.diff_lam[128 + lane] * p.diff_lam[192 + lane]);
        lam = expf(sa) - expf(sb) + LAM_INIT;
    }
    const int h = lane >> 4, jj = lane & 15;
    const float4 sA = *(const float4*)(p.diff_subln + 8 * jj), sB = *(const float4*)(p.diff_subln + 8 * jj + 4);
    const float sw[8] = {sA.x, sA.y, sA.z, sA.w, sB.x, sB.y, sB.z, sB.w};
    for (int t = gw; t < T; t += nwv) {
        const u32x4 a = *(const u32x4*)(dbuf + (size_t)t * 1024 + (2 * h) * 128 + 8 * jj), b = *(const u32x4*)(dbuf + (size_t)t * 1024 + (2 * h + 1) * 128 + 8 * jj);
        float d[8];
#pragma unroll
        for (int e = 0; e < 4; ++e) { d[2 * e] = bflo(a[e]) - lam * bflo(b[e]); d[2 * e + 1] = bfhi(a[e]) - lam * bfhi(b[e]); }
        float ss = 0.f;
#pragma unroll
        for (int e = 0; e < 8; ++e) ss += d[e] * d[e];
        ss += __shfl_xor(ss, 1); ss += __shfl_xor(ss, 2); ss += __shfl_xor(ss, 4); ss += __shfl_xor(ss, 8);
        const float r = rsqrtf(ss * (1.f / 128.f) + EPS) * (1.f - LAM_INIT);
#pragma unroll
        for (int e = 0; e < 8; ++e) d[e] *= r * sw[e];
        *(u32x4*)(obuf + (size_t)t * 1024 + h * 128 + 8 * jj) = (u32x4){pk2(d[0], d[1]), pk2(d[2], d[3]), pk2(d[4], d[5]), pk2(d[6], d[7])};
    }
    {
        const bfu* po01 = (const bfu*)(p.ws + OFF_HBUF); const bfu* po2 = (const bfu*)(p.ws + OFF_PO2); const float* plse = (const float*)(p.ws + OFF_PLSE);
        const int hm = lane >> 3, j8 = (lane & 7) * 8;
        for (int t = gw; t < T; t += nwv) {
            const float4 ls = *(const float4*)(plse + ((size_t)t * 8 + hm) * 4);
            const float mx = fmaxf(fmaxf(ls.x, ls.y), fmaxf(ls.z, ls.w));
            float w0 = exp2f(ls.x - mx), w1 = exp2f(ls.y - mx), w2 = exp2f(ls.z - mx), w3 = exp2f(ls.w - mx);
            const float inv = 1.f / (w0 + w1 + w2 + w3); w0 *= inv; w1 *= inv; w2 *= inv; w3 *= inv;
            bfu* dst = obuf + (size_t)t * 1024 + 512 + hm * 64 + j8;
            const u32x4 z = {0u, 0u, 0u, 0u};
            const u32x4 a0 = (w0 > 0.f) ? *(const u32x4*)(po01 + (size_t)t * 512 + hm * 64 + j8) : z;
            const u32x4 a1 = (w1 > 0.f) ? *(const u32x4*)(po01 + (size_t)T * 512 + (size_t)t * 512 + hm * 64 + j8) : z;
            const u32x4 a2 = (w2 > 0.f) ? *(const u32x4*)(po2 + (size_t)t * 512 + hm * 64 + j8) : z;
            const u32x4 a3 = *(const u32x4*)dst;
            unsigned r[4];
#pragma unroll
            for (int e = 0; e < 4; ++e) {
                const float lo = w0 * bflo(a0[e]) + w1 * bflo(a1[e]) + w2 * bflo(a2[e]) + w3 * bflo(a3[e]);
                const float hi = w0 * bfhi(a0[e]) + w1 * bfhi(a1[e]) + w2 * bfhi(a2[e]) + w3 * bfhi(a3[e]);
                r[e] = pk2(lo, hi);
            }
            *(u32x4*)dst = (u32x4){r[0], r[1], r[2], r[3]};
        }
    }
}

struct Top3 { float v0, v1, v2; int i0, i1, i2; };
DI Top3 top3_ins(Top3 t, float v, int i) {
    const bool g0 = (v > t.v0) || (v == t.v0 && i < t.i0), g1 = (v > t.v1) || (v == t.v1 && i < t.i1), g2 = (v > t.v2) || (v == t.v2 && i < t.i2);
    Top3 r;
    r.v2 = g1 ? t.v1 : (g2 ? v : t.v2); r.i2 = g1 ? t.i1 : (g2 ? i : t.i2);
    r.v1 = g0 ? t.v0 : (g1 ? v : t.v1); r.i1 = g0 ? t.i0 : (g1 ? i : t.i1);
    r.v0 = g0 ? v : t.v0; r.i0 = g0 ? i : t.i0;
    return r;
}

struct MobaG {
    const int* cnt; const unsigned short* seg; int chunk, jblk, tokbase, h; bfu *po01, *po2; float* plse;
};
template <int DK, int DV, int MODE>
DI void attn_item(const bfu* __restrict__ Qp, int qp, const bfu* __restrict__ Kp, int kp, const bfu* __restrict__ Vp, int vp,
                  long rowbase, int rs, int q0, bfu* __restrict__ Op, int op, float* __restrict__ lsep, int lsest,
                  const float* __restrict__ kpart, char* smem, int jfirst = 0, const MobaG* mg = nullptr) {
    constexpr int KPT = DK + 8, KCH = DK / 8, VCH = DV / 8, NKL = (64 * KCH + NT - 1) / NT, NVL = 64 * VCH / NT, NDV = DV / 32, ND0 = DK / 16;
    constexpr int KST = 64 * KPT, VST = 64 * DV;
    bfu* Ks = (bfu*)smem; bfu* Vs = Ks + 3 * KST;
    short* tlist = (short*)(Vs + 3 * VST);
    int* misc = (int*)(tlist + 192);
    float* km = (float*)(misc + 4);
    unsigned* selm = (unsigned*)(km + 2048);
    float* cand = (float*)(selm + 256);
    const int tid = threadIdx.x, lane = tid & 63, wid = tid >> 6, l32 = lane & 31, hi = lane >> 5;
    const int qw = q0 + wid * 32, qstep = qw + l32;
    unsigned mysel = 0;
    bool g_active = true; size_t g_tok = 0; int g_slot = 0, g_total = 0;
    if (MODE == 3) {
        const int myc = (lane < 32 && lane > mg->jblk) ? mg->cnt[lane] : 0;
        int inc = myc;
#pragma unroll
        for (int d = 1; d < 32; d <<= 1) { const int t_ = __shfl_up(inc, d); if ((lane & 31) >= d) inc += t_; }
        const int exc = inc - myc;
        g_total = __builtin_amdgcn_readlane(inc, 31);
        const int pp = mg->chunk * 256 + wid * 32 + l32;
        g_active = pp < g_total;
        int n = 31, pbase = __builtin_amdgcn_readlane(exc, 31);
#pragma unroll
        for (int c = 31; c >= 1; --c) { const int pc = __builtin_amdgcn_readlane(exc, c); if (pp < pc) { n = c - 1; } }
#pragma unroll
        for (int c = 0; c < 32; ++c) { const int pc = __builtin_amdgcn_readlane(exc, c); if (c == n) pbase = pc; }
        const unsigned short e = g_active ? mg->seg[(size_t)n * 256 + (pp - pbase)] : (unsigned short)0;
        g_slot = e >> 8;
        g_tok = (size_t)mg->tokbase + (g_active ? (size_t)(n * 256 + (e & 255)) : 0);
    }
    if (MODE == 2) {
        const int nb = q0 >> 8;
        for (int idx = tid; idx < nb * 64; idx += NT) {
            const int blk = idx >> 6, d = idx & 63; const float* kq = kpart + (size_t)(blk * 4) * 512 + d;
            km[idx] = (kq[0] + kq[512] + kq[1024] + kq[1536]) * (1.f / 256.f);
        }
        if (tid == 0) misc[1] = 0;
        __syncthreads();
        {
            const int qq = tid & 255, hf = tid >> 8;
            const bfu* qr = Qp + (size_t)(rowbase + q0 + qq) * qp;
            float qv[64];
#pragma unroll
            for (int c8 = 0; c8 < 8; ++c8) {
                const u32x4 w = *(const u32x4*)(qr + c8 * 8);
#pragma unroll
                for (int e = 0; e < 4; ++e) { qv[c8 * 8 + 2 * e] = bflo(w[e]); qv[c8 * 8 + 2 * e + 1] = bfhi(w[e]); }
            }
            Top3 tp; tp.v0 = -3e38f; tp.v1 = -3e38f; tp.v2 = -3e38f; tp.i0 = 64; tp.i1 = 64; tp.i2 = 64;
            for (int blk = hf; blk < nb; blk += 2) {
                float g = 0.f;
#pragma unroll
                for (int d = 0; d < 64; ++d) g += qv[d] * km[blk * 64 + d];
                tp = top3_ins(tp, g, blk);
            }
            cand[tid * 6 + 0] = tp.v0; cand[tid * 6 + 1] = tp.v1; cand[tid * 6 + 2] = tp.v2;
            cand[tid * 6 + 3] = __int_as_float(tp.i0); cand[tid * 6 + 4] = __int_as_float(tp.i1); cand[tid * 6 + 5] = __int_as_float(tp.i2);
        }
        __syncthreads();
        if (tid < 256) {
            Top3 tp; tp.v0 = cand[tid * 6]; tp.v1 = cand[tid * 6 + 1]; tp.v2 = cand[tid * 6 + 2];
            tp.i0 = __float_as_int(cand[tid * 6 + 3]); tp.i1 = __float_as_int(cand[tid * 6 + 4]); tp.i2 = __float_as_int(cand[tid * 6 + 5]);
            const int o = (tid + 256) * 6;
#pragma unroll
            for (int e = 0; e < 3; ++e) { const int ii = __float_as_int(cand[o + 3 + e]); tp = top3_ins(tp, cand[o + e], ii); }
            unsigned mk = 0;
            if (tp.i0 < 32) mk |= 1u << tp.i0;
            if (tp.i1 < 32) mk |= 1u << tp.i1;
            if (tp.i2 < 32) mk |= 1u << tp.i2;
            selm[tid] = mk;
            atomicOr((unsigned*)&misc[1], mk);
        }
        __syncthreads();
        mysel = selm[wid * 32 + l32];
    }
    int jbase = 0, nt;
    if (MODE == 0) { jbase = jfirst; nt = (q0 >> 6) + 4 - jfirst; }
    else if (MODE == 1) { jbase = (q0 >> 6) >= 2 ? (q0 >> 6) - 2 : 0; nt = (q0 >> 6) + 4 - jbase; }
    else if (MODE == 3) { jbase = mg->jblk * 4; nt = 4; }
    else {
        if (tid == 0) {
            const unsigned om = (unsigned)misc[1]; const int nb = q0 >> 8; int n = 0;
            for (int blk = 0; blk < nb; ++blk) if ((om >> blk) & 1u) { tlist[n++] = (short)(blk * 4); tlist[n++] = (short)(blk * 4 + 1); tlist[n++] = (short)(blk * 4 + 2); tlist[n++] = (short)(blk * 4 + 3); }
            for (int jx = nb * 4; jx <= nb * 4 + 3; ++jx) tlist[n++] = (short)jx;
            misc[0] = n;
        }
        __syncthreads();
        nt = misc[0];
    }
#define ATT_TILE(I) ((MODE == 2) ? (int)tlist[(I)] : jbase + (I))
    bf16x8 qf[ND0];
    {
        const bfu* qr = Qp + ((MODE == 3) ? g_tok : (size_t)(rowbase + (long)qstep * rs)) * qp + hi * 8;
#pragma unroll
        for (int d0 = 0; d0 < ND0; ++d0) qf[d0] = *(const bf16x8*)(qr + d0 * 16);
    }
    float m = 0.f, l = 0.f; bool anym = false;
    f32x16 o[NDV];
#pragma unroll
    for (int dvb = 0; dvb < NDV; ++dvb)
#pragma unroll
        for (int r = 0; r < 16; ++r) o[dvb][r] = 0.f;
    int krow[NKL], kch[NKL], vrow[NVL], vch[NVL];
#pragma unroll
    for (int i = 0; i < NKL; ++i) { const int id = tid + NT * i; krow[i] = id / KCH; kch[i] = id % KCH; }
#pragma unroll
    for (int i = 0; i < NVL; ++i) { const int id = tid + NT * i; vrow[i] = id / VCH; vch[i] = id % VCH; }
    u32x4 rk[NKL], rv[NVL];
#define ATT_LOAD(JJ) do { const int j_ = __builtin_amdgcn_readfirstlane((int)(JJ)); \
    _Pragma("unroll") for (int i = 0; i < NKL; ++i) if (tid + NT * i < 64 * KCH) rk[i] = *(const u32x4*)(Kp + (size_t)(rowbase + (long)(j_ * 64 + krow[i]) * rs) * kp + kch[i] * 8); \
    _Pragma("unroll") for (int i = 0; i < NVL; ++i) rv[i] = *(const u32x4*)(Vp + (size_t)(rowbase + (long)(j_ * 64 + vrow[i]) * rs) * vp + vch[i] * 8); } while (0)
#define ATT_STORE(ST) do { bfu* ks_ = Ks + (ST) * KST; bfu* vs_ = Vs + (ST) * VST; \
    _Pragma("unroll") for (int i = 0; i < NKL; ++i) if (tid + NT * i < 64 * KCH) *(u32x4*)(ks_ + krow[i] * KPT + kch[i] * 8) = rk[i]; \
    _Pragma("unroll") for (int i = 0; i < NVL; ++i) *(u32x4*)(vs_ + (vch[i] >> 2) * 2048 + vrow[i] * 32 + (vch[i] & 3) * 8) = rv[i]; } while (0)
    ATT_LOAD(ATT_TILE(0));
    ATT_STORE(0);
    if (nt > 1) ATT_LOAD(ATT_TILE(1));
    __syncthreads();
    const lds_cptr vb0 = (lds_cptr)Vs + ((lane >> 4) & 1) * 32 + (lane & 3) * 8 + (4 * hi + ((lane & 15) >> 2)) * 64;
    const bfu* ksr0 = Ks + l32 * KPT + hi * 8;
    constexpr int NQK = 2 * ND0, NPV = 4 * NDV, OPA = 48 / NQK, EXB = 32 / NPV;
    static_assert(48 % NQK == 0 && 32 % NPV == 0, "filler split");
    f32x16 pA0, pA1;
    u32x4 pw[4];
    bool pend = false; int pstage = 0;
#define ATT_SLOW() do { if (__builtin_expect(anym || __any(ps > 1e12f), 0)) { \
        float mxp = fmaxf(pA0[0], pA1[0]); \
        _Pragma("unroll") for (int r = 1; r < 16; ++r) mxp = fmaxf(mxp, fmaxf(pA0[r], pA1[r])); \
        mxp = fmaxf(mxp, __shfl_xor(mxp, 32)); \
        const float e_ = (mxp > 0.f) ? (__builtin_amdgcn_logf(mxp) - m) : -1e30f; \
        const float delta = (e_ > 24.f) ? floorf(e_) : 0.f; \
        m += delta; \
        const float alpha = __builtin_amdgcn_exp2f(-delta), sc = __builtin_amdgcn_exp2f(-m); \
        l *= alpha; \
        _Pragma("unroll") for (int dvb = 0; dvb < NDV; ++dvb) _Pragma("unroll") for (int r = 0; r < 16; ++r) o[dvb][r] *= alpha; \
        ps = 0.f; \
        _Pragma("unroll") for (int r = 0; r < 16; ++r) { pA0[r] *= sc; pA1[r] *= sc; ps += pA0[r] + pA1[r]; } \
        _Pragma("unroll") for (int q = 0; q < 16; ++q) pw[q >> 2][q & 3] = (q < 8) ? pk2(pA0[2 * q], pA0[2 * q + 1]) : pk2(pA1[2 * q - 16], pA1[2 * q - 15]); \
        anym = anym || (__any(m != 0.f) != 0); } } while (0)
#define ATT_VFRAG(STG, G) ({ const lds_cptr vb_ = vb0 + (STG) * (VST * 2) + ((G) % NDV) * 4096 + ((G) / NDV) * 1024; \
        const s16x4 lo_ = vtr(vb_), hh_ = vtr(vb_ + 512); (bf16x8){lo_[0], lo_[1], lo_[2], lo_[3], hh_[0], hh_[1], hh_[2], hh_[3]}; })
#define ATT_FLUSH() do { float ps = 0.f; \
        _Pragma("unroll") for (int r = 0; r < 16; ++r) ps += pA0[r] + pA1[r]; \
        _Pragma("unroll") for (int q = 0; q < 16; ++q) pw[q >> 2][q & 3] = (q < 8) ? pk2(pA0[2 * q], pA0[2 * q + 1]) : pk2(pA1[2 * q - 16], pA1[2 * q - 15]); \
        ATT_SLOW(); l += ps; \
        _Pragma("unroll") for (int g = 0; g < NPV; ++g) { const bf16x8 vf_ = ATT_VFRAG(pstage, g); o[g % NDV] = MFMA(vf_, __builtin_bit_cast(bf16x8, pw[g / NDV]), o[g % NDV]); } \
        pend = false; } while (0)
    int cur = 0;
    for (int it = 0; it < nt; ++it) {
        const int nxt = (cur == 2) ? 0 : cur + 1;
        const int jc = __builtin_amdgcn_readfirstlane(ATT_TILE(it));
        if (it + 1 < nt) ATT_STORE(nxt);
        if (it + 2 < nt) ATT_LOAD(ATT_TILE(it + 2));
        __builtin_amdgcn_sched_barrier(0);
        bool need;
        if (MODE == 1) need = (jc * 64 <= qw + 31) && (jc * 64 + 63 >= qw - 128);
        else if (MODE == 3) need = (mg->chunk * 256 + wid * 32 < g_total);
        else {
            need = (jc * 64 <= qw + 31);
            if (MODE == 2) { const int blk = jc >> 2; if (blk < (q0 >> 8)) need = __any((mysel >> blk) & 1u) != 0; }
        }
        if (need) {
            const bfu* ksr = ksr0 + cur * KST;
            f32x16 s0, s1;
#pragma unroll
            for (int r = 0; r < 16; ++r) { s0[r] = 0.f; s1[r] = 0.f; }
            bf16x8 kf0[ND0], kf1[ND0];
#pragma unroll
            for (int d0 = 0; d0 < ND0; ++d0) { kf0[d0] = *(const bf16x8*)(ksr + d0 * 16); kf1[d0] = *(const bf16x8*)(ksr + 32 * KPT + d0 * 16); }
            __builtin_amdgcn_sched_barrier(0);
            if (pend) {
                float ps = 0.f;
#pragma unroll
                for (int g = 0; g < NQK; ++g) {
                    if (g & 1) s1 = MFMA(kf1[g >> 1], qf[g >> 1], s1); else s0 = MFMA(kf0[g >> 1], qf[g >> 1], s0);
#pragma unroll
                    for (int k = g * OPA; k < (g + 1) * OPA; ++k) {
                        if (k < 32) ps += (k < 16) ? pA0[k & 15] : pA1[k & 15];
                        else { const int q = k - 32; unsigned w_ = (q < 8) ? pk2(pA0[(2 * q) & 15], pA0[(2 * q + 1) & 15]) : pk2(pA1[(2 * q) & 15], pA1[(2 * q + 1) & 15]);
                               asm volatile("" : "+v"(w_)); pw[q >> 2][q & 3] = w_; }
                    }
                    asm volatile("" : "+v"(ps));
                    __builtin_amdgcn_sched_barrier(0);
                }
                ATT_SLOW();
                l += ps;
            } else {
#pragma unroll
                for (int d0 = 0; d0 < ND0; ++d0) { s0 = MFMA(kf0[d0], qf[d0], s0); s1 = MFMA(kf1[d0], qf[d0], s1); }
            }
            const int kbase = jc * 64 + 4 * hi;
            if (MODE == 1) {
#pragma unroll
                for (int r = 0; r < 16; ++r) {
                    const int dd = qstep - (kbase + (r & 3) + 8 * (r >> 2));
                    if (dd < 0 || dd > 128) s0[r] = -INFINITY;
                    if (dd - 32 < 0 || dd - 32 > 128) s1[r] = -INFINITY;
                }
            } else if (MODE != 3) {
                if (jc * 64 + 63 > qw) {
#pragma unroll
                    for (int r = 0; r < 16; ++r) {
                        const int ks = kbase + (r & 3) + 8 * (r >> 2);
                        if (ks > qstep) s0[r] = -INFINITY;
                        if (ks + 32 > qstep) s1[r] = -INFINITY;
                    }
                }
                if (MODE == 2) {
                    const int blk = jc >> 2;
                    if (blk < (q0 >> 8) && !((mysel >> blk) & 1u)) {
#pragma unroll
                        for (int r = 0; r < 16; ++r) { s0[r] = -INFINITY; s1[r] = -INFINITY; }
                    }
                }
            }
            if (pend) {
                asm volatile("" : "+v"(s0), "+v"(s1));
                __builtin_amdgcn_sched_barrier(0);
                bf16x8 vfc_ = ATT_VFRAG(pstage, 0), vfd_ = ATT_VFRAG(pstage, 1);
#pragma unroll
                for (int g = 0; g < NPV; ++g) {
                    const bf16x8 vfn_ = (g + 2 < NPV) ? ATT_VFRAG(pstage, (g + 2 < NPV ? g + 2 : g)) : vfd_;
                    o[g % NDV] = MFMA(vfc_, __builtin_bit_cast(bf16x8, pw[g / NDV]), o[g % NDV]);
                    vfc_ = vfd_; vfd_ = vfn_;
#pragma unroll
                    for (int k = g * EXB; k < (g + 1) * EXB; ++k) {
                        float t_ = __builtin_amdgcn_exp2f((k < 16) ? s0[k & 15] : s1[k & 15]);
                        asm volatile("" : "+v"(t_));
                        if (k < 16) s0[k & 15] = t_; else s1[k & 15] = t_;
                    }
                    __builtin_amdgcn_sched_barrier(0);
                }
            } else {
#pragma unroll
                for (int r = 0; r < 16; ++r) { s0[r] = __builtin_amdgcn_exp2f(s0[r]); s1[r] = __builtin_amdgcn_exp2f(s1[r]); }
            }
            pA0 = s0; pA1 = s1; pend = true; pstage = cur;
        } else if (pend) {
            ATT_FLUSH();
        }
        __syncthreads();
        cur = nxt;
    }
    if (pend) ATT_FLUSH();
#undef ATT_SLOW
#undef ATT_VFRAG
#undef ATT_FLUSH
#undef ATT_LOAD
#undef ATT_TILE
#undef ATT_STORE
    l += __shfl_xor(l, 32);
    const float inv = 1.f / l;
    const size_t tok = (MODE == 3) ? g_tok : (size_t)(rowbase + (long)qstep * rs);
    bfu* Ow = Op + tok * op;
    if (MODE == 3) Ow = (g_slot == 2 ? mg->po2 : mg->po01 + (size_t)g_slot * ((size_t)T * 512)) + tok * 512 + mg->h * 64;
    if (MODE != 3 || g_active) {
#pragma unroll
        for (int dvb = 0; dvb < NDV; ++dvb)
#pragma unroll
            for (int i = 0; i < 4; ++i) {
                const int dv = dvb * 32 + 8 * i + 4 * hi;
                *(u32x2*)(Ow + dv) = (u32x2){pk2(o[dvb][4 * i] * inv, o[dvb][4 * i + 1] * inv), pk2(o[dvb][4 * i + 2] * inv, o[dvb][4 * i + 3] * inv)};
            }
        if (MODE == 3) { if (hi == 0) mg->plse[(tok * 8 + mg->h) * 4 + g_slot] = m + __builtin_amdgcn_logf(l); }
        else if (MODE == 1 || (MODE == 0 && lsep != nullptr)) { if (hi == 0) lsep[tok * lsest] = m + __builtin_amdgcn_logf(l); }
    }
}

DI void phase_attn_even(const Params& p, char* smem, int* s_item, int rep) {
    char* ws = p.ws;
    const bfu* ubuf = (const bfu*)(ws + OFF_UBUF);
    const bfu* Qa = (const bfu*)p.out; const bfu* Ka = Qa + (size_t)T * 768; const bfu* Va = Ka + (size_t)T * 768;
    bfu* obuf = (bfu*)(ws + OFF_OBUF); bfu* dil_o = (bfu*)(ws + OFF_HBUF); float* dil_lse = (float*)(ws + OFF_HBUF + 48 * MiB);
    const int nblk = gridDim.x;
    for (int it = blockIdx.x; it < 1024; it += nblk) {
        int bh, qt;
        if (nblk == 256) { const int x = blockIdx.x & 7, li = blockIdx.x >> 3, hs = it >> 8; bh = x + 8 * hs; qt = (hs & 1) ? li : 31 - li; }
        else { bh = it & 31; qt = 31 - (it >> 5); }
        const int b = bh >> 3, h = bh & 7;
        __syncthreads();
        attn_item<96, 64, 0>(Qa + h * 96, 768, Ka + h * 96, 768, Va + h * 64, 512, (long)b * SEQ, 1, qt * 256, obuf + h * 64, 768, nullptr, 0, nullptr, smem);
    }
    for (int i2 = blockIdx.x; i2 < 1536; i2 += nblk) {
        const int g = i2 >> 9, r2 = i2 & 511, h = r2 & 3, b = (r2 >> 2) & 3, qi = r2 >> 4;
        const int rr = (g == 0) ? 1 : (g == 1 ? 4 : 16), tpc = 32 / rr, cls = qi / tpc, st = qi % tpc;
        const int gh = g * 4 + h;
        __syncthreads();
        attn_item<64, 64, 1>(ubuf + 672 + gh * 64, 3072, ubuf + 672 + 768 + gh * 64, 3072, ubuf + 672 + 1536 + gh * 64, 3072, (long)b * SEQ + cls, rr, st * 256,
                             dil_o + gh * 64, 768, dil_lse + gh, 12, nullptr, smem);
    }
}
DI void phase_moba_select(const Params& p, char* smem) {
    char* ws = p.ws;
    const bfu* ubuf = (const bfu*)(ws + OFF_UBUF); const float* kpart_all = (const float*)(ws + OFF_KPART);
    float* plse = (float*)(ws + OFF_PLSE); unsigned short* seg = (unsigned short*)(ws + OFF_SEG); int* cnt = (int*)(ws + OFF_CNT);
    float* km = (float*)smem; float* cand = km + 2048; int* sel3 = (int*)(cand + NT * 6); int* wcnt = sel3 + 768;
    const int tid = threadIdx.x, lane = tid & 63, wid = tid >> 6;
    for (int it = blockIdx.x; it < 1024; it += gridDim.x) {
        const int bh = it & 31, n = 31 - (it >> 5), b = bh >> 3, h = bh & 7;
        const float* kpart = kpart_all + (size_t)b * (32 * 4 * 512) + h * 64;
        const bfu* Qp = ubuf + 1536 + h * 64;
        __syncthreads();
        for (int idx = tid; idx < n * 64; idx += NT) {
            const int blk = idx >> 6, d = idx & 63; const float* kq = kpart + (size_t)(blk * 4) * 512 + d;
            km[idx] = (kq[0] + kq[512] + kq[1024] + kq[1536]) * (1.f / 256.f);
        }
        if (tid < 32 && tid >= n) cnt[(bh * 32 + tid) * 32 + n] = 0;
        __syncthreads();
        {
            const int qq = tid & 255, hf = tid >> 8;
            const bfu* qr = Qp + (size_t)(b * SEQ + n * 256 + qq) * 3072;
            float qv[64];
#pragma unroll
            for (int c8 = 0; c8 < 8; ++c8) {
                const u32x4 w = *(const u32x4*)(qr + c8 * 8);
#pragma unroll
                for (int e = 0; e < 4; ++e) { qv[c8 * 8 + 2 * e] = bflo(w[e]); qv[c8 * 8 + 2 * e + 1] = bfhi(w[e]); }
            }
            Top3 tp; tp.v0 = -3e38f; tp.v1 = -3e38f; tp.v2 = -3e38f; tp.i0 = 64; tp.i1 = 64; tp.i2 = 64;
            for (int blk = hf; blk < n; blk += 2) {
                float g = 0.f;
#pragma unroll
                for (int d = 0; d < 64; ++d) g += qv[d] * km[blk * 64 + d];
                tp = top3_ins(tp, g, blk);
            }
            cand[tid * 6 + 0] = tp.v0; cand[tid * 6 + 1] = tp.v1; cand[tid * 6 + 2] = tp.v2;
            cand[tid * 6 + 3] = __int_as_float(tp.i0); cand[tid * 6 + 4] = __int_as_float(tp.i1); cand[tid * 6 + 5] = __int_as_float(tp.i2);
        }
        __syncthreads();
        if (tid < 256) {
            Top3 tp; tp.v0 = cand[tid * 6]; tp.v1 = cand[tid * 6 + 1]; tp.v2 = cand[tid * 6 + 2];
            tp.i0 = __float_as_int(cand[tid * 6 + 3]); tp.i1 = __float_as_int(cand[tid * 6 + 4]); tp.i2 = __float_as_int(cand[tid * 6 + 5]);
            const int o = (tid + 256) * 6;
#pragma unroll
            for (int e = 0; e < 3; ++e) { const int ii = __float_as_int(cand[o + 3 + e]); tp = top3_ins(tp, cand[o + e], ii); }
            sel3[tid * 3 + 0] = tp.i0 < 32 ? tp.i0 : -1; sel3[tid * 3 + 1] = tp.i1 < 32 ? tp.i1 : -1; sel3[tid * 3 + 2] = tp.i2 < 32 ? tp.i2 : -1;
            float* pl = plse + ((size_t)(b * SEQ + n * 256 + tid) * 8 + h) * 4;
            if (tp.i0 >= 32) pl[0] = -INFINITY;
            if (tp.i1 >= 32) pl[1] = -INFINITY;
            if (tp.i2 >= 32) pl[2] = -INFINITY;
        }
        __syncthreads();
        for (int j = 0; j < n; ++j) {
            int sl = -1;
            if (tid < 256) sl = (sel3[tid * 3] == j) ? 0 : (sel3[tid * 3 + 1] == j) ? 1 : (sel3[tid * 3 + 2] == j) ? 2 : -1;
            const unsigned long long bal = __ballot(sl >= 0);
            const int wpre = __popcll(bal & ((1ull << lane) - 1ull));
            if (lane == 0 && wid < 4) wcnt[wid] = __popcll(bal);
            __syncthreads();
            if (sl >= 0) {
                int off = wpre;
                for (int w = 0; w < wid; ++w) off += wcnt[w];
                seg[((size_t)((bh * 32 + j) * 32 + n)) * 256 + off] = (unsigned short)(tid | (sl << 8));
            }
            if (tid == 0) cnt[(bh * 32 + j) * 32 + n] = wcnt[0] + wcnt[1] + wcnt[2] + wcnt[3];
            __syncthreads();
        }
    }
    __syncthreads();
}

DI void phase_attn_odd(const Params& p, char* smem, int* s_item, int rep) {
    char* ws = p.ws;
    const bfu* ubuf = (const bfu*)(ws + OFF_UBUF);
    bfu* obuf = (bfu*)(ws + OFF_OBUF); bfu* dbuf = (bfu*)(ws + OFF_DBUF);
    float* plse = (float*)(ws + OFF_PLSE); const unsigned short* seg = (const unsigned short*)(ws + OFF_SEG); const int* cnt = (const int*)(ws + OFF_CNT);
    const int nblk = gridDim.x, tid = threadIdx.x;
    int* cpre = (int*)(smem + 114688);
    __syncthreads();
    for (int e = tid; e < 1024; e += NT) {
        const int j = e & 31; int sum = 0;
        for (int n = j + 1; n < 32; ++n) sum += cnt[e * 32 + n];
        cpre[e + 1] = (sum + 255) >> 8;
    }
    __syncthreads();
    if (tid == 0) { int a = 0; cpre[0] = 0; for (int e = 1; e <= 1024; ++e) { a += cpre[e]; cpre[e] = a; } }
    __syncthreads();
    const int nchunks = cpre[1024];
    for (int it = blockIdx.x; it < 2048; it += nblk) {
        int bh, qt, kind;
        if (nblk == 256) { const int x = blockIdx.x & 7, li = blockIdx.x >> 3, hs = it >> 8; kind = hs >> 2; bh = x + 8 * (hs & 3); qt = (hs & 1) ? li : 31 - li; }
        else { kind = (it >> 5) & 1; bh = it & 31; qt = 31 - (it >> 6); }
        const int b = bh >> 3, hh = bh & 7;
        __syncthreads();
        if (kind == 0) {
            attn_item<64, 128, 0>(ubuf + hh * 64, 3072, ubuf + 512 + hh * 64, 3072, ubuf + 1024 + (hh >> 1) * 128, 3072, (long)b * SEQ, 1, qt * 256,
                                  dbuf + hh * 128, 1024, nullptr, 0, nullptr, smem);
        } else {
            attn_item<64, 64, 0>(ubuf + 1536 + hh * 64, 3072, ubuf + 2048 + hh * 64, 3072, ubuf + 2560 + hh * 64, 3072, (long)b * SEQ, 1, qt * 256,
                                 obuf + 512 + hh * 64, 1024, plse + hh * 4 + 3, 32, nullptr, smem, qt * 4);
        }
    }
    for (int i = blockIdx.x; i < nchunks; i += nblk) {
        int lo = 0, hi2 = 1023;
        while (lo < hi2) { const int mid = (lo + hi2 + 1) >> 1; if (cpre[mid] <= i) lo = mid; else hi2 = mid - 1; }
        const int e = lo, bh = e >> 5, j = e & 31, b = bh >> 3, hh = bh & 7;
        MobaG mg; mg.cnt = cnt + e * 32; mg.seg = seg + (size_t)(e * 32) * 256; mg.chunk = i - cpre[e]; mg.jblk = j; mg.tokbase = b * SEQ; mg.h = hh;
        mg.po01 = (bfu*)(ws + OFF_HBUF); mg.po2 = (bfu*)(ws + OFF_PO2); mg.plse = plse;
        __syncthreads();
        attn_item<64, 64, 3>(ubuf + 1536 + hh * 64, 3072, ubuf + 2048 + hh * 64, 3072, ubuf + 2560 + hh * 64, 3072, (long)b * SEQ, 1, 0,
                             nullptr, 0, nullptr, 0, nullptr, smem, 0, &mg);
    }
}

#define XB_TMO      128
#define XB_XCNT(j)  (256  + 64 * (j))
#define XB_XSUB(j)  (1280 + 64 * (j))
#define XB_XGEN(j)  (2304 + 64 * (j))
#define XB_TOP      3328
#define XB_TOPGEN   3392
#define XCD_BAR_WORDS 3456
#define XB_SPIN_CAP (1u << 18)
#define LAS __attribute__((address_space(3)))

__device__ __forceinline__ unsigned xb_ld(unsigned* p)              { return __hip_atomic_load(p, __ATOMIC_RELAXED, __HIP_MEMORY_SCOPE_AGENT); }
__device__ __forceinline__ unsigned xb_add(unsigned* p, unsigned v) { return __hip_atomic_fetch_add(p, v, __ATOMIC_RELAXED, __HIP_MEMORY_SCOPE_AGENT); }
__device__ __forceinline__ unsigned xb_xcc_id() { return (unsigned)__builtin_amdgcn_s_getreg((3 << 11) | 20) & 0xFu; }
#define XB_SPIN(cond, bar) do { unsigned _sp = 0; while (cond) { __builtin_amdgcn_s_sleep(1); \
    if ((++_sp & 255u) == 0u) { if (xb_ld(&(bar)[XB_TMO])) break; if (_sp > XB_SPIN_CAP) { atomicAdd(&(bar)[XB_TMO], 1u); break; } } } } while (0)

struct XcdBarrier {
    unsigned* bar; unsigned x;
    volatile LAS unsigned* st;
};

__device__ __forceinline__ XcdBarrier xcd_barrier_post(unsigned* bar, volatile LAS unsigned* st) {
    XcdBarrier b; b.bar = bar; b.x = xb_xcc_id(); b.st = st;
    if (threadIdx.x == 0) (void)xb_add(&bar[XB_XCNT(b.x)], 1u);
    return b;
}
__device__ __forceinline__ void xcd_barrier_complete(unsigned* bar, unsigned x, unsigned& nloc, unsigned& nx) {
    const unsigned G = gridDim.x * gridDim.y * gridDim.z;
    unsigned sum, cnt, mine, sp = 0u;
    for (;;) {
        sum = 0u; cnt = 0u; mine = 0u;
#pragma unroll
        for (unsigned j = 0; j < 16; ++j) { const unsigned c = xb_ld(&bar[XB_XCNT(j)]); sum += c; cnt += (c > 0u) ? 1u : 0u; mine = (j == x) ? c : mine; }
        if (sum == G) break;
        __builtin_amdgcn_s_sleep(1);
        if ((++sp & 255u) == 0u) { if (xb_ld(&bar[XB_TMO])) break; if (sp > XB_SPIN_CAP) { atomicAdd(&bar[XB_TMO], 1u); break; } }
    }
    nloc = mine > 0u ? mine : 1u; nx = cnt > 0u ? cnt : 1u;
}

__device__ __forceinline__ void xcd_barrier(const XcdBarrier& b) {
    asm volatile("s_waitcnt vmcnt(0)" ::: "memory");
    __syncthreads();
    if (threadIdx.x == 0) {
        unsigned* bar = b.bar;
        __builtin_amdgcn_s_waitcnt(0);
        unsigned nloc = b.st[0], nx = b.st[1];
        if (nloc == 0u) { xcd_barrier_complete(bar, b.x, nloc, nx); b.st[0] = nloc; b.st[1] = nx; }
        const unsigned old = xb_add(&bar[XB_XSUB(b.x)], 1u);
        const unsigned gen = old / nloc;
        if (old + 1u == (gen + 1u) * nloc) {
            __builtin_amdgcn_fence(__ATOMIC_RELEASE, "agent");
            asm volatile("s_waitcnt vmcnt(0)" ::: "memory");
            const unsigned og = xb_add(&bar[XB_TOP], 1u);
            const unsigned tg = og / nx;
            if (og + 1u == (tg + 1u) * nx) xb_add(&bar[XB_TOPGEN], 1u);
            else XB_SPIN(xb_ld(&bar[XB_TOPGEN]) == tg, bar);
            __builtin_amdgcn_fence(__ATOMIC_ACQUIRE, "agent");
            xb_add(&bar[XB_XGEN(b.x)], 1u);
            asm volatile("s_waitcnt vmcnt(0)" ::: "memory");
        } else {
            XB_SPIN(xb_ld(&bar[XB_XGEN(b.x)]) == gen, bar);
            __builtin_amdgcn_fence(__ATOMIC_ACQUIRE, "agent");
            asm volatile("s_waitcnt vmcnt(0)" ::: "memory");
        }
    }
    __syncthreads();
}

#ifndef MK_REPMASK
#define MK_REPMASK 0u
#endif
#define PHASE_BEGIN(k) if (p.phase_lo <= (k) && (k) < p.phase_hi) { for (int rep_ = 0; rep_ < (((MK_REPMASK >> (k)) & 1u) ? 2 : 1); ++rep_) {
#define PHASE_MID(k) if (rep_ == 0 && ((MK_REPMASK >> (k)) & 1u)) xcd_barrier(xb); }
#define PHASE_END(k) PHASE_MID(k) if (p.coop && (k) + 1 < p.phase_hi) xcd_barrier(xb); }
__global__ void __launch_bounds__(512, 2) mega(Params p) {
    extern __shared__ __attribute__((aligned(16))) char smem[];
    __shared__ int s_item;
    __shared__ uint4 xb_words;
    char* ws = p.ws;
    if (threadIdx.x == 0) xb_words = make_uint4(0u, 0u, 0u, 0u);
    __syncthreads();
    XcdBarrier xb = xcd_barrier_post((unsigned*)(ws + OFF_CTR + 4096), (volatile LAS unsigned*)&xb_words);
    bfu* hbuf = (bfu*)(ws + OFF_HBUF); bfu* obuf = (bfu*)(ws + OFF_OBUF); bfu* ubuf = (bfu*)(ws + OFF_UBUF); bfu* hid = ubuf;
    const float* mod0 = (const float*)(ws + OFF_MOD); const float* mod1 = mod0 + 4 * 6144;
    PHASE_BEGIN(0) phase_prep(p, smem); PHASE_END(0)
    PHASE_BEGIN(1) phase_modfin(p); PHASE_END(1)
    PHASE_BEGIN(2) phase_normmod(p.x, p.norm_mix, mod0, 0, hbuf); PHASE_END(2)
    PHASE_BEGIN(3) phase_gemm8<0>(hbuf, 1024, (const bfu*)(ws + OFF_WIN0), 1024, 2976, 12, ubuf, 3072, nullptr, nullptr, nullptr, smem); PHASE_END(3)
#if MK_PROBE
    if (p.coop) { phase_gemm_probe<MK_PROBE - 1>(hbuf, (const bfu*)(ws + OFF_WIN0), (float*)(ws + OFF_DBUF), p.pad_, smem); xcd_barrier(xb); }
#endif
    PHASE_BEGIN(4)
            phase_gemm8<0>(ubuf, 3072, (const bfu*)(ws + OFF_WUQ), 384, 768, 3, hbuf, 768, nullptr, nullptr, nullptr, smem);
            phase_gemm8<0>(ubuf + 384, 3072, (const bfu*)(ws + OFF_WUKV), 256, 1024, 4, obuf, 1024, nullptr, nullptr, nullptr, smem);
    PHASE_END(4)
    PHASE_BEGIN(5) phase_post_even(p); PHASE_END(5)
    PHASE_BEGIN(6) phase_attn_even(p, smem, &s_item, rep_); PHASE_END(6)
    PHASE_BEGIN(7) phase_dil_merge(p); PHASE_END(7)
    PHASE_BEGIN(8) phase_gemm8<2>(obuf, 768, (const bfu*)(ws + OFF_WOUT0), 768, 1024, 4, nullptr, 0, p.x, p.out, mod0 + 2048, smem); PHASE_END(8)
    PHASE_BEGIN(9) phase_normmod(p.out, p.norm_mlp, mod0, 3072, hbuf); PHASE_END(9)
    PHASE_BEGIN(10) phase_gemm8<1>(hbuf, 1024, (const bfu*)(ws + OFF_W1_0), 1024, 4096, 16, hid, 4096, nullptr, nullptr, nullptr, smem); PHASE_END(10)
    PHASE_BEGIN(11) phase_gemm8<2>(hid, 4096, (const bfu*)(ws + OFF_W2_0), 4096, 1024, 4, nullptr, 0, p.out, p.out, mod0 + 5120, smem); PHASE_END(11)
    PHASE_BEGIN(12) phase_normmod(p.out, p.norm_mix + 1024, mod1, 0, hbuf); PHASE_END(12)
    PHASE_BEGIN(13) phase_gemm_heads(p, hbuf, (const bfu*)(ws + OFF_WIN1), ubuf, smem); PHASE_END(13)
    PHASE_BEGIN(15) phase_moba_select(p, smem); if (p.coop) xcd_barrier(xb); phase_attn_odd(p, smem, &s_item, rep_); PHASE_END(15)
    PHASE_BEGIN(16) phase_diff_combine(p); PHASE_END(16)
    PHASE_BEGIN(17) phase_gemm8<2>(obuf, 1024, (const bfu*)(ws + OFF_WOUT1), 1024, 1024, 4, nullptr, 0, p.out, p.out, mod1 + 2048, smem); PHASE_END(17)
    PHASE_BEGIN(18) phase_normmod(p.out, p.norm_mlp + 1024, mod1, 3072, hbuf); PHASE_END(18)
    PHASE_BEGIN(19) phase_gemm8<1>(hbuf, 1024, (const bfu*)(ws + OFF_W1_1), 1024, 4096, 16, hid, 4096, nullptr, nullptr, nullptr, smem); PHASE_END(19)
    PHASE_BEGIN(20) phase_gemm8<2>(hid, 4096, (const bfu*)(ws + OFF_W2_1), 4096, 1024, 4, nullptr, 0, p.out, p.out, mod1 + 5120, smem); PHASE_END(20)
    if (p.coop == 2) cg::this_grid().sync();
}

extern "C" void kernel_launch(void* const* d_in, const int* in_sizes, int n_in, void* d_out, int out_size, void* d_ws, size_t ws_size, hipStream_t stream) {
    static int grid_blocks = 0;
    if (!grid_blocks) {
        int dev = 0, cus = 0, per_cu = 0;
        (void)hipGetDevice(&dev);
        (void)hipDeviceGetAttribute(&cus, hipDeviceAttributeMultiprocessorCount, dev);
        (void)hipFuncSetAttribute((const void*)mega, hipFuncAttributeMaxDynamicSharedMemorySize, DYN_LDS);
        (void)hipOccupancyMaxActiveBlocksPerMultiprocessor(&per_cu, mega, NT, DYN_LDS);
        if (per_cu != 1) per_cu = 1;
        grid_blocks = cus * per_cu;
    }
    if (ws_size < WS_END) fprintf(stderr, "workspace too small: %zu < %zu\n", ws_size, (size_t)WS_END);
    Params p{};
    p.x = (const float*)d_in[0]; p.c = (const float*)d_in[1]; p.pos = (const int*)d_in[2];
    p.ada_w = (const float*)d_in[3]; p.ada_b = (const float*)d_in[4]; p.norm_mix = (const float*)d_in[5]; p.norm_mlp = (const float*)d_in[6];
    p.w1 = (const float*)d_in[7]; p.w2 = (const float*)d_in[8]; p.e_win = (const float*)d_in[9]; p.e_wout = (const float*)d_in[10];
    p.qlat = (const float*)d_in[11]; p.kvlat = (const float*)d_in[12]; p.wuq = (const float*)d_in[13]; p.wukv = (const float*)d_in[14];
    p.mla_qn = (const float*)d_in[15]; p.mla_kn = (const float*)d_in[16]; p.dil_qn = (const float*)d_in[17]; p.dil_kn = (const float*)d_in[18];
    p.o_win = (const float*)d_in[19]; p.o_wout = (const float*)d_in[20]; p.diff_qn = (const float*)d_in[21]; p.diff_kn = (const float*)d_in[22];
    p.diff_lam = (const float*)d_in[23]; p.diff_subln = (const float*)d_in[24]; p.moba_qn = (const float*)d_in[25]; p.moba_kn = (const float*)d_in[26];
    p.out = (float*)d_out; p.ws = (char*)d_ws;
    for (int i = 0; i < 32; ++i) p.invf64[i] = (float)pow(10000.0, -(double)i / 32.0);
    for (int i = 0; i < 16; ++i) p.invf32[i] = (float)pow(10000.0, -(double)i / 16.0);
    (void)hipMemsetAsync((char*)d_ws + OFF_CTR, 0, 32768, stream);
#if MK_COOP
    p.phase_lo = 0; p.phase_hi = NPH; p.coop = 1;
    void* args[] = {&p};
    hipError_t e = hipLaunchCooperativeKernel((void*)mega, dim3(grid_blocks), dim3(NT), args, DYN_LDS, stream);
    if (e != hipSuccess) fprintf(stderr, "cooperative launch failed: %s (grid %d)\n", hipGetErrorString(e), grid_blocks);
#else
    for (int ph = 0; ph < NPH; ++ph) {
        p.phase_lo = ph; p.phase_hi = ph + 1; p.coop = 0;
        hipLaunchKernelGGL(mega, dim3(grid_blocks), dim3(NT), DYN_LDS, stream, p);
    }
#endif
}
```

```cpp
#include <hip/hip_runtime.h>
#include <hip/hip_cooperative_groups.h>
#include <stdint.h>
#include <cstdio>
#include <cmath>
namespace cg = cooperative_groups;

#ifndef MK_COOP
#define MK_COOP 1
#endif

typedef unsigned short bfu;
typedef __attribute__((ext_vector_type(8))) short bf16x8;
typedef __attribute__((ext_vector_type(4))) short s16x4;
typedef short v4i16_t __attribute__((ext_vector_type(4)));
typedef __attribute__((ext_vector_type(16))) float f32x16;
typedef __attribute__((ext_vector_type(4))) float f32x4;
typedef __attribute__((ext_vector_type(2))) float f32x2;
typedef __attribute__((ext_vector_type(4))) unsigned u32x4;
typedef __attribute__((ext_vector_type(2))) unsigned u32x2;
typedef __attribute__((ext_vector_type(2))) __bf16 bf2_t;
typedef __attribute__((address_space(3))) const char* lds_cptr;

#define DI __device__ __forceinline__
#define MFMA(a, b, c) __builtin_amdgcn_mfma_f32_32x32x16_bf16((a), (b), (c), 0, 0, 0)

constexpr int T = 32768, SEQ = 8192;
constexpr float EPS = 1e-6f;
constexpr float LOG2E = 1.4426950408889634f;
constexpr float SC_MLA = 0.10206207261596577f * LOG2E;
constexpr float SC_64 = 0.125f * LOG2E;
constexpr float LAM_INIT = 0.35550906759096926f;
constexpr int NPH = 21;
constexpr int NT = 512, NW = 8;
constexpr int DYN_LDS = 2 * 512 * 72 * 2;

constexpr size_t MiB = 1048576;
constexpr size_t OFF_WIN0 = 0, OFF_WIN1 = 6 * MiB, OFF_W1_0 = 12 * MiB, OFF_W1_1 = 20 * MiB, OFF_W2_0 = 28 * MiB, OFF_W2_1 = 36 * MiB,
                 OFF_WOUT0 = 44 * MiB, OFF_WOUT1 = 46 * MiB, OFF_WUQ = 48 * MiB, OFF_WUKV = 49 * MiB, OFF_MODP = 50 * MiB, OFF_MOD = 52 * MiB,
                 OFF_ROPE64 = 53 * MiB, OFF_ROPE32 = 61 * MiB, OFF_KPART = 65 * MiB, OFF_CTR = 66 * MiB,
                 OFF_HBUF = 72 * MiB, OFF_OBUF = 136 * MiB, OFF_UBUF = 200 * MiB, OFF_DBUF = 392 * MiB,
                 OFF_PO2 = 456 * MiB, OFF_PLSE = 488 * MiB, OFF_SEG = 492 * MiB, OFF_CNT = 508 * MiB, WS_END = 509 * MiB;

struct Params {
    const float *x, *c; const int* pos;
    const float *ada_w, *ada_b, *norm_mix, *norm_mlp, *w1, *w2, *e_win, *e_wout, *qlat, *kvlat, *wuq, *wukv, *mla_qn, *mla_kn, *dil_qn, *dil_kn,
        *o_win, *o_wout, *diff_qn, *diff_kn, *diff_lam, *diff_subln, *moba_qn, *moba_kn;
    float* out; char* ws;
    float invf64[32]; float invf32[16];
    int phase_lo, phase_hi, coop, pad_;
};

DI unsigned pk2(float a, float b) { f32x2 v = {a, b}; bf2_t r = __builtin_convertvector(v, bf2_t); return __builtin_bit_cast(unsigned, r); }
DI float bflo(unsigned u) { return __uint_as_float(u << 16); }
DI float bfhi(unsigned u) { return __uint_as_float(u & 0xffff0000u); }
DI float wave_sum(float v) {
#pragma unroll
    for (int o = 32; o; o >>= 1) v += __shfl_xor(v, o);
    return v; }
DI s16x4 vtr(lds_cptr p) { return __builtin_bit_cast(s16x4, __builtin_amdgcn_ds_read_tr16_b64_v4i16((__attribute__((address_space(3))) v4i16_t*)p)); }

DI int hp_col(int n) { return (n & ~255) + 64 * ((n >> 5) & 3) + 32 * ((n >> 7) & 1) + (n & 31); }
DI void tr_tile(const float* __restrict__ src, int K, int N, bfu* __restrict__ dst, const float* __restrict__ kscale, int it, float* tl, int hperm) {
    const int nkt = K >> 6; const int kt = it % nkt, nt = it / nkt; const int tid = threadIdx.x;
#pragma unroll
    for (int rr = 0; rr < 2; ++rr) {
        const int kl = rr * 32 + (tid >> 4), k = kt * 64 + kl, nl = (tid & 15) * 4, n = nt * 64 + nl;
        float4 v = make_float4(0.f, 0.f, 0.f, 0.f);
        if (n < N) v = *(const float4*)(src + (size_t)k * N + (hperm ? hp_col(n) : n));
        if (kscale) { const float sc = kscale[k]; v.x *= sc; v.y *= sc; v.z *= sc; v.w *= sc; }
        tl[kl * 65 + nl] = v.x; tl[kl * 65 + nl + 1] = v.y; tl[kl * 65 + nl + 2] = v.z; tl[kl * 65 + nl + 3] = v.w;
    }
    __syncthreads();
    {
        const int nl = tid >> 3, kc = (tid & 7) * 8;
        unsigned w[4];
#pragma unroll
        for (int i = 0; i < 4; ++i) w[i] = pk2(tl[(kc + 2 * i) * 65 + nl], tl[(kc + 2 * i + 1) * 65 + nl]);
        bfu* d = dst + (size_t)(nt * 64 + nl) * K + kt * 64 + kc;
        *(u32x4*)d = (u32x4){w[0], w[1], w[2], w[3]};
    }
    __syncthreads();
}
DI void tr_matrix(const float* src, int K, int N, int Npad, bfu* dst, const float* kscale, float* tl, int hperm = 0) {
    const int nit = (K >> 6) * (Npad >> 6);
    for (int it = blockIdx.x; it < nit; it += gridDim.x) tr_tile(src, K, N, dst, kscale, it, tl, hperm);
}

DI void phase_prep(const Params& p, char* smem) {
    float* tl = (float*)smem;
    char* ws = p.ws;
    if (blockIdx.x == 0 && threadIdx.x < 4) ((int*)(ws + OFF_CTR))[threadIdx.x] = 0;
    tr_matrix(p.e_win, 1024, 2976, 3072, (bfu*)(ws + OFF_WIN0), nullptr, tl);
    tr_matrix(p.o_win, 1024, 3072, 3072, (bfu*)(ws + OFF_WIN1), nullptr, tl, 1);
    tr_matrix(p.w1, 1024, 4096, 4096, (bfu*)(ws + OFF_W1_0), nullptr, tl);
    tr_matrix(p.w1 + (size_t)1024 * 4096, 1024, 4096, 4096, (bfu*)(ws + OFF_W1_1), nullptr, tl);
    tr_matrix(p.w2, 4096, 1024, 1024, (bfu*)(ws + OFF_W2_0), nullptr, tl);
    tr_matrix(p.w2 + (size_t)1024 * 4096, 4096, 1024, 1024, (bfu*)(ws + OFF_W2_1), nullptr, tl);
    tr_matrix(p.e_wout, 768, 1024, 1024, (bfu*)(ws + OFF_WOUT0), nullptr, tl);
    tr_matrix(p.o_wout, 1024, 1024, 1024, (bfu*)(ws + OFF_WOUT1), nullptr, tl);
    tr_matrix(p.wuq, 384, 768, 768, (bfu*)(ws + OFF_WUQ), p.qlat, tl);
    tr_matrix(p.wukv, 256, 1024, 1024, (bfu*)(ws + OFF_WUKV), p.kvlat, tl);
    {
        float2* r64 = (float2*)(ws + OFF_ROPE64); float2* r32 = (float2*)(ws + OFF_ROPE32);
        for (int idx = blockIdx.x * NT + threadIdx.x; idx < T * 48; idx += gridDim.x * NT) {
            const int t = idx / 48, i = idx % 48;
            const float invf = (i < 32) ? p.invf64[i] : p.invf32[i - 32];
            const float a = (float)p.pos[t] * invf;
            double rev = (double)a * 0.15915494309189535; rev -= floor(rev);
            const double y = (rev > 0.5 ? rev - 1.0 : rev) * 6.283185307179586;
            const double y2 = y * y; double s = 1.0, c = 1.0;
#pragma unroll
            for (int k = 15; k >= 1; --k) { s = 1.0 - s * y2 * (1.0 / (double)((2 * k) * (2 * k + 1))); c = 1.0 - c * y2 * (1.0 / (double)((2 * k - 1) * (2 * k))); }
            s *= y;
            const float2 o = make_float2((float)c, (float)s);
            if (i < 32) r64[(size_t)t * 32 + i] = o; else r32[(size_t)t * 16 + (i - 32)] = o;
        }
    }
    {
        float* sl = (float*)smem; float* modp = (float*)(ws + OFF_MODP);
        for (int it = blockIdx.x; it < 2 * 12 * 8; it += gridDim.x) {
            const int l = it / 96, cc = (it % 96) / 8, kc = it % 8;
            __syncthreads();
            { const int i = threadIdx.x, b = i >> 7, kk = i & 127; const float cv = p.c[b * 1024 + kc * 128 + kk]; sl[i] = cv / (1.f + __expf(-cv)); }
            __syncthreads();
            const int j = cc * 512 + threadIdx.x;
            const float* w = p.ada_w + ((size_t)l * 1024 + kc * 128) * 6144 + j;
            float a0 = 0.f, a1 = 0.f, a2 = 0.f, a3 = 0.f;
#pragma unroll 8
            for (int kk = 0; kk < 128; ++kk) { const float wv = w[(size_t)kk * 6144]; a0 += sl[kk] * wv; a1 += sl[128 + kk] * wv; a2 += sl[256 + kk] * wv; a3 += sl[384 + kk] * wv; }
            float* o = modp + (size_t)((l * 8 + kc) * 4) * 6144 + j;
            o[0] = a0; o[6144] = a1; o[2 * 6144] = a2; o[3 * 6144] = a3;
        }
        __syncthreads();
    }
}

DI void phase_modfin(const Params& p) {
    const float* modp = (const float*)(p.ws + OFF_MODP); float* mod = (float*)(p.ws + OFF_MOD);
    for (int idx = blockIdx.x * NT + threadIdx.x; idx < 2 * 4 * 6144; idx += gridDim.x * NT) {
        const int l = idx / 24576, rem = idx % 24576, j = rem % 6144;
        float s = p.ada_b[l * 6144 + j];
#pragma unroll
        for (int kc = 0; kc < 8; ++kc) s += modp[(size_t)((l * 8 + kc) * 4) * 6144 + rem];
        mod[idx] = s;
    }
}

DI void phase_normmod(const float* xs, const float* __restrict__ nw, const float* __restrict__ mod, int sh_off, bfu* __restrict__ hb) {
    const int lane = threadIdx.x & 63, gw = blockIdx.x * NW + (threadIdx.x >> 6), nwv = gridDim.x * NW;
    for (int t = gw; t < T; t += nwv) {
        const int b = t >> 13; const float* xr = xs + (size_t)t * 1024;
        float4 v[4]; float ss = 0.f;
#pragma unroll
        for (int i = 0; i < 4; ++i) { v[i] = *(const float4*)(xr + (i * 64 + lane) * 4); ss += v[i].x * v[i].x + v[i].y * v[i].y + v[i].z * v[i].z + v[i].w * v[i].w; }
        ss = wave_sum(ss);
        const float rinv = rsqrtf(ss * (1.f / 1024.f) + EPS);
        const float* mb = mod + b * 6144 + sh_off;
#pragma unroll
        for (int i = 0; i < 4; ++i) {
            const int col = (i * 64 + lane) * 4;
            const float4 w = *(const float4*)(nw + col), sh = *(const float4*)(mb + col), sc = *(const float4*)(mb + 1024 + col);
            const float o0 = v[i].x * rinv * w.x * (1.f + sc.x) + sh.x, o1 = v[i].y * rinv * w.y * (1.f + sc.y) + sh.y;
            const float o2 = v[i].z * rinv * w.z * (1.f + sc.z) + sh.z, o3 = v[i].w * rinv * w.w * (1.f + sc.w) + sh.w;
            *(u32x2*)(hb + (size_t)t * 1024 + col) = (u32x2){pk2(o0, o1), pk2(o2, o3)};
        }
    }
}

template <int EPI>
DI void gemm_tile(const bfu* __restrict__ A, int lda, const bfu* __restrict__ Bt, int K, int m0, int n0, int N,
                  bfu* Cb, int ldc, const float* resid, float* outf, const float* __restrict__ gate, char* smem) {
    constexpr int STG = 512 * 72;
    bfu* S0 = (bfu*)smem;
    const int tid = threadIdx.x, lane = tid & 63, wid = tid >> 6, l32 = lane & 31, hi = lane >> 5;
    const int wm = wid & 3, wn = wid >> 2;
    f32x16 acc[4][2];
#pragma unroll
    for (int nb = 0; nb < 4; ++nb)
#pragma unroll
        for (int mb = 0; mb < 2; ++mb)
#pragma unroll
            for (int r = 0; r < 16; ++r) acc[nb][mb][r] = 0.f;
    const bfu* Ag = A + (size_t)(m0 + (tid >> 3)) * lda + (tid & 7) * 8;
    const bfu* Bg = Bt + (size_t)(n0 + (tid >> 3)) * K + (tid & 7) * 8;
    u32x4 ra[4], rb[4];
#pragma unroll
    for (int i = 0; i < 4; ++i) { ra[i] = *(const u32x4*)(Ag + (size_t)(64 * i) * lda); rb[i] = *(const u32x4*)(Bg + (size_t)(64 * i) * K); }
    const int nk = K >> 6;
    const int wofs = (tid >> 3) * 72 + (tid & 7) * 8;
    const int arofs = (wm * 64 + l32) * 72 + hi * 8, brofs = 256 * 72 + (wn * 128 + l32) * 72 + hi * 8;
    __syncthreads();
#pragma unroll
    for (int i = 0; i < 4; ++i) { *(u32x4*)(S0 + wofs + 64 * i * 72) = ra[i]; *(u32x4*)(S0 + 256 * 72 + wofs + 64 * i * 72) = rb[i]; }
    if (nk > 1) {
#pragma unroll
        for (int i = 0; i < 4; ++i) { ra[i] = *(const u32x4*)(Ag + (size_t)(64 * i) * lda + 64); rb[i] = *(const u32x4*)(Bg + (size_t)(64 * i) * K + 64); }
    }
    __syncthreads();
#pragma unroll 1
    for (int kt = 0; kt < nk; ++kt) {
        const bfu* Sc = S0 + (kt & 1) * STG; bfu* Sn = S0 + ((kt & 1) ^ 1) * STG;
        if (kt + 1 < nk) {
#pragma unroll
            for (int i = 0; i < 4; ++i) { *(u32x4*)(Sn + wofs + 64 * i * 72) = ra[i]; *(u32x4*)(Sn + 256 * 72 + wofs + 64 * i * 72) = rb[i]; }
        }
        __builtin_amdgcn_sched_barrier(0);
        if (kt + 2 < nk) {
            const int ko = (kt + 2) * 64;
#pragma unroll
            for (int i = 0; i < 4; ++i) { ra[i] = *(const u32x4*)(Ag + (size_t)(64 * i) * lda + ko); rb[i] = *(const u32x4*)(Bg + (size_t)(64 * i) * K + ko); }
        }
        __builtin_amdgcn_sched_barrier(0);
#pragma unroll
        for (int k16 = 0; k16 < 4; ++k16) {
            bf16x8 af[2], bfr[4];
#pragma unroll
            for (int mb = 0; mb < 2; ++mb) af[mb] = *(const bf16x8*)(Sc + arofs + mb * 32 * 72 + k16 * 16);
#pragma unroll
            for (int nb = 0; nb < 4; ++nb) bfr[nb] = *(const bf16x8*)(Sc + brofs + nb * 32 * 72 + k16 * 16);
#pragma unroll
            for (int nb = 0; nb < 4; ++nb)
#pragma unroll
                for (int mb = 0; mb < 2; ++mb) acc[nb][mb] = MFMA(bfr[nb], af[mb], acc[nb][mb]);
        }
        __syncthreads();
    }
    if (EPI != 2) {
        constexpr int CP = 264;
        bfu* Cs = (bfu*)smem;
#pragma unroll
        for (int nb = 0; nb < 4; ++nb)
#pragma unroll
            for (int mb = 0; mb < 2; ++mb) {
                const int row = wm * 64 + mb * 32 + l32;
#pragma unroll
                for (int i = 0; i < 4; ++i) {
                    const int col = wn * 128 + nb * 32 + 8 * i + 4 * hi;
                    float v0 = acc[nb][mb][4 * i], v1 = acc[nb][mb][4 * i + 1], v2 = acc[nb][mb][4 * i + 2], v3 = acc[nb][mb][4 * i + 3];
                    if (EPI == 1) { v0 = fmaxf(v0, 0.f); v1 = fmaxf(v1, 0.f); v2 = fmaxf(v2, 0.f); v3 = fmaxf(v3, 0.f); v0 *= v0; v1 *= v1; v2 *= v2; v3 *= v3; }
                    *(u32x2*)(Cs + row * CP + col) = (u32x2){pk2(v0, v1), pk2(v2, v3)};
                }
            }
        __syncthreads();
        const int c8 = (tid & 31) * 8, n = n0 + c8;
#pragma unroll 1
        for (int ps = 0; ps < 16; ++ps) {
            const int row = ps * 16 + (tid >> 5);
            const u32x4 v = *(const u32x4*)(Cs + row * CP + c8);
            if (n < N) *(u32x4*)(Cb + (size_t)(m0 + row) * ldc + n) = v;
        }
        __syncthreads();
    } else {
        constexpr int CPF = 132;
        float* Cs = (float*)smem;
#pragma unroll
        for (int p2 = 0; p2 < 2; ++p2) {
#pragma unroll
            for (int nbl = 0; nbl < 2; ++nbl)
#pragma unroll
                for (int mb = 0; mb < 2; ++mb) {
                    const int row = wm * 64 + mb * 32 + l32;
#pragma unroll
                    for (int i = 0; i < 4; ++i) {
                        const int col = wn * 64 + nbl * 32 + 8 * i + 4 * hi;
                        *(f32x4*)(Cs + row * CPF + col) = (f32x4){acc[2 * p2 + nbl][mb][4 * i], acc[2 * p2 + nbl][mb][4 * i + 1], acc[2 * p2 + nbl][mb][4 * i + 2], acc[2 * p2 + nbl][mb][4 * i + 3]};
                    }
                }
            __syncthreads();
            const int cl = (tid & 31) * 4;
            const int n = n0 + (cl >> 6) * 128 + (2 * p2 + ((cl >> 5) & 1)) * 32 + (cl & 31);
#pragma unroll 1
            for (int ps = 0; ps < 16; ++ps) {
                const int row = ps * 16 + (tid >> 5), m = m0 + row, b = m >> 13;
                const f32x4 v = *(const f32x4*)(Cs + row * CPF + cl);
                const float4 g = *(const float4*)(gate + b * 6144 + n);
                const float4 r = *(const float4*)(resid + (size_t)m * 1024 + n);
                float4 o; o.x = r.x + g.x * v[0]; o.y = r.y + g.y * v[1]; o.z = r.z + g.z * v[2]; o.w = r.w + g.w * v[3];
                *(float4*)(outf + (size_t)m * 1024 + n) = o;
            }
            __syncthreads();
        }
    }
}

DI bool gemm_map(int round, int nsn, int nwt, int& mt, int& nt) {
    const int x = blockIdx.x & 7, li = blockIdx.x >> 3;
    const int st = round * 8 + x;
    if (st >= 16 * nsn || (li >> 3) >= nwt) return false;
    const int sm = st / nsn, sn = st % nsn;
    mt = sm * 8 + (li & 7); nt = sn * nwt + (li >> 3);
    return true;
}
template <int EPI>
DI void phase_gemm(const bfu* A, int lda, const bfu* Bt, int K, int N, int ntn, bfu* Cb, int ldc, const float* resid, float* outf, const float* gate, char* smem) {
    const bool xcd = (gridDim.x == 256);
    const int nwt = (ntn % 4 == 0) ? 4 : ntn, nsn = ntn / nwt;
    const int rounds = xcd ? 2 * nsn : (128 * ntn + (int)gridDim.x - 1) / (int)gridDim.x;
    for (int r = 0; r < rounds; ++r) {
        int mt = 0, nt = 0; bool ok;
        if (xcd) ok = gemm_map(r, nsn, nwt, mt, nt);
        else { const int tile = r * gridDim.x + blockIdx.x; ok = tile < 128 * ntn; mt = tile / ntn; nt = tile % ntn; }
        if (ok) gemm_tile<EPI>(A, lda, Bt, K, mt * 256, nt * 256, N, Cb, ldc, resid, outf, gate, smem);
    }
}


namespace pg8 {
#define PG8_LAS __attribute__((address_space(3)))
typedef unsigned short bf16_t;
typedef short bf16x8 __attribute__((ext_vector_type(8)));
typedef float f32x4 __attribute__((ext_vector_type(4)));
typedef unsigned u32x4 __attribute__((ext_vector_type(4)));
constexpr int BM = 256, BK = 64, HALF = 128, HTB = HALF * BK * 2  , STAGE_BYTES = 8 * HTB, NXCD = 8, WGM = 8;

__host__ __device__ __forceinline__ int lds_byte(int r, int c) { const int st = (r >> 4) * 2 + (c >> 5), rr = r & 15, cc = c & 31, ob = rr * 64 + cc * 2; return st * 1024 + (ob ^ (((ob >> 9) & 1) << 5)); }
__host__ __device__ __forceinline__ void stage_rc(int b, int& R, int& C) { const int st = b / 1024, sb = b % 1024, swz = sb ^ (((sb >> 9) & 1) << 5); R = (st >> 1) * 16 + swz / 64; C = (st & 1) * 32 + (swz % 64) / 2; }
__host__ __device__ __forceinline__ int perm32(int rho) { const int n = rho >> 4, i = rho & 15; return 8 * (i >> 2) + 4 * n + (i & 3); }

struct Unit { int pm, pn; };
struct Gemm { const bf16_t* A; const bf16_t* Bt; int lda, K; };

template <class Epi, class Sched, bool STAMP = false>
__device__ __forceinline__ void gemm_phase(PG8_LAS unsigned char* lds, const Gemm g, const Sched& S, const Epi& E, unsigned long long* stamps) {
    const int tid = threadIdx.x, wid = __builtin_amdgcn_readfirstlane(tid >> 6), lane = tid & 63, wr = wid >> 2, wc = wid & 3, fr = lane & 15, fq = lane >> 4;
    const int K = g.K, nt = K / BK;
    int ts_lo = 0, ts_hi = 0, nts = 0; const unsigned long long rt_entry = STAMP ? (unsigned long long)wall_clock64() : 0ull;
#define PG8_STAMP() do { if (STAMP && wid == 0 && nts < 64) { const unsigned long long _c = (unsigned long long)clock64(); \
        ts_lo = (lane == nts) ? (int)(unsigned)_c : ts_lo; ts_hi = (lane == nts) ? (int)(unsigned)(_c >> 32) : ts_hi; ++nts; } } while (0)
    PG8_STAMP();
    unsigned voffA[2], voffB[2];
#pragma unroll
    for (int i = 0; i < 2; ++i) { int R, C; stage_rc(tid * 16 + i * 8192, R, C); const int Rb = Epi::PERM ? ((R & ~31) + perm32(R & 31)) : R;
        voffA[i] = (unsigned)(R * g.lda + C) * 2u; voffB[i] = (unsigned)(Rb * K + C) * 2u; }
    const size_t kstep = (size_t)(BK * 2);
    const size_t hstep = (size_t)HALF * K * 2, hstepA = (size_t)HALF * g.lda * 2;
    const size_t tstep = 2 * hstep, tstepA = 2 * hstepA;
    const unsigned ldsw = (unsigned)wid * 1024u;
    const int aoff = lds_byte(wr * 64 + fr, fq * 8), boff = lds_byte(wc * 32 + fr, fq * 8);
#define PG8_SA(b, h) (((b) * 2 + (h)) * HTB)
#define PG8_SB(b, h) ((4 + (b) * 2 + (h)) * HTB)
#define PG8_STAGE(bufoff, gbase, voff) do { _Pragma("unroll") for (int _i = 0; _i < 2; ++_i) \
        __builtin_amdgcn_global_load_lds((const unsigned*)((const char*)(gbase) + (voff)[_i]), (PG8_LAS unsigned*)(lds + (bufoff) + ldsw + _i * 8192), 16, 0, 0); } while (0)
#define PG8_LDA(dst, b, h) do { _Pragma("unroll") for (int m = 0; m < 4; ++m) _Pragma("unroll") for (int k = 0; k < 2; ++k) dst[m][k] = *(const PG8_LAS bf16x8*)(lds + PG8_SA(b, h) + aoff + m * 2048 + k * 1024); } while (0)
#define PG8_LDB(dst, b, h) do { _Pragma("unroll") for (int n = 0; n < 2; ++n) _Pragma("unroll") for (int k = 0; k < 2; ++k) dst[n][k] = *(const PG8_LAS bf16x8*)(lds + PG8_SB(b, h) + boff + n * 2048 + k * 1024); } while (0)
#define PG8_MMA(ai, bj, At, Bt) do { __builtin_amdgcn_s_setprio(1); _Pragma("unroll") for (int m = 0; m < 4; ++m) _Pragma("unroll") for (int n = 0; n < 2; ++n) _Pragma("unroll") for (int k = 0; k < 2; ++k) \
        acc[ai][bj][m][n] = __builtin_amdgcn_mfma_f32_16x16x32_bf16(Bt[n][k], At[m][k], acc[ai][bj][m][n], 0, 0, 0); __builtin_amdgcn_s_setprio(0); } while (0)
#define PG8_WAIT_V(n) asm volatile("s_waitcnt vmcnt(" #n ")" ::: "memory")
#define PG8_WAIT_L(n) asm volatile("s_waitcnt lgkmcnt(" #n ")" ::: "memory")
#define PG8_BAR __builtin_amdgcn_s_barrier()
#define PG8_SCHED __builtin_amdgcn_sched_barrier(0)
    Unit cur, nxt; int ui = 0;
    if (!S.next(0, cur)) return;
    f32x4 acc[2][2][4][2];
#pragma unroll
    for (int a = 0; a < 2; ++a)
#pragma unroll
        for (int b = 0; b < 2; ++b)
#pragma unroll
            for (int m = 0; m < 4; ++m)
#pragma unroll
                for (int n = 0; n < 2; ++n) acc[a][b][m][n] = (f32x4){0.f, 0.f, 0.f, 0.f};
    bf16x8 At[4][2], B0[2][2], B1[2][2];
    const char* cA = (const char*)g.A + (size_t)cur.pm * tstepA; const char* cB = (const char*)g.Bt + (size_t)cur.pn * tstep;
    S.a_ready(cur);
    PG8_STAGE(PG8_SB(0, 0), cB, voffB); PG8_STAGE(PG8_SA(0, 0), cA, voffA); PG8_STAGE(PG8_SB(0, 1), cB + hstep, voffB); PG8_STAGE(PG8_SA(0, 1), cA + hstepA, voffA);
    if (wr == 1) PG8_BAR;
    PG8_WAIT_V(4); PG8_BAR;
    PG8_STAGE(PG8_SB(1, 0), cB + kstep, voffB); PG8_STAGE(PG8_SA(1, 0), cA + kstep, voffA); PG8_STAGE(PG8_SB(1, 1), cB + hstep + kstep, voffB);
    PG8_WAIT_V(6); PG8_BAR;
    PG8_STAMP();
    for (;;) {
        const bool has_next = S.next(ui + 1, nxt);
        const char* nA = has_next ? (const char*)g.A + (size_t)nxt.pm * tstepA : cA; const char* nB = has_next ? (const char*)g.Bt + (size_t)nxt.pn * tstep : cB;
        for (int t = 0; t < nt; t += 2) {
            const bool last = (t == nt - 2);
            const char* a1 = cA + (size_t)(t + 1) * kstep;
            const char* a2 = last ? nA : cA + (size_t)(t + 2) * kstep; const char* b2 = last ? nB : cB + (size_t)(t + 2) * kstep;
            const char* a3 = a2 + kstep; const char* b3 = b2 + kstep;
            if (last && has_next) S.a_ready(nxt);
            PG8_LDB(B0, 0, 0); PG8_SCHED; PG8_LDA(At, 0, 0); PG8_STAGE(PG8_SA(1, 1), a1 + hstepA, voffA);
            PG8_WAIT_L(8); PG8_BAR; PG8_WAIT_L(0); PG8_MMA(0, 0, At, B0); PG8_BAR; PG8_SCHED;
            PG8_LDB(B1, 0, 1); PG8_STAGE(PG8_SB(0, 0), b2, voffB);
            PG8_BAR; PG8_WAIT_L(0); PG8_MMA(0, 1, At, B1); PG8_BAR;
            PG8_LDA(At, 0, 1); PG8_STAGE(PG8_SA(0, 0), a2, voffA);
            PG8_BAR; PG8_WAIT_L(0); PG8_MMA(1, 0, At, B0); PG8_BAR; PG8_SCHED;
            PG8_STAGE(PG8_SB(0, 1), b2 + hstep, voffB);
            PG8_WAIT_V(6); PG8_BAR; PG8_MMA(1, 1, At, B1); PG8_BAR;
            PG8_LDB(B0, 1, 0); PG8_SCHED; PG8_LDA(At, 1, 0); PG8_STAGE(PG8_SA(0, 1), a2 + hstepA, voffA);
            PG8_WAIT_L(8); PG8_BAR; PG8_WAIT_L(0); PG8_MMA(0, 0, At, B0); PG8_BAR; PG8_SCHED;
            PG8_LDB(B1, 1, 1); PG8_STAGE(PG8_SB(1, 0), b3, voffB);
            PG8_BAR; PG8_WAIT_L(0); PG8_MMA(0, 1, At, B1); PG8_BAR;
            PG8_LDA(At, 1, 1); PG8_STAGE(PG8_SA(1, 0), a3, voffA);
            PG8_BAR; PG8_WAIT_L(0); PG8_MMA(1, 0, At, B0); PG8_BAR; PG8_SCHED;
            PG8_STAGE(PG8_SB(1, 1), b3 + hstep, voffB);
            PG8_WAIT_V(6); PG8_BAR; PG8_MMA(1, 1, At, B1); PG8_BAR;
        }
        PG8_STAMP();
        if constexpr (!Epi::AFTER_DRAIN) { E(acc, cur, wr, wc, fr, fq); S.done(cur); }
        PG8_STAMP();
        if (!has_next) break;
#pragma unroll
        for (int a = 0; a < 2; ++a)
#pragma unroll
            for (int b = 0; b < 2; ++b)
#pragma unroll
                for (int m = 0; m < 4; ++m)
#pragma unroll
                    for (int n = 0; n < 2; ++n) acc[a][b][m][n] = (f32x4){0.f, 0.f, 0.f, 0.f};
        cur = nxt; cA = nA; cB = nB; ++ui;
    }
    PG8_WAIT_V(0);
    if (wr == 0) PG8_BAR;
    PG8_BAR;
    if constexpr (Epi::AFTER_DRAIN) { E.fused(acc, cur, wr, wc, fr, fq, lds, wid, lane); S.done(cur); }
    PG8_STAMP();
    if (STAMP && wid == 0) { stamps[lane] = lane < nts ? (((unsigned long long)(unsigned)ts_hi << 32) | (unsigned)ts_lo) : 0ull;
        if (lane == 62) stamps[62] = rt_entry; if (lane == 63) stamps[63] = (unsigned long long)wall_clock64(); }
#undef PG8_STAMP
#undef PG8_SA
#undef PG8_SB
#undef PG8_STAGE
#undef PG8_LDA
#undef PG8_LDB
#undef PG8_MMA
#undef PG8_WAIT_V
#undef PG8_WAIT_L
#undef PG8_BAR
#undef PG8_SCHED
}
}

struct XcdOrder {
    int nsn, nwt, ntn;
    DI bool next(int i, pg8::Unit& u) const {
        int mt, nt;
        if (gridDim.x == 256) { if (!gemm_map(i, nsn, nwt, mt, nt)) return false; }
        else { const int tile = i * (int)gridDim.x + (int)blockIdx.x; if (tile >= 128 * ntn) return false; mt = tile / ntn; nt = tile % ntn; }
        u.pm = mt; u.pn = nt; return true;
    }
    DI void a_ready(const pg8::Unit&) const {}
    DI void done(const pg8::Unit&) const {}
};
template <int ACT> struct EpiOutBf16 {
    static constexpr bool PERM = true, AFTER_DRAIN = false;
    bfu* O; int ldc, N;
    DI void operator()(const pg8::f32x4 (&acc)[2][2][4][2], const pg8::Unit& u, int wr, int wc, int fr, int fq) const {
        const int row0 = u.pm * 256 + wr * 64 + fr, col0 = u.pn * 256 + wc * 32 + 8 * fq;
#pragma unroll
        for (int ai = 0; ai < 2; ++ai)
#pragma unroll
            for (int m = 0; m < 4; ++m) {
                bfu* rowp = O + (size_t)(row0 + ai * 128 + m * 16) * ldc + col0;
#pragma unroll
                for (int bj = 0; bj < 2; ++bj) {
                    pg8::f32x4 v0 = acc[ai][bj][m][0], v1 = acc[ai][bj][m][1];
                    if (ACT == 1) {
#pragma unroll
                        for (int j = 0; j < 4; ++j) { const float a = fmaxf(v0[j], 0.f), b = fmaxf(v1[j], 0.f); v0[j] = a * a; v1[j] = b * b; }
                    }
                    if (col0 + bj * 128 < N) *(u32x4*)(rowp + bj * 128) = (u32x4){pk2(v0[0], v0[1]), pk2(v0[2], v0[3]), pk2(v1[0], v1[1]), pk2(v1[2], v1[3])};
                }
            }
    }
};
struct EpiResid {
    static constexpr bool PERM = false, AFTER_DRAIN = false;
    const float* resid; float* out; const float* gate;
    DI void operator()(const pg8::f32x4 (&acc)[2][2][4][2], const pg8::Unit& u, int wr, int wc, int fr, int fq) const {
        const int row0 = u.pm * 256 + wr * 64 + fr, col0 = u.pn * 256 + wc * 32 + 4 * fq;
        const float* gb = gate + ((u.pm * 256) >> 13) * 6144 + col0;
        pg8::f32x4 gv[2][2];
#pragma unroll
        for (int bj = 0; bj < 2; ++bj)
#pragma unroll
            for (int n = 0; n < 2; ++n) gv[bj][n] = *(const pg8::f32x4*)(gb + bj * 128 + n * 16);
#pragma unroll
        for (int ai = 0; ai < 2; ++ai)
#pragma unroll
            for (int m = 0; m < 4; ++m) {
                const size_t ro = (size_t)(row0 + ai * 128 + m * 16) * 1024 + col0;
#pragma unroll
                for (int bj = 0; bj < 2; ++bj)
#pragma unroll
                    for (int n = 0; n < 2; ++n) {
                        const pg8::f32x4 r = *(const pg8::f32x4*)(resid + ro + bj * 128 + n * 16);
                        *(pg8::f32x4*)(out + ro + bj * 128 + n * 16) = r + gv[bj][n] * acc[ai][bj][m][n];
                    }
            }
    }
};
template <int EPI>
DI void phase_gemm8(const bfu* A, int lda, const bfu* Bt, int K, int N, int ntn, bfu* Cb, int ldc, const float* resid, float* outf, const float* gate, char* smem) {
    pg8::Gemm g; g.A = A; g.Bt = Bt; g.lda = lda; g.K = K;
    XcdOrder S; S.ntn = ntn; S.nwt = (ntn % 4 == 0) ? 4 : ntn; S.nsn = ntn / S.nwt;
    __syncthreads();
    if (EPI == 2) { EpiResid E; E.resid = resid; E.out = outf; E.gate = gate; pg8::gemm_phase<EpiResid, XcdOrder, false>((PG8_LAS unsigned char*)smem, g, S, E, nullptr); }
    else { EpiOutBf16<EPI> E; E.O = Cb; E.ldc = ldc; E.N = N; pg8::gemm_phase<EpiOutBf16<EPI>, XcdOrder, false>((PG8_LAS unsigned char*)smem, g, S, E, nullptr); }
    __syncthreads();
}


struct EpiHeads {
    static constexpr bool PERM = true, AFTER_DRAIN = false;
    bfu* O; const float2* rope; const float *w_dq, *w_dk, *w_mq, *w_mk; float* kpart;
    DI void operator()(const pg8::f32x4 (&acc)[2][2][4][2], const pg8::Unit& u, int wr, int wc, int fr, int fq) const {
        const int pn = u.pn;
        const int kind = (pn < 2) ? 1 : (pn < 4) ? 2 : (pn < 6) ? 0 : (pn < 8) ? 3 : (pn < 10) ? 4 : 0;
        const float scale = (kind == 1 || kind == 3) ? SC_64 : 1.f;
        const int colbase = pn * 256 + wc * 64 + 8 * fq;
        float wa[8], wb[8];
#pragma unroll
        for (int e = 0; e < 8; ++e) {
            const int d = 8 * fq + e;
            const float a1 = w_dq[d], a2 = w_dk[d], a3 = w_mq[d], a4 = w_mk[d], b1 = w_dq[32 + d], b2 = w_dk[32 + d], b3 = w_mq[32 + d], b4 = w_mk[32 + d];
            wa[e] = ((kind == 1) ? a1 : (kind == 2) ? a2 : (kind == 3) ? a3 : a4) * scale;
            wb[e] = ((kind == 1) ? b1 : (kind == 2) ? b2 : (kind == 3) ? b3 : b4) * scale;
        }
#pragma unroll
        for (int ai = 0; ai < 2; ++ai) {
            float ks1[8], ks2[8];
#pragma unroll
            for (int e = 0; e < 8; ++e) { ks1[e] = 0.f; ks2[e] = 0.f; }
#pragma unroll
            for (int m = 0; m < 4; ++m) {
                const int row = u.pm * 256 + ai * 128 + wr * 64 + m * 16 + fr;
                float x1[8], x2[8];
#pragma unroll
                for (int e = 0; e < 8; ++e) { x1[e] = acc[ai][0][m][e >> 2][e & 3]; x2[e] = acc[ai][1][m][e >> 2][e & 3]; }
                if (kind) {
                    float ss = 0.f;
#pragma unroll
                    for (int e = 0; e < 8; ++e) ss += x1[e] * x1[e] + x2[e] * x2[e];
                    ss += __shfl_xor(ss, 16); ss += __shfl_xor(ss, 32);
                    const float r = rsqrtf(ss * (1.f / 64.f) + EPS);
                    const float4* cp = (const float4*)(rope + (size_t)row * 32 + 8 * fq);
#pragma unroll
                    for (int e2 = 0; e2 < 4; ++e2) {
                        const float4 cs = cp[e2];
                        {   const int e = 2 * e2; const float y1 = x1[e] * r * wa[e], y2 = x2[e] * r * wb[e];
                            x1[e] = y1 * cs.x - y2 * cs.y; x2[e] = y2 * cs.x + y1 * cs.y; }
                        {   const int e = 2 * e2 + 1; const float y1 = x1[e] * r * wa[e], y2 = x2[e] * r * wb[e];
                            x1[e] = y1 * cs.z - y2 * cs.w; x2[e] = y2 * cs.z + y1 * cs.w; }
                    }
                    if (kind == 4) {
#pragma unroll
                        for (int e = 0; e < 8; ++e) { ks1[e] += x1[e]; ks2[e] += x2[e]; }
                    }
                }
                bfu* rowp = O + (size_t)row * 3072 + colbase;
                *(u32x4*)rowp = (u32x4){pk2(x1[0], x1[1]), pk2(x1[2], x1[3]), pk2(x1[4], x1[5]), pk2(x1[6], x1[7])};
                *(u32x4*)(rowp + 32) = (u32x4){pk2(x2[0], x2[1]), pk2(x2[2], x2[3]), pk2(x2[4], x2[5]), pk2(x2[6], x2[7])};
            }
            if (kind == 4) {
#pragma unroll
                for (int e = 0; e < 8; ++e) {
                    float a = ks1[e], b = ks2[e];
                    a += __shfl_xor(a, 1); a += __shfl_xor(a, 2); a += __shfl_xor(a, 4); a += __shfl_xor(a, 8);
                    b += __shfl_xor(b, 1); b += __shfl_xor(b, 2); b += __shfl_xor(b, 4); b += __shfl_xor(b, 8);
                    ks1[e] = a; ks2[e] = b;
                }
                if (fr == 0) {
                    float* kp = kpart + (size_t)(4 * u.pm + 2 * ai + wr) * 512 + ((pn - 8) * 4 + wc) * 64 + 8 * fq;
#pragma unroll
                    for (int e = 0; e < 8; ++e) { kp[e] = ks1[e]; kp[32 + e] = ks2[e]; }
                }
            }
        }
    }
};
DI void phase_gemm_heads(const Params& p, const bfu* A, const bfu* Bt, bfu* O, char* smem) {
    pg8::Gemm g; g.A = A; g.Bt = Bt; g.lda = 1024; g.K = 1024;
    XcdOrder S; S.ntn = 12; S.nwt = 4; S.nsn = 3;
    EpiHeads E; E.O = O; E.rope = (const float2*)(p.ws + OFF_ROPE64); E.w_dq = p.diff_qn; E.w_dk = p.diff_kn; E.w_mq = p.moba_qn; E.w_mk = p.moba_kn;
    E.kpart = (float*)(p.ws + OFF_KPART);
    __syncthreads();
    pg8::gemm_phase<EpiHeads, XcdOrder, false>((PG8_LAS unsigned char*)smem, g, S, E, nullptr);
    __syncthreads();
}

#ifndef MK_PROBE
#define MK_PROBE 0
#endif
#if MK_PROBE
template <int VAR>
DI void gemm_probe(const bfu* __restrict__ A, int lda, const bfu* __restrict__ Bt, int K, int m0, int n0, float* sinkp, int sink, char* smem) {
    constexpr int STG = 512 * 72;
    bfu* S0 = (bfu*)smem;
    const int tid = threadIdx.x, lane = tid & 63, wid = tid >> 6, l32 = lane & 31, hi = lane >> 5;
    const int wm = wid & 3, wn = wid >> 2;
    f32x16 acc[4][2];
#pragma unroll
    for (int nb = 0; nb < 4; ++nb)
#pragma unroll
        for (int mb = 0; mb < 2; ++mb)
#pragma unroll
            for (int r = 0; r < 16; ++r) acc[nb][mb][r] = 0.f;
    const bfu* Ag = A + (size_t)(m0 + (tid >> 3)) * lda + (tid & 7) * 8;
    const bfu* Bg = Bt + (size_t)(n0 + (tid >> 3)) * K + (tid & 7) * 8;
    u32x4 ra[4], rb[4];
#pragma unroll
    for (int i = 0; i < 4; ++i) { ra[i] = *(const u32x4*)(Ag + (size_t)(64 * i) * lda); rb[i] = *(const u32x4*)(Bg + (size_t)(64 * i) * K); }
    const int nk = K >> 6;
    const int wofs = (tid >> 3) * 72 + (tid & 7) * 8;
    const int arofs = (wm * 64 + l32) * 72 + hi * 8, brofs = 256 * 72 + (wn * 128 + l32) * 72 + hi * 8;
    __syncthreads();
#pragma unroll
    for (int i = 0; i < 4; ++i) { *(u32x4*)(S0 + wofs + 64 * i * 72) = ra[i]; *(u32x4*)(S0 + 256 * 72 + wofs + 64 * i * 72) = rb[i]; }
    __syncthreads();
#pragma unroll 1
    for (int kt = 0; kt < nk; ++kt) {
        const bfu* Sc = S0 + (kt & 1) * STG; bfu* Sn = S0 + ((kt & 1) ^ 1) * STG;
        if (VAR != 2 && kt + 1 < nk) {
#pragma unroll
            for (int i = 0; i < 4; ++i) { *(u32x4*)(Sn + wofs + 64 * i * 72) = ra[i]; *(u32x4*)(Sn + 256 * 72 + wofs + 64 * i * 72) = rb[i]; }
        }
        __builtin_amdgcn_sched_barrier(0);
        if (VAR != 1 && VAR != 2 && kt + 2 < nk) {
            const int ko = (kt + 2) * 64;
#pragma unroll
            for (int i = 0; i < 4; ++i) { ra[i] = *(const u32x4*)(Ag + (size_t)(64 * i) * lda + ko); rb[i] = *(const u32x4*)(Bg + (size_t)(64 * i) * K + ko); }
        }
        __builtin_amdgcn_sched_barrier(0);
        if (VAR == 3) {
            bf16x8 af[2], bfr[4];
#pragma unroll
            for (int mb = 0; mb < 2; ++mb) af[mb] = *(const bf16x8*)(Sc + arofs + mb * 32 * 72);
#pragma unroll
            for (int nb = 0; nb < 4; ++nb) bfr[nb] = *(const bf16x8*)(Sc + brofs + nb * 32 * 72);
#pragma unroll
            for (int k16 = 0; k16 < 4; ++k16)
#pragma unroll
                for (int nb = 0; nb < 4; ++nb)
#pragma unroll
                    for (int mb = 0; mb < 2; ++mb) acc[nb][mb] = MFMA(bfr[nb], af[mb], acc[nb][mb]);
        } else {
#pragma unroll
            for (int k16 = 0; k16 < 4; ++k16) {
                bf16x8 af[2], bfr[4];
#pragma unroll
                for (int mb = 0; mb < 2; ++mb) af[mb] = *(const bf16x8*)(Sc + arofs + mb * 32 * 72 + k16 * 16);
#pragma unroll
                for (int nb = 0; nb < 4; ++nb) bfr[nb] = *(const bf16x8*)(Sc + brofs + nb * 32 * 72 + k16 * 16);
#pragma unroll
                for (int nb = 0; nb < 4; ++nb)
#pragma unroll
                    for (int mb = 0; mb < 2; ++mb) acc[nb][mb] = MFMA(bfr[nb], af[mb], acc[nb][mb]);
            }
        }
        __syncthreads();
    }
    if (sink) {
#pragma unroll
        for (int nb = 0; nb < 4; ++nb)
#pragma unroll
            for (int mb = 0; mb < 2; ++mb)
#pragma unroll
                for (int r = 0; r < 16; ++r) sinkp[tid * 128 + (nb * 2 + mb) * 16 + r] = acc[nb][mb][r];
    }
}
template <int VAR>
DI void phase_gemm_probe(const bfu* A, const bfu* Bt, float* sinkp, int sink, char* smem) {
    for (int r = 0; r < 6; ++r) { int mt, nt; if (gemm_map(r, 3, 4, mt, nt)) gemm_probe<VAR>(A, 1024, Bt, 1024, mt * 256, nt * 256, sinkp, sink, smem); }
}
#endif

DI void headnorm64(bfu* hp, const float* __restrict__ w, const float2* __restrict__ cs, float scale, int j, bool acc_on, f32x4& ka1, f32x4& ka2) {
    const u32x2 a = *(const u32x2*)(hp + 4 * j), b = *(const u32x2*)(hp + 32 + 4 * j);
    float x1[4] = {bflo(a[0]), bfhi(a[0]), bflo(a[1]), bfhi(a[1])}, x2[4] = {bflo(b[0]), bfhi(b[0]), bflo(b[1]), bfhi(b[1])};
    float ss = 0.f;
#pragma unroll
    for (int e = 0; e < 4; ++e) ss += x1[e] * x1[e] + x2[e] * x2[e];
    ss += __shfl_xor(ss, 1); ss += __shfl_xor(ss, 2); ss += __shfl_xor(ss, 4);
    const float r = rsqrtf(ss * (1.f / 64.f) + EPS);
    const float4 w1 = *(const float4*)(w + 4 * j), w2 = *(const float4*)(w + 32 + 4 * j);
    const float wa[4] = {w1.x, w1.y, w1.z, w1.w}, wb[4] = {w2.x, w2.y, w2.z, w2.w};
    float o1[4], o2[4];
#pragma unroll
    for (int e = 0; e < 4; ++e) {
        const float y1 = x1[e] * r * wa[e], y2 = x2[e] * r * wb[e]; const float2 c = cs[4 * j + e];
        o1[e] = y1 * c.x - y2 * c.y; o2[e] = y2 * c.x + y1 * c.y;
    }
    if (acc_on) {
#pragma unroll
        for (int e = 0; e < 4; ++e) { ka1[e] += o1[e]; ka2[e] += o2[e]; }
    }
    *(u32x2*)(hp + 4 * j) = (u32x2){pk2(o1[0] * scale, o1[1] * scale), pk2(o1[2] * scale, o1[3] * scale)};
    *(u32x2*)(hp + 32 + 4 * j) = (u32x2){pk2(o2[0] * scale, o2[1] * scale), pk2(o2[2] * scale, o2[3] * scale)};
}

DI float sq4(u32x2 a) { const float x0 = bflo(a[0]), x1 = bfhi(a[0]), x2 = bflo(a[1]), x3 = bfhi(a[1]); return x0 * x0 + x1 * x1 + x2 * x2 + x3 * x3; }

DI void mla_head(u32x4 nv, unsigned x1, unsigned x2, float rn, float rr, const float* __restrict__ wn, int j, float2 csA, float2 csB, float scale, bfu* dst) {
    float f[8] = {bflo(nv[0]) * rn, bfhi(nv[0]) * rn, bflo(nv[1]) * rn, bfhi(nv[1]) * rn, bflo(nv[2]) * rn, bfhi(nv[2]) * rn, bflo(nv[3]) * rn, bfhi(nv[3]) * rn};
    const float a0 = bflo(x1) * rr, a1 = bfhi(x1) * rr, b0 = bflo(x2) * rr, b1 = bfhi(x2) * rr;
    float ss = a0 * a0 + a1 * a1 + b0 * b0 + b1 * b1;
#pragma unroll
    for (int e = 0; e < 8; ++e) ss += f[e] * f[e];
    ss += __shfl_xor(ss, 1); ss += __shfl_xor(ss, 2); ss += __shfl_xor(ss, 4);
    const float r = rsqrtf(ss * (1.f / 96.f) + EPS) * scale;
    const float4 wA = *(const float4*)(wn + 8 * j), wB = *(const float4*)(wn + 8 * j + 4);
    const float wv[8] = {wA.x, wA.y, wA.z, wA.w, wB.x, wB.y, wB.z, wB.w};
#pragma unroll
    for (int e = 0; e < 8; ++e) f[e] *= r * wv[e];
    *(u32x4*)(dst + 8 * j) = (u32x4){pk2(f[0], f[1]), pk2(f[2], f[3]), pk2(f[4], f[5]), pk2(f[6], f[7])};
    const float y10 = a0 * r * wn[64 + 2 * j], y11 = a1 * r * wn[65 + 2 * j], y20 = b0 * r * wn[80 + 2 * j], y21 = b1 * r * wn[81 + 2 * j];
    *(unsigned*)(dst + 64 + 2 * j) = pk2(y10 * csA.x - y20 * csA.y, y11 * csB.x - y21 * csB.y);
    *(unsigned*)(dst + 80 + 2 * j) = pk2(y20 * csA.x + y10 * csA.y, y21 * csB.x + y11 * csB.y);
}

DI void phase_post_even(const Params& p) {
    char* ws = p.ws;
    bfu* ubuf = (bfu*)(ws + OFF_UBUF); const bfu* qraw = (const bfu*)(ws + OFF_HBUF); const bfu* kvraw = (const bfu*)(ws + OFF_OBUF);
    bfu* Qa = (bfu*)p.out; bfu* Ka = Qa + (size_t)T * 768; bfu* Va = Ka + (size_t)T * 768;
    const float2* r64 = (const float2*)(ws + OFF_ROPE64); const float2* r32 = (const float2*)(ws + OFF_ROPE32);
    const int lane = threadIdx.x & 63, gw = blockIdx.x * NW + (threadIdx.x >> 6), nwv = gridDim.x * NW;
    const int h = lane >> 3, j = lane & 7;
    for (int t = gw; t < T; t += nwv) {
        bfu* ur = ubuf + (size_t)t * 3072;
        float ssq = sq4(*(const u32x2*)(ur + lane * 4));
        if (lane < 32) ssq += sq4(*(const u32x2*)(ur + 256 + lane * 4));
        float sskv = sq4(*(const u32x2*)(ur + 384 + lane * 4));
        ssq = wave_sum(ssq); sskv = wave_sum(sskv);
        const float rq = rsqrtf(ssq * (1.f / 384.f) + EPS), rkv = rsqrtf(sskv * (1.f / 256.f) + EPS);
        const float2 csA = r32[(size_t)t * 16 + 2 * j], csB = r32[(size_t)t * 16 + 2 * j + 1];
        {
            const bfu* qr = qraw + (size_t)t * 768 + h * 96;
            mla_head(*(const u32x4*)(qr + 8 * j), *(const unsigned*)(qr + 64 + 2 * j), *(const unsigned*)(qr + 80 + 2 * j), rq, rq, p.mla_qn, j, csA, csB, SC_MLA, Qa + (size_t)t * 768 + h * 96);
        }
        {
            const bfu* kr = kvraw + (size_t)t * 1024 + h * 128;
            mla_head(*(const u32x4*)(kr + 8 * j), *(const unsigned*)(ur + 640 + 2 * j), *(const unsigned*)(ur + 656 + 2 * j), rkv, 1.f, p.mla_kn, j, csA, csB, 1.f, Ka + (size_t)t * 768 + h * 96);
            const u32x4 vv = *(const u32x4*)(kr + 64 + 8 * j);
            *(u32x4*)(Va + (size_t)t * 512 + h * 64 + 8 * j) = (u32x4){pk2(bflo(vv[0]) * rkv, bfhi(vv[0]) * rkv), pk2(bflo(vv[1]) * rkv, bfhi(vv[1]) * rkv),
                                                                      pk2(bflo(vv[2]) * rkv, bfhi(vv[2]) * rkv), pk2(bflo(vv[3]) * rkv, bfhi(vv[3]) * rkv)};
        }
        f32x4 d1, d2;
#pragma unroll
        for (int rd = 0; rd < 3; ++rd) {
            const int hh = rd * 8 + h, which = hh / 12, gh = hh % 12;
            headnorm64(ur + 672 + which * 768 + gh * 64, which ? p.dil_kn : p.dil_qn, r64 + (size_t)t * 32, which ? 1.f : SC_64, j, false, d1, d2);
        }
    }
}

DI void phase_post_odd(const Params& p, char* smem) {
    char* ws = p.ws;
    bfu* ubuf = (bfu*)(ws + OFF_UBUF); const float2* r64 = (const float2*)(ws + OFF_ROPE64); float* kpart = (float*)(ws + OFF_KPART);
    const int tid = threadIdx.x, lane = tid & 63, wid = tid >> 6, h = lane >> 3, j = lane & 7;
    float* red = (float*)smem;
    for (int it = blockIdx.x; it < T / 64; it += gridDim.x) {
        f32x4 ka1 = {0.f, 0.f, 0.f, 0.f}, ka2 = {0.f, 0.f, 0.f, 0.f}, d1, d2;
        for (int tt = 0; tt < 8; ++tt) {
            const int t = it * 64 + wid * 8 + tt;
            bfu* ur = ubuf + (size_t)t * 3072; const float2* cs = r64 + (size_t)t * 32;
            headnorm64(ur + h * 64, p.diff_qn, cs, SC_64, j, false, d1, d2);
            headnorm64(ur + 512 + h * 64, p.diff_kn, cs, 1.f, j, false, d1, d2);
            headnorm64(ur + 1536 + h * 64, p.moba_qn, cs, SC_64, j, false, d1, d2);
            headnorm64(ur + 2048 + h * 64, p.moba_kn, cs, 1.f, j, true, ka1, ka2);
        }
        __syncthreads();
#pragma unroll
        for (int e = 0; e < 4; ++e) { red[(wid * 64 + lane) * 8 + e] = ka1[e]; red[(wid * 64 + lane) * 8 + 4 + e] = ka2[e]; }
        __syncthreads();
        {
            const int o = tid, hh = o >> 6, d = o & 63, jj = (d & 31) >> 2, e = (d & 3) + ((d >> 5) << 2), ln = hh * 8 + jj;
            float sum = 0.f;
#pragma unroll
            for (int w = 0; w < NW; ++w) sum += red[(w * 64 + ln) * 8 + e];
            kpart[(size_t)it * 512 + o] = sum;
        }
    }
    __syncthreads();
}

DI void phase_dil_merge(const Params& p) {
    const bfu* dil_o = (const bfu*)(p.ws + OFF_HBUF); const float* dil_lse = (const float*)(p.ws + OFF_HBUF + 48 * MiB);
    bfu* obuf = (bfu*)(p.ws + OFF_OBUF);
    for (int idx = blockIdx.x * NT + threadIdx.x; idx < T * 64; idx += gridDim.x * NT) {
        const int t = idx >> 6, r = idx & 63, h = r >> 4, jj = r & 15;
        const float l0 = dil_lse[(size_t)t * 12 + h], l1 = dil_lse[(size_t)t * 12 + 4 + h], l2 = dil_lse[(size_t)t * 12 + 8 + h];
        const float mx = fmaxf(l0, fmaxf(l1, l2));
        float w0 = exp2f(l0 - mx), w1 = exp2f(l1 - mx), w2 = exp2f(l2 - mx); const float inv = 1.f / (w0 + w1 + w2); w0 *= inv; w1 *= inv; w2 *= inv;
        const u32x2 a = *(const u32x2*)(dil_o + (size_t)t * 768 + h * 64 + 4 * jj), b = *(const u32x2*)(dil_o + (size_t)t * 768 + (4 + h) * 64 + 4 * jj),
                    c = *(const u32x2*)(dil_o + (size_t)t * 768 + (8 + h) * 64 + 4 * jj);
        const float o0 = w0 * bflo(a[0]) + w1 * bflo(b[0]) + w2 * bflo(c[0]), o1 = w0 * bfhi(a[0]) + w1 * bfhi(b[0]) + w2 * bfhi(c[0]);
        const float o2 = w0 * bflo(a[1]) + w1 * bflo(b[1]) + w2 * bflo(c[1]), o3 = w0 * bfhi(a[1]) + w1 * bfhi(b[1]) + w2 * bfhi(c[1]);
        *(u32x2*)(obuf + (size_t)t * 768 + 512 + h * 64 + 4 * jj) = (u32x2){pk2(o0, o1), pk2(o2, o3)};
    }
}

DI void phase_diff_combine(const Params& p) {
    const bfu* dbuf = (const bfu*)(p.ws + OFF_DBUF); bfu* obuf = (bfu*)(p.ws + OFF_OBUF);
    const int lane = threadIdx.x & 63, gw = blockIdx.x * NW + (threadIdx.x >> 6), nwv = gridDim.x * NW;
    float lam;
    {
        const float sa = wave_sum(p.diff_lam[lane] * p.diff_lam[64 + lane]), sb = wave_sum(p.diff_lam[128 + lane] * p.diff_lam[192 + lane]);
        lam = expf(sa) - expf(sb) + LAM_INIT;
    }
    const int h = lane >> 4, jj = lane & 15;
    const float4 sA = *(const float4*)(p.diff_subln + 8 * jj), sB = *(const float4*)(p.diff_subln + 8 * jj + 4);
    const float sw[8] = {sA.x, sA.y, sA.z, sA.w, sB.x, sB.y, sB.z, sB.w};
    for (int t = gw; t < T; t += nwv) {
        const u32x4 a = *(const u32x4*)(dbuf + (size_t)t * 1024 + (2 * h) * 128 + 8 * jj), b = *(const u32x4*)(dbuf + (size_t)t * 1024 + (2 * h + 1) * 128 + 8 * jj);
        float d[8];
#pragma unroll
        for (int e = 0; e < 4; ++e) { d[2 * e] = bflo(a[e]) - lam * bflo(b[e]); d[2 * e + 1] = bfhi(a[e]) - lam * bfhi(b[e]); }
        float ss = 0.f;
#pragma unroll
        for (int e = 0; e < 8; ++e) ss += d[e] * d[e];
        ss += __shfl_xor(ss, 1); ss += __shfl_xor(ss, 2); ss += __shfl_xor(ss, 4); ss += __shfl_xor(ss, 8);
        const float r = rsqrtf(ss * (1.f / 128.f) + EPS) * (1.f - LAM_INIT);
#pragma unroll
        for (int e = 0; e < 8; ++e) d[e] *= r * sw[e];
        *(u32x4*)(obuf + (size_t)t * 1024 + h * 128 + 8 * jj) = (u32x4){pk2(d[0], d[1]), pk2(d[2], d[3]), pk2(d[4], d[5]), pk2(d[6], d[7])};
    }
    {
        const bfu* po01 = (const bfu*)(p.ws + OFF_HBUF); const bfu* po2 = (const bfu*)(p.ws + OFF_PO2); const float* plse = (const float*)(p.ws + OFF_PLSE);
        const int hm = lane >> 3, j8 = (lane & 7) * 8;
        for (int t = gw; t < T; t += nwv) {
            const float4 ls = *(const float4*)(plse + ((size_t)t * 8 + hm) * 4);
            const float mx = fmaxf(fmaxf(ls.x, ls.y), fmaxf(ls.z, ls.w));
            float w0 = exp2f(ls.x - mx), w1 = exp2f(ls.y - mx), w2 = exp2f(ls.z - mx), w3 = exp2f(ls.w - mx);
            const float inv = 1.f / (w0 + w1 + w2 + w3); w0 *= inv; w1 *= inv; w2 *= inv; w3 *= inv;
            bfu* dst = obuf + (size_t)t * 1024 + 512 + hm * 64 + j8;
            const u32x4 z = {0u, 0u, 0u, 0u};
            const u32x4 a0 = (w0 > 0.f) ? *(const u32x4*)(po01 + (size_t)t * 512 + hm * 64 + j8) : z;
            const u32x4 a1 = (w1 > 0.f) ? *(const u32x4*)(po01 + (size_t)T * 512 + (size_t)t * 512 + hm * 64 + j8) : z;
            const u32x4 a2 = (w2 > 0.f) ? *(const u32x4*)(po2 + (size_t)t * 512 + hm * 64 + j8) : z;
            const u32x4 a3 = *(const u32x4*)dst;
            unsigned r[4];
#pragma unroll
            for (int e = 0; e < 4; ++e) {
                const float lo = w0 * bflo(a0[e]) + w1 * bflo(a1[e]) + w2 * bflo(a2[e]) + w3 * bflo(a3[e]);
                const float hi = w0 * bfhi(a0[e]) + w1 * bfhi(a1[e]) + w2 * bfhi(a2[e]) + w3 * bfhi(a3[e]);
                r[e] = pk2(lo, hi);
            }
            *(u32x4*)dst = (u32x4){r[0], r[1], r[2], r[3]};
        }
    }
}

struct Top3 { float v0, v1, v2; int i0, i1, i2; };
DI Top3 top3_ins(Top3 t, float v, int i) {
    const bool g0 = (v > t.v0) || (v == t.v0 && i < t.i0), g1 = (v > t.v1) || (v == t.v1 && i < t.i1), g2 = (v > t.v2) || (v == t.v2 && i < t.i2);
    Top3 r;
    r.v2 = g1 ? t.v1 : (g2 ? v : t.v2); r.i2 = g1 ? t.i1 : (g2 ? i : t.i2);
    r.v1 = g0 ? t.v0 : (g1 ? v : t.v1); r.i1 = g0 ? t.i0 : (g1 ? i : t.i1);
    r.v0 = g0 ? v : t.v0; r.i0 = g0 ? i : t.i0;
    return r;
}

struct MobaG {
    const int* cnt; const unsigned short* seg; int chunk, jblk, tokbase, h; bfu *po01, *po2; float* plse;
};
template <int DK, int DV, int MODE>
DI void attn_item(const bfu* __restrict__ Qp, int qp, const bfu* __restrict__ Kp, int kp, const bfu* __restrict__ Vp, int vp,
                  long rowbase, int rs, int q0, bfu* __restrict__ Op, int op, float* __restrict__ lsep, int lsest,
                  const float* __restrict__ kpart, char* smem, int jfirst = 0, const MobaG* mg = nullptr) {
    constexpr int KPT = DK + 8, KCH = DK / 8, VCH = DV / 8, NKL = (64 * KCH + NT - 1) / NT, NVL = 64 * VCH / NT, NDV = DV / 32, ND0 = DK / 16;
    constexpr int KST = 64 * KPT, VST = 64 * DV;
    bfu* Ks = (bfu*)smem; bfu* Vs = Ks + 3 * KST;
    short* tlist = (short*)(Vs + 3 * VST);
    int* misc = (int*)(tlist + 192);
    float* km = (float*)(misc + 4);
    unsigned* selm = (unsigned*)(km + 2048);
    float* cand = (float*)(selm + 256);
    const int tid = threadIdx.x, lane = tid & 63, wid = tid >> 6, l32 = lane & 31, hi = lane >> 5;
    const int qw = q0 + wid * 32, qstep = qw + l32;
    unsigned mysel = 0;
    bool g_active = true; size_t g_tok = 0; int g_slot = 0, g_total = 0;
    if (MODE == 3) {
        int* pre = (int*)km;
        if (tid < 32) pre[64 + tid] = mg->cnt[tid];
        __syncthreads();
        if (tid == 0) { int a = 0; for (int n = 0; n < 32; ++n) { pre[n] = a; a += (n > mg->jblk) ? pre[64 + n] : 0; } pre[32] = a; }
        __syncthreads();
        g_total = pre[32];
        const int pp = mg->chunk * 256 + wid * 32 + l32;
        g_active = pp < g_total;
        int n = 31;
        for (int c = 31; c >= 1; --c) if (pp < pre[c]) n = c - 1;
        const unsigned short e = g_active ? mg->seg[(size_t)n * 256 + (pp - pre[n])] : (unsigned short)0;
        g_slot = e >> 8;
        g_tok = (size_t)mg->tokbase + (g_active ? (size_t)(n * 256 + (e & 255)) : 0);
    }
    if (MODE == 2) {
        const int nb = q0 >> 8;
        for (int idx = tid; idx < nb * 64; idx += NT) {
            const int blk = idx >> 6, d = idx & 63; const float* kq = kpart + (size_t)(blk * 4) * 512 + d;
            km[idx] = (kq[0] + kq[512] + kq[1024] + kq[1536]) * (1.f / 256.f);
        }
        if (tid == 0) misc[1] = 0;
        __syncthreads();
        {
            const int qq = tid & 255, hf = tid >> 8;
            const bfu* qr = Qp + (size_t)(rowbase + q0 + qq) * qp;
            float qv[64];
#pragma unroll
            for (int c8 = 0; c8 < 8; ++c8) {
                const u32x4 w = *(const u32x4*)(qr + c8 * 8);
#pragma unroll
                for (int e = 0; e < 4; ++e) { qv[c8 * 8 + 2 * e] = bflo(w[e]); qv[c8 * 8 + 2 * e + 1] = bfhi(w[e]); }
            }
            Top3 tp; tp.v0 = -3e38f; tp.v1 = -3e38f; tp.v2 = -3e38f; tp.i0 = 64; tp.i1 = 64; tp.i2 = 64;
            for (int blk = hf; blk < nb; blk += 2) {
                float g = 0.f;
#pragma unroll
                for (int d = 0; d < 64; ++d) g += qv[d] * km[blk * 64 + d];
                tp = top3_ins(tp, g, blk);
            }
            cand[tid * 6 + 0] = tp.v0; cand[tid * 6 + 1] = tp.v1; cand[tid * 6 + 2] = tp.v2;
            cand[tid * 6 + 3] = __int_as_float(tp.i0); cand[tid * 6 + 4] = __int_as_float(tp.i1); cand[tid * 6 + 5] = __int_as_float(tp.i2);
        }
        __syncthreads();
        if (tid < 256) {
            Top3 tp; tp.v0 = cand[tid * 6]; tp.v1 = cand[tid * 6 + 1]; tp.v2 = cand[tid * 6 + 2];
            tp.i0 = __float_as_int(cand[tid * 6 + 3]); tp.i1 = __float_as_int(cand[tid * 6 + 4]); tp.i2 = __float_as_int(cand[tid * 6 + 5]);
            const int o = (tid + 256) * 6;
#pragma unroll
            for (int e = 0; e < 3; ++e) { const int ii = __float_as_int(cand[o + 3 + e]); tp = top3_ins(tp, cand[o + e], ii); }
            unsigned mk = 0;
            if (tp.i0 < 32) mk |= 1u << tp.i0;
            if (tp.i1 < 32) mk |= 1u << tp.i1;
            if (tp.i2 < 32) mk |= 1u << tp.i2;
            selm[tid] = mk;
            atomicOr((unsigned*)&misc[1], mk);
        }
        __syncthreads();
        mysel = selm[wid * 32 + l32];
    }
    int jbase = 0, nt;
    if (MODE == 0) { jbase = jfirst; nt = (q0 >> 6) + 4 - jfirst; }
    else if (MODE == 1) { jbase = (q0 >> 6) >= 2 ? (q0 >> 6) - 2 : 0; nt = (q0 >> 6) + 4 - jbase; }
    else if (MODE == 3) { jbase = mg->jblk * 4; nt = 4; }
    else {
        if (tid == 0) {
            const unsigned om = (unsigned)misc[1]; const int nb = q0 >> 8; int n = 0;
            for (int blk = 0; blk < nb; ++blk) if ((om >> blk) & 1u) { tlist[n++] = (short)(blk * 4); tlist[n++] = (short)(blk * 4 + 1); tlist[n++] = (short)(blk * 4 + 2); tlist[n++] = (short)(blk * 4 + 3); }
            for (int jx = nb * 4; jx <= nb * 4 + 3; ++jx) tlist[n++] = (short)jx;
            misc[0] = n;
        }
        __syncthreads();
        nt = misc[0];
    }
#define ATT_TILE(I) ((MODE == 2) ? (int)tlist[(I)] : jbase + (I))
    bf16x8 qf[ND0];
    {
        const bfu* qr = Qp + ((MODE == 3) ? g_tok : (size_t)(rowbase + (long)qstep * rs)) * qp + hi * 8;
#pragma unroll
        for (int d0 = 0; d0 < ND0; ++d0) qf[d0] = *(const bf16x8*)(qr + d0 * 16);
    }
    float m = 0.f, l = 0.f; bool anym = false;
    f32x16 o[NDV];
#pragma unroll
    for (int dvb = 0; dvb < NDV; ++dvb)
#pragma unroll
        for (int r = 0; r < 16; ++r) o[dvb][r] = 0.f;
    int krow[NKL], kch[NKL], vrow[NVL], vch[NVL];
#pragma unroll
    for (int i = 0; i < NKL; ++i) { const int id = tid + NT * i; krow[i] = id / KCH; kch[i] = id % KCH; }
#pragma unroll
    for (int i = 0; i < NVL; ++i) { const int id = tid + NT * i; vrow[i] = id / VCH; vch[i] = id % VCH; }
    u32x4 rk[NKL], rv[NVL];
#define ATT_LOAD(JJ) do { const int j_ = __builtin_amdgcn_readfirstlane((int)(JJ)); \
    _Pragma("unroll") for (int i = 0; i < NKL; ++i) if (NT * (i + 1) <= 64 * KCH || tid + NT * i < 64 * KCH) rk[i] = *(const u32x4*)(Kp + (size_t)(rowbase + (long)(j_ * 64 + krow[i]) * rs) * kp + kch[i] * 8); \
    _Pragma("unroll") for (int i = 0; i < NVL; ++i) rv[i] = *(const u32x4*)(Vp + (size_t)(rowbase + (long)(j_ * 64 + vrow[i]) * rs) * vp + vch[i] * 8); } while (0)
#define ATT_STORE(ST) do { bfu* ks_ = Ks + (ST) * KST; bfu* vs_ = Vs + (ST) * VST; \
    _Pragma("unroll") for (int i = 0; i < NKL; ++i) if (NT * (i + 1) <= 64 * KCH || tid + NT * i < 64 * KCH) *(u32x4*)(ks_ + krow[i] * KPT + kch[i] * 8) = rk[i]; \
    _Pragma("unroll") for (int i = 0; i < NVL; ++i) *(u32x4*)(vs_ + (vch[i] >> 2) * 2048 + vrow[i] * 32 + (vch[i] & 3) * 8) = rv[i]; } while (0)
    ATT_LOAD(ATT_TILE(0));
    ATT_STORE(0);
    if (nt > 1) ATT_LOAD(ATT_TILE(1));
    __syncthreads();
    const lds_cptr vb0 = (lds_cptr)Vs + ((lane >> 4) & 1) * 32 + (lane & 3) * 8 + (4 * hi + ((lane & 15) >> 2)) * 64;
    const bfu* ksr0 = Ks + l32 * KPT + hi * 8;
    constexpr int NQK = 2 * ND0, NPV = 4 * NDV, OPA = 48 / NQK, EXB = 32 / NPV;
    static_assert(48 % NQK == 0 && 32 % NPV == 0, "filler split");
    f32x16 pA0, pA1;
    u32x4 pw[4];
    bool pend = false; int pstage = 0;
#define ATT_SLOW() do { if (__builtin_expect(anym || __any(ps > 1e12f), 0)) { \
        float mxp = fmaxf(pA0[0], pA1[0]); \
        _Pragma("unroll") for (int r = 1; r < 16; ++r) mxp = fmaxf(mxp, fmaxf(pA0[r], pA1[r])); \
        mxp = fmaxf(mxp, __shfl_xor(mxp, 32)); \
        const float e_ = (mxp > 0.f) ? (__builtin_amdgcn_logf(mxp) - m) : -1e30f; \
        const float delta = (e_ > 24.f) ? floorf(e_) : 0.f; \
        m += delta; \
        const float alpha = __builtin_amdgcn_exp2f(-delta), sc = __builtin_amdgcn_exp2f(-m); \
        l *= alpha; \
        _Pragma("unroll") for (int dvb = 0; dvb < NDV; ++dvb) _Pragma("unroll") for (int r = 0; r < 16; ++r) o[dvb][r] *= alpha; \
        ps = 0.f; \
        _Pragma("unroll") for (int r = 0; r < 16; ++r) { pA0[r] *= sc; pA1[r] *= sc; ps += pA0[r] + pA1[r]; } \
        _Pragma("unroll") for (int q = 0; q < 16; ++q) pw[q >> 2][q & 3] = (q < 8) ? pk2(pA0[2 * q], pA0[2 * q + 1]) : pk2(pA1[2 * q - 16], pA1[2 * q - 15]); \
        anym = anym || (__any(m != 0.f) != 0); } } while (0)
#define ATT_VFRAG(STG, G) ({ const lds_cptr vb_ = vb0 + (STG) * (VST * 2) + ((G) % NDV) * 4096 + ((G) / NDV) * 1024; \
        const s16x4 lo_ = vtr(vb_), hh_ = vtr(vb_ + 512); (bf16x8){lo_[0], lo_[1], lo_[2], lo_[3], hh_[0], hh_[1], hh_[2], hh_[3]}; })
#define ATT_FLUSH() do { float ps = 0.f; \
        _Pragma("unroll") for (int r = 0; r < 16; ++r) ps += pA0[r] + pA1[r]; \
        _Pragma("unroll") for (int q = 0; q < 16; ++q) pw[q >> 2][q & 3] = (q < 8) ? pk2(pA0[2 * q], pA0[2 * q + 1]) : pk2(pA1[2 * q - 16], pA1[2 * q - 15]); \
        ATT_SLOW(); l += ps; \
        _Pragma("unroll") for (int g = 0; g < NPV; ++g) { const bf16x8 vf_ = ATT_VFRAG(pstage, g); o[g % NDV] = MFMA(vf_, __builtin_bit_cast(bf16x8, pw[g / NDV]), o[g % NDV]); } \
        pend = false; } while (0)
    int cur = 0;
    for (int it = 0; it < nt; ++it) {
        const int nxt = (cur == 2) ? 0 : cur + 1;
        const int jc = __builtin_amdgcn_readfirstlane(ATT_TILE(it));
        if (it + 1 < nt) ATT_STORE(nxt);
        if (it + 2 < nt) ATT_LOAD(ATT_TILE(it + 2));
        __builtin_amdgcn_sched_barrier(0);
        bool need;
        if (MODE == 1) need = (jc * 64 <= qw + 31) && (jc * 64 + 63 >= qw - 128);
        else if (MODE == 3) need = (mg->chunk * 256 + wid * 32 < g_total);
        else {
            need = (jc * 64 <= qw + 31);
            if (MODE == 2) { const int blk = jc >> 2; if (blk < (q0 >> 8)) need = __any((mysel >> blk) & 1u) != 0; }
        }
        if (need) {
            const bfu* ksr = ksr0 + cur * KST;
            f32x16 s0, s1;
#pragma unroll
            for (int r = 0; r < 16; ++r) { s0[r] = 0.f; s1[r] = 0.f; }
            bf16x8 kf0[ND0], kf1[ND0];
#pragma unroll
            for (int d0 = 0; d0 < ND0; ++d0) { kf0[d0] = *(const bf16x8*)(ksr + d0 * 16); kf1[d0] = *(const bf16x8*)(ksr + 32 * KPT + d0 * 16); }
            __builtin_amdgcn_sched_barrier(0);
            if (pend) {
                float ps = 0.f;
#pragma unroll
                for (int g = 0; g < NQK; ++g) {
                    if (g & 1) s1 = MFMA(kf1[g >> 1], qf[g >> 1], s1); else s0 = MFMA(kf0[g >> 1], qf[g >> 1], s0);
#pragma unroll
                    for (int k = g * OPA; k < (g + 1) * OPA; ++k) {
                        if (k < 32) ps += (k < 16) ? pA0[k & 15] : pA1[k & 15];
                        else { const int q = k - 32; unsigned w_ = (q < 8) ? pk2(pA0[(2 * q) & 15], pA0[(2 * q + 1) & 15]) : pk2(pA1[(2 * q) & 15], pA1[(2 * q + 1) & 15]);
                               asm volatile("" : "+v"(w_)); pw[q >> 2][q & 3] = w_; }
                    }
                    asm volatile("" : "+v"(ps));
                    __builtin_amdgcn_sched_barrier(0);
                }
                ATT_SLOW();
                l += ps;
            } else {
#pragma unroll
                for (int d0 = 0; d0 < ND0; ++d0) { s0 = MFMA(kf0[d0], qf[d0], s0); s1 = MFMA(kf1[d0], qf[d0], s1); }
            }
            const int kbase = jc * 64 + 4 * hi;
            if (MODE == 1) {
#pragma unroll
                for (int r = 0; r < 16; ++r) {
                    const int dd = qstep - (kbase + (r & 3) + 8 * (r >> 2));
                    if (dd < 0 || dd > 128) s0[r] = -INFINITY;
                    if (dd - 32 < 0 || dd - 32 > 128) s1[r] = -INFINITY;
                }
            } else if (MODE != 3) {
                if (jc * 64 + 63 > qw) {
#pragma unroll
                    for (int r = 0; r < 16; ++r) {
                        const int ks = kbase + (r & 3) + 8 * (r >> 2);
                        if (ks > qstep) s0[r] = -INFINITY;
                        if (ks + 32 > qstep) s1[r] = -INFINITY;
                    }
                }
                if (MODE == 2) {
                    const int blk = jc >> 2;
                    if (blk < (q0 >> 8) && !((mysel >> blk) & 1u)) {
#pragma unroll
                        for (int r = 0; r < 16; ++r) { s0[r] = -INFINITY; s1[r] = -INFINITY; }
                    }
                }
            }
            if (pend) {
                asm volatile("" : "+v"(s0), "+v"(s1));
                __builtin_amdgcn_sched_barrier(0);
                bf16x8 vfc_ = ATT_VFRAG(pstage, 0), vfd_ = ATT_VFRAG(pstage, 1);
#pragma unroll
                for (int g = 0; g < NPV; ++g) {
                    const bf16x8 vfn_ = (g + 2 < NPV) ? ATT_VFRAG(pstage, (g + 2 < NPV ? g + 2 : g)) : vfd_;
                    o[g % NDV] = MFMA(vfc_, __builtin_bit_cast(bf16x8, pw[g / NDV]), o[g % NDV]);
                    vfc_ = vfd_; vfd_ = vfn_;
#pragma unroll
                    for (int k = g * EXB; k < (g + 1) * EXB; ++k) {
                        float t_ = __builtin_amdgcn_exp2f((k < 16) ? s0[k & 15] : s1[k & 15]);
                        asm volatile("" : "+v"(t_));
                        if (k < 16) s0[k & 15] = t_; else s1[k & 15] = t_;
                    }
                    __builtin_amdgcn_sched_barrier(0);
                }
            } else {
#pragma unroll
                for (int r = 0; r < 16; ++r) { s0[r] = __builtin_amdgcn_exp2f(s0[r]); s1[r] = __builtin_amdgcn_exp2f(s1[r]); }
            }
            pA0 = s0; pA1 = s1; pend = true; pstage = cur;
        } else if (pend) {
            ATT_FLUSH();
        }
        __syncthreads();
        cur = nxt;
    }
    if (pend) ATT_FLUSH();
#undef ATT_SLOW
#undef ATT_VFRAG
#undef ATT_FLUSH
#undef ATT_LOAD
#undef ATT_TILE
#undef ATT_STORE
    l += __shfl_xor(l, 32);
    const float inv = 1.f / l;
    const size_t tok = (MODE == 3) ? g_tok : (size_t)(rowbase + (long)qstep * rs);
    bfu* Ow = Op + tok * op;
    if (MODE == 3) Ow = (g_slot == 2 ? mg->po2 : mg->po01 + (size_t)g_slot * ((size_t)T * 512)) + tok * 512 + mg->h * 64;
    if (MODE != 3 || g_active) {
#pragma unroll
        for (int dvb = 0; dvb < NDV; ++dvb)
#pragma unroll
            for (int i = 0; i < 4; ++i) {
                const int dv = dvb * 32 + 8 * i + 4 * hi;
                *(u32x2*)(Ow + dv) = (u32x2){pk2(o[dvb][4 * i] * inv, o[dvb][4 * i + 1] * inv), pk2(o[dvb][4 * i + 2] * inv, o[dvb][4 * i + 3] * inv)};
            }
        if (MODE == 3) { if (hi == 0) mg->plse[(tok * 8 + mg->h) * 4 + g_slot] = m + __builtin_amdgcn_logf(l); }
        else if (MODE == 1 || (MODE == 0 && lsep != nullptr)) { if (hi == 0) lsep[tok * lsest] = m + __builtin_amdgcn_logf(l); }
    }
}

DI void phase_attn_even(const Params& p, char* smem, int* s_item, int rep) {
    char* ws = p.ws;
    const bfu* ubuf = (const bfu*)(ws + OFF_UBUF);
    const bfu* Qa = (const bfu*)p.out; const bfu* Ka = Qa + (size_t)T * 768; const bfu* Va = Ka + (size_t)T * 768;
    bfu* obuf = (bfu*)(ws + OFF_OBUF); bfu* dil_o = (bfu*)(ws + OFF_HBUF); float* dil_lse = (float*)(ws + OFF_HBUF + 48 * MiB);
    const int nblk = gridDim.x;
    for (int it = blockIdx.x; it < 1024; it += nblk) {
        int bh, qt;
        if (nblk == 256) { const int x = blockIdx.x & 7, li = blockIdx.x >> 3, hs = it >> 8; bh = x + 8 * hs; qt = (hs & 1) ? li : 31 - li; }
        else { bh = it & 31; qt = 31 - (it >> 5); }
        const int b = bh >> 3, h = bh & 7;
        __syncthreads();
        attn_item<96, 64, 0>(Qa + h * 96, 768, Ka + h * 96, 768, Va + h * 64, 512, (long)b * SEQ, 1, qt * 256, obuf + h * 64, 768, nullptr, 0, nullptr, smem);
    }
    for (int i2 = blockIdx.x; i2 < 1536; i2 += nblk) {
        const int g = i2 >> 9, r2 = i2 & 511, h = r2 & 3, b = (r2 >> 2) & 3, qi = r2 >> 4;
        const int rr = (g == 0) ? 1 : (g == 1 ? 4 : 16), tpc = 32 / rr, cls = qi / tpc, st = qi % tpc;
        const int gh = g * 4 + h;
        __syncthreads();
        attn_item<64, 64, 1>(ubuf + 672 + gh * 64, 3072, ubuf + 672 + 768 + gh * 64, 3072, ubuf + 672 + 1536 + gh * 64, 3072, (long)b * SEQ + cls, rr, st * 256,
                             dil_o + gh * 64, 768, dil_lse + gh, 12, nullptr, smem);
    }
}
DI void phase_moba_select(const Params& p, char* smem) {
    char* ws = p.ws;
    const bfu* ubuf = (const bfu*)(ws + OFF_UBUF); const float* kpart_all = (const float*)(ws + OFF_KPART);
    float* plse = (float*)(ws + OFF_PLSE); unsigned short* seg = (unsigned short*)(ws + OFF_SEG); int* cnt = (int*)(ws + OFF_CNT);
    float* km = (float*)smem; float* cand = km + 2048; int* sel3 = (int*)(cand + NT * 6); int* wcnt = sel3 + 768;
    const int tid = threadIdx.x, lane = tid & 63, wid = tid >> 6;
    for (int it = blockIdx.x; it < 1024; it += gridDim.x) {
        const int bh = it & 31, n = 31 - (it >> 5), b = bh >> 3, h = bh & 7;
        const float* kpart = kpart_all + (size_t)b * (32 * 4 * 512) + h * 64;
        const bfu* Qp = ubuf + 1536 + h * 64;
        __syncthreads();
        for (int idx = tid; idx < n * 64; idx += NT) {
            const int blk = idx >> 6, d = idx & 63; const float* kq = kpart + (size_t)(blk * 4) * 512 + d;
            km[idx] = (kq[0] + kq[512] + kq[1024] + kq[1536]) * (1.f / 256.f);
        }
        if (tid < 32 && tid >= n) cnt[(bh * 32 + tid) * 32 + n] = 0;
        __syncthreads();
        {
            const int qq = tid & 255, hf = tid >> 8;
            const bfu* qr = Qp + (size_t)(b * SEQ + n * 256 + qq) * 3072;
            float qv[64];
#pragma unroll
            for (int c8 = 0; c8 < 8; ++c8) {
                const u32x4 w = *(const u32x4*)(qr + c8 * 8);
#pragma unroll
                for (int e = 0; e < 4; ++e) { qv[c8 * 8 + 2 * e] = bflo(w[e]); qv[c8 * 8 + 2 * e + 1] = bfhi(w[e]); }
            }
            Top3 tp; tp.v0 = -3e38f; tp.v1 = -3e38f; tp.v2 = -3e38f; tp.i0 = 64; tp.i1 = 64; tp.i2 = 64;
            for (int blk = hf; blk < n; blk += 2) {
                float g = 0.f;
#pragma unroll
                for (int d = 0; d < 64; ++d) g += qv[d] * km[blk * 64 + d];
                tp = top3_ins(tp, g, blk);
            }
            cand[tid * 6 + 0] = tp.v0; cand[tid * 6 + 1] = tp.v1; cand[tid * 6 + 2] = tp.v2;
            cand[tid * 6 + 3] = __int_as_float(tp.i0); cand[tid * 6 + 4] = __int_as_float(tp.i1); cand[tid * 6 + 5] = __int_as_float(tp.i2);
        }
        __syncthreads();
        if (tid < 256) {
            Top3 tp; tp.v0 = cand[tid * 6]; tp.v1 = cand[tid * 6 + 1]; tp.v2 = cand[tid * 6 + 2];
            tp.i0 = __float_as_int(cand[tid * 6 + 3]); tp.i1 = __float_as_int(cand[tid * 6 + 4]); tp.i2 = __float_as_int(cand[tid * 6 + 5]);
            const int o = (tid + 256) * 6;
#pragma unroll
            for (int e = 0; e < 3; ++e) { const int ii = __float_as_int(cand[o + 3 + e]); tp = top3_ins(tp, cand[o + e], ii); }
            sel3[tid * 3 + 0] = tp.i0 < 32 ? tp.i0 : -1; sel3[tid * 3 + 1] = tp.i1 < 32 ? tp.i1 : -1; sel3[tid * 3 + 2] = tp.i2 < 32 ? tp.i2 : -1;
            float* pl = plse + ((size_t)(b * SEQ + n * 256 + tid) * 8 + h) * 4;
            if (tp.i0 >= 32) pl[0] = -INFINITY;
            if (tp.i1 >= 32) pl[1] = -INFINITY;
            if (tp.i2 >= 32) pl[2] = -INFINITY;
        }
        __syncthreads();
        for (int j = 0; j < n; ++j) {
            int sl = -1;
            if (tid < 256) sl = (sel3[tid * 3] == j) ? 0 : (sel3[tid * 3 + 1] == j) ? 1 : (sel3[tid * 3 + 2] == j) ? 2 : -1;
            const unsigned long long bal = __ballot(sl >= 0);
            const int wpre = __popcll(bal & ((1ull << lane) - 1ull));
            if (lane == 0 && wid < 4) wcnt[wid] = __popcll(bal);
            __syncthreads();
            if (sl >= 0) {
                int off = wpre;
                for (int w = 0; w < wid; ++w) off += wcnt[w];
                seg[((size_t)((bh * 32 + j) * 32 + n)) * 256 + off] = (unsigned short)(tid | (sl << 8));
            }
            if (tid == 0) cnt[(bh * 32 + j) * 32 + n] = wcnt[0] + wcnt[1] + wcnt[2] + wcnt[3];
            __syncthreads();
        }
    }
    __syncthreads();
}

DI void phase_attn_odd(const Params& p, char* smem, int* s_item, int rep) {
    char* ws = p.ws;
    const bfu* ubuf = (const bfu*)(ws + OFF_UBUF);
    bfu* obuf = (bfu*)(ws + OFF_OBUF); bfu* dbuf = (bfu*)(ws + OFF_DBUF);
    float* plse = (float*)(ws + OFF_PLSE); const unsigned short* seg = (const unsigned short*)(ws + OFF_SEG); const int* cnt = (const int*)(ws + OFF_CNT);
    const int nblk = gridDim.x, tid = threadIdx.x;
    int* cpre = (int*)(smem + 114688);
    __syncthreads();
    for (int e = tid; e < 1024; e += NT) {
        const int j = e & 31; int sum = 0;
        for (int n = j + 1; n < 32; ++n) sum += cnt[e * 32 + n];
        cpre[e + 1] = (sum + 255) >> 8;
    }
    __syncthreads();
    if (tid == 0) { int a = 0; cpre[0] = 0; for (int e = 1; e <= 1024; ++e) { a += cpre[e]; cpre[e] = a; } }
    __syncthreads();
    const int nchunks = cpre[1024];
    for (int it = blockIdx.x; it < 2048; it += nblk) {
        int bh, qt, kind;
        if (nblk == 256) { const int x = blockIdx.x & 7, li = blockIdx.x >> 3, hs = it >> 8; kind = hs >> 2; bh = x + 8 * (hs & 3); qt = (hs & 1) ? li : 31 - li; }
        else { kind = (it >> 5) & 1; bh = it & 31; qt = 31 - (it >> 6); }
        const int b = bh >> 3, hh = bh & 7;
        __syncthreads();
        if (kind == 0) {
            attn_item<64, 128, 0>(ubuf + hh * 64, 3072, ubuf + 512 + hh * 64, 3072, ubuf + 1024 + (hh >> 1) * 128, 3072, (long)b * SEQ, 1, qt * 256,
                                  dbuf + hh * 128, 1024, nullptr, 0, nullptr, smem);
        } else {
            attn_item<64, 64, 0>(ubuf + 1536 + hh * 64, 3072, ubuf + 2048 + hh * 64, 3072, ubuf + 2560 + hh * 64, 3072, (long)b * SEQ, 1, qt * 256,
                                 obuf + 512 + hh * 64, 1024, plse + hh * 4 + 3, 32, nullptr, smem, qt * 4);
        }
    }
    for (int i = blockIdx.x; i < nchunks; i += nblk) {
        int lo = 0, hi2 = 1023;
        while (lo < hi2) { const int mid = (lo + hi2 + 1) >> 1; if (cpre[mid] <= i) lo = mid; else hi2 = mid - 1; }
        const int e = lo, bh = e >> 5, j = e & 31, b = bh >> 3, hh = bh & 7;
        MobaG mg; mg.cnt = cnt + e * 32; mg.seg = seg + (size_t)(e * 32) * 256; mg.chunk = i - cpre[e]; mg.jblk = j; mg.tokbase = b * SEQ; mg.h = hh;
        mg.po01 = (bfu*)(ws + OFF_HBUF); mg.po2 = (bfu*)(ws + OFF_PO2); mg.plse = plse;
        __syncthreads();
        attn_item<64, 64, 3>(ubuf + 1536 + hh * 64, 3072, ubuf + 2048 + hh * 64, 3072, ubuf + 2560 + hh * 64, 3072, (long)b * SEQ, 1, 0,
                             nullptr, 0, nullptr, 0, nullptr, smem, 0, &mg);
    }
}

#define XB_TMO      128
#define XB_XCNT(j)  (256  + 64 * (j))
#define XB_XSUB(j)  (1280 + 64 * (j))
#define XB_XGEN(j)  (2304 + 64 * (j))
#define XB_TOP      3328
#define XB_TOPGEN   3392
#define XCD_BAR_WORDS 3456
#define XB_SPIN_CAP (1u << 18)
#define LAS __attribute__((address_space(3)))

__device__ __forceinline__ unsigned xb_ld(unsigned* p)              { return __hip_atomic_load(p, __ATOMIC_RELAXED, __HIP_MEMORY_SCOPE_AGENT); }
__device__ __forceinline__ unsigned xb_add(unsigned* p, unsigned v) { return __hip_atomic_fetch_add(p, v, __ATOMIC_RELAXED, __HIP_MEMORY_SCOPE_AGENT); }
__device__ __forceinline__ unsigned xb_xcc_id() { return (unsigned)__builtin_amdgcn_s_getreg((3 << 11) | 20) & 0xFu; }
#define XB_SPIN(cond, bar) do { unsigned _sp = 0; while (cond) { __builtin_amdgcn_s_sleep(1); \
    if ((++_sp & 255u) == 0u) { if (xb_ld(&(bar)[XB_TMO])) break; if (_sp > XB_SPIN_CAP) { atomicAdd(&(bar)[XB_TMO], 1u); break; } } } } while (0)

struct XcdBarrier {
    unsigned* bar; unsigned x;
    volatile LAS unsigned* st;
};

__device__ __forceinline__ XcdBarrier xcd_barrier_post(unsigned* bar, volatile LAS unsigned* st) {
    XcdBarrier b; b.bar = bar; b.x = xb_xcc_id(); b.st = st;
    if (threadIdx.x == 0) (void)xb_add(&bar[XB_XCNT(b.x)], 1u);
    return b;
}
__device__ __forceinline__ void xcd_barrier_complete(unsigned* bar, unsigned x, unsigned& nloc, unsigned& nx) {
    const unsigned G = gridDim.x * gridDim.y * gridDim.z;
    unsigned sum, cnt, mine, sp = 0u;
    for (;;) {
        sum = 0u; cnt = 0u; mine = 0u;
#pragma unroll
        for (unsigned j = 0; j < 16; ++j) { const unsigned c = xb_ld(&bar[XB_XCNT(j)]); sum += c; cnt += (c > 0u) ? 1u : 0u; mine = (j == x) ? c : mine; }
        if (sum == G) break;
        __builtin_amdgcn_s_sleep(1);
        if ((++sp & 255u) == 0u) { if (xb_ld(&bar[XB_TMO])) break; if (sp > XB_SPIN_CAP) { atomicAdd(&bar[XB_TMO], 1u); break; } }
    }
    nloc = mine > 0u ? mine : 1u; nx = cnt > 0u ? cnt : 1u;
}

__device__ __forceinline__ void xcd_barrier(const XcdBarrier& b) {
    asm volatile("s_waitcnt vmcnt(0)" ::: "memory");
    __syncthreads();
    if (threadIdx.x == 0) {
        unsigned* bar = b.bar;
        __builtin_amdgcn_s_waitcnt(0);
        unsigned nloc = b.st[0], nx = b.st[1];
        if (nloc == 0u) { xcd_barrier_complete(bar, b.x, nloc, nx); b.st[0] = nloc; b.st[1] = nx; }
        const unsigned old = xb_add(&bar[XB_XSUB(b.x)], 1u);
        const unsigned gen = old / nloc;
        if (old + 1u == (gen + 1u) * nloc) {
            __builtin_amdgcn_fence(__ATOMIC_RELEASE, "agent");
            asm volatile("s_waitcnt vmcnt(0)" ::: "memory");
            const unsigned og = xb_add(&bar[XB_TOP], 1u);
            const unsigned tg = og / nx;
            if (og + 1u == (tg + 1u) * nx) xb_add(&bar[XB_TOPGEN], 1u);
            else XB_SPIN(xb_ld(&bar[XB_TOPGEN]) == tg, bar);
            __builtin_amdgcn_fence(__ATOMIC_ACQUIRE, "agent");
            xb_add(&bar[XB_XGEN(b.x)], 1u);
            asm volatile("s_waitcnt vmcnt(0)" ::: "memory");
        } else {
            XB_SPIN(xb_ld(&bar[XB_XGEN(b.x)]) == gen, bar);
            __builtin_amdgcn_fence(__ATOMIC_ACQUIRE, "agent");
            asm volatile("s_waitcnt vmcnt(0)" ::: "memory");
        }
    }
    __syncthreads();
}

#ifndef MK_REPMASK
#define MK_REPMASK 0u
#endif
#define PHASE_BEGIN(k) if (p.phase_lo <= (k) && (k) < p.phase_hi) { for (int rep_ = 0; rep_ < (((MK_REPMASK >> (k)) & 1u) ? 2 : 1); ++rep_) {
#define PHASE_MID(k) if (rep_ == 0 && ((MK_REPMASK >> (k)) & 1u)) xcd_barrier(xb); }
#define PHASE_END(k) PHASE_MID(k) if (p.coop && (k) + 1 < p.phase_hi) xcd_barrier(xb); }
__global__ void __launch_bounds__(512, 2) mega(Params p) {
    extern __shared__ __attribute__((aligned(16))) char smem[];
    __shared__ int s_item;
    __shared__ uint4 xb_words;
    char* ws = p.ws;
    if (threadIdx.x == 0) xb_words = make_uint4(0u, 0u, 0u, 0u);
    __syncthreads();
    XcdBarrier xb = xcd_barrier_post((unsigned*)(ws + OFF_CTR + 4096), (volatile LAS unsigned*)&xb_words);
    bfu* hbuf = (bfu*)(ws + OFF_HBUF); bfu* obuf = (bfu*)(ws + OFF_OBUF); bfu* ubuf = (bfu*)(ws + OFF_UBUF); bfu* hid = ubuf;
    const float* mod0 = (const float*)(ws + OFF_MOD); const float* mod1 = mod0 + 4 * 6144;
    PHASE_BEGIN(0) phase_prep(p, smem); PHASE_END(0)
    PHASE_BEGIN(1) phase_modfin(p); PHASE_END(1)
    PHASE_BEGIN(2) phase_normmod(p.x, p.norm_mix, mod0, 0, hbuf); PHASE_END(2)
    PHASE_BEGIN(3) phase_gemm8<0>(hbuf, 1024, (const bfu*)(ws + OFF_WIN0), 1024, 2976, 12, ubuf, 3072, nullptr, nullptr, nullptr, smem); PHASE_END(3)
#if MK_PROBE
    if (p.coop) { phase_gemm_probe<MK_PROBE - 1>(hbuf, (const bfu*)(ws + OFF_WIN0), (float*)(ws + OFF_DBUF), p.pad_, smem); xcd_barrier(xb); }
#endif
    PHASE_BEGIN(4)
            phase_gemm8<0>(ubuf, 3072, (const bfu*)(ws + OFF_WUQ), 384, 768, 3, hbuf, 768, nullptr, nullptr, nullptr, smem);
            phase_gemm8<0>(ubuf + 384, 3072, (const bfu*)(ws + OFF_WUKV), 256, 1024, 4, obuf, 1024, nullptr, nullptr, nullptr, smem);
    PHASE_END(4)
    PHASE_BEGIN(5) phase_post_even(p); PHASE_END(5)
    PHASE_BEGIN(6) phase_attn_even(p, smem, &s_item, rep_); PHASE_END(6)
    PHASE_BEGIN(7) phase_dil_merge(p); PHASE_END(7)
    PHASE_BEGIN(8) phase_gemm8<2>(obuf, 768, (const bfu*)(ws + OFF_WOUT0), 768, 1024, 4, nullptr, 0, p.x, p.out, mod0 + 2048, smem); PHASE_END(8)
    PHASE_BEGIN(9) phase_normmod(p.out, p.norm_mlp, mod0, 3072, hbuf); PHASE_END(9)
    PHASE_BEGIN(10) phase_gemm8<1>(hbuf, 1024, (const bfu*)(ws + OFF_W1_0), 1024, 4096, 16, hid, 4096, nullptr, nullptr, nullptr, smem); PHASE_END(10)
    PHASE_BEGIN(11) phase_gemm8<2>(hid, 4096, (const bfu*)(ws + OFF_W2_0), 4096, 1024, 4, nullptr, 0, p.out, p.out, mod0 + 5120, smem); PHASE_END(11)
    PHASE_BEGIN(12) phase_normmod(p.out, p.norm_mix + 1024, mod1, 0, hbuf); PHASE_END(12)
    PHASE_BEGIN(13) phase_gemm_heads(p, hbuf, (const bfu*)(ws + OFF_WIN1), ubuf, smem); PHASE_END(13)
    PHASE_BEGIN(15) phase_moba_select(p, smem); if (p.coop) xcd_barrier(xb); phase_attn_odd(p, smem, &s_item, rep_); PHASE_END(15)
    PHASE_BEGIN(16) phase_diff_combine(p); PHASE_END(16)
    PHASE_BEGIN(17) phase_gemm8<2>(obuf, 1024, (const bfu*)(ws + OFF_WOUT1), 1024, 1024, 4, nullptr, 0, p.out, p.out, mod1 + 2048, smem); PHASE_END(17)
    PHASE_BEGIN(18) phase_normmod(p.out, p.norm_mlp + 1024, mod1, 3072, hbuf); PHASE_END(18)
    PHASE_BEGIN(19) phase_gemm8<1>(hbuf, 1024, (const bfu*)(ws + OFF_W1_1), 1024, 4096, 16, hid, 4096, nullptr, nullptr, nullptr, smem); PHASE_END(19)
    PHASE_BEGIN(20) phase_gemm8<2>(hid, 4096, (const bfu*)(ws + OFF_W2_1), 4096, 1024, 4, nullptr, 0, p.out, p.out, mod1 + 5120, smem); PHASE_END(20)
    if (p.coop == 2) cg::this_grid().sync();
}

extern "C" void kernel_launch(void* const* d_in, const int* in_sizes, int n_in, void* d_out, int out_size, void* d_ws, size_t ws_size, hipStream_t stream) {
    static int grid_blocks = 0;
    if (!grid_blocks) {
        int dev = 0, cus = 0, per_cu = 0;
        (void)hipGetDevice(&dev);
        (void)hipDeviceGetAttribute(&cus, hipDeviceAttributeMultiprocessorCount, dev);
        (void)hipFuncSetAttribute((const void*)mega, hipFuncAttributeMaxDynamicSharedMemorySize, DYN_LDS);
        (void)hipOccupancyMaxActiveBlocksPerMultiprocessor(&per_cu, mega, NT, DYN_LDS);
        if (per_cu != 1) per_cu = 1;
        grid_blocks = cus * per_cu;
    }
    if (ws_size < WS_END) fprintf(stderr, "workspace too small: %zu < %zu\n", ws_size, (size_t)WS_END);
    Params p{};
    p.x = (const float*)d_in[0]; p.c = (const float*)d_in[1]; p.pos = (const int*)d_in[2];
    p.ada_w = (const float*)d_in[3]; p.ada_b = (const float*)d_in[4]; p.norm_mix = (const float*)d_in[5]; p.norm_mlp = (const float*)d_in[6];
    p.w1 = (const float*)d_in[7]; p.w2 = (const float*)d_in[8]; p.e_win = (const float*)d_in[9]; p.e_wout = (const float*)d_in[10];
    p.qlat = (const float*)d_in[11]; p.kvlat = (const float*)d_in[12]; p.wuq = (const float*)d_in[13]; p.wukv = (const float*)d_in[14];
    p.mla_qn = (const float*)d_in[15]; p.mla_kn = (const float*)d_in[16]; p.dil_qn = (const float*)d_in[17]; p.dil_kn = (const float*)d_in[18];
    p.o_win = (const float*)d_in[19]; p.o_wout = (const float*)d_in[20]; p.diff_qn = (const float*)d_in[21]; p.diff_kn = (const float*)d_in[22];
    p.diff_lam = (const float*)d_in[23]; p.diff_subln = (const float*)d_in[24]; p.moba_qn = (const float*)d_in[25]; p.moba_kn = (const float*)d_in[26];
    p.out = (float*)d_out; p.ws = (char*)d_ws;
    for (int i = 0; i < 32; ++i) p.invf64[i] = (float)pow(10000.0, -(double)i / 32.0);
    for (int i = 0; i < 16; ++i) p.invf32[i] = (float)pow(10000.0, -(double)i / 16.0);
    (void)hipMemsetAsync((char*)d_ws + OFF_CTR, 0, 32768, stream);
#if MK_COOP
    p.phase_lo = 0; p.phase_hi = NPH; p.coop = 1;
    void* args[] = {&p};
    hipError_t e = hipLaunchCooperativeKernel((void*)mega, dim3(grid_blocks), dim3(NT), args, DYN_LDS, stream);
    if (e != hipSuccess) fprintf(stderr, "cooperative launch failed: %s (grid %d)\n", hipGetErrorString(e), grid_blocks);
#else
    for (int ph = 0; ph < NPH; ++ph) {
        p.phase_lo = ph; p.phase_hi = ph + 1; p.coop = 0;
        hipLaunchKernelGGL(mega, dim3(grid_blocks), dim3(NT), DYN_LDS, stream, p);
    }
#endif
}
```

```cpp
#include <hip/hip_runtime.h>
#include <hip/hip_cooperative_groups.h>
#include <stdint.h>
#include <cstdio>
#include <cmath>
namespace cg = cooperative_groups;

#ifndef MK_COOP
#define MK_COOP 1
#endif

typedef unsigned short bfu;
typedef __attribute__((ext_vector_type(8))) short bf16x8;
typedef __attribute__((ext_vector_type(4))) short s16x4;
typedef short v4i16_t __attribute__((ext_vector_type(4)));
typedef __attribute__((ext_vector_type(16))) float f32x16;
typedef __attribute__((ext_vector_type(4))) float f32x4;
typedef __attribute__((ext_vector_type(2))) float f32x2;
typedef __attribute__((ext_vector_type(4))) unsigned u32x4;
typedef __attribute__((ext_vector_type(2))) unsigned u32x2;
typedef __attribute__((ext_vector_type(2))) __bf16 bf2_t;
typedef __attribute__((address_space(3))) const char* lds_cptr;

#define DI __device__ __forceinline__
#define MFMA(a, b, c) __builtin_amdgcn_mfma_f32_32x32x16_bf16((a), (b), (c), 0, 0, 0)

constexpr int T = 32768, SEQ = 8192;
constexpr float EPS = 1e-6f;
constexpr float LOG2E = 1.4426950408889634f;
constexpr float SC_MLA = 0.10206207261596577f * LOG2E;
constexpr float SC_64 = 0.125f * LOG2E;
constexpr float LAM_INIT = 0.35550906759096926f;
constexpr int NPH = 21;
constexpr int NT = 512, NW = 8;
constexpr int DYN_LDS = 2 * 512 * 72 * 2;

constexpr size_t MiB = 1048576;
constexpr size_t OFF_WIN0 = 0, OFF_WIN1 = 6 * MiB, OFF_W1_0 = 12 * MiB, OFF_W1_1 = 20 * MiB, OFF_W2_0 = 28 * MiB, OFF_W2_1 = 36 * MiB,
                 OFF_WOUT0 = 44 * MiB, OFF_WOUT1 = 46 * MiB, OFF_WUQ = 48 * MiB, OFF_WUKV = 49 * MiB, OFF_MODP = 50 * MiB, OFF_MOD = 52 * MiB,
                 OFF_ROPE64 = 53 * MiB, OFF_ROPE32 = 61 * MiB, OFF_KPART = 65 * MiB, OFF_CTR = 66 * MiB,
                 OFF_HBUF = 72 * MiB, OFF_OBUF = 136 * MiB, OFF_UBUF = 200 * MiB, OFF_DBUF = 392 * MiB,
                 OFF_PO2 = 456 * MiB, OFF_PLSE = 488 * MiB, OFF_SEG = 492 * MiB, OFF_CNT = 508 * MiB, WS_END = 509 * MiB;

struct Params {
    const float *x, *c; const int* pos;
    const float *ada_w, *ada_b, *norm_mix, *norm_mlp, *w1, *w2, *e_win, *e_wout, *qlat, *kvlat, *wuq, *wukv, *mla_qn, *mla_kn, *dil_qn, *dil_kn,
        *o_win, *o_wout, *diff_qn, *diff_kn, *diff_lam, *diff_subln, *moba_qn, *moba_kn;
    float* out; char* ws;
    float invf64[32]; float invf32[16];
    int phase_lo, phase_hi, coop, pad_;
};

DI unsigned pk2(float a, float b) { f32x2 v = {a, b}; bf2_t r = __builtin_convertvector(v, bf2_t); return __builtin_bit_cast(unsigned, r); }
DI float bflo(unsigned u) { return __uint_as_float(u << 16); }
DI float bfhi(unsigned u) { return __uint_as_float(u & 0xffff0000u); }
DI float wave_sum(float v) {
#pragma unroll
    for (int o = 32; o; o >>= 1) v += __shfl_xor(v, o);
    return v; }
DI s16x4 vtr(lds_cptr p) { return __builtin_bit_cast(s16x4, __builtin_amdgcn_ds_read_tr16_b64_v4i16((__attribute__((address_space(3))) v4i16_t*)p)); }

DI int hp_col(int n) { return (n & ~255) + 64 * ((n >> 5) & 3) + 32 * ((n >> 7) & 1) + (n & 31); }
DI void tr_tile(const float* __restrict__ src, int K, int N, bfu* __restrict__ dst, const float* __restrict__ kscale, int it, float* tl, int hperm) {
    const int nkt = K >> 6; const int kt = it % nkt, nt = it / nkt; const int tid = threadIdx.x;
#pragma unroll
    for (int rr = 0; rr < 2; ++rr) {
        const int kl = rr * 32 + (tid >> 4), k = kt * 64 + kl, nl = (tid & 15) * 4, n = nt * 64 + nl;
        float4 v = make_float4(0.f, 0.f, 0.f, 0.f);
        if (n < N) v = *(const float4*)(src + (size_t)k * N + (hperm ? hp_col(n) : n));
        if (kscale) { const float sc = kscale[k]; v.x *= sc; v.y *= sc; v.z *= sc; v.w *= sc; }
        tl[kl * 65 + nl] = v.x; tl[kl * 65 + nl + 1] = v.y; tl[kl * 65 + nl + 2] = v.z; tl[kl * 65 + nl + 3] = v.w;
    }
    __syncthreads();
    {
        const int nl = tid >> 3, kc = (tid & 7) * 8;
        unsigned w[4];
#pragma unroll
        for (int i = 0; i < 4; ++i) w[i] = pk2(tl[(kc + 2 * i) * 65 + nl], tl[(kc + 2 * i + 1) * 65 + nl]);
        bfu* d = dst + (size_t)(nt * 64 + nl) * K + kt * 64 + kc;
        *(u32x4*)d = (u32x4){w[0], w[1], w[2], w[3]};
    }
    __syncthreads();
}
DI void tr_matrix(const float* src, int K, int N, int Npad, bfu* dst, const float* kscale, float* tl, int hperm = 0) {
    const int nit = (K >> 6) * (Npad >> 6);
    for (int it = blockIdx.x; it < nit; it += gridDim.x) tr_tile(src, K, N, dst, kscale, it, tl, hperm);
}

DI void phase_prep(const Params& p, char* smem) {
    float* tl = (float*)smem;
    char* ws = p.ws;
    if (blockIdx.x == 0 && threadIdx.x < 4) ((int*)(ws + OFF_CTR))[threadIdx.x] = 0;
    tr_matrix(p.e_win, 1024, 2976, 3072, (bfu*)(ws + OFF_WIN0), nullptr, tl);
    tr_matrix(p.o_win, 1024, 3072, 3072, (bfu*)(ws + OFF_WIN1), nullptr, tl, 1);
    tr_matrix(p.w1, 1024, 4096, 4096, (bfu*)(ws + OFF_W1_0), nullptr, tl);
    tr_matrix(p.w1 + (size_t)1024 * 4096, 1024, 4096, 4096, (bfu*)(ws + OFF_W1_1), nullptr, tl);
    tr_matrix(p.w2, 4096, 1024, 1024, (bfu*)(ws + OFF_W2_0), nullptr, tl);
    tr_matrix(p.w2 + (size_t)1024 * 4096, 4096, 1024, 1024, (bfu*)(ws + OFF_W2_1), nullptr, tl);
    tr_matrix(p.e_wout, 768, 1024, 1024, (bfu*)(ws + OFF_WOUT0), nullptr, tl);
    tr_matrix(p.o_wout, 1024, 1024, 1024, (bfu*)(ws + OFF_WOUT1), nullptr, tl);
    tr_matrix(p.wuq, 384, 768, 768, (bfu*)(ws + OFF_WUQ), p.qlat, tl);
    tr_matrix(p.wukv, 256, 1024, 1024, (bfu*)(ws + OFF_WUKV), p.kvlat, tl);
    {
        float2* r64 = (float2*)(ws + OFF_ROPE64); float2* r32 = (float2*)(ws + OFF_ROPE32);
        for (int idx = blockIdx.x * NT + threadIdx.x; idx < T * 48; idx += gridDim.x * NT) {
            const int t = idx / 48, i = idx % 48;
            const float invf = (i < 32) ? p.invf64[i] : p.invf32[i - 32];
            const float a = (float)p.pos[t] * invf;
            double rev = (double)a * 0.15915494309189535; rev -= floor(rev);
            const double y = (rev > 0.5 ? rev - 1.0 : rev) * 6.283185307179586;
            const double y2 = y * y; double s = 1.0, c = 1.0;
#pragma unroll
            for (int k = 15; k >= 1; --k) { s = 1.0 - s * y2 * (1.0 / (double)((2 * k) * (2 * k + 1))); c = 1.0 - c * y2 * (1.0 / (double)((2 * k - 1) * (2 * k))); }
            s *= y;
            const float2 o = make_float2((float)c, (float)s);
            if (i < 32) r64[(size_t)t * 32 + i] = o; else r32[(size_t)t * 16 + (i - 32)] = o;
        }
    }
    {
        float* sl = (float*)smem; float* modp = (float*)(ws + OFF_MODP);
        for (int it = blockIdx.x; it < 2 * 12 * 8; it += gridDim.x) {
            const int l = it / 96, cc = (it % 96) / 8, kc = it % 8;
            __syncthreads();
            { const int i = threadIdx.x, b = i >> 7, kk = i & 127; const float cv = p.c[b * 1024 + kc * 128 + kk]; sl[i] = cv / (1.f + __expf(-cv)); }
            __syncthreads();
            const int j = cc * 512 + threadIdx.x;
            const float* w = p.ada_w + ((size_t)l * 1024 + kc * 128) * 6144 + j;
            float a0 = 0.f, a1 = 0.f, a2 = 0.f, a3 = 0.f;
#pragma unroll 8
            for (int kk = 0; kk < 128; ++kk) { const float wv = w[(size_t)kk * 6144]; a0 += sl[kk] * wv; a1 += sl[128 + kk] * wv; a2 += sl[256 + kk] * wv; a3 += sl[384 + kk] * wv; }
            float* o = modp + (size_t)((l * 8 + kc) * 4) * 6144 + j;
            o[0] = a0; o[6144] = a1; o[2 * 6144] = a2; o[3 * 6144] = a3;
        }
        __syncthreads();
    }
}

DI void phase_modfin(const Params& p) {
    const float* modp = (const float*)(p.ws + OFF_MODP); float* mod = (float*)(p.ws + OFF_MOD);
    for (int idx = blockIdx.x * NT + threadIdx.x; idx < 2 * 4 * 6144; idx += gridDim.x * NT) {
        const int l = idx / 24576, rem = idx % 24576, j = rem % 6144;
        float s = p.ada_b[l * 6144 + j];
#pragma unroll
        for (int kc = 0; kc < 8; ++kc) s += modp[(size_t)((l * 8 + kc) * 4) * 6144 + rem];
        mod[idx] = s;
    }
}

DI void phase_normmod(const float* xs, const float* __restrict__ nw, const float* __restrict__ mod, int sh_off, bfu* __restrict__ hb) {
    const int lane = threadIdx.x & 63, gw = blockIdx.x * NW + (threadIdx.x >> 6), nwv = gridDim.x * NW;
    for (int t = gw; t < T; t += nwv) {
        const int b = t >> 13; const float* xr = xs + (size_t)t * 1024;
        float4 v[4]; float ss = 0.f;
#pragma unroll
        for (int i = 0; i < 4; ++i) { v[i] = *(const float4*)(xr + (i * 64 + lane) * 4); ss += v[i].x * v[i].x + v[i].y * v[i].y + v[i].z * v[i].z + v[i].w * v[i].w; }
        ss = wave_sum(ss);
        const float rinv = rsqrtf(ss * (1.f / 1024.f) + EPS);
        const float* mb = mod + b * 6144 + sh_off;
#pragma unroll
        for (int i = 0; i < 4; ++i) {
            const int col = (i * 64 + lane) * 4;
            const float4 w = *(const float4*)(nw + col), sh = *(const float4*)(mb + col), sc = *(const float4*)(mb + 1024 + col);
            const float o0 = v[i].x * rinv * w.x * (1.f + sc.x) + sh.x, o1 = v[i].y * rinv * w.y * (1.f + sc.y) + sh.y;
            const float o2 = v[i].z * rinv * w.z * (1.f + sc.z) + sh.z, o3 = v[i].w * rinv * w.w * (1.f + sc.w) + sh.w;
            *(u32x2*)(hb + (size_t)t * 1024 + col) = (u32x2){pk2(o0, o1), pk2(o2, o3)};
        }
    }
}

template <int EPI>
DI void gemm_tile(const bfu* __restrict__ A, int lda, const bfu* __restrict__ Bt, int K, int m0, int n0, int N,
                  bfu* Cb, int ldc, const float* resid, float* outf, const float* __restrict__ gate, char* smem) {
    constexpr int STG = 512 * 72;
    bfu* S0 = (bfu*)smem;
    const int tid = threadIdx.x, lane = tid & 63, wid = tid >> 6, l32 = lane & 31, hi = lane >> 5;
    const int wm = wid & 3, wn = wid >> 2;
    f32x16 acc[4][2];
#pragma unroll
    for (int nb = 0; nb < 4; ++nb)
#pragma unroll
        for (int mb = 0; mb < 2; ++mb)
#pragma unroll
            for (int r = 0; r < 16; ++r) acc[nb][mb][r] = 0.f;
    const bfu* Ag = A + (size_t)(m0 + (tid >> 3)) * lda + (tid & 7) * 8;
    const bfu* Bg = Bt + (size_t)(n0 + (tid >> 3)) * K + (tid & 7) * 8;
    u32x4 ra[4], rb[4];
#pragma unroll
    for (int i = 0; i < 4; ++i) { ra[i] = *(const u32x4*)(Ag + (size_t)(64 * i) * lda); rb[i] = *(const u32x4*)(Bg + (size_t)(64 * i) * K); }
    const int nk = K >> 6;
    const int wofs = (tid >> 3) * 72 + (tid & 7) * 8;
    const int arofs = (wm * 64 + l32) * 72 + hi * 8, brofs = 256 * 72 + (wn * 128 + l32) * 72 + hi * 8;
    __syncthreads();
#pragma unroll
    for (int i = 0; i < 4; ++i) { *(u32x4*)(S0 + wofs + 64 * i * 72) = ra[i]; *(u32x4*)(S0 + 256 * 72 + wofs + 64 * i * 72) = rb[i]; }
    if (nk > 1) {
#pragma unroll
        for (int i = 0; i < 4; ++i) { ra[i] = *(const u32x4*)(Ag + (size_t)(64 * i) * lda + 64); rb[i] = *(const u32x4*)(Bg + (size_t)(64 * i) * K + 64); }
    }
    __syncthreads();
#pragma unroll 1
    for (int kt = 0; kt < nk; ++kt) {
        const bfu* Sc = S0 + (kt & 1) * STG; bfu* Sn = S0 + ((kt & 1) ^ 1) * STG;
        if (kt + 1 < nk) {
#pragma unroll
            for (int i = 0; i < 4; ++i) { *(u32x4*)(Sn + wofs + 64 * i * 72) = ra[i]; *(u32x4*)(Sn + 256 * 72 + wofs + 64 * i * 72) = rb[i]; }
        }
        __builtin_amdgcn_sched_barrier(0);
        if (kt + 2 < nk) {
            const int ko = (kt + 2) * 64;
#pragma unroll
            for (int i = 0; i < 4; ++i) { ra[i] = *(const u32x4*)(Ag + (size_t)(64 * i) * lda + ko); rb[i] = *(const u32x4*)(Bg + (size_t)(64 * i) * K + ko); }
        }
        __builtin_amdgcn_sched_barrier(0);
#pragma unroll
        for (int k16 = 0; k16 < 4; ++k16) {
            bf16x8 af[2], bfr[4];
#pragma unroll
            for (int mb = 0; mb < 2; ++mb) af[mb] = *(const bf16x8*)(Sc + arofs + mb * 32 * 72 + k16 * 16);
#pragma unroll
            for (int nb = 0; nb < 4; ++nb) bfr[nb] = *(const bf16x8*)(Sc + brofs + nb * 32 * 72 + k16 * 16);
#pragma unroll
            for (int nb = 0; nb < 4; ++nb)
#pragma unroll
                for (int mb = 0; mb < 2; ++mb) acc[nb][mb] = MFMA(bfr[nb], af[mb], acc[nb][mb]);
        }
        __syncthreads();
    }
    if (EPI != 2) {
        constexpr int CP = 264;
        bfu* Cs = (bfu*)smem;
#pragma unroll
        for (int nb = 0; nb < 4; ++nb)
#pragma unroll
            for (int mb = 0; mb < 2; ++mb) {
                const int row = wm * 64 + mb * 32 + l32;
#pragma unroll
                for (int i = 0; i < 4; ++i) {
                    const int col = wn * 128 + nb * 32 + 8 * i + 4 * hi;
                    float v0 = acc[nb][mb][4 * i], v1 = acc[nb][mb][4 * i + 1], v2 = acc[nb][mb][4 * i + 2], v3 = acc[nb][mb][4 * i + 3];
                    if (EPI == 1) { v0 = fmaxf(v0, 0.f); v1 = fmaxf(v1, 0.f); v2 = fmaxf(v2, 0.f); v3 = fmaxf(v3, 0.f); v0 *= v0; v1 *= v1; v2 *= v2; v3 *= v3; }
                    *(u32x2*)(Cs + row * CP + col) = (u32x2){pk2(v0, v1), pk2(v2, v3)};
                }
            }
        __syncthreads();
        const int c8 = (tid & 31) * 8, n = n0 + c8;
#pragma unroll 1
        for (int ps = 0; ps < 16; ++ps) {
            const int row = ps * 16 + (tid >> 5);
            const u32x4 v = *(const u32x4*)(Cs + row * CP + c8);
            if (n < N) *(u32x4*)(Cb + (size_t)(m0 + row) * ldc + n) = v;
        }
        __syncthreads();
    } else {
        constexpr int CPF = 132;
        float* Cs = (float*)smem;
#pragma unroll
        for (int p2 = 0; p2 < 2; ++p2) {
#pragma unroll
            for (int nbl = 0; nbl < 2; ++nbl)
#pragma unroll
                for (int mb = 0; mb < 2; ++mb) {
                    const int row = wm * 64 + mb * 32 + l32;
#pragma unroll
                    for (int i = 0; i < 4; ++i) {
                        const int col = wn * 64 + nbl * 32 + 8 * i + 4 * hi;
                        *(f32x4*)(Cs + row * CPF + col) = (f32x4){acc[2 * p2 + nbl][mb][4 * i], acc[2 * p2 + nbl][mb][4 * i + 1], acc[2 * p2 + nbl][mb][4 * i + 2], acc[2 * p2 + nbl][mb][4 * i + 3]};
                    }
                }
            __syncthreads();
            const int cl = (tid & 31) * 4;
            const int n = n0 + (cl >> 6) * 128 + (2 * p2 + ((cl >> 5) & 1)) * 32 + (cl & 31);
#pragma unroll 1
            for (int ps = 0; ps < 16; ++ps) {
                const int row = ps * 16 + (tid >> 5), m = m0 + row, b = m >> 13;
                const f32x4 v = *(const f32x4*)(Cs + row * CPF + cl);
                const float4 g = *(const float4*)(gate + b * 6144 + n);
                const float4 r = *(const float4*)(resid + (size_t)m * 1024 + n);
                float4 o; o.x = r.x + g.x * v[0]; o.y = r.y + g.y * v[1]; o.z = r.z + g.z * v[2]; o.w = r.w + g.w * v[3];
                *(float4*)(outf + (size_t)m * 1024 + n) = o;
            }
            __syncthreads();
        }
    }
}

DI bool gemm_map(int round, int nsn, int nwt, int& mt, int& nt) {
    const int x = blockIdx.x & 7, li = blockIdx.x >> 3;
    const int st = round * 8 + x;
    if (st >= 16 * nsn || (li >> 3) >= nwt) return false;
    const int sm = st / nsn, sn = st % nsn;
    mt = sm * 8 + (li & 7); nt = sn * nwt + (li >> 3);
    return true;
}
template <int EPI>
DI void phase_gemm(const bfu* A, int lda, const bfu* Bt, int K, int N, int ntn, bfu* Cb, int ldc, const float* resid, float* outf, const float* gate, char* smem) {
    const bool xcd = (gridDim.x == 256);
    const int nwt = (ntn % 4 == 0) ? 4 : ntn, nsn = ntn / nwt;
    const int rounds = xcd ? 2 * nsn : (128 * ntn + (int)gridDim.x - 1) / (int)gridDim.x;
    for (int r = 0; r < rounds; ++r) {
        int mt = 0, nt = 0; bool ok;
        if (xcd) ok = gemm_map(r, nsn, nwt, mt, nt);
        else { const int tile = r * gridDim.x + blockIdx.x; ok = tile < 128 * ntn; mt = tile / ntn; nt = tile % ntn; }
        if (ok) gemm_tile<EPI>(A, lda, Bt, K, mt * 256, nt * 256, N, Cb, ldc, resid, outf, gate, smem);
    }
}


namespace pg8 {
#define PG8_LAS __attribute__((address_space(3)))
typedef unsigned short bf16_t;
typedef short bf16x8 __attribute__((ext_vector_type(8)));
typedef float f32x4 __attribute__((ext_vector_type(4)));
typedef unsigned u32x4 __attribute__((ext_vector_type(4)));
constexpr int BM = 256, BK = 64, HALF = 128, HTB = HALF * BK * 2  , STAGE_BYTES = 8 * HTB, NXCD = 8, WGM = 8;

__host__ __device__ __forceinline__ int lds_byte(int r, int c) { const int st = (r >> 4) * 2 + (c >> 5), rr = r & 15, cc = c & 31, ob = rr * 64 + cc * 2; return st * 1024 + (ob ^ (((ob >> 9) & 1) << 5)); }
__host__ __device__ __forceinline__ void stage_rc(int b, int& R, int& C) { const int st = b / 1024, sb = b % 1024, swz = sb ^ (((sb >> 9) & 1) << 5); R = (st >> 1) * 16 + swz / 64; C = (st & 1) * 32 + (swz % 64) / 2; }
__host__ __device__ __forceinline__ int perm32(int rho) { const int n = rho >> 4, i = rho & 15; return 8 * (i >> 2) + 4 * n + (i & 3); }

struct Unit { int pm, pn; };
struct Gemm { const bf16_t* A; const bf16_t* Bt; int lda, K; };

template <class Epi, class Sched, bool STAMP = false>
__device__ __forceinline__ void gemm_phase(PG8_LAS unsigned char* lds, const Gemm g, const Sched& S, const Epi& E, unsigned long long* stamps) {
    const int tid = threadIdx.x, wid = __builtin_amdgcn_readfirstlane(tid >> 6), lane = tid & 63, wr = wid >> 2, wc = wid & 3, fr = lane & 15, fq = lane >> 4;
    const int K = g.K, nt = K / BK;
    int ts_lo = 0, ts_hi = 0, nts = 0; const unsigned long long rt_entry = STAMP ? (unsigned long long)wall_clock64() : 0ull;
#define PG8_STAMP() do { if (STAMP && wid == 0 && nts < 64) { const unsigned long long _c = (unsigned long long)clock64(); \
        ts_lo = (lane == nts) ? (int)(unsigned)_c : ts_lo; ts_hi = (lane == nts) ? (int)(unsigned)(_c >> 32) : ts_hi; ++nts; } } while (0)
    PG8_STAMP();
    unsigned voffA[2], voffB[2];
#pragma unroll
    for (int i = 0; i < 2; ++i) { int R, C; stage_rc(tid * 16 + i * 8192, R, C); const int Rb = Epi::PERM ? ((R & ~31) + perm32(R & 31)) : R;
        voffA[i] = (unsigned)(R * g.lda + C) * 2u; voffB[i] = (unsigned)(Rb * K + C) * 2u; }
    const size_t kstep = (size_t)(BK * 2);
    const size_t hstep = (size_t)HALF * K * 2, hstepA = (size_t)HALF * g.lda * 2;
    const size_t tstep = 2 * hstep, tstepA = 2 * hstepA;
    const unsigned ldsw = (unsigned)wid * 1024u;
    const int aoff = lds_byte(wr * 64 + fr, fq * 8), boff = lds_byte(wc * 32 + fr, fq * 8);
#define PG8_SA(b, h) (((b) * 2 + (h)) * HTB)
#define PG8_SB(b, h) ((4 + (b) * 2 + (h)) * HTB)
#define PG8_STAGE(bufoff, gbase, voff) do { _Pragma("unroll") for (int _i = 0; _i < 2; ++_i) \
        __builtin_amdgcn_global_load_lds((const unsigned*)((const char*)(gbase) + (voff)[_i]), (PG8_LAS unsigned*)(lds + (bufoff) + ldsw + _i * 8192), 16, 0, 0); } while (0)
#define PG8_LDA(dst, b, h) do { _Pragma("unroll") for (int m = 0; m < 4; ++m) _Pragma("unroll") for (int k = 0; k < 2; ++k) dst[m][k] = *(const PG8_LAS bf16x8*)(lds + PG8_SA(b, h) + aoff + m * 2048 + k * 1024); } while (0)
#define PG8_LDB(dst, b, h) do { _Pragma("unroll") for (int n = 0; n < 2; ++n) _Pragma("unroll") for (int k = 0; k < 2; ++k) dst[n][k] = *(const PG8_LAS bf16x8*)(lds + PG8_SB(b, h) + boff + n * 2048 + k * 1024); } while (0)
#define PG8_MMA(ai, bj, At, Bt) do { __builtin_amdgcn_s_setprio(1); _Pragma("unroll") for (int m = 0; m < 4; ++m) _Pragma("unroll") for (int n = 0; n < 2; ++n) _Pragma("unroll") for (int k = 0; k < 2; ++k) \
        acc[ai][bj][m][n] = __builtin_amdgcn_mfma_f32_16x16x32_bf16(Bt[n][k], At[m][k], acc[ai][bj][m][n], 0, 0, 0); __builtin_amdgcn_s_setprio(0); } while (0)
#define PG8_WAIT_V(n) asm volatile("s_waitcnt vmcnt(" #n ")" ::: "memory")
#define PG8_WAIT_L(n) asm volatile("s_waitcnt lgkmcnt(" #n ")" ::: "memory")
#define PG8_BAR __builtin_amdgcn_s_barrier()
#define PG8_SCHED __builtin_amdgcn_sched_barrier(0)
    Unit cur, nxt; int ui = 0;
    if (!S.next(0, cur)) return;
    f32x4 acc[2][2][4][2];
#pragma unroll
    for (int a = 0; a < 2; ++a)
#pragma unroll
        for (int b = 0; b < 2; ++b)
#pragma unroll
            for (int m = 0; m < 4; ++m)
#pragma unroll
                for (int n = 0; n < 2; ++n) acc[a][b][m][n] = (f32x4){0.f, 0.f, 0.f, 0.f};
    bf16x8 At[4][2], B0[2][2], B1[2][2];
    const char* cA = (const char*)g.A + (size_t)cur.pm * tstepA; const char* cB = (const char*)g.Bt + (size_t)cur.pn * tstep;
    S.a_ready(cur);
    PG8_STAGE(PG8_SB(0, 0), cB, voffB); PG8_STAGE(PG8_SA(0, 0), cA, voffA); PG8_STAGE(PG8_SB(0, 1), cB + hstep, voffB); PG8_STAGE(PG8_SA(0, 1), cA + hstepA, voffA);
    if (wr == 1) PG8_BAR;
    PG8_WAIT_V(4); PG8_BAR;
    PG8_STAGE(PG8_SB(1, 0), cB + kstep, voffB); PG8_STAGE(PG8_SA(1, 0), cA + kstep, voffA); PG8_STAGE(PG8_SB(1, 1), cB + hstep + kstep, voffB);
    PG8_WAIT_V(6); PG8_BAR;
    PG8_STAMP();
    for (;;) {
        const bool has_next = S.next(ui + 1, nxt);
        const char* nA = has_next ? (const char*)g.A + (size_t)nxt.pm * tstepA : cA; const char* nB = has_next ? (const char*)g.Bt + (size_t)nxt.pn * tstep : cB;
        for (int t = 0; t < nt; t += 2) {
            const bool last = (t == nt - 2);
            const char* a1 = cA + (size_t)(t + 1) * kstep;
            const char* a2 = last ? nA : cA + (size_t)(t + 2) * kstep; const char* b2 = last ? nB : cB + (size_t)(t + 2) * kstep;
            const char* a3 = a2 + kstep; const char* b3 = b2 + kstep;
            if (last && has_next) S.a_ready(nxt);
            PG8_LDB(B0, 0, 0); PG8_SCHED; PG8_LDA(At, 0, 0); PG8_STAGE(PG8_SA(1, 1), a1 + hstepA, voffA);
            PG8_WAIT_L(8); PG8_BAR; PG8_WAIT_L(0); PG8_MMA(0, 0, At, B0); PG8_BAR; PG8_SCHED;
            PG8_LDB(B1, 0, 1); PG8_STAGE(PG8_SB(0, 0), b2, voffB);
            PG8_BAR; PG8_WAIT_L(0); PG8_MMA(0, 1, At, B1); PG8_BAR;
            PG8_LDA(At, 0, 1); PG8_STAGE(PG8_SA(0, 0), a2, voffA);
            PG8_BAR; PG8_WAIT_L(0); PG8_MMA(1, 0, At, B0); PG8_BAR; PG8_SCHED;
            PG8_STAGE(PG8_SB(0, 1), b2 + hstep, voffB);
            PG8_WAIT_V(6); PG8_BAR; PG8_MMA(1, 1, At, B1); PG8_BAR;
            PG8_LDB(B0, 1, 0); PG8_SCHED; PG8_LDA(At, 1, 0); PG8_STAGE(PG8_SA(0, 1), a2 + hstepA, voffA);
            PG8_WAIT_L(8); PG8_BAR; PG8_WAIT_L(0); PG8_MMA(0, 0, At, B0); PG8_BAR; PG8_SCHED;
            PG8_LDB(B1, 1, 1); PG8_STAGE(PG8_SB(1, 0), b3, voffB);
            PG8_BAR; PG8_WAIT_L(0); PG8_MMA(0, 1, At, B1); PG8_BAR;
            PG8_LDA(At, 1, 1); PG8_STAGE(PG8_SA(1, 0), a3, voffA);
            PG8_BAR; PG8_WAIT_L(0); PG8_MMA(1, 0, At, B0); PG8_BAR; PG8_SCHED;
            PG8_STAGE(PG8_SB(1, 1), b3 + hstep, voffB);
            PG8_WAIT_V(6); PG8_BAR; PG8_MMA(1, 1, At, B1); PG8_BAR;
        }
        PG8_STAMP();
        if constexpr (!Epi::AFTER_DRAIN) { E(acc, cur, wr, wc, fr, fq); S.done(cur); }
        PG8_STAMP();
        if (!has_next) break;
#pragma unroll
        for (int a = 0; a < 2; ++a)
#pragma unroll
            for (int b = 0; b < 2; ++b)
#pragma unroll
                for (int m = 0; m < 4; ++m)
#pragma unroll
                    for (int n = 0; n < 2; ++n) acc[a][b][m][n] = (f32x4){0.f, 0.f, 0.f, 0.f};
        cur = nxt; cA = nA; cB = nB; ++ui;
    }
    PG8_WAIT_V(0);
    if (wr == 0) PG8_BAR;
    PG8_BAR;
    if constexpr (Epi::AFTER_DRAIN) { E.fused(acc, cur, wr, wc, fr, fq, lds, wid, lane); S.done(cur); }
    PG8_STAMP();
    if (STAMP && wid == 0) { stamps[lane] = lane < nts ? (((unsigned long long)(unsigned)ts_hi << 32) | (unsigned)ts_lo) : 0ull;
        if (lane == 62) stamps[62] = rt_entry; if (lane == 63) stamps[63] = (unsigned long long)wall_clock64(); }
#undef PG8_STAMP
#undef PG8_SA
#undef PG8_SB
#undef PG8_STAGE
#undef PG8_LDA
#undef PG8_LDB
#undef PG8_MMA
#undef PG8_WAIT_V
#undef PG8_WAIT_L
#undef PG8_BAR
#undef PG8_SCHED
}
}

struct XcdOrder {
    int nsn, nwt, ntn;
    DI bool next(int i, pg8::Unit& u) const {
        int mt, nt;
        if (gridDim.x == 256) { if (!gemm_map(i, nsn, nwt, mt, nt)) return false; }
        else { const int tile = i * (int)gridDim.x + (int)blockIdx.x; if (tile >= 128 * ntn) return false; mt = tile / ntn; nt = tile % ntn; }
        u.pm = mt; u.pn = nt; return true;
    }
    DI void a_ready(const pg8::Unit&) const {}
    DI void done(const pg8::Unit&) const {}
};
template <int ACT> struct EpiOutBf16 {
    static constexpr bool PERM = true, AFTER_DRAIN = false;
    bfu* O; int ldc, N;
    DI void operator()(const pg8::f32x4 (&acc)[2][2][4][2], const pg8::Unit& u, int wr, int wc, int fr, int fq) const {
        const int row0 = u.pm * 256 + wr * 64 + fr, col0 = u.pn * 256 + wc * 32 + 8 * fq;
#pragma unroll
        for (int ai = 0; ai < 2; ++ai)
#pragma unroll
            for (int m = 0; m < 4; ++m) {
                bfu* rowp = O + (size_t)(row0 + ai * 128 + m * 16) * ldc + col0;
#pragma unroll
                for (int bj = 0; bj < 2; ++bj) {
                    pg8::f32x4 v0 = acc[ai][bj][m][0], v1 = acc[ai][bj][m][1];
                    if (ACT == 1) {
#pragma unroll
                        for (int j = 0; j < 4; ++j) { const float a = fmaxf(v0[j], 0.f), b = fmaxf(v1[j], 0.f); v0[j] = a * a; v1[j] = b * b; }
                    }
                    if (col0 + bj * 128 < N) *(u32x4*)(rowp + bj * 128) = (u32x4){pk2(v0[0], v0[1]), pk2(v0[2], v0[3]), pk2(v1[0], v1[1]), pk2(v1[2], v1[3])};
                }
            }
    }
};
struct EpiResid {
    static constexpr bool PERM = false, AFTER_DRAIN = false;
    const float* resid; float* out; const float* gate;
    DI void operator()(const pg8::f32x4 (&acc)[2][2][4][2], const pg8::Unit& u, int wr, int wc, int fr, int fq) const {
        const int row0 = u.pm * 256 + wr * 64 + fr, col0 = u.pn * 256 + wc * 32 + 4 * fq;
        const float* gb = gate + ((u.pm * 256) >> 13) * 6144 + col0;
        pg8::f32x4 gv[2][2];
#pragma unroll
        for (int bj = 0; bj < 2; ++bj)
#pragma unroll
            for (int n = 0; n < 2; ++n) gv[bj][n] = *(const pg8::f32x4*)(gb + bj * 128 + n * 16);
#pragma unroll
        for (int ai = 0; ai < 2; ++ai)
#pragma unroll
            for (int m = 0; m < 4; ++m) {
                const size_t ro = (size_t)(row0 + ai * 128 + m * 16) * 1024 + col0;
#pragma unroll
                for (int bj = 0; bj < 2; ++bj)
#pragma unroll
                    for (int n = 0; n < 2; ++n) {
                        const pg8::f32x4 r = *(const pg8::f32x4*)(resid + ro + bj * 128 + n * 16);
                        *(pg8::f32x4*)(out + ro + bj * 128 + n * 16) = r + gv[bj][n] * acc[ai][bj][m][n];
                    }
            }
    }
};
template <int EPI>
DI void phase_gemm8(const bfu* A, int lda, const bfu* Bt, int K, int N, int ntn, bfu* Cb, int ldc, const float* resid, float* outf, const float* gate, char* smem) {
    pg8::Gemm g; g.A = A; g.Bt = Bt; g.lda = lda; g.K = K;
    XcdOrder S; S.ntn = ntn; S.nwt = (ntn % 4 == 0) ? 4 : ntn; S.nsn = ntn / S.nwt;
    __syncthreads();
    if (EPI == 2) { EpiResid E; E.resid = resid; E.out = outf; E.gate = gate; pg8::gemm_phase<EpiResid, XcdOrder, false>((PG8_LAS unsigned char*)smem, g, S, E, nullptr); }
    else { EpiOutBf16<EPI> E; E.O = Cb; E.ldc = ldc; E.N = N; pg8::gemm_phase<EpiOutBf16<EPI>, XcdOrder, false>((PG8_LAS unsigned char*)smem, g, S, E, nullptr); }
    __syncthreads();
}


struct EpiHeads {
    static constexpr bool PERM = true, AFTER_DRAIN = false;
    bfu* O; const float2* rope; const float *w_dq, *w_dk, *w_mq, *w_mk; float* kpart;
    DI void operator()(const pg8::f32x4 (&acc)[2][2][4][2], const pg8::Unit& u, int wr, int wc, int fr, int fq) const {
        const int pn = u.pn;
        const int kind = (pn < 2) ? 1 : (pn < 4) ? 2 : (pn < 6) ? 0 : (pn < 8) ? 3 : (pn < 10) ? 4 : 0;
        const float scale = (kind == 1 || kind == 3) ? SC_64 : 1.f;
        const int colbase = pn * 256 + wc * 64 + 8 * fq;
        float wa[8], wb[8];
#pragma unroll
        for (int e = 0; e < 8; ++e) {
            const int d = 8 * fq + e;
            const float a1 = w_dq[d], a2 = w_dk[d], a3 = w_mq[d], a4 = w_mk[d], b1 = w_dq[32 + d], b2 = w_dk[32 + d], b3 = w_mq[32 + d], b4 = w_mk[32 + d];
            wa[e] = ((kind == 1) ? a1 : (kind == 2) ? a2 : (kind == 3) ? a3 : a4) * scale;
            wb[e] = ((kind == 1) ? b1 : (kind == 2) ? b2 : (kind == 3) ? b3 : b4) * scale;
        }
#pragma unroll
        for (int ai = 0; ai < 2; ++ai) {
            float ks1[8], ks2[8];
#pragma unroll
            for (int e = 0; e < 8; ++e) { ks1[e] = 0.f; ks2[e] = 0.f; }
#pragma unroll
            for (int m = 0; m < 4; ++m) {
                const int row = u.pm * 256 + ai * 128 + wr * 64 + m * 16 + fr;
                float x1[8], x2[8];
#pragma unroll
                for (int e = 0; e < 8; ++e) { x1[e] = acc[ai][0][m][e >> 2][e & 3]; x2[e] = acc[ai][1][m][e >> 2][e & 3]; }
                if (kind) {
                    float ss = 0.f;
#pragma unroll
                    for (int e = 0; e < 8; ++e) ss += x1[e] * x1[e] + x2[e] * x2[e];
                    ss += __shfl_xor(ss, 16); ss += __shfl_xor(ss, 32);
                    const float r = rsqrtf(ss * (1.f / 64.f) + EPS);
                    const float4* cp = (const float4*)(rope + (size_t)row * 32 + 8 * fq);
#pragma unroll
                    for (int e2 = 0; e2 < 4; ++e2) {
                        const float4 cs = cp[e2];
                        {   const int e = 2 * e2; const float y1 = x1[e] * r * wa[e], y2 = x2[e] * r * wb[e];
                            x1[e] = y1 * cs.x - y2 * cs.y; x2[e] = y2 * cs.x + y1 * cs.y; }
                        {   const int e = 2 * e2 + 1; const float y1 = x1[e] * r * wa[e], y2 = x2[e] * r * wb[e];
                            x1[e] = y1 * cs.z - y2 * cs.w; x2[e] = y2 * cs.z + y1 * cs.w; }
                    }
                    if (kind == 4) {
#pragma unroll
                        for (int e = 0; e < 8; ++e) { ks1[e] += x1[e]; ks2[e] += x2[e]; }
                    }
                }
                bfu* rowp = O + (size_t)row * 3072 + colbase;
                *(u32x4*)rowp = (u32x4){pk2(x1[0], x1[1]), pk2(x1[2], x1[3]), pk2(x1[4], x1[5]), pk2(x1[6], x1[7])};
                *(u32x4*)(rowp + 32) = (u32x4){pk2(x2[0], x2[1]), pk2(x2[2], x2[3]), pk2(x2[4], x2[5]), pk2(x2[6], x2[7])};
            }
            if (kind == 4) {
#pragma unroll
                for (int e = 0; e < 8; ++e) {
                    float a = ks1[e], b = ks2[e];
                    a += __shfl_xor(a, 1); a += __shfl_xor(a, 2); a += __shfl_xor(a, 4); a += __shfl_xor(a, 8);
                    b += __shfl_xor(b, 1); b += __shfl_xor(b, 2); b += __shfl_xor(b, 4); b += __shfl_xor(b, 8);
                    ks1[e] = a; ks2[e] = b;
                }
                if (fr == 0) {
                    float* kp = kpart + (size_t)(4 * u.pm + 2 * ai + wr) * 512 + ((pn - 8) * 4 + wc) * 64 + 8 * fq;
#pragma unroll
                    for (int e = 0; e < 8; ++e) { kp[e] = ks1[e]; kp[32 + e] = ks2[e]; }
                }
            }
        }
    }
};
DI void phase_gemm_heads(const Params& p, const bfu* A, const bfu* Bt, bfu* O, char* smem) {
    pg8::Gemm g; g.A = A; g.Bt = Bt; g.lda = 1024; g.K = 1024;
    XcdOrder S; S.ntn = 12; S.nwt = 4; S.nsn = 3;
    EpiHeads E; E.O = O; E.rope = (const float2*)(p.ws + OFF_ROPE64); E.w_dq = p.diff_qn; E.w_dk = p.diff_kn; E.w_mq = p.moba_qn; E.w_mk = p.moba_kn;
    E.kpart = (float*)(p.ws + OFF_KPART);
    __syncthreads();
    pg8::gemm_phase<EpiHeads, XcdOrder, false>((PG8_LAS unsigned char*)smem, g, S, E, nullptr);
    __syncthreads();
}

#ifndef MK_PROBE
#define MK_PROBE 0
#endif
#if MK_PROBE
template <int VAR>
DI void gemm_probe(const bfu* __restrict__ A, int lda, const bfu* __restrict__ Bt, int K, int m0, int n0, float* sinkp, int sink, char* smem) {
    constexpr int STG = 512 * 72;
    bfu* S0 = (bfu*)smem;
    const int tid = threadIdx.x, lane = tid & 63, wid = tid >> 6, l32 = lane & 31, hi = lane >> 5;
    const int wm = wid & 3, wn = wid >> 2;
    f32x16 acc[4][2];
#pragma unroll
    for (int nb = 0; nb < 4; ++nb)
#pragma unroll
        for (int mb = 0; mb < 2; ++mb)
#pragma unroll
            for (int r = 0; r < 16; ++r) acc[nb][mb][r] = 0.f;
    const bfu* Ag = A + (size_t)(m0 + (tid >> 3)) * lda + (tid & 7) * 8;
    const bfu* Bg = Bt + (size_t)(n0 + (tid >> 3)) * K + (tid & 7) * 8;
    u32x4 ra[4], rb[4];
#pragma unroll
    for (int i = 0; i < 4; ++i) { ra[i] = *(const u32x4*)(Ag + (size_t)(64 * i) * lda); rb[i] = *(const u32x4*)(Bg + (size_t)(64 * i) * K); }
    const int nk = K >> 6;
    const int wofs = (tid >> 3) * 72 + (tid & 7) * 8;
    const int arofs = (wm * 64 + l32) * 72 + hi * 8, brofs = 256 * 72 + (wn * 128 + l32) * 72 + hi * 8;
    __syncthreads();
#pragma unroll
    for (int i = 0; i < 4; ++i) { *(u32x4*)(S0 + wofs + 64 * i * 72) = ra[i]; *(u32x4*)(S0 + 256 * 72 + wofs + 64 * i * 72) = rb[i]; }
    __syncthreads();
#pragma unroll 1
    for (int kt = 0; kt < nk; ++kt) {
        const bfu* Sc = S0 + (kt & 1) * STG; bfu* Sn = S0 + ((kt & 1) ^ 1) * STG;
        if (VAR != 2 && kt + 1 < nk) {
#pragma unroll
            for (int i = 0; i < 4; ++i) { *(u32x4*)(Sn + wofs + 64 * i * 72) = ra[i]; *(u32x4*)(Sn + 256 * 72 + wofs + 64 * i * 72) = rb[i]; }
        }
        __builtin_amdgcn_sched_barrier(0);
        if (VAR != 1 && VAR != 2 && kt + 2 < nk) {
            const int ko = (kt + 2) * 64;
#pragma unroll
            for (int i = 0; i < 4; ++i) { ra[i] = *(const u32x4*)(Ag + (size_t)(64 * i) * lda + ko); rb[i] = *(const u32x4*)(Bg + (size_t)(64 * i) * K + ko); }
        }
        __builtin_amdgcn_sched_barrier(0);
        if (VAR == 3) {
            bf16x8 af[2], bfr[4];
#pragma unroll
            for (int mb = 0; mb < 2; ++mb) af[mb] = *(const bf16x8*)(Sc + arofs + mb * 32 * 72);
#pragma unroll
            for (int nb = 0; nb < 4; ++nb) bfr[nb] = *(const bf16x8*)(Sc + brofs + nb * 32 * 72);
#pragma unroll
            for (int k16 = 0; k16 < 4; ++k16)
#pragma unroll
                for (int nb = 0; nb < 4; ++nb)
#pragma unroll
                    for (int mb = 0; mb < 2; ++mb) acc[nb][mb] = MFMA(bfr[nb], af[mb], acc[nb][mb]);
        } else {
#pragma unroll
            for (int k16 = 0; k16 < 4; ++k16) {
                bf16x8 af[2], bfr[4];
#pragma unroll
                for (int mb = 0; mb < 2; ++mb) af[mb] = *(const bf16x8*)(Sc + arofs + mb * 32 * 72 + k16 * 16);
#pragma unroll
                for (int nb = 0; nb < 4; ++nb) bfr[nb] = *(const bf16x8*)(Sc + brofs + nb * 32 * 72 + k16 * 16);
#pragma unroll
                for (int nb = 0; nb < 4; ++nb)
#pragma unroll
                    for (int mb = 0; mb < 2; ++mb) acc[nb][mb] = MFMA(bfr[nb], af[mb], acc[nb][mb]);
            }
        }
        __syncthreads();
    }
    if (sink) {
#pragma unroll
        for (int nb = 0; nb < 4; ++nb)
#pragma unroll
            for (int mb = 0; mb < 2; ++mb)
#pragma unroll
                for (int r = 0; r < 16; ++r) sinkp[tid * 128 + (nb * 2 + mb) * 16 + r] = acc[nb][mb][r];
    }
}
template <int VAR>
DI void phase_gemm_probe(const bfu* A, const bfu* Bt, float* sinkp, int sink, char* smem) {
    for (int r = 0; r < 6; ++r) { int mt, nt; if (gemm_map(r, 3, 4, mt, nt)) gemm_probe<VAR>(A, 1024, Bt, 1024, mt * 256, nt * 256, sinkp, sink, smem); }
}
#endif

DI void headnorm64(bfu* hp, const float* __restrict__ w, const float2* __restrict__ cs, float scale, int j, bool acc_on, f32x4& ka1, f32x4& ka2) {
    const u32x2 a = *(const u32x2*)(hp + 4 * j), b = *(const u32x2*)(hp + 32 + 4 * j);
    float x1[4] = {bflo(a[0]), bfhi(a[0]), bflo(a[1]), bfhi(a[1])}, x2[4] = {bflo(b[0]), bfhi(b[0]), bflo(b[1]), bfhi(b[1])};
    float ss = 0.f;
#pragma unroll
    for (int e = 0; e < 4; ++e) ss += x1[e] * x1[e] + x2[e] * x2[e];
    ss += __shfl_xor(ss, 1); ss += __shfl_xor(ss, 2); ss += __shfl_xor(ss, 4);
    const float r = rsqrtf(ss * (1.f / 64.f) + EPS);
    const float4 w1 = *(const float4*)(w + 4 * j), w2 = *(const float4*)(w + 32 + 4 * j);
    const float wa[4] = {w1.x, w1.y, w1.z, w1.w}, wb[4] = {w2.x, w2.y, w2.z, w2.w};
    float o1[4], o2[4];
#pragma unroll
    for (int e = 0; e < 4; ++e) {
        const float y1 = x1[e] * r * wa[e], y2 = x2[e] * r * wb[e]; const float2 c = cs[4 * j + e];
        o1[e] = y1 * c.x - y2 * c.y; o2[e] = y2 * c.x + y1 * c.y;
    }
    if (acc_on) {
#pragma unroll
        for (int e = 0; e < 4; ++e) { ka1[e] += o1[e]; ka2[e] += o2[e]; }
    }
    *(u32x2*)(hp + 4 * j) = (u32x2){pk2(o1[0] * scale, o1[1] * scale), pk2(o1[2] * scale, o1[3] * scale)};
    *(u32x2*)(hp + 32 + 4 * j) = (u32x2){pk2(o2[0] * scale, o2[1] * scale), pk2(o2[2] * scale, o2[3] * scale)};
}

DI float sq4(u32x2 a) { const float x0 = bflo(a[0]), x1 = bfhi(a[0]), x2 = bflo(a[1]), x3 = bfhi(a[1]); return x0 * x0 + x1 * x1 + x2 * x2 + x3 * x3; }

DI void mla_head(u32x4 nv, unsigned x1, unsigned x2, float rn, float rr, const float* __restrict__ wn, int j, float2 csA, float2 csB, float scale, bfu* dst) {
    float f[8] = {bflo(nv[0]) * rn, bfhi(nv[0]) * rn, bflo(nv[1]) * rn, bfhi(nv[1]) * rn, bflo(nv[2]) * rn, bfhi(nv[2]) * rn, bflo(nv[3]) * rn, bfhi(nv[3]) * rn};
    const float a0 = bflo(x1) * rr, a1 = bfhi(x1) * rr, b0 = bflo(x2) * rr, b1 = bfhi(x2) * rr;
    float ss = a0 * a0 + a1 * a1 + b0 * b0 + b1 * b1;
#pragma unroll
    for (int e = 0; e < 8; ++e) ss += f[e] * f[e];
    ss += __shfl_xor(ss, 1); ss += __shfl_xor(ss, 2); ss += __shfl_xor(ss, 4);
    const float r = rsqrtf(ss * (1.f / 96.f) + EPS) * scale;
    const float4 wA = *(const float4*)(wn + 8 * j), wB = *(const float4*)(wn + 8 * j + 4);
    const float wv[8] = {wA.x, wA.y, wA.z, wA.w, wB.x, wB.y, wB.z, wB.w};
#pragma unroll
    for (int e = 0; e < 8; ++e) f[e] *= r * wv[e];
    *(u32x4*)(dst + 8 * j) = (u32x4){pk2(f[0], f[1]), pk2(f[2], f[3]), pk2(f[4], f[5]), pk2(f[6], f[7])};
    const float y10 = a0 * r * wn[64 + 2 * j], y11 = a1 * r * wn[65 + 2 * j], y20 = b0 * r * wn[80 + 2 * j], y21 = b1 * r * wn[81 + 2 * j];
    *(unsigned*)(dst + 64 + 2 * j) = pk2(y10 * csA.x - y20 * csA.y, y11 * csB.x - y21 * csB.y);
    *(unsigned*)(dst + 80 + 2 * j) = pk2(y20 * csA.x + y10 * csA.y, y21 * csB.x + y11 * csB.y);
}

DI void phase_post_even(const Params& p) {
    char* ws = p.ws;
    bfu* ubuf = (bfu*)(ws + OFF_UBUF); const bfu* qraw = (const bfu*)(ws + OFF_HBUF); const bfu* kvraw = (const bfu*)(ws + OFF_OBUF);
    bfu* Qa = (bfu*)p.out; bfu* Ka = Qa + (size_t)T * 768; bfu* Va = Ka + (size_t)T * 768;
    const float2* r64 = (const float2*)(ws + OFF_ROPE64); const float2* r32 = (const float2*)(ws + OFF_ROPE32);
    const int lane = threadIdx.x & 63, gw = blockIdx.x * NW + (threadIdx.x >> 6), nwv = gridDim.x * NW;
    const int h = lane >> 3, j = lane & 7;
    for (int t = gw; t < T; t += nwv) {
        bfu* ur = ubuf + (size_t)t * 3072;
        float ssq = sq4(*(const u32x2*)(ur + lane * 4));
        if (lane < 32) ssq += sq4(*(const u32x2*)(ur + 256 + lane * 4));
        float sskv = sq4(*(const u32x2*)(ur + 384 + lane * 4));
        ssq = wave_sum(ssq); sskv = wave_sum(sskv);
        const float rq = rsqrtf(ssq * (1.f / 384.f) + EPS), rkv = rsqrtf(sskv * (1.f / 256.f) + EPS);
        const float2 csA = r32[(size_t)t * 16 + 2 * j], csB = r32[(size_t)t * 16 + 2 * j + 1];
        {
            const bfu* qr = qraw + (size_t)t * 768 + h * 96;
            mla_head(*(const u32x4*)(qr + 8 * j), *(const unsigned*)(qr + 64 + 2 * j), *(const unsigned*)(qr + 80 + 2 * j), rq, rq, p.mla_qn, j, csA, csB, SC_MLA, Qa + (size_t)t * 768 + h * 96);
        }
        {
            const bfu* kr = kvraw + (size_t)t * 1024 + h * 128;
            mla_head(*(const u32x4*)(kr + 8 * j), *(const unsigned*)(ur + 640 + 2 * j), *(const unsigned*)(ur + 656 + 2 * j), rkv, 1.f, p.mla_kn, j, csA, csB, 1.f, Ka + (size_t)t * 768 + h * 96);
            const u32x4 vv = *(const u32x4*)(kr + 64 + 8 * j);
            *(u32x4*)(Va + (size_t)t * 512 + h * 64 + 8 * j) = (u32x4){pk2(bflo(vv[0]) * rkv, bfhi(vv[0]) * rkv), pk2(bflo(vv[1]) * rkv, bfhi(vv[1]) * rkv),
                                                                      pk2(bflo(vv[2]) * rkv, bfhi(vv[2]) * rkv), pk2(bflo(vv[3]) * rkv, bfhi(vv[3]) * rkv)};
        }
        f32x4 d1, d2;
#pragma unroll
        for (int rd = 0; rd < 3; ++rd) {
            const int hh = rd * 8 + h, which = hh / 12, gh = hh % 12;
            headnorm64(ur + 672 + which * 768 + gh * 64, which ? p.dil_kn : p.dil_qn, r64 + (size_t)t * 32, which ? 1.f : SC_64, j, false, d1, d2);
        }
    }
}

DI void phase_post_odd(const Params& p, char* smem) {
    char* ws = p.ws;
    bfu* ubuf = (bfu*)(ws + OFF_UBUF); const float2* r64 = (const float2*)(ws + OFF_ROPE64); float* kpart = (float*)(ws + OFF_KPART);
    const int tid = threadIdx.x, lane = tid & 63, wid = tid >> 6, h = lane >> 3, j = lane & 7;
    float* red = (float*)smem;
    for (int it = blockIdx.x; it < T / 64; it += gridDim.x) {
        f32x4 ka1 = {0.f, 0.f, 0.f, 0.f}, ka2 = {0.f, 0.f, 0.f, 0.f}, d1, d2;
        for (int tt = 0; tt < 8; ++tt) {
            const int t = it * 64 + wid * 8 + tt;
            bfu* ur = ubuf + (size_t)t * 3072; const float2* cs = r64 + (size_t)t * 32;
            headnorm64(ur + h * 64, p.diff_qn, cs, SC_64, j, false, d1, d2);
            headnorm64(ur + 512 + h * 64, p.diff_kn, cs, 1.f, j, false, d1, d2);
            headnorm64(ur + 1536 + h * 64, p.moba_qn, cs, SC_64, j, false, d1, d2);
            headnorm64(ur + 2048 + h * 64, p.moba_kn, cs, 1.f, j, true, ka1, ka2);
        }
        __syncthreads();
#pragma unroll
        for (int e = 0; e < 4; ++e) { red[(wid * 64 + lane) * 8 + e] = ka1[e]; red[(wid * 64 + lane) * 8 + 4 + e] = ka2[e]; }
        __syncthreads();
        {
            const int o = tid, hh = o >> 6, d = o & 63, jj = (d & 31) >> 2, e = (d & 3) + ((d >> 5) << 2), ln = hh * 8 + jj;
            float sum = 0.f;
#pragma unroll
            for (int w = 0; w < NW; ++w) sum += red[(w * 64 + ln) * 8 + e];
            kpart[(size_t)it * 512 + o] = sum;
        }
    }
    __syncthreads();
}

DI void phase_dil_merge(const Params& p) {
    const bfu* dil_o = (const bfu*)(p.ws + OFF_HBUF); const float* dil_lse = (const float*)(p.ws + OFF_HBUF + 48 * MiB);
    bfu* obuf = (bfu*)(p.ws + OFF_OBUF);
    for (int idx = blockIdx.x * NT + threadIdx.x; idx < T * 64; idx += gridDim.x * NT) {
        const int t = idx >> 6, r = idx & 63, h = r >> 4, jj = r & 15;
        const float l0 = dil_lse[(size_t)t * 12 + h], l1 = dil_lse[(size_t)t * 12 + 4 + h], l2 = dil_lse[(size_t)t * 12 + 8 + h];
        const float mx = fmaxf(l0, fmaxf(l1, l2));
        float w0 = exp2f(l0 - mx), w1 = exp2f(l1 - mx), w2 = exp2f(l2 - mx); const float inv = 1.f / (w0 + w1 + w2); w0 *= inv; w1 *= inv; w2 *= inv;
        const u32x2 a = *(const u32x2*)(dil_o + (size_t)t * 768 + h * 64 + 4 * jj), b = *(const u32x2*)(dil_o + (size_t)t * 768 + (4 + h) * 64 + 4 * jj),
                    c = *(const u32x2*)(dil_o + (size_t)t * 768 + (8 + h) * 64 + 4 * jj);
        const float o0 = w0 * bflo(a[0]) + w1 * bflo(b[0]) + w2 * bflo(c[0]), o1 = w0 * bfhi(a[0]) + w1 * bfhi(b[0]) + w2 * bfhi(c[0]);
        const float o2 = w0 * bflo(a[1]) + w1 * bflo(b[1]) + w2 * bflo(c[1]), o3 = w0 * bfhi(a[1]) + w1 * bfhi(b[1]) + w2 * bfhi(c[1]);
        *(u32x2*)(obuf + (size_t)t * 768 + 512 + h * 64 + 4 * jj) = (u32x2){pk2(o0, o1), pk2(o2, o3)};
    }
}

DI void phase_diff_combine(const Params& p) {
    const bfu* dbuf = (const bfu*)(p.ws + OFF_DBUF); bfu* obuf = (bfu*)(p.ws + OFF_OBUF);
    const int lane = threadIdx.x & 63, gw = blockIdx.x * NW + (threadIdx.x >> 6), nwv = gridDim.x * NW;
    float lam;
    {
        const float sa = wave_sum(p.diff_lam[lane] * p.diff_lam[64 + lane]), sb = wave_sum(p.diff_lam[128 + lane] * p.diff_lam[192 + lane]);
        lam = expf(sa) - expf(sb) + LAM_INIT;
    }
    const int h = lane >> 4, jj = lane & 15;
    const float4 sA = *(const float4*)(p.diff_subln + 8 * jj), sB = *(const float4*)(p.diff_subln + 8 * jj + 4);
    const float sw[8] = {sA.x, sA.y, sA.z, sA.w, sB.x, sB.y, sB.z, sB.w};
    for (int t = gw; t < T; t += nwv) {
        const u32x4 a = *(const u32x4*)(dbuf + (size_t)t * 1024 + (2 * h) * 128 + 8 * jj), b = *(const u32x4*)(dbuf + (size_t)t * 1024 + (2 * h + 1) * 128 + 8 * jj);
        float d[8];
#pragma unroll
        for (int e = 0; e < 4; ++e) { d[2 * e] = bflo(a[e]) - lam * bflo(b[e]); d[2 * e + 1] = bfhi(a[e]) - lam * bfhi(b[e]); }
        float ss = 0.f;
#pragma unroll
        for (int e = 0; e < 8; ++e) ss += d[e] * d[e];
        ss += __shfl_xor(ss, 1); ss += __shfl_xor(ss, 2); ss += __shfl_xor(ss, 4); ss += __shfl_xor(ss, 8);
        const float r = rsqrtf(ss * (1.f / 128.f) + EPS) * (1.f - LAM_INIT);
#pragma unroll
        for (int e = 0; e < 8; ++e) d[e] *= r * sw[e];
        *(u32x4*)(obuf + (size_t)t * 1024 + h * 128 + 8 * jj) = (u32x4){pk2(d[0], d[1]), pk2(d[2], d[3]), pk2(d[4], d[5]), pk2(d[6], d[7])};
    }
    {
        const bfu* po01 = (const bfu*)(p.ws + OFF_HBUF); const bfu* po2 = (const bfu*)(p.ws + OFF_PO2); const float* plse = (const float*)(p.ws + OFF_PLSE);
        const int hm = lane >> 3, j8 = (lane & 7) * 8;
        for (int t = gw; t < T; t += nwv) {
            const float4 ls = *(const float4*)(plse + ((size_t)t * 8 + hm) * 4);
            const float mx = fmaxf(fmaxf(ls.x, ls.y), fmaxf(ls.z, ls.w));
            float w0 = exp2f(ls.x - mx), w1 = exp2f(ls.y - mx), w2 = exp2f(ls.z - mx), w3 = exp2f(ls.w - mx);
            const float inv = 1.f / (w0 + w1 + w2 + w3); w0 *= inv; w1 *= inv; w2 *= inv; w3 *= inv;
            bfu* dst = obuf + (size_t)t * 1024 + 512 + hm * 64 + j8;
            const u32x4 z = {0u, 0u, 0u, 0u};
            const u32x4 a0 = (w0 > 0.f) ? *(const u32x4*)(po01 + (size_t)t * 512 + hm * 64 + j8) : z;
            const u32x4 a1 = (w1 > 0.f) ? *(const u32x4*)(po01 + (size_t)T * 512 + (size_t)t * 512 + hm * 64 + j8) : z;
            const u32x4 a2 = (w2 > 0.f) ? *(const u32x4*)(po2 + (size_t)t * 512 + hm * 64 + j8) : z;
            const u32x4 a3 = *(const u32x4*)dst;
            unsigned r[4];
#pragma unroll
            for (int e = 0; e < 4; ++e) {
                const float lo = w0 * bflo(a0[e]) + w1 * bflo(a1[e]) + w2 * bflo(a2[e]) + w3 * bflo(a3[e]);
                const float hi = w0 * bfhi(a0[e]) + w1 * bfhi(a1[e]) + w2 * bfhi(a2[e]) + w3 * bfhi(a3[e]);
                r[e] = pk2(lo, hi);
            }
            *(u32x4*)dst = (u32x4){r[0], r[1], r[2], r[3]};
        }
    }
}

struct Top3 { float v0, v1, v2; int i0, i1, i2; };
DI Top3 top3_ins(Top3 t, float v, int i) {
    const bool g0 = (v > t.v0) || (v == t.v0 && i < t.i0), g1 = (v > t.v1) || (v == t.v1 && i < t.i1), g2 = (v > t.v2) || (v == t.v2 && i < t.i2);
    Top3 r;
    r.v2 = g1 ? t.v1 : (g2 ? v : t.v2); r.i2 = g1 ? t.i1 : (g2 ? i : t.i2);
    r.v1 = g0 ? t.v0 : (g1 ? v : t.v1); r.i1 = g0 ? t.i0 : (g1 ? i : t.i1);
    r.v0 = g0 ? v : t.v0; r.i0 = g0 ? i : t.i0;
    return r;
}

struct MobaG {
    const int* cnt; const unsigned short* seg; int chunk, jblk, tokbase, h; bfu *po01, *po2; float* plse;
};
template <int DK, int DV, int MODE>
DI void attn_item(const bfu* __restrict__ Qp, int qp, const bfu* __restrict__ Kp, int kp, const bfu* __restrict__ Vp, int vp,
                  long rowbase, int rs, int q0, bfu* __restrict__ Op, int op, float* __restrict__ lsep, int lsest,
                  const float* __restrict__ kpart, char* smem, int jfirst = 0, const MobaG* mg = nullptr) {
    constexpr int KPT = DK + 8, KCH = DK / 8, VCH = DV / 8, NKL = (64 * KCH + NT - 1) / NT, NVL = 64 * VCH / NT, NDV = DV / 32, ND0 = DK / 16;
    constexpr int KST = 64 * KPT, VST = 64 * DV;
    bfu* Ks = (bfu*)smem; bfu* Vs = Ks + 3 * KST;
    short* tlist = (short*)(Vs + 3 * VST);
    int* misc = (int*)(tlist + 192);
    float* km = (float*)(misc + 4);
    unsigned* selm = (unsigned*)(km + 2048);
    float* cand = (float*)(selm + 256);
    const int tid = threadIdx.x, lane = tid & 63, wid = tid >> 6, l32 = lane & 31, hi = lane >> 5;
    const int qw = q0 + wid * 32, qstep = qw + l32;
    unsigned mysel = 0;
    bool g_active = true; size_t g_tok = 0; int g_slot = 0, g_total = 0;
    if (MODE == 3) {
        int* pre = (int*)km;
        if (tid < 32) pre[64 + tid] = mg->cnt[tid];
        __syncthreads();
        if (tid == 0) { int a = 0; for (int n = 0; n < 32; ++n) { pre[n] = a; a += (n > mg->jblk) ? pre[64 + n] : 0; } pre[32] = a; }
        __syncthreads();
        g_total = pre[32];
        const int pp = mg->chunk * 256 + wid * 32 + l32;
        g_active = pp < g_total;
        int n = 31;
        for (int c = 31; c >= 1; --c) if (pp < pre[c]) n = c - 1;
        const unsigned short e = g_active ? mg->seg[(size_t)n * 256 + (pp - pre[n])] : (unsigned short)0;
        g_slot = e >> 8;
        g_tok = (size_t)mg->tokbase + (g_active ? (size_t)(n * 256 + (e & 255)) : 0);
    }
    if (MODE == 2) {
        const int nb = q0 >> 8;
        for (int idx = tid; idx < nb * 64; idx += NT) {
            const int blk = idx >> 6, d = idx & 63; const float* kq = kpart + (size_t)(blk * 4) * 512 + d;
            km[idx] = (kq[0] + kq[512] + kq[1024] + kq[1536]) * (1.f / 256.f);
        }
        if (tid == 0) misc[1] = 0;
        __syncthreads();
        {
            const int qq = tid & 255, hf = tid >> 8;
            const bfu* qr = Qp + (size_t)(rowbase + q0 + qq) * qp;
            float qv[64];
#pragma unroll
            for (int c8 = 0; c8 < 8; ++c8) {
                const u32x4 w = *(const u32x4*)(qr + c8 * 8);
#pragma unroll
                for (int e = 0; e < 4; ++e) { qv[c8 * 8 + 2 * e] = bflo(w[e]); qv[c8 * 8 + 2 * e + 1] = bfhi(w[e]); }
            }
            Top3 tp; tp.v0 = -3e38f; tp.v1 = -3e38f; tp.v2 = -3e38f; tp.i0 = 64; tp.i1 = 64; tp.i2 = 64;
            for (int blk = hf; blk < nb; blk += 2) {
                float g = 0.f;
#pragma unroll
                for (int d = 0; d < 64; ++d) g += qv[d] * km[blk * 64 + d];
                tp = top3_ins(tp, g, blk);
            }
            cand[tid * 6 + 0] = tp.v0; cand[tid * 6 + 1] = tp.v1; cand[tid * 6 + 2] = tp.v2;
            cand[tid * 6 + 3] = __int_as_float(tp.i0); cand[tid * 6 + 4] = __int_as_float(tp.i1); cand[tid * 6 + 5] = __int_as_float(tp.i2);
        }
        __syncthreads();
        if (tid < 256) {
            Top3 tp; tp.v0 = cand[tid * 6]; tp.v1 = cand[tid * 6 + 1]; tp.v2 = cand[tid * 6 + 2];
            tp.i0 = __float_as_int(cand[tid * 6 + 3]); tp.i1 = __float_as_int(cand[tid * 6 + 4]); tp.i2 = __float_as_int(cand[tid * 6 + 5]);
            const int o = (tid + 256) * 6;
#pragma unroll
            for (int e = 0; e < 3; ++e) { const int ii = __float_as_int(cand[o + 3 + e]); tp = top3_ins(tp, cand[o + e], ii); }
            unsigned mk = 0;
            if (tp.i0 < 32) mk |= 1u << tp.i0;
            if (tp.i1 < 32) mk |= 1u << tp.i1;
            if (tp.i2 < 32) mk |= 1u << tp.i2;
            selm[tid] = mk;
            atomicOr((unsigned*)&misc[1], mk);
        }
        __syncthreads();
        mysel = selm[wid * 32 + l32];
    }
    int jbase = 0, nt;
    if (MODE == 0) { jbase = jfirst; nt = (q0 >> 6) + 4 - jfirst; }
    else if (MODE == 1) { jbase = (q0 >> 6) >= 2 ? (q0 >> 6) - 2 : 0; nt = (q0 >> 6) + 4 - jbase; }
    else if (MODE == 3) { jbase = mg->jblk * 4; nt = 4; }
    else {
        if (tid == 0) {
            const unsigned om = (unsigned)misc[1]; const int nb = q0 >> 8; int n = 0;
            for (int blk = 0; blk < nb; ++blk) if ((om >> blk) & 1u) { tlist[n++] = (short)(blk * 4); tlist[n++] = (short)(blk * 4 + 1); tlist[n++] = (short)(blk * 4 + 2); tlist[n++] = (short)(blk * 4 + 3); }
            for (int jx = nb * 4; jx <= nb * 4 + 3; ++jx) tlist[n++] = (short)jx;
            misc[0] = n;
        }
        __syncthreads();
        nt = misc[0];
    }
#define ATT_TILE(I) ((MODE == 2) ? (int)tlist[(I)] : jbase + (I))
    bf16x8 qf[ND0];
    {
        const bfu* qr = Qp + ((MODE == 3) ? g_tok : (size_t)(rowbase + (long)qstep * rs)) * qp + hi * 8;
#pragma unroll
        for (int d0 = 0; d0 < ND0; ++d0) qf[d0] = *(const bf16x8*)(qr + d0 * 16);
    }
    float m = 0.f, l = 0.f; bool anym = false;
    f32x16 o[NDV];
#pragma unroll
    for (int dvb = 0; dvb < NDV; ++dvb)
#pragma unroll
        for (int r = 0; r < 16; ++r) o[dvb][r] = 0.f;
    int krow[NKL], kch[NKL], vrow[NVL], vch[NVL];
#pragma unroll
    for (int i = 0; i < NKL; ++i) { const int id = tid + NT * i; krow[i] = id / KCH; kch[i] = id % KCH; }
#pragma unroll
    for (int i = 0; i < NVL; ++i) { const int id = tid + NT * i; vrow[i] = id / VCH; vch[i] = id % VCH; }
    u32x4 rk[NKL], rv[NVL];
#define ATT_LOAD(JJ) do { const int j_ = __builtin_amdgcn_readfirstlane((int)(JJ)); \
    _Pragma("unroll") for (int i = 0; i < NKL; ++i) if (tid + NT * i < 64 * KCH) rk[i] = *(const u32x4*)(Kp + (size_t)(rowbase + (long)(j_ * 64 + krow[i]) * rs) * kp + kch[i] * 8); \
    _Pragma("unroll") for (int i = 0; i < NVL; ++i) rv[i] = *(const u32x4*)(Vp + (size_t)(rowbase + (long)(j_ * 64 + vrow[i]) * rs) * vp + vch[i] * 8); } while (0)
#define ATT_STORE(ST) do { bfu* ks_ = Ks + (ST) * KST; bfu* vs_ = Vs + (ST) * VST; \
    _Pragma("unroll") for (int i = 0; i < NKL; ++i) if (tid + NT * i < 64 * KCH) *(u32x4*)(ks_ + krow[i] * KPT + kch[i] * 8) = rk[i]; \
    _Pragma("unroll") for (int i = 0; i < NVL; ++i) *(u32x4*)(vs_ + (vch[i] >> 2) * 2048 + vrow[i] * 32 + (vch[i] & 3) * 8) = rv[i]; } while (0)
    ATT_LOAD(ATT_TILE(0));
    ATT_STORE(0);
    if (nt > 1) ATT_LOAD(ATT_TILE(1));
    __syncthreads();
    const lds_cptr vb0 = (lds_cptr)Vs + ((lane >> 4) & 1) * 32 + (lane & 3) * 8 + (4 * hi + ((lane & 15) >> 2)) * 64;
    const bfu* ksr0 = Ks + l32 * KPT + hi * 8;
    constexpr int NQK = 2 * ND0, NPV = 4 * NDV, OPA = 48 / NQK, EXB = 32 / NPV;
    static_assert(48 % NQK == 0 && 32 % NPV == 0, "filler split");
    f32x16 pA0, pA1;
    u32x4 pw[4];
    bool pend = false; int pstage = 0;
#define ATT_SLOW() do { if (__builtin_expect(anym || __any(ps > 1e12f), 0)) { \
        float mxp = fmaxf(pA0[0], pA1[0]); \
        _Pragma("unroll") for (int r = 1; r < 16; ++r) mxp = fmaxf(mxp, fmaxf(pA0[r], pA1[r])); \
        mxp = fmaxf(mxp, __shfl_xor(mxp, 32)); \
        const float e_ = (mxp > 0.f) ? (__builtin_amdgcn_logf(mxp) - m) : -1e30f; \
        const float delta = (e_ > 24.f) ? floorf(e_) : 0.f; \
        m += delta; \
        const float alpha = __builtin_amdgcn_exp2f(-delta), sc = __builtin_amdgcn_exp2f(-m); \
        l *= alpha; \
        _Pragma("unroll") for (int dvb = 0; dvb < NDV; ++dvb) _Pragma("unroll") for (int r = 0; r < 16; ++r) o[dvb][r] *= alpha; \
        ps = 0.f; \
        _Pragma("unroll") for (int r = 0; r < 16; ++r) { pA0[r] *= sc; pA1[r] *= sc; ps += pA0[r] + pA1[r]; } \
        _Pragma("unroll") for (int q = 0; q < 16; ++q) pw[q >> 2][q & 3] = (q < 8) ? pk2(pA0[2 * q], pA0[2 * q + 1]) : pk2(pA1[2 * q - 16], pA1[2 * q - 15]); \
        anym = anym || (__any(m != 0.f) != 0); } } while (0)
#define ATT_VFRAG(STG, G) ({ const lds_cptr vb_ = vb0 + (STG) * (VST * 2) + ((G) % NDV) * 4096 + ((G) / NDV) * 1024; \
        const s16x4 lo_ = vtr(vb_), hh_ = vtr(vb_ + 512); (bf16x8){lo_[0], lo_[1], lo_[2], lo_[3], hh_[0], hh_[1], hh_[2], hh_[3]}; })
#define ATT_FLUSH() do { float ps = 0.f; \
        _Pragma("unroll") for (int r = 0; r < 16; ++r) ps += pA0[r] + pA1[r]; \
        _Pragma("unroll") for (int q = 0; q < 16; ++q) pw[q >> 2][q & 3] = (q < 8) ? pk2(pA0[2 * q], pA0[2 * q + 1]) : pk2(pA1[2 * q - 16], pA1[2 * q - 15]); \
        ATT_SLOW(); l += ps; \
        _Pragma("unroll") for (int g = 0; g < NPV; ++g) { const bf16x8 vf_ = ATT_VFRAG(pstage, g); o[g % NDV] = MFMA(vf_, __builtin_bit_cast(bf16x8, pw[g / NDV]), o[g % NDV]); } \
        pend = false; } while (0)
    int cur = 0;
    for (int it = 0; it < nt; ++it) {
        const int nxt = (cur == 2) ? 0 : cur + 1;
        const int jc = __builtin_amdgcn_readfirstlane(ATT_TILE(it));
        if (it + 1 < nt) ATT_STORE(nxt);
        if (it + 2 < nt) ATT_LOAD(ATT_TILE(it + 2));
        __builtin_amdgcn_sched_barrier(0);
        bool need;
        if (MODE == 1) need = (jc * 64 <= qw + 31) && (jc * 64 + 63 >= qw - 128);
        else if (MODE == 3) need = (mg->chunk * 256 + wid * 32 < g_total);
        else {
            need = (jc * 64 <= qw + 31);
            if (MODE == 2) { const int blk = jc >> 2; if (blk < (q0 >> 8)) need = __any((mysel >> blk) & 1u) != 0; }
        }
        if (need) {
            const bfu* ksr = ksr0 + cur * KST;
            f32x16 s0, s1;
#pragma unroll
            for (int r = 0; r < 16; ++r) { s0[r] = 0.f; s1[r] = 0.f; }
            bf16x8 kf0[ND0], kf1[ND0];
#pragma unroll
            for (int d0 = 0; d0 < ND0; ++d0) { kf0[d0] = *(const bf16x8*)(ksr + d0 * 16); kf1[d0] = *(const bf16x8*)(ksr + 32 * KPT + d0 * 16); }
            __builtin_amdgcn_sched_barrier(0);
            if (pend) {
                float ps = 0.f;
#pragma unroll
                for (int g = 0; g < NQK; ++g) {
                    if (g & 1) s1 = MFMA(kf1[g >> 1], qf[g >> 1], s1); else s0 = MFMA(kf0[g >> 1], qf[g >> 1], s0);
#pragma unroll
                    for (int k = g * OPA; k < (g + 1) * OPA; ++k) {
                        if (k < 32) ps += (k < 16) ? pA0[k & 15] : pA1[k & 15];
                        else { const int q = k - 32; unsigned w_ = (q < 8) ? pk2(pA0[(2 * q) & 15], pA0[(2 * q + 1) & 15]) : pk2(pA1[(2 * q) & 15], pA1[(2 * q + 1) & 15]);
                               asm volatile("" : "+v"(w_)); pw[q >> 2][q & 3] = w_; }
                    }
                    asm volatile("" : "+v"(ps));
                    __builtin_amdgcn_sched_barrier(0);
                }
                ATT_SLOW();
                l += ps;
            } else {
#pragma unroll
                for (int d0 = 0; d0 < ND0; ++d0) { s0 = MFMA(kf0[d0], qf[d0], s0); s1 = MFMA(kf1[d0], qf[d0], s1); }
            }
            const int kbase = jc * 64 + 4 * hi;
            if (MODE == 1) {
#pragma unroll
                for (int r = 0; r < 16; ++r) {
                    const int dd = qstep - (kbase + (r & 3) + 8 * (r >> 2));
                    if (dd < 0 || dd > 128) s0[r] = -INFINITY;
                    if (dd - 32 < 0 || dd - 32 > 128) s1[r] = -INFINITY;
                }
            } else if (MODE != 3) {
                if (jc * 64 + 63 > qw) {
#pragma unroll
                    for (int r = 0; r < 16; ++r) {
                        const int ks = kbase + (r & 3) + 8 * (r >> 2);
                        if (ks > qstep) s0[r] = -INFINITY;
                        if (ks + 32 > qstep) s1[r] = -INFINITY;
                    }
                }
                if (MODE == 2) {
                    const int blk = jc >> 2;
                    if (blk < (q0 >> 8) && !((mysel >> blk) & 1u)) {
#pragma unroll
                        for (int r = 0; r < 16; ++r) { s0[r] = -INFINITY; s1[r] = -INFINITY; }
                    }
                }
            }
            if (pend) {
                asm volatile("" : "+v"(s0), "+v"(s1));
                __builtin_amdgcn_sched_barrier(0);
                bf16x8 vfc_ = ATT_VFRAG(pstage, 0), vfd_ = ATT_VFRAG(pstage, 1);
#pragma unroll
                for (int g = 0; g < NPV; ++g) {
                    const bf16x8 vfn_ = (g + 2 < NPV) ? ATT_VFRAG(pstage, (g + 2 < NPV ? g + 2 : g)) : vfd_;
                    o[g % NDV] = MFMA(vfc_, __builtin_bit_cast(bf16x8, pw[g / NDV]), o[g % NDV]);
                    vfc_ = vfd_; vfd_ = vfn_;
#pragma unroll
                    for (int k = g * EXB; k < (g + 1) * EXB; ++k) {
                        float t_ = __builtin_amdgcn_exp2f((k < 16) ? s0[k & 15] : s1[k & 15]);
                        asm volatile("" : "+v"(t_));
                        if (k < 16) s0[k & 15] = t_; else s1[k & 15] = t_;
                    }
                    __builtin_amdgcn_sched_barrier(0);
                }
            } else {
#pragma unroll
                for (int r = 0; r < 16; ++r) { s0[r] = __builtin_amdgcn_exp2f(s0[r]); s1[r] = __builtin_amdgcn_exp2f(s1[r]); }
            }
            pA0 = s0; pA1 = s1; pend = true; pstage = cur;
        } else if (pend) {
            ATT_FLUSH();
        }
        __syncthreads();
        cur = nxt;
    }
    if (pend) ATT_FLUSH();
#undef ATT_SLOW
#undef ATT_VFRAG
#undef ATT_FLUSH
#undef ATT_LOAD
#undef ATT_TILE
#undef ATT_STORE
    l += __shfl_xor(l, 32);
    const float inv = 1.f / l;
    const size_t tok = (MODE == 3) ? g_tok : (size_t)(rowbase + (long)qstep * rs);
    bfu* Ow = Op + tok * op;
    if (MODE == 3) Ow = (g_slot == 2 ? mg->po2 : mg->po01 + (size_t)g_slot * ((size_t)T * 512)) + tok * 512 + mg->h * 64;
    if (MODE != 3 || g_active) {
#pragma unroll
        for (int dvb = 0; dvb < NDV; ++dvb)
#pragma unroll
            for (int i = 0; i < 4; ++i) {
                const int dv = dvb * 32 + 8 * i + 4 * hi;
                *(u32x2*)(Ow + dv) = (u32x2){pk2(o[dvb][4 * i] * inv, o[dvb][4 * i + 1] * inv), pk2(o[dvb][4 * i + 2] * inv, o[dvb][4 * i + 3] * inv)};
            }
        if (MODE == 3) { if (hi == 0) mg->plse[(tok * 8 + mg->h) * 4 + g_slot] = m + __builtin_amdgcn_logf(l); }
        else if (MODE == 1 || (MODE == 0 && lsep != nullptr)) { if (hi == 0) lsep[tok * lsest] = m + __builtin_amdgcn_logf(l); }
    }
}

DI void phase_attn_even(const Params& p, char* smem, int* s_item, int rep) {
    char* ws = p.ws;
    const bfu* ubuf = (const bfu*)(ws + OFF_UBUF);
    const bfu* Qa = (const bfu*)p.out; const bfu* Ka = Qa + (size_t)T * 768; const bfu* Va = Ka + (size_t)T * 768;
    bfu* obuf = (bfu*)(ws + OFF_OBUF); bfu* dil_o = (bfu*)(ws + OFF_HBUF); float* dil_lse = (float*)(ws + OFF_HBUF + 48 * MiB);
    const int nblk = gridDim.x;
    for (int it = blockIdx.x; it < 1024; it += nblk) {
        int bh, qt;
        if (nblk == 256) { const int x = blockIdx.x & 7, li = blockIdx.x >> 3, hs = it >> 8; bh = x + 8 * hs; qt = (hs & 1) ? li : 31 - li; }
        else { bh = it & 31; qt = 31 - (it >> 5); }
        const int b = bh >> 3, h = bh & 7;
        __syncthreads();
        attn_item<96, 64, 0>(Qa + h * 96, 768, Ka + h * 96, 768, Va + h * 64, 512, (long)b * SEQ, 1, qt * 256, obuf + h * 64, 768, nullptr, 0, nullptr, smem);
    }
    for (int i2 = blockIdx.x; i2 < 1536; i2 += nblk) {
        const int g = i2 >> 9, r2 = i2 & 511, h = r2 & 3, b = (r2 >> 2) & 3, qi = r2 >> 4;
        const int rr = (g == 0) ? 1 : (g == 1 ? 4 : 16), tpc = 32 / rr, cls = qi / tpc, st = qi % tpc;
        const int gh = g * 4 + h;
        __syncthreads();
        attn_item<64, 64, 1>(ubuf + 672 + gh * 64, 3072, ubuf + 672 + 768 + gh * 64, 3072, ubuf + 672 + 1536 + gh * 64, 3072, (long)b * SEQ + cls, rr, st * 256,
                             dil_o + gh * 64, 768, dil_lse + gh, 12, nullptr, smem);
    }
}
DI void phase_moba_select(const Params& p, char* smem) {
    char* ws = p.ws;
    const bfu* ubuf = (const bfu*)(ws + OFF_UBUF); const float* kpart_all = (const float*)(ws + OFF_KPART);
    float* plse = (float*)(ws + OFF_PLSE); unsigned short* seg = (unsigned short*)(ws + OFF_SEG); int* cnt = (int*)(ws + OFF_CNT);
    float* km = (float*)smem; float* cand = km + 2048; int* sel3 = (int*)(cand + NT * 6); int* wcnt = sel3 + 768;
    const int tid = threadIdx.x, lane = tid & 63, wid = tid >> 6;
    for (int it = blockIdx.x; it < 1024; it += gridDim.x) {
        const int bh = it & 31, n = 31 - (it >> 5), b = bh >> 3, h = bh & 7;
        const float* kpart = kpart_all + (size_t)b * (32 * 4 * 512) + h * 64;
        const bfu* Qp = ubuf + 1536 + h * 64;
        __syncthreads();
        for (int idx = tid; idx < n * 64; idx += NT) {
            const int blk = idx >> 6, d = idx & 63; const float* kq = kpart + (size_t)(blk * 4) * 512 + d;
            km[idx] = (kq[0] + kq[512] + kq[1024] + kq[1536]) * (1.f / 256.f);
        }
        if (tid < 32 && tid >= n) cnt[(bh * 32 + tid) * 32 + n] = 0;
        __syncthreads();
        {
            const int qq = tid & 255, hf = tid >> 8;
            const bfu* qr = Qp + (size_t)(b * SEQ + n * 256 + qq) * 3072;
            float qv[64];
#pragma unroll
            for (int c8 = 0; c8 < 8; ++c8) {
                const u32x4 w = *(const u32x4*)(qr + c8 * 8);
#pragma unroll
                for (int e = 0; e < 4; ++e) { qv[c8 * 8 + 2 * e] = bflo(w[e]); qv[c8 * 8 + 2 * e + 1] = bfhi(w[e]); }
            }
            Top3 tp; tp.v0 = -3e38f; tp.v1 = -3e38f; tp.v2 = -3e38f; tp.i0 = 64; tp.i1 = 64; tp.i2 = 64;
            for (int blk = hf; blk < n; blk += 2) {
                float g = 0.f;
#pragma unroll
                for (int d = 0; d < 64; ++d) g += qv[d] * km[blk * 64 + d];
                tp = top3_ins(tp, g, blk);
            }
            cand[tid * 6 + 0] = tp.v0; cand[tid * 6 + 1] = tp.v1; cand[tid * 6 + 2] = tp.v2;
            cand[tid * 6 + 3] = __int_as_float(tp.i0); cand[tid * 6 + 4] = __int_as_float(tp.i1); cand[tid * 6 + 5] = __int_as_float(tp.i2);
        }
        __syncthreads();
        if (tid < 256) {
            Top3 tp; tp.v0 = cand[tid * 6]; tp.v1 = cand[tid * 6 + 1]; tp.v2 = cand[tid * 6 + 2];
            tp.i0 = __float_as_int(cand[tid * 6 + 3]); tp.i1 = __float_as_int(cand[tid * 6 + 4]); tp.i2 = __float_as_int(cand[tid * 6 + 5]);
            const int o = (tid + 256) * 6;
#pragma unroll
            for (int e = 0; e < 3; ++e) { const int ii = __float_as_int(cand[o + 3 + e]); tp = top3_ins(tp, cand[o + e], ii); }
            sel3[tid * 3 + 0] = tp.i0 < 32 ? tp.i0 : -1; sel3[tid * 3 + 1] = tp.i1 < 32 ? tp.i1 : -1; sel3[tid * 3 + 2] = tp.i2 < 32 ? tp.i2 : -1;
            float* pl = plse + ((size_t)(b * SEQ + n * 256 + tid) * 8 + h) * 4;
            if (tp.i0 >= 32) pl[0] = -INFINITY;
            if (tp.i1 >= 32) pl[1] = -INFINITY;
            if (tp.i2 >= 32) pl[2] = -INFINITY;
        }
        __syncthreads();
        int q0s = -1, q1s = -1, q2s = -1;
        if (tid < 256) { q0s = sel3[tid * 3]; q1s = sel3[tid * 3 + 1]; q2s = sel3[tid * 3 + 2]; }
        for (int j = 0; j < n; ++j) {
            const unsigned long long bal = __ballot(q0s == j || q1s == j || q2s == j);
            if (lane == 0 && wid < 4) wcnt[j * 4 + wid] = __popcll(bal);
        }
        __syncthreads();
        for (int j = 0; j < n; ++j) {
            const int sl = (q0s == j) ? 0 : (q1s == j) ? 1 : (q2s == j) ? 2 : -1;
            const unsigned long long bal = __ballot(sl >= 0);
            if (sl >= 0) {
                int off = __popcll(bal & ((1ull << lane) - 1ull));
                for (int w = 0; w < wid; ++w) off += wcnt[j * 4 + w];
                seg[((size_t)((bh * 32 + j) * 32 + n)) * 256 + off] = (unsigned short)(tid | (sl << 8));
            }
            if (tid == 0) cnt[(bh * 32 + j) * 32 + n] = wcnt[j * 4] + wcnt[j * 4 + 1] + wcnt[j * 4 + 2] + wcnt[j * 4 + 3];
        }
    }
    __syncthreads();
}

DI void phase_attn_odd(const Params& p, char* smem, int* s_item, int rep) {
    char* ws = p.ws;
    const bfu* ubuf = (const bfu*)(ws + OFF_UBUF);
    bfu* obuf = (bfu*)(ws + OFF_OBUF); bfu* dbuf = (bfu*)(ws + OFF_DBUF);
    float* plse = (float*)(ws + OFF_PLSE); const unsigned short* seg = (const unsigned short*)(ws + OFF_SEG); const int* cnt = (const int*)(ws + OFF_CNT);
    const int nblk = gridDim.x, tid = threadIdx.x;
    int* cpre = (int*)(smem + 114688);
    __syncthreads();
    for (int e = tid; e < 1024; e += NT) {
        const int j = e & 31; int sum = 0;
        for (int n = j + 1; n < 32; ++n) sum += cnt[e * 32 + n];
        cpre[e + 1] = (sum + 255) >> 8;
    }
    __syncthreads();
    if (tid == 0) { int a = 0; cpre[0] = 0; for (int e = 1; e <= 1024; ++e) { a += cpre[e]; cpre[e] = a; } }
    __syncthreads();
    const int nchunks = cpre[1024];
    for (int it = blockIdx.x; it < 2048; it += nblk) {
        int bh, qt, kind;
        if (nblk == 256) { const int x = blockIdx.x & 7, li = blockIdx.x >> 3, hs = it >> 8; kind = hs >> 2; bh = x + 8 * (hs & 3); qt = (hs & 1) ? li : 31 - li; }
        else { kind = (it >> 5) & 1; bh = it & 31; qt = 31 - (it >> 6); }
        const int b = bh >> 3, hh = bh & 7;
        __syncthreads();
        if (kind == 0) {
            attn_item<64, 128, 0>(ubuf + hh * 64, 3072, ubuf + 512 + hh * 64, 3072, ubuf + 1024 + (hh >> 1) * 128, 3072, (long)b * SEQ, 1, qt * 256,
                                  dbuf + hh * 128, 1024, nullptr, 0, nullptr, smem);
        } else {
            attn_item<64, 64, 0>(ubuf + 1536 + hh * 64, 3072, ubuf + 2048 + hh * 64, 3072, ubuf + 2560 + hh * 64, 3072, (long)b * SEQ, 1, qt * 256,
                                 obuf + 512 + hh * 64, 1024, plse + hh * 4 + 3, 32, nullptr, smem, qt * 4);
        }
    }
    for (int i = blockIdx.x; i < nchunks; i += nblk) {
        int lo = 0, hi2 = 1023;
        while (lo < hi2) { const int mid = (lo + hi2 + 1) >> 1; if (cpre[mid] <= i) lo = mid; else hi2 = mid - 1; }
        const int e = lo, bh = e >> 5, j = e & 31, b = bh >> 3, hh = bh & 7;
        MobaG mg; mg.cnt = cnt + e * 32; mg.seg = seg + (size_t)(e * 32) * 256; mg.chunk = i - cpre[e]; mg.jblk = j; mg.tokbase = b * SEQ; mg.h = hh;
        mg.po01 = (bfu*)(ws + OFF_HBUF); mg.po2 = (bfu*)(ws + OFF_PO2); mg.plse = plse;
        __syncthreads();
        attn_item<64, 64, 3>(ubuf + 1536 + hh * 64, 3072, ubuf + 2048 + hh * 64, 3072, ubuf + 2560 + hh * 64, 3072, (long)b * SEQ, 1, 0,
                             nullptr, 0, nullptr, 0, nullptr, smem, 0, &mg);
    }
}

#define XB_TMO      128
#define XB_XCNT(j)  (256  + 64 * (j))
#define XB_XSUB(j)  (1280 + 64 * (j))
#define XB_XGEN(j)  (2304 + 64 * (j))
#define XB_TOP      3328
#define XB_TOPGEN   3392
#define XCD_BAR_WORDS 3456
#define XB_SPIN_CAP (1u << 18)
#define LAS __attribute__((address_space(3)))

__device__ __forceinline__ unsigned xb_ld(unsigned* p)              { return __hip_atomic_load(p, __ATOMIC_RELAXED, __HIP_MEMORY_SCOPE_AGENT); }
__device__ __forceinline__ unsigned xb_add(unsigned* p, unsigned v) { return __hip_atomic_fetch_add(p, v, __ATOMIC_RELAXED, __HIP_MEMORY_SCOPE_AGENT); }
__device__ __forceinline__ unsigned xb_xcc_id() { return (unsigned)__builtin_amdgcn_s_getreg((3 << 11) | 20) & 0xFu; }
#define XB_SPIN(cond, bar) do { unsigned _sp = 0; while (cond) { __builtin_amdgcn_s_sleep(1); \
    if ((++_sp & 255u) == 0u) { if (xb_ld(&(bar)[XB_TMO])) break; if (_sp > XB_SPIN_CAP) { atomicAdd(&(bar)[XB_TMO], 1u); break; } } } } while (0)

struct XcdBarrier {
    unsigned* bar; unsigned x;
    volatile LAS unsigned* st;
};

__device__ __forceinline__ XcdBarrier xcd_barrier_post(unsigned* bar, volatile LAS unsigned* st) {
    XcdBarrier b; b.bar = bar; b.x = xb_xcc_id(); b.st = st;
    if (threadIdx.x == 0) (void)xb_add(&bar[XB_XCNT(b.x)], 1u);
    return b;
}
__device__ __forceinline__ void xcd_barrier_complete(unsigned* bar, unsigned x, unsigned& nloc, unsigned& nx) {
    const unsigned G = gridDim.x * gridDim.y * gridDim.z;
    unsigned sum, cnt, mine, sp = 0u;
    for (;;) {
        sum = 0u; cnt = 0u; mine = 0u;
#pragma unroll
        for (unsigned j = 0; j < 16; ++j) { const unsigned c = xb_ld(&bar[XB_XCNT(j)]); sum += c; cnt += (c > 0u) ? 1u : 0u; mine = (j == x) ? c : mine; }
        if (sum == G) break;
        __builtin_amdgcn_s_sleep(1);
        if ((++sp & 255u) == 0u) { if (xb_ld(&bar[XB_TMO])) break; if (sp > XB_SPIN_CAP) { atomicAdd(&bar[XB_TMO], 1u); break; } }
    }
    nloc = mine > 0u ? mine : 1u; nx = cnt > 0u ? cnt : 1u;
}

__device__ __forceinline__ void xcd_barrier(const XcdBarrier& b) {
    asm volatile("s_waitcnt vmcnt(0)" ::: "memory");
    __syncthreads();
    if (threadIdx.x == 0) {
        unsigned* bar = b.bar;
        __builtin_amdgcn_s_waitcnt(0);
        unsigned nloc = b.st[0], nx = b.st[1];
        if (nloc == 0u) { xcd_barrier_complete(bar, b.x, nloc, nx); b.st[0] = nloc; b.st[1] = nx; }
        const unsigned old = xb_add(&bar[XB_XSUB(b.x)], 1u);
        const unsigned gen = old / nloc;
        if (old + 1u == (gen + 1u) * nloc) {
            __builtin_amdgcn_fence(__ATOMIC_RELEASE, "agent");
            asm volatile("s_waitcnt vmcnt(0)" ::: "memory");
            const unsigned og = xb_add(&bar[XB_TOP], 1u);
            const unsigned tg = og / nx;
            if (og + 1u == (tg + 1u) * nx) xb_add(&bar[XB_TOPGEN], 1u);
            else XB_SPIN(xb_ld(&bar[XB_TOPGEN]) == tg, bar);
            __builtin_amdgcn_fence(__ATOMIC_ACQUIRE, "agent");
            xb_add(&bar[XB_XGEN(b.x)], 1u);
            asm volatile("s_waitcnt vmcnt(0)" ::: "memory");
        } else {
            XB_SPIN(xb_ld(&bar[XB_XGEN(b.x)]) == gen, bar);
            __builtin_amdgcn_fence(__ATOMIC_ACQUIRE, "agent");
            asm volatile("s_waitcnt vmcnt(0)" ::: "memory");
        }
    }
    __syncthreads();
}

#ifndef MK_REPMASK
#define MK_REPMASK 0u
#endif
#define PHASE_BEGIN(k) if (p.phase_lo <= (k) && (k) < p.phase_hi) { for (int rep_ = 0; rep_ < (((MK_REPMASK >> (k)) & 1u) ? 2 : 1); ++rep_) {
#define PHASE_MID(k) if (rep_ == 0 && ((MK_REPMASK >> (k)) & 1u)) xcd_barrier(xb); }
#define PHASE_END(k) PHASE_MID(k) if (p.coop && (k) + 1 < p.phase_hi) xcd_barrier(xb); }
__global__ void __launch_bounds__(512, 2) mega(Params p) {
    extern __shared__ __attribute__((aligned(16))) char smem[];
    __shared__ int s_item;
    __shared__ uint4 xb_words;
    char* ws = p.ws;
    if (threadIdx.x == 0) xb_words = make_uint4(0u, 0u, 0u, 0u);
    __syncthreads();
    XcdBarrier xb = xcd_barrier_post((unsigned*)(ws + OFF_CTR + 4096), (volatile LAS unsigned*)&xb_words);
    bfu* hbuf = (bfu*)(ws + OFF_HBUF); bfu* obuf = (bfu*)(ws + OFF_OBUF); bfu* ubuf = (bfu*)(ws + OFF_UBUF); bfu* hid = ubuf;
    const float* mod0 = (const float*)(ws + OFF_MOD); const float* mod1 = mod0 + 4 * 6144;
    PHASE_BEGIN(0) phase_prep(p, smem); PHASE_END(0)
    PHASE_BEGIN(1) phase_modfin(p); PHASE_END(1)
    PHASE_BEGIN(2) phase_normmod(p.x, p.norm_mix, mod0, 0, hbuf); PHASE_END(2)
    PHASE_BEGIN(3) phase_gemm8<0>(hbuf, 1024, (const bfu*)(ws + OFF_WIN0), 1024, 2976, 12, ubuf, 3072, nullptr, nullptr, nullptr, smem); PHASE_END(3)
#if MK_PROBE
    if (p.coop) { phase_gemm_probe<MK_PROBE - 1>(hbuf, (const bfu*)(ws + OFF_WIN0), (float*)(ws + OFF_DBUF), p.pad_, smem); xcd_barrier(xb); }
#endif
    PHASE_BEGIN(4)
            phase_gemm8<0>(ubuf, 3072, (const bfu*)(ws + OFF_WUQ), 384, 768, 3, hbuf, 768, nullptr, nullptr, nullptr, smem);
            phase_gemm8<0>(ubuf + 384, 3072, (const bfu*)(ws + OFF_WUKV), 256, 1024, 4, obuf, 1024, nullptr, nullptr, nullptr, smem);
    PHASE_END(4)
    PHASE_BEGIN(5) phase_post_even(p); PHASE_END(5)
    PHASE_BEGIN(6) phase_attn_even(p, smem, &s_item, rep_); PHASE_END(6)
    PHASE_BEGIN(7) phase_dil_merge(p); PHASE_END(7)
    PHASE_BEGIN(8) phase_gemm8<2>(obuf, 768, (const bfu*)(ws + OFF_WOUT0), 768, 1024, 4, nullptr, 0, p.x, p.out, mod0 + 2048, smem); PHASE_END(8)
    PHASE_BEGIN(9) phase_normmod(p.out, p.norm_mlp, mod0, 3072, hbuf); PHASE_END(9)
    PHASE_BEGIN(10) phase_gemm8<1>(hbuf, 1024, (const bfu*)(ws + OFF_W1_0), 1024, 4096, 16, hid, 4096, nullptr, nullptr, nullptr, smem); PHASE_END(10)
    PHASE_BEGIN(11) phase_gemm8<2>(hid, 4096, (const bfu*)(ws + OFF_W2_0), 4096, 1024, 4, nullptr, 0, p.out, p.out, mod0 + 5120, smem); PHASE_END(11)
    PHASE_BEGIN(12) phase_normmod(p.out, p.norm_mix + 1024, mod1, 0, hbuf); PHASE_END(12)
    PHASE_BEGIN(13) phase_gemm_heads(p, hbuf, (const bfu*)(ws + OFF_WIN1), ubuf, smem); PHASE_END(13)
    PHASE_BEGIN(15) phase_moba_select(p, smem); if (p.coop) xcd_barrier(xb); phase_attn_odd(p, smem, &s_item, rep_); PHASE_END(15)
    PHASE_BEGIN(16) phase_diff_combine(p); PHASE_END(16)
    PHASE_BEGIN(17) phase_gemm8<2>(obuf, 1024, (const bfu*)(ws + OFF_WOUT1), 1024, 1024, 4, nullptr, 0, p.out, p.out, mod1 + 2048, smem); PHASE_END(17)
    PHASE_BEGIN(18) phase_normmod(p.out, p.norm_mlp + 1024, mod1, 3072, hbuf); PHASE_END(18)
    PHASE_BEGIN(19) phase_gemm8<1>(hbuf, 1024, (const bfu*)(ws + OFF_W1_1), 1024, 4096, 16, hid, 4096, nullptr, nullptr, nullptr, smem); PHASE_END(19)
    PHASE_BEGIN(20) phase_gemm8<2>(hid, 4096, (const bfu*)(ws + OFF_W2_1), 4096, 1024, 4, nullptr, 0, p.out, p.out, mod1 + 5120, smem); PHASE_END(20)
    if (p.coop == 2) cg::this_grid().sync();
}

extern "C" void kernel_launch(void* const* d_in, const int* in_sizes, int n_in, void* d_out, int out_size, void* d_ws, size_t ws_size, hipStream_t stream) {
    static int grid_blocks = 0;
    if (!grid_blocks) {
        int dev = 0, cus = 0, per_cu = 0;
        (void)hipGetDevice(&dev);
        (void)hipDeviceGetAttribute(&cus, hipDeviceAttributeMultiprocessorCount, dev);
        (void)hipFuncSetAttribute((const void*)mega, hipFuncAttributeMaxDynamicSharedMemorySize, DYN_LDS);
        (void)hipOccupancyMaxActiveBlocksPerMultiprocessor(&per_cu, mega, NT, DYN_LDS);
        if (per_cu != 1) per_cu = 1;
        grid_blocks = cus * per_cu;
    }
    if (ws_size < WS_END) fprintf(stderr, "workspace too small: %zu < %zu\n", ws_size, (size_t)WS_END);
    Params p{};
    p.x = (const float*)d_in[0]; p.c = (const float*)d_in[1]; p.pos = (const int*)d_in[2];
    p.ada_w = (const float*)d_in[3]; p.ada_b = (const float*)d_in[4]; p.norm_mix = (const float*)d_in[5]; p.norm_mlp = (const float*)d_in[6];
    p.w1 = (const float*)d_in[7]; p.w2 = (const float*)d_in[8]; p.e_win = (const float*)d_in[9]; p.e_wout = (const float*)d_in[10];
    p.qlat = (const float*)d_in[11]; p.kvlat = (const float*)d_in[12]; p.wuq = (const float*)d_in[13]; p.wukv = (const float*)d_in[14];
    p.mla_qn = (const float*)d_in[15]; p.mla_kn = (const float*)d_in[16]; p.dil_qn = (const float*)d_in[17]; p.dil_kn = (const float*)d_in[18];
    p.o_win = (const float*)d_in[19]; p.o_wout = (const float*)d_in[20]; p.diff_qn = (const float*)d_in[21]; p.diff_kn = (const float*)d_in[22];
    p.diff_lam = (const float*)d_in[23]; p.diff_subln = (const float*)d_in[24]; p.moba_qn = (const float*)d_in[25]; p.moba_kn = (const float*)d_in[26];
    p.out = (float*)d_out; p.ws = (char*)d_ws;
    for (int i = 0; i < 32; ++i) p.invf64[i] = (float)pow(10000.0, -(double)i / 32.0);
    for (int i = 0; i < 16; ++i) p.invf32[i] = (float)pow(10000.0, -(double)i / 16.0);
    (void)hipMemsetAsync((char*)d_ws + OFF_CTR, 0, 32768, stream);
#if MK_COOP
    p.phase_lo = 0; p.phase_hi = NPH; p.coop = 1;
    void* args[] = {&p};
    hipError_t e = hipLaunchCooperativeKernel((void*)mega, dim3(grid_blocks), dim3(NT), args, DYN_LDS, stream);
    if (e != hipSuccess) fprintf(stderr, "cooperative launch failed: %s (grid %d)\n", hipGetErrorString(e), grid_blocks);
#else
    for (int ph = 0; ph < NPH; ++ph) {
        p.phase_lo = ph; p.phase_hi = ph + 1; p.coop = 0;
        hipLaunchKernelGGL(mega, dim3(grid_blocks), dim3(NT), DYN_LDS, stream, p);
    }
#endif
}
```

```cpp
#include <hip/hip_runtime.h>
#include <hip/hip_cooperative_groups.h>
#include <stdint.h>
#include <cstdio>
#include <cmath>
namespace cg = cooperative_groups;

#ifndef MK_COOP
#define MK_COOP 1
#endif

typedef unsigned short bfu;
typedef __attribute__((ext_vector_type(8))) short bf16x8;
typedef __attribute__((ext_vector_type(4))) short s16x4;
typedef short v4i16_t __attribute__((ext_vector_type(4)));
typedef __attribute__((ext_vector_type(16))) float f32x16;
typedef __attribute__((ext_vector_type(4))) float f32x4;
typedef __attribute__((ext_vector_type(2))) float f32x2;
typedef __attribute__((ext_vector_type(4))) unsigned u32x4;
typedef __attribute__((ext_vector_type(2))) unsigned u32x2;
typedef __attribute__((ext_vector_type(2))) __bf16 bf2_t;
typedef __attribute__((address_space(3))) const char* lds_cptr;

#define DI __device__ __forceinline__
#define MFMA(a, b, c) __builtin_amdgcn_mfma_f32_32x32x16_bf16((a), (b), (c), 0, 0, 0)

constexpr int T = 32768, SEQ = 8192;
constexpr float EPS = 1e-6f;
constexpr float LOG2E = 1.4426950408889634f;
constexpr float SC_MLA = 0.10206207261596577f * LOG2E;
constexpr float SC_64 = 0.125f * LOG2E;
constexpr float LAM_INIT = 0.35550906759096926f;
constexpr int NPH = 21;
constexpr int NT = 512, NW = 8;
constexpr int DYN_LDS = 2 * 512 * 72 * 2;

constexpr size_t MiB = 1048576;
constexpr size_t OFF_WIN0 = 0, OFF_WIN1 = 6 * MiB, OFF_W1_0 = 12 * MiB, OFF_W1_1 = 20 * MiB, OFF_W2_0 = 28 * MiB, OFF_W2_1 = 36 * MiB,
                 OFF_WOUT0 = 44 * MiB, OFF_WOUT1 = 46 * MiB, OFF_WUQ = 48 * MiB, OFF_WUKV = 49 * MiB, OFF_MODP = 50 * MiB, OFF_MOD = 52 * MiB,
                 OFF_ROPE64 = 53 * MiB, OFF_ROPE32 = 61 * MiB, OFF_KPART = 65 * MiB, OFF_CTR = 66 * MiB,
                 OFF_HBUF = 72 * MiB, OFF_OBUF = 136 * MiB, OFF_UBUF = 200 * MiB, OFF_DBUF = 392 * MiB,
                 OFF_PO2 = 456 * MiB, OFF_PLSE = 488 * MiB, OFF_SEG = 492 * MiB, OFF_CNT = 508 * MiB, WS_END = 509 * MiB;

struct Params {
    const float *x, *c; const int* pos;
    const float *ada_w, *ada_b, *norm_mix, *norm_mlp, *w1, *w2, *e_win, *e_wout, *qlat, *kvlat, *wuq, *wukv, *mla_qn, *mla_kn, *dil_qn, *dil_kn,
        *o_win, *o_wout, *diff_qn, *diff_kn, *diff_lam, *diff_subln, *moba_qn, *moba_kn;
    float* out; char* ws;
    float invf64[32]; float invf32[16];
    int phase_lo, phase_hi, coop, pad_;
};

DI unsigned pk2(float a, float b) { f32x2 v = {a, b}; bf2_t r = __builtin_convertvector(v, bf2_t); return __builtin_bit_cast(unsigned, r); }
DI float bflo(unsigned u) { return __uint_as_float(u << 16); }
DI float bfhi(unsigned u) { return __uint_as_float(u & 0xffff0000u); }
DI float wave_sum(float v) {
#pragma unroll
    for (int o = 32; o; o >>= 1) v += __shfl_xor(v, o);
    return v; }
DI s16x4 vtr(lds_cptr p) { return __builtin_bit_cast(s16x4, __builtin_amdgcn_ds_read_tr16_b64_v4i16((__attribute__((address_space(3))) v4i16_t*)p)); }

DI int hp_col(int n) { return (n & ~255) + 64 * ((n >> 5) & 3) + 32 * ((n >> 7) & 1) + (n & 31); }
DI void tr_tile(const float* __restrict__ src, int K, int N, bfu* __restrict__ dst, const float* __restrict__ kscale, int it, float* tl, int hperm) {
    const int nkt = K >> 6; const int kt = it % nkt, nt = it / nkt; const int tid = threadIdx.x;
#pragma unroll
    for (int rr = 0; rr < 2; ++rr) {
        const int kl = rr * 32 + (tid >> 4), k = kt * 64 + kl, nl = (tid & 15) * 4, n = nt * 64 + nl;
        float4 v = make_float4(0.f, 0.f, 0.f, 0.f);
        if (n < N) v = *(const float4*)(src + (size_t)k * N + (hperm ? hp_col(n) : n));
        if (kscale) { const float sc = kscale[k]; v.x *= sc; v.y *= sc; v.z *= sc; v.w *= sc; }
        tl[kl * 65 + nl] = v.x; tl[kl * 65 + nl + 1] = v.y; tl[kl * 65 + nl + 2] = v.z; tl[kl * 65 + nl + 3] = v.w;
    }
    __syncthreads();
    {
        const int nl = tid >> 3, kc = (tid & 7) * 8;
        unsigned w[4];
#pragma unroll
        for (int i = 0; i < 4; ++i) w[i] = pk2(tl[(kc + 2 * i) * 65 + nl], tl[(kc + 2 * i + 1) * 65 + nl]);
        bfu* d = dst + (size_t)(nt * 64 + nl) * K + kt * 64 + kc;
        *(u32x4*)d = (u32x4){w[0], w[1], w[2], w[3]};
    }
    __syncthreads();
}
DI void tr_matrix(const float* src, int K, int N, int Npad, bfu* dst, const float* kscale, float* tl, int hperm = 0) {
    const int nit = (K >> 6) * (Npad >> 6);
    for (int it = blockIdx.x; it < nit; it += gridDim.x) tr_tile(src, K, N, dst, kscale, it, tl, hperm);
}

DI void phase_prep(const Params& p, char* smem) {
    float* tl = (float*)smem;
    char* ws = p.ws;
    if (blockIdx.x == 0 && threadIdx.x < 4) ((int*)(ws + OFF_CTR))[threadIdx.x] = 0;
    tr_matrix(p.e_win, 1024, 2976, 3072, (bfu*)(ws + OFF_WIN0), nullptr, tl);
    tr_matrix(p.o_win, 1024, 3072, 3072, (bfu*)(ws + OFF_WIN1), nullptr, tl, 1);
    tr_matrix(p.w1, 1024, 4096, 4096, (bfu*)(ws + OFF_W1_0), nullptr, tl);
    tr_matrix(p.w1 + (size_t)1024 * 4096, 1024, 4096, 4096, (bfu*)(ws + OFF_W1_1), nullptr, tl);
    tr_matrix(p.w2, 4096, 1024, 1024, (bfu*)(ws + OFF_W2_0), nullptr, tl);
    tr_matrix(p.w2 + (size_t)1024 * 4096, 4096, 1024, 1024, (bfu*)(ws + OFF_W2_1), nullptr, tl);
    tr_matrix(p.e_wout, 768, 1024, 1024, (bfu*)(ws + OFF_WOUT0), nullptr, tl);
    tr_matrix(p.o_wout, 1024, 1024, 1024, (bfu*)(ws + OFF_WOUT1), nullptr, tl);
    tr_matrix(p.wuq, 384, 768, 768, (bfu*)(ws + OFF_WUQ), p.qlat, tl);
    tr_matrix(p.wukv, 256, 1024, 1024, (bfu*)(ws + OFF_WUKV), p.kvlat, tl);
    {
        float2* r64 = (float2*)(ws + OFF_ROPE64); float2* r32 = (float2*)(ws + OFF_ROPE32);
        for (int idx = blockIdx.x * NT + threadIdx.x; idx < T * 48; idx += gridDim.x * NT) {
            const int t = idx / 48, i = idx % 48;
            const float invf = (i < 32) ? p.invf64[i] : p.invf32[i - 32];
            const float a = (float)p.pos[t] * invf;
            double rev = (double)a * 0.15915494309189535; rev -= floor(rev);
            const double y = (rev > 0.5 ? rev - 1.0 : rev) * 6.283185307179586;
            const double y2 = y * y; double s = 1.0, c = 1.0;
#pragma unroll
            for (int k = 15; k >= 1; --k) { s = 1.0 - s * y2 * (1.0 / (double)((2 * k) * (2 * k + 1))); c = 1.0 - c * y2 * (1.0 / (double)((2 * k - 1) * (2 * k))); }
            s *= y;
            const float2 o = make_float2((float)c, (float)s);
            if (i < 32) r64[(size_t)t * 32 + i] = o; else r32[(size_t)t * 16 + (i - 32)] = o;
        }
    }
    {
        float* sl = (float*)smem; float* modp = (float*)(ws + OFF_MODP);
        for (int it = blockIdx.x; it < 2 * 12 * 8; it += gridDim.x) {
            const int l = it / 96, cc = (it % 96) / 8, kc = it % 8;
            __syncthreads();
            { const int i = threadIdx.x, b = i >> 7, kk = i & 127; const float cv = p.c[b * 1024 + kc * 128 + kk]; sl[i] = cv / (1.f + __expf(-cv)); }
            __syncthreads();
            const int j = cc * 512 + threadIdx.x;
            const float* w = p.ada_w + ((size_t)l * 1024 + kc * 128) * 6144 + j;
            float a0 = 0.f, a1 = 0.f, a2 = 0.f, a3 = 0.f;
#pragma unroll 8
            for (int kk = 0; kk < 128; ++kk) { const float wv = w[(size_t)kk * 6144]; a0 += sl[kk] * wv; a1 += sl[128 + kk] * wv; a2 += sl[256 + kk] * wv; a3 += sl[384 + kk] * wv; }
            float* o = modp + (size_t)((l * 8 + kc) * 4) * 6144 + j;
            o[0] = a0; o[6144] = a1; o[2 * 6144] = a2; o[3 * 6144] = a3;
        }
        __syncthreads();
    }
}

DI void phase_modfin(const Params& p) {
    const float* modp = (const float*)(p.ws + OFF_MODP); float* mod = (float*)(p.ws + OFF_MOD);
    for (int idx = blockIdx.x * NT + threadIdx.x; idx < 2 * 4 * 6144; idx += gridDim.x * NT) {
        const int l = idx / 24576, rem = idx % 24576, j = rem % 6144;
        float s = p.ada_b[l * 6144 + j];
#pragma unroll
        for (int kc = 0; kc < 8; ++kc) s += modp[(size_t)((l * 8 + kc) * 4) * 6144 + rem];
        mod[idx] = s;
    }
}

DI void phase_normmod(const float* xs, const float* __restrict__ nw, const float* __restrict__ mod, int sh_off, bfu* __restrict__ hb) {
    const int lane = threadIdx.x & 63, gw = blockIdx.x * NW + (threadIdx.x >> 6), nwv = gridDim.x * NW;
    for (int t = gw; t < T; t += nwv) {
        const int b = t >> 13; const float* xr = xs + (size_t)t * 1024;
        float4 v[4]; float ss = 0.f;
#pragma unroll
        for (int i = 0; i < 4; ++i) { v[i] = *(const float4*)(xr + (i * 64 + lane) * 4); ss += v[i].x * v[i].x + v[i].y * v[i].y + v[i].z * v[i].z + v[i].w * v[i].w; }
        ss = wave_sum(ss);
        const float rinv = rsqrtf(ss * (1.f / 1024.f) + EPS);
        const float* mb = mod + b * 6144 + sh_off;
#pragma unroll
        for (int i = 0; i < 4; ++i) {
            const int col = (i * 64 + lane) * 4;
            const float4 w = *(const float4*)(nw + col), sh = *(const float4*)(mb + col), sc = *(const float4*)(mb + 1024 + col);
            const float o0 = v[i].x * rinv * w.x * (1.f + sc.x) + sh.x, o1 = v[i].y * rinv * w.y * (1.f + sc.y) + sh.y;
            const float o2 = v[i].z * rinv * w.z * (1.f + sc.z) + sh.z, o3 = v[i].w * rinv * w.w * (1.f + sc.w) + sh.w;
            *(u32x2*)(hb + (size_t)t * 1024 + col) = (u32x2){pk2(o0, o1), pk2(o2, o3)};
        }
    }
}

template <int EPI>
DI void gemm_tile(const bfu* __restrict__ A, int lda, const bfu* __restrict__ Bt, int K, int m0, int n0, int N,
                  bfu* Cb, int ldc, const float* resid, float* outf, const float* __restrict__ gate, char* smem) {
    constexpr int STG = 512 * 72;
    bfu* S0 = (bfu*)smem;
    const int tid = threadIdx.x, lane = tid & 63, wid = tid >> 6, l32 = lane & 31, hi = lane >> 5;
    const int wm = wid & 3, wn = wid >> 2;
    f32x16 acc[4][2];
#pragma unroll
    for (int nb = 0; nb < 4; ++nb)
#pragma unroll
        for (int mb = 0; mb < 2; ++mb)
#pragma unroll
            for (int r = 0; r < 16; ++r) acc[nb][mb][r] = 0.f;
    const bfu* Ag = A + (size_t)(m0 + (tid >> 3)) * lda + (tid & 7) * 8;
    const bfu* Bg = Bt + (size_t)(n0 + (tid >> 3)) * K + (tid & 7) * 8;
    u32x4 ra[4], rb[4];
#pragma unroll
    for (int i = 0; i < 4; ++i) { ra[i] = *(const u32x4*)(Ag + (size_t)(64 * i) * lda); rb[i] = *(const u32x4*)(Bg + (size_t)(64 * i) * K); }
    const int nk = K >> 6;
    const int wofs = (tid >> 3) * 72 + (tid & 7) * 8;
    const int arofs = (wm * 64 + l32) * 72 + hi * 8, brofs = 256 * 72 + (wn * 128 + l32) * 72 + hi * 8;
    __syncthreads();
#pragma unroll
    for (int i = 0; i < 4; ++i) { *(u32x4*)(S0 + wofs + 64 * i * 72) = ra[i]; *(u32x4*)(S0 + 256 * 72 + wofs + 64 * i * 72) = rb[i]; }
    if (nk > 1) {
#pragma unroll
        for (int i = 0; i < 4; ++i) { ra[i] = *(const u32x4*)(Ag + (size_t)(64 * i) * lda + 64); rb[i] = *(const u32x4*)(Bg + (size_t)(64 * i) * K + 64); }
    }
    __syncthreads();
#pragma unroll 1
    for (int kt = 0; kt < nk; ++kt) {
        const bfu* Sc = S0 + (kt & 1) * STG; bfu* Sn = S0 + ((kt & 1) ^ 1) * STG;
        if (kt + 1 < nk) {
#pragma unroll
            for (int i = 0; i < 4; ++i) { *(u32x4*)(Sn + wofs + 64 * i * 72) = ra[i]; *(u32x4*)(Sn + 256 * 72 + wofs + 64 * i * 72) = rb[i]; }
        }
        __builtin_amdgcn_sched_barrier(0);
        if (kt + 2 < nk) {
            const int ko = (kt + 2) * 64;
#pragma unroll
            for (int i = 0; i < 4; ++i) { ra[i] = *(const u32x4*)(Ag + (size_t)(64 * i) * lda + ko); rb[i] = *(const u32x4*)(Bg + (size_t)(64 * i) * K + ko); }
        }
        __builtin_amdgcn_sched_barrier(0);
#pragma unroll
        for (int k16 = 0; k16 < 4; ++k16) {
            bf16x8 af[2], bfr[4];
#pragma unroll
            for (int mb = 0; mb < 2; ++mb) af[mb] = *(const bf16x8*)(Sc + arofs + mb * 32 * 72 + k16 * 16);
#pragma unroll
            for (int nb = 0; nb < 4; ++nb) bfr[nb] = *(const bf16x8*)(Sc + brofs + nb * 32 * 72 + k16 * 16);
#pragma unroll
            for (int nb = 0; nb < 4; ++nb)
#pragma unroll
                for (int mb = 0; mb < 2; ++mb) acc[nb][mb] = MFMA(bfr[nb], af[mb], acc[nb][mb]);
        }
        __syncthreads();
    }
    if (EPI != 2) {
        constexpr int CP = 264;
        bfu* Cs = (bfu*)smem;
#pragma unroll
        for (int nb = 0; nb < 4; ++nb)
#pragma unroll
            for (int mb = 0; mb < 2; ++mb) {
                const int row = wm * 64 + mb * 32 + l32;
#pragma unroll
                for (int i = 0; i < 4; ++i) {
                    const int col = wn * 128 + nb * 32 + 8 * i + 4 * hi;
                    float v0 = acc[nb][mb][4 * i], v1 = acc[nb][mb][4 * i + 1], v2 = acc[nb][mb][4 * i + 2], v3 = acc[nb][mb][4 * i + 3];
                    if (EPI == 1) { v0 = fmaxf(v0, 0.f); v1 = fmaxf(v1, 0.f); v2 = fmaxf(v2, 0.f); v3 = fmaxf(v3, 0.f); v0 *= v0; v1 *= v1; v2 *= v2; v3 *= v3; }
                    *(u32x2*)(Cs + row * CP + col) = (u32x2){pk2(v0, v1), pk2(v2, v3)};
                }
            }
        __syncthreads();
        const int c8 = (tid & 31) * 8, n = n0 + c8;
#pragma unroll 1
        for (int ps = 0; ps < 16; ++ps) {
            const int row = ps * 16 + (tid >> 5);
            const u32x4 v = *(const u32x4*)(Cs + row * CP + c8);
            if (n < N) *(u32x4*)(Cb + (size_t)(m0 + row) * ldc + n) = v;
        }
        __syncthreads();
    } else {
        constexpr int CPF = 132;
        float* Cs = (float*)smem;
#pragma unroll
        for (int p2 = 0; p2 < 2; ++p2) {
#pragma unroll
            for (int nbl = 0; nbl < 2; ++nbl)
#pragma unroll
                for (int mb = 0; mb < 2; ++mb) {
                    const int row = wm * 64 + mb * 32 + l32;
#pragma unroll
                    for (int i = 0; i < 4; ++i) {
                        const int col = wn * 64 + nbl * 32 + 8 * i + 4 * hi;
                        *(f32x4*)(Cs + row * CPF + col) = (f32x4){acc[2 * p2 + nbl][mb][4 * i], acc[2 * p2 + nbl][mb][4 * i + 1], acc[2 * p2 + nbl][mb][4 * i + 2], acc[2 * p2 + nbl][mb][4 * i + 3]};
                    }
                }
            __syncthreads();
            const int cl = (tid & 31) * 4;
            const int n = n0 + (cl >> 6) * 128 + (2 * p2 + ((cl >> 5) & 1)) * 32 + (cl & 31);
#pragma unroll 1
            for (int ps = 0; ps < 16; ++ps) {
                const int row = ps * 16 + (tid >> 5), m = m0 + row, b = m >> 13;
                const f32x4 v = *(const f32x4*)(Cs + row * CPF + cl);
                const float4 g = *(const float4*)(gate + b * 6144 + n);
                const float4 r = *(const float4*)(resid + (size_t)m * 1024 + n);
                float4 o; o.x = r.x + g.x * v[0]; o.y = r.y + g.y * v[1]; o.z = r.z + g.z * v[2]; o.w = r.w + g.w * v[3];
                *(float4*)(outf + (size_t)m * 1024 + n) = o;
            }
            __syncthreads();
        }
    }
}

DI bool gemm_map(int round, int nsn, int nwt, int& mt, int& nt) {
    const int x = blockIdx.x & 7, li = blockIdx.x >> 3;
    const int st = round * 8 + x;
    if (st >= 16 * nsn || (li >> 3) >= nwt) return false;
    const int sm = st / nsn, sn = st % nsn;
    mt = sm * 8 + (li & 7); nt = sn * nwt + (li >> 3);
    return true;
}
template <int EPI>
DI void phase_gemm(const bfu* A, int lda, const bfu* Bt, int K, int N, int ntn, bfu* Cb, int ldc, const float* resid, float* outf, const float* gate, char* smem) {
    const bool xcd = (gridDim.x == 256);
    const int nwt = (ntn % 4 == 0) ? 4 : ntn, nsn = ntn / nwt;
    const int rounds = xcd ? 2 * nsn : (128 * ntn + (int)gridDim.x - 1) / (int)gridDim.x;
    for (int r = 0; r < rounds; ++r) {
        int mt = 0, nt = 0; bool ok;
        if (xcd) ok = gemm_map(r, nsn, nwt, mt, nt);
        else { const int tile = r * gridDim.x + blockIdx.x; ok = tile < 128 * ntn; mt = tile / ntn; nt = tile % ntn; }
        if (ok) gemm_tile<EPI>(A, lda, Bt, K, mt * 256, nt * 256, N, Cb, ldc, resid, outf, gate, smem);
    }
}


namespace pg8 {
#define PG8_LAS __attribute__((address_space(3)))
typedef unsigned short bf16_t;
typedef short bf16x8 __attribute__((ext_vector_type(8)));
typedef float f32x4 __attribute__((ext_vector_type(4)));
typedef unsigned u32x4 __attribute__((ext_vector_type(4)));
constexpr int BM = 256, BK = 64, HALF = 128, HTB = HALF * BK * 2  , STAGE_BYTES = 8 * HTB, NXCD = 8, WGM = 8;

__host__ __device__ __forceinline__ int lds_byte(int r, int c) { const int st = (r >> 4) * 2 + (c >> 5), rr = r & 15, cc = c & 31, ob = rr * 64 + cc * 2; return st * 1024 + (ob ^ (((ob >> 9) & 1) << 5)); }
__host__ __device__ __forceinline__ void stage_rc(int b, int& R, int& C) { const int st = b / 1024, sb = b % 1024, swz = sb ^ (((sb >> 9) & 1) << 5); R = (st >> 1) * 16 + swz / 64; C = (st & 1) * 32 + (swz % 64) / 2; }
__host__ __device__ __forceinline__ int perm32(int rho) { const int n = rho >> 4, i = rho & 15; return 8 * (i >> 2) + 4 * n + (i & 3); }

struct Unit { int pm, pn; };
struct Gemm { const bf16_t* A; const bf16_t* Bt; int lda, K; };

template <class Epi, class Sched, bool STAMP = false>
__device__ __forceinline__ void gemm_phase(PG8_LAS unsigned char* lds, const Gemm g, const Sched& S, const Epi& E, unsigned long long* stamps) {
    const int tid = threadIdx.x, wid = __builtin_amdgcn_readfirstlane(tid >> 6), lane = tid & 63, wr = wid >> 2, wc = wid & 3, fr = lane & 15, fq = lane >> 4;
    const int K = g.K, nt = K / BK;
    int ts_lo = 0, ts_hi = 0, nts = 0; const unsigned long long rt_entry = STAMP ? (unsigned long long)wall_clock64() : 0ull;
#define PG8_STAMP() do { if (STAMP && wid == 0 && nts < 64) { const unsigned long long _c = (unsigned long long)clock64(); \
        ts_lo = (lane == nts) ? (int)(unsigned)_c : ts_lo; ts_hi = (lane == nts) ? (int)(unsigned)(_c >> 32) : ts_hi; ++nts; } } while (0)
    PG8_STAMP();
    unsigned voffA[2], voffB[2];
#pragma unroll
    for (int i = 0; i < 2; ++i) { int R, C; stage_rc(tid * 16 + i * 8192, R, C); const int Rb = Epi::PERM ? ((R & ~31) + perm32(R & 31)) : R;
        voffA[i] = (unsigned)(R * g.lda + C) * 2u; voffB[i] = (unsigned)(Rb * K + C) * 2u; }
    const size_t kstep = (size_t)(BK * 2);
    const size_t hstep = (size_t)HALF * K * 2, hstepA = (size_t)HALF * g.lda * 2;
    const size_t tstep = 2 * hstep, tstepA = 2 * hstepA;
    const unsigned ldsw = (unsigned)wid * 1024u;
    const int aoff = lds_byte(wr * 64 + fr, fq * 8), boff = lds_byte(wc * 32 + fr, fq * 8);
#define PG8_SA(b, h) (((b) * 2 + (h)) * HTB)
#define PG8_SB(b, h) ((4 + (b) * 2 + (h)) * HTB)
#define PG8_STAGE(bufoff, gbase, voff) do { _Pragma("unroll") for (int _i = 0; _i < 2; ++_i) \
        __builtin_amdgcn_global_load_lds((const unsigned*)((const char*)(gbase) + (voff)[_i]), (PG8_LAS unsigned*)(lds + (bufoff) + ldsw + _i * 8192), 16, 0, 0); } while (0)
#define PG8_LDA(dst, b, h) do { _Pragma("unroll") for (int m = 0; m < 4; ++m) _Pragma("unroll") for (int k = 0; k < 2; ++k) dst[m][k] = *(const PG8_LAS bf16x8*)(lds + PG8_SA(b, h) + aoff + m * 2048 + k * 1024); } while (0)
#define PG8_LDB(dst, b, h) do { _Pragma("unroll") for (int n = 0; n < 2; ++n) _Pragma("unroll") for (int k = 0; k < 2; ++k) dst[n][k] = *(const PG8_LAS bf16x8*)(lds + PG8_SB(b, h) + boff + n * 2048 + k * 1024); } while (0)
#define PG8_MMA(ai, bj, At, Bt) do { __builtin_amdgcn_s_setprio(1); _Pragma("unroll") for (int m = 0; m < 4; ++m) _Pragma("unroll") for (int n = 0; n < 2; ++n) _Pragma("unroll") for (int k = 0; k < 2; ++k) \
        acc[ai][bj][m][n] = __builtin_amdgcn_mfma_f32_16x16x32_bf16(Bt[n][k], At[m][k], acc[ai][bj][m][n], 0, 0, 0); __builtin_amdgcn_s_setprio(0); } while (0)
#define PG8_WAIT_V(n) asm volatile("s_waitcnt vmcnt(" #n ")" ::: "memory")
#define PG8_WAIT_L(n) asm volatile("s_waitcnt lgkmcnt(" #n ")" ::: "memory")
#define PG8_BAR __builtin_amdgcn_s_barrier()
#define PG8_SCHED __builtin_amdgcn_sched_barrier(0)
    Unit cur, nxt; int ui = 0;
    if (!S.next(0, cur)) return;
    f32x4 acc[2][2][4][2];
#pragma unroll
    for (int a = 0; a < 2; ++a)
#pragma unroll
        for (int b = 0; b < 2; ++b)
#pragma unroll
            for (int m = 0; m < 4; ++m)
#pragma unroll
                for (int n = 0; n < 2; ++n) acc[a][b][m][n] = (f32x4){0.f, 0.f, 0.f, 0.f};
    bf16x8 At[4][2], B0[2][2], B1[2][2];
    const char* cA = (const char*)g.A + (size_t)cur.pm * tstepA; const char* cB = (const char*)g.Bt + (size_t)cur.pn * tstep;
    S.a_ready(cur);
    PG8_STAGE(PG8_SB(0, 0), cB, voffB); PG8_STAGE(PG8_SA(0, 0), cA, voffA); PG8_STAGE(PG8_SB(0, 1), cB + hstep, voffB); PG8_STAGE(PG8_SA(0, 1), cA + hstepA, voffA);
    if (wr == 1) PG8_BAR;
    PG8_WAIT_V(4); PG8_BAR;
    PG8_STAGE(PG8_SB(1, 0), cB + kstep, voffB); PG8_STAGE(PG8_SA(1, 0), cA + kstep, voffA); PG8_STAGE(PG8_SB(1, 1), cB + hstep + kstep, voffB);
    PG8_WAIT_V(6); PG8_BAR;
    PG8_STAMP();
    for (;;) {
        const bool has_next = S.next(ui + 1, nxt);
        const char* nA = has_next ? (const char*)g.A + (size_t)nxt.pm * tstepA : cA; const char* nB = has_next ? (const char*)g.Bt + (size_t)nxt.pn * tstep : cB;
        for (int t = 0; t < nt; t += 2) {
            const bool last = (t == nt - 2);
            const char* a1 = cA + (size_t)(t + 1) * kstep;
            const char* a2 = last ? nA : cA + (size_t)(t + 2) * kstep; const char* b2 = last ? nB : cB + (size_t)(t + 2) * kstep;
            const char* a3 = a2 + kstep; const char* b3 = b2 + kstep;
            if (last && has_next) S.a_ready(nxt);
            PG8_LDB(B0, 0, 0); PG8_SCHED; PG8_LDA(At, 0, 0); PG8_STAGE(PG8_SA(1, 1), a1 + hstepA, voffA);
            PG8_WAIT_L(8); PG8_BAR; PG8_WAIT_L(0); PG8_MMA(0, 0, At, B0); PG8_BAR; PG8_SCHED;
            PG8_LDB(B1, 0, 1); PG8_STAGE(PG8_SB(0, 0), b2, voffB);
            PG8_BAR; PG8_WAIT_L(0); PG8_MMA(0, 1, At, B1); PG8_BAR;
            PG8_LDA(At, 0, 1); PG8_STAGE(PG8_SA(0, 0), a2, voffA);
            PG8_BAR; PG8_WAIT_L(0); PG8_MMA(1, 0, At, B0); PG8_BAR; PG8_SCHED;
            PG8_STAGE(PG8_SB(0, 1), b2 + hstep, voffB);
            PG8_WAIT_V(6); PG8_BAR; PG8_MMA(1, 1, At, B1); PG8_BAR;
            PG8_LDB(B0, 1, 0); PG8_SCHED; PG8_LDA(At, 1, 0); PG8_STAGE(PG8_SA(0, 1), a2 + hstepA, voffA);
            PG8_WAIT_L(8); PG8_BAR; PG8_WAIT_L(0); PG8_MMA(0, 0, At, B0); PG8_BAR; PG8_SCHED;
            PG8_LDB(B1, 1, 1); PG8_STAGE(PG8_SB(1, 0), b3, voffB);
            PG8_BAR; PG8_WAIT_L(0); PG8_MMA(0, 1, At, B1); PG8_BAR;
            PG8_LDA(At, 1, 1); PG8_STAGE(PG8_SA(1, 0), a3, voffA);
            PG8_BAR; PG8_WAIT_L(0); PG8_MMA(1, 0, At, B0); PG8_BAR; PG8_SCHED;
            PG8_STAGE(PG8_SB(1, 1), b3 + hstep, voffB);
            PG8_WAIT_V(6); PG8_BAR; PG8_MMA(1, 1, At, B1); PG8_BAR;
        }
        PG8_STAMP();
        if constexpr (!Epi::AFTER_DRAIN) { E(acc, cur, wr, wc, fr, fq); S.done(cur); }
        PG8_STAMP();
        if (!has_next) break;
#pragma unroll
        for (int a = 0; a < 2; ++a)
#pragma unroll
            for (int b = 0; b < 2; ++b)
#pragma unroll
                for (int m = 0; m < 4; ++m)
#pragma unroll
                    for (int n = 0; n < 2; ++n) acc[a][b][m][n] = (f32x4){0.f, 0.f, 0.f, 0.f};
        cur = nxt; cA = nA; cB = nB; ++ui;
    }
    PG8_WAIT_V(0);
    if (wr == 0) PG8_BAR;
    PG8_BAR;
    if constexpr (Epi::AFTER_DRAIN) { E.fused(acc, cur, wr, wc, fr, fq, lds, wid, lane); S.done(cur); }
    PG8_STAMP();
    if (STAMP && wid == 0) { stamps[lane] = lane < nts ? (((unsigned long long)(unsigned)ts_hi << 32) | (unsigned)ts_lo) : 0ull;
        if (lane == 62) stamps[62] = rt_entry; if (lane == 63) stamps[63] = (unsigned long long)wall_clock64(); }
#undef PG8_STAMP
#undef PG8_SA
#undef PG8_SB
#undef PG8_STAGE
#undef PG8_LDA
#undef PG8_LDB
#undef PG8_MMA
#undef PG8_WAIT_V
#undef PG8_WAIT_L
#undef PG8_BAR
#undef PG8_SCHED
}
}

struct XcdOrder {
    int nsn, nwt, ntn;
    DI bool next(int i, pg8::Unit& u) const {
        int mt, nt;
        if (gridDim.x == 256) { if (!gemm_map(i, nsn, nwt, mt, nt)) return false; }
        else { const int tile = i * (int)gridDim.x + (int)blockIdx.x; if (tile >= 128 * ntn) return false; mt = tile / ntn; nt = tile % ntn; }
        u.pm = mt; u.pn = nt; return true;
    }
    DI void a_ready(const pg8::Unit&) const {}
    DI void done(const pg8::Unit&) const {}
};
template <int ACT> struct EpiOutBf16 {
    static constexpr bool PERM = true, AFTER_DRAIN = false;
    bfu* O; int ldc, N;
    DI void operator()(const pg8::f32x4 (&acc)[2][2][4][2], const pg8::Unit& u, int wr, int wc, int fr, int fq) const {
        const int row0 = u.pm * 256 + wr * 64 + fr, col0 = u.pn * 256 + wc * 32 + 8 * fq;
#pragma unroll
        for (int ai = 0; ai < 2; ++ai)
#pragma unroll
            for (int m = 0; m < 4; ++m) {
                bfu* rowp = O + (size_t)(row0 + ai * 128 + m * 16) * ldc + col0;
#pragma unroll
                for (int bj = 0; bj < 2; ++bj) {
                    pg8::f32x4 v0 = acc[ai][bj][m][0], v1 = acc[ai][bj][m][1];
                    if (ACT == 1) {
#pragma unroll
                        for (int j = 0; j < 4; ++j) { const float a = fmaxf(v0[j], 0.f), b = fmaxf(v1[j], 0.f); v0[j] = a * a; v1[j] = b * b; }
                    }
                    if (col0 + bj * 128 < N) *(u32x4*)(rowp + bj * 128) = (u32x4){pk2(v0[0], v0[1]), pk2(v0[2], v0[3]), pk2(v1[0], v1[1]), pk2(v1[2], v1[3])};
                }
            }
    }
};
struct EpiResid {
    static constexpr bool PERM = false, AFTER_DRAIN = false;
    const float* resid; float* out; const float* gate;
    DI void operator()(const pg8::f32x4 (&acc)[2][2][4][2], const pg8::Unit& u, int wr, int wc, int fr, int fq) const {
        const int row0 = u.pm * 256 + wr * 64 + fr, col0 = u.pn * 256 + wc * 32 + 4 * fq;
        const float* gb = gate + ((u.pm * 256) >> 13) * 6144 + col0;
        pg8::f32x4 gv[2][2];
#pragma unroll
        for (int bj = 0; bj < 2; ++bj)
#pragma unroll
            for (int n = 0; n < 2; ++n) gv[bj][n] = *(const pg8::f32x4*)(gb + bj * 128 + n * 16);
#pragma unroll
        for (int ai = 0; ai < 2; ++ai)
#pragma unroll
            for (int m = 0; m < 4; ++m) {
                const size_t ro = (size_t)(row0 + ai * 128 + m * 16) * 1024 + col0;
#pragma unroll
                for (int bj = 0; bj < 2; ++bj)
#pragma unroll
                    for (int n = 0; n < 2; ++n) {
                        const pg8::f32x4 r = *(const pg8::f32x4*)(resid + ro + bj * 128 + n * 16);
                        *(pg8::f32x4*)(out + ro + bj * 128 + n * 16) = r + gv[bj][n] * acc[ai][bj][m][n];
                    }
            }
    }
};
template <int EPI>
DI void phase_gemm8(const bfu* A, int lda, const bfu* Bt, int K, int N, int ntn, bfu* Cb, int ldc, const float* resid, float* outf, const float* gate, char* smem) {
    pg8::Gemm g; g.A = A; g.Bt = Bt; g.lda = lda; g.K = K;
    XcdOrder S; S.ntn = ntn; S.nwt = (ntn % 4 == 0) ? 4 : ntn; S.nsn = ntn / S.nwt;
    __syncthreads();
    if (EPI == 2) { EpiResid E; E.resid = resid; E.out = outf; E.gate = gate; pg8::gemm_phase<EpiResid, XcdOrder, false>((PG8_LAS unsigned char*)smem, g, S, E, nullptr); }
    else { EpiOutBf16<EPI> E; E.O = Cb; E.ldc = ldc; E.N = N; pg8::gemm_phase<EpiOutBf16<EPI>, XcdOrder, false>((PG8_LAS unsigned char*)smem, g, S, E, nullptr); }
    __syncthreads();
}


struct EpiHeads {
    static constexpr bool PERM = true, AFTER_DRAIN = false;
    bfu* O; const float2* rope; const float *w_dq, *w_dk, *w_mq, *w_mk; float* kpart;
    DI void operator()(const pg8::f32x4 (&acc)[2][2][4][2], const pg8::Unit& u, int wr, int wc, int fr, int fq) const {
        const int pn = u.pn;
        const int kind = (pn < 2) ? 1 : (pn < 4) ? 2 : (pn < 6) ? 0 : (pn < 8) ? 3 : (pn < 10) ? 4 : 0;
        const float scale = (kind == 1 || kind == 3) ? SC_64 : 1.f;
        const int colbase = pn * 256 + wc * 64 + 8 * fq;
        float wa[8], wb[8];
#pragma unroll
        for (int e = 0; e < 8; ++e) {
            const int d = 8 * fq + e;
            const float a1 = w_dq[d], a2 = w_dk[d], a3 = w_mq[d], a4 = w_mk[d], b1 = w_dq[32 + d], b2 = w_dk[32 + d], b3 = w_mq[32 + d], b4 = w_mk[32 + d];
            wa[e] = ((kind == 1) ? a1 : (kind == 2) ? a2 : (kind == 3) ? a3 : a4) * scale;
            wb[e] = ((kind == 1) ? b1 : (kind == 2) ? b2 : (kind == 3) ? b3 : b4) * scale;
        }
#pragma unroll
        for (int ai = 0; ai < 2; ++ai) {
            float ks1[8], ks2[8];
#pragma unroll
            for (int e = 0; e < 8; ++e) { ks1[e] = 0.f; ks2[e] = 0.f; }
#pragma unroll
            for (int m = 0; m < 4; ++m) {
                const int row = u.pm * 256 + ai * 128 + wr * 64 + m * 16 + fr;
                float x1[8], x2[8];
#pragma unroll
                for (int e = 0; e < 8; ++e) { x1[e] = acc[ai][0][m][e >> 2][e & 3]; x2[e] = acc[ai][1][m][e >> 2][e & 3]; }
                if (kind) {
                    float ss = 0.f;
#pragma unroll
                    for (int e = 0; e < 8; ++e) ss += x1[e] * x1[e] + x2[e] * x2[e];
                    ss += __shfl_xor(ss, 16); ss += __shfl_xor(ss, 32);
                    const float r = rsqrtf(ss * (1.f / 64.f) + EPS);
                    const float4* cp = (const float4*)(rope + (size_t)row * 32 + 8 * fq);
#pragma unroll
                    for (int e2 = 0; e2 < 4; ++e2) {
                        const float4 cs = cp[e2];
                        {   const int e = 2 * e2; const float y1 = x1[e] * r * wa[e], y2 = x2[e] * r * wb[e];
                            x1[e] = y1 * cs.x - y2 * cs.y; x2[e] = y2 * cs.x + y1 * cs.y; }
                        {   const int e = 2 * e2 + 1; const float y1 = x1[e] * r * wa[e], y2 = x2[e] * r * wb[e];
                            x1[e] = y1 * cs.z - y2 * cs.w; x2[e] = y2 * cs.z + y1 * cs.w; }
                    }
                    if (kind == 4) {
#pragma unroll
                        for (int e = 0; e < 8; ++e) { ks1[e] += x1[e]; ks2[e] += x2[e]; }
                    }
                }
                bfu* rowp = O + (size_t)row * 3072 + colbase;
                *(u32x4*)rowp = (u32x4){pk2(x1[0], x1[1]), pk2(x1[2], x1[3]), pk2(x1[4], x1[5]), pk2(x1[6], x1[7])};
                *(u32x4*)(rowp + 32) = (u32x4){pk2(x2[0], x2[1]), pk2(x2[2], x2[3]), pk2(x2[4], x2[5]), pk2(x2[6], x2[7])};
            }
            if (kind == 4) {
#pragma unroll
                for (int e = 0; e < 8; ++e) {
                    float a = ks1[e], b = ks2[e];
                    a += __shfl_xor(a, 1); a += __shfl_xor(a, 2); a += __shfl_xor(a, 4); a += __shfl_xor(a, 8);
                    b += __shfl_xor(b, 1); b += __shfl_xor(b, 2); b += __shfl_xor(b, 4); b += __shfl_xor(b, 8);
                    ks1[e] = a; ks2[e] = b;
                }
                if (fr == 0) {
                    float* kp = kpart + (size_t)(4 * u.pm + 2 * ai + wr) * 512 + ((pn - 8) * 4 + wc) * 64 + 8 * fq;
#pragma unroll
                    for (int e = 0; e < 8; ++e) { kp[e] = ks1[e]; kp[32 + e] = ks2[e]; }
                }
            }
        }
    }
};
DI void phase_gemm_heads(const Params& p, const bfu* A, const bfu* Bt, bfu* O, char* smem) {
    pg8::Gemm g; g.A = A; g.Bt = Bt; g.lda = 1024; g.K = 1024;
    XcdOrder S; S.ntn = 12; S.nwt = 4; S.nsn = 3;
    EpiHeads E; E.O = O; E.rope = (const float2*)(p.ws + OFF_ROPE64); E.w_dq = p.diff_qn; E.w_dk = p.diff_kn; E.w_mq = p.moba_qn; E.w_mk = p.moba_kn;
    E.kpart = (float*)(p.ws + OFF_KPART);
    __syncthreads();
    pg8::gemm_phase<EpiHeads, XcdOrder, false>((PG8_LAS unsigned char*)smem, g, S, E, nullptr);
    __syncthreads();
}

#ifndef MK_PROBE
#define MK_PROBE 0
#endif
#if MK_PROBE
template <int VAR>
DI void gemm_probe(const bfu* __restrict__ A, int lda, const bfu* __restrict__ Bt, int K, int m0, int n0, float* sinkp, int sink, char* smem) {
    constexpr int STG = 512 * 72;
    bfu* S0 = (bfu*)smem;
    const int tid = threadIdx.x, lane = tid & 63, wid = tid >> 6, l32 = lane & 31, hi = lane >> 5;
    const int wm = wid & 3, wn = wid >> 2;
    f32x16 acc[4][2];
#pragma unroll
    for (int nb = 0; nb < 4; ++nb)
#pragma unroll
        for (int mb = 0; mb < 2; ++mb)
#pragma unroll
            for (int r = 0; r < 16; ++r) acc[nb][mb][r] = 0.f;
    const bfu* Ag = A + (size_t)(m0 + (tid >> 3)) * lda + (tid & 7) * 8;
    const bfu* Bg = Bt + (size_t)(n0 + (tid >> 3)) * K + (tid & 7) * 8;
    u32x4 ra[4], rb[4];
#pragma unroll
    for (int i = 0; i < 4; ++i) { ra[i] = *(const u32x4*)(Ag + (size_t)(64 * i) * lda); rb[i] = *(const u32x4*)(Bg + (size_t)(64 * i) * K); }
    const int nk = K >> 6;
    const int wofs = (tid >> 3) * 72 + (tid & 7) * 8;
    const int arofs = (wm * 64 + l32) * 72 + hi * 8, brofs = 256 * 72 + (wn * 128 + l32) * 72 + hi * 8;
    __syncthreads();
#pragma unroll
    for (int i = 0; i < 4; ++i) { *(u32x4*)(S0 + wofs + 64 * i * 72) = ra[i]; *(u32x4*)(S0 + 256 * 72 + wofs + 64 * i * 72) = rb[i]; }
    __syncthreads();
#pragma unroll 1
    for (int kt = 0; kt < nk; ++kt) {
        const bfu* Sc = S0 + (kt & 1) * STG; bfu* Sn = S0 + ((kt & 1) ^ 1) * STG;
        if (VAR != 2 && kt + 1 < nk) {
#pragma unroll
            for (int i = 0; i < 4; ++i) { *(u32x4*)(Sn + wofs + 64 * i * 72) = ra[i]; *(u32x4*)(Sn + 256 * 72 + wofs + 64 * i * 72) = rb[i]; }
        }
        __builtin_amdgcn_sched_barrier(0);
        if (VAR != 1 && VAR != 2 && kt + 2 < nk) {
            const int ko = (kt + 2) * 64;
#pragma unroll
            for (int i = 0; i < 4; ++i) { ra[i] = *(const u32x4*)(Ag + (size_t)(64 * i) * lda + ko); rb[i] = *(const u32x4*)(Bg + (size_t)(64 * i) * K + ko); }
        }
        __builtin_amdgcn_sched_barrier(0);
        if (VAR == 3) {
            bf16x8 af[2], bfr[4];
#pragma unroll
            for (int mb = 0; mb < 2; ++mb) af[mb] = *(const bf16x8*)(Sc + arofs + mb * 32 * 72);
#pragma unroll
            for (int nb = 0; nb < 4; ++nb) bfr[nb] = *(const bf16x8*)(Sc + brofs + nb * 32 * 72);
#pragma unroll
            for (int k16 = 0; k16 < 4; ++k16)
#pragma unroll
                for (int nb = 0; nb < 4; ++nb)
#pragma unroll
                    for (int mb = 0; mb < 2; ++mb) acc[nb][mb] = MFMA(bfr[nb], af[mb], acc[nb][mb]);
        } else {
#pragma unroll
            for (int k16 = 0; k16 < 4; ++k16) {
                bf16x8 af[2], bfr[4];
#pragma unroll
                for (int mb = 0; mb < 2; ++mb) af[mb] = *(const bf16x8*)(Sc + arofs + mb * 32 * 72 + k16 * 16);
#pragma unroll
                for (int nb = 0; nb < 4; ++nb) bfr[nb] = *(const bf16x8*)(Sc + brofs + nb * 32 * 72 + k16 * 16);
#pragma unroll
                for (int nb = 0; nb < 4; ++nb)
#pragma unroll
                    for (int mb = 0; mb < 2; ++mb) acc[nb][mb] = MFMA(bfr[nb], af[mb], acc[nb][mb]);
            }
        }
        __syncthreads();
    }
    if (sink) {
#pragma unroll
        for (int nb = 0; nb < 4; ++nb)
#pragma unroll
            for (int mb = 0; mb < 2; ++mb)
#pragma unroll
                for (int r = 0; r < 16; ++r) sinkp[tid * 128 + (nb * 2 + mb) * 16 + r] = acc[nb][mb][r];
    }
}
template <int VAR>
DI void phase_gemm_probe(const bfu* A, const bfu* Bt, float* sinkp, int sink, char* smem) {
    for (int r = 0; r < 6; ++r) { int mt, nt; if (gemm_map(r, 3, 4, mt, nt)) gemm_probe<VAR>(A, 1024, Bt, 1024, mt * 256, nt * 256, sinkp, sink, smem); }
}
#endif

DI void headnorm64(bfu* hp, const float* __restrict__ w, const float2* __restrict__ cs, float scale, int j, bool acc_on, f32x4& ka1, f32x4& ka2) {
    const u32x2 a = *(const u32x2*)(hp + 4 * j), b = *(const u32x2*)(hp + 32 + 4 * j);
    float x1[4] = {bflo(a[0]), bfhi(a[0]), bflo(a[1]), bfhi(a[1])}, x2[4] = {bflo(b[0]), bfhi(b[0]), bflo(b[1]), bfhi(b[1])};
    float ss = 0.f;
#pragma unroll
    for (int e = 0; e < 4; ++e) ss += x1[e] * x1[e] + x2[e] * x2[e];
    ss += __shfl_xor(ss, 1); ss += __shfl_xor(ss, 2); ss += __shfl_xor(ss, 4);
    const float r = rsqrtf(ss * (1.f / 64.f) + EPS);
    const float4 w1 = *(const float4*)(w + 4 * j), w2 = *(const float4*)(w + 32 + 4 * j);
    const float wa[4] = {w1.x, w1.y, w1.z, w1.w}, wb[4] = {w2.x, w2.y, w2.z, w2.w};
    float o1[4], o2[4];
#pragma unroll
    for (int e = 0; e < 4; ++e) {
        const float y1 = x1[e] * r * wa[e], y2 = x2[e] * r * wb[e]; const float2 c = cs[4 * j + e];
        o1[e] = y1 * c.x - y2 * c.y; o2[e] = y2 * c.x + y1 * c.y;
    }
    if (acc_on) {
#pragma unroll
        for (int e = 0; e < 4; ++e) { ka1[e] += o1[e]; ka2[e] += o2[e]; }
    }
    *(u32x2*)(hp + 4 * j) = (u32x2){pk2(o1[0] * scale, o1[1] * scale), pk2(o1[2] * scale, o1[3] * scale)};
    *(u32x2*)(hp + 32 + 4 * j) = (u32x2){pk2(o2[0] * scale, o2[1] * scale), pk2(o2[2] * scale, o2[3] * scale)};
}

DI float sq4(u32x2 a) { const float x0 = bflo(a[0]), x1 = bfhi(a[0]), x2 = bflo(a[1]), x3 = bfhi(a[1]); return x0 * x0 + x1 * x1 + x2 * x2 + x3 * x3; }

DI void mla_head(u32x4 nv, unsigned x1, unsigned x2, float rn, float rr, const float* __restrict__ wn, int j, float2 csA, float2 csB, float scale, bfu* dst) {
    float f[8] = {bflo(nv[0]) * rn, bfhi(nv[0]) * rn, bflo(nv[1]) * rn, bfhi(nv[1]) * rn, bflo(nv[2]) * rn, bfhi(nv[2]) * rn, bflo(nv[3]) * rn, bfhi(nv[3]) * rn};
    const float a0 = bflo(x1) * rr, a1 = bfhi(x1) * rr, b0 = bflo(x2) * rr, b1 = bfhi(x2) * rr;
    float ss = a0 * a0 + a1 * a1 + b0 * b0 + b1 * b1;
#pragma unroll
    for (int e = 0; e < 8; ++e) ss += f[e] * f[e];
    ss += __shfl_xor(ss, 1); ss += __shfl_xor(ss, 2); ss += __shfl_xor(ss, 4);
    const float r = rsqrtf(ss * (1.f / 96.f) + EPS) * scale;
    const float4 wA = *(const float4*)(wn + 8 * j), wB = *(const float4*)(wn + 8 * j + 4);
    const float wv[8] = {wA.x, wA.y, wA.z, wA.w, wB.x, wB.y, wB.z, wB.w};
#pragma unroll
    for (int e = 0; e < 8; ++e) f[e] *= r * wv[e];
    *(u32x4*)(dst + 8 * j) = (u32x4){pk2(f[0], f[1]), pk2(f[2], f[3]), pk2(f[4], f[5]), pk2(f[6], f[7])};
    const float y10 = a0 * r * wn[64 + 2 * j], y11 = a1 * r * wn[65 + 2 * j], y20 = b0 * r * wn[80 + 2 * j], y21 = b1 * r * wn[81 + 2 * j];
    *(unsigned*)(dst + 64 + 2 * j) = pk2(y10 * csA.x - y20 * csA.y, y11 * csB.x - y21 * csB.y);
    *(unsigned*)(dst + 80 + 2 * j) = pk2(y20 * csA.x + y10 * csA.y, y21 * csB.x + y11 * csB.y);
}

DI void phase_post_even(const Params& p) {
    char* ws = p.ws;
    bfu* ubuf = (bfu*)(ws + OFF_UBUF); const bfu* qraw = (const bfu*)(ws + OFF_HBUF); const bfu* kvraw = (const bfu*)(ws + OFF_OBUF);
    bfu* Qa = (bfu*)p.out; bfu* Ka = Qa + (size_t)T * 768; bfu* Va = Ka + (size_t)T * 768;
    const float2* r64 = (const float2*)(ws + OFF_ROPE64); const float2* r32 = (const float2*)(ws + OFF_ROPE32);
    const int lane = threadIdx.x & 63, gw = blockIdx.x * NW + (threadIdx.x >> 6), nwv = gridDim.x * NW;
    const int h = lane >> 3, j = lane & 7;
    for (int t = gw; t < T; t += nwv) {
        bfu* ur = ubuf + (size_t)t * 3072;
        float ssq = sq4(*(const u32x2*)(ur + lane * 4));
        if (lane < 32) ssq += sq4(*(const u32x2*)(ur + 256 + lane * 4));
        float sskv = sq4(*(const u32x2*)(ur + 384 + lane * 4));
        ssq = wave_sum(ssq); sskv = wave_sum(sskv);
        const float rq = rsqrtf(ssq * (1.f / 384.f) + EPS), rkv = rsqrtf(sskv * (1.f / 256.f) + EPS);
        const float2 csA = r32[(size_t)t * 16 + 2 * j], csB = r32[(size_t)t * 16 + 2 * j + 1];
        {
            const bfu* qr = qraw + (size_t)t * 768 + h * 96;
            mla_head(*(const u32x4*)(qr + 8 * j), *(const unsigned*)(qr + 64 + 2 * j), *(const unsigned*)(qr + 80 + 2 * j), rq, rq, p.mla_qn, j, csA, csB, SC_MLA, Qa + (size_t)t * 768 + h * 96);
        }
        {
            const bfu* kr = kvraw + (size_t)t * 1024 + h * 128;
            mla_head(*(const u32x4*)(kr + 8 * j), *(const unsigned*)(ur + 640 + 2 * j), *(const unsigned*)(ur + 656 + 2 * j), rkv, 1.f, p.mla_kn, j, csA, csB, 1.f, Ka + (size_t)t * 768 + h * 96);
            const u32x4 vv = *(const u32x4*)(kr + 64 + 8 * j);
            *(u32x4*)(Va + (size_t)t * 512 + h * 64 + 8 * j) = (u32x4){pk2(bflo(vv[0]) * rkv, bfhi(vv[0]) * rkv), pk2(bflo(vv[1]) * rkv, bfhi(vv[1]) * rkv),
                                                                      pk2(bflo(vv[2]) * rkv, bfhi(vv[2]) * rkv), pk2(bflo(vv[3]) * rkv, bfhi(vv[3]) * rkv)};
        }
        f32x4 d1, d2;
#pragma unroll
        for (int rd = 0; rd < 3; ++rd) {
            const int hh = rd * 8 + h, which = hh / 12, gh = hh % 12;
            headnorm64(ur + 672 + which * 768 + gh * 64, which ? p.dil_kn : p.dil_qn, r64 + (size_t)t * 32, which ? 1.f : SC_64, j, false, d1, d2);
        }
    }
}

DI void phase_post_odd(const Params& p, char* smem) {
    char* ws = p.ws;
    bfu* ubuf = (bfu*)(ws + OFF_UBUF); const float2* r64 = (const float2*)(ws + OFF_ROPE64); float* kpart = (float*)(ws + OFF_KPART);
    const int tid = threadIdx.x, lane = tid & 63, wid = tid >> 6, h = lane >> 3, j = lane & 7;
    float* red = (float*)smem;
    for (int it = blockIdx.x; it < T / 64; it += gridDim.x) {
        f32x4 ka1 = {0.f, 0.f, 0.f, 0.f}, ka2 = {0.f, 0.f, 0.f, 0.f}, d1, d2;
        for (int tt = 0; tt < 8; ++tt) {
            const int t = it * 64 + wid * 8 + tt;
            bfu* ur = ubuf + (size_t)t * 3072; const float2* cs = r64 + (size_t)t * 32;
            headnorm64(ur + h * 64, p.diff_qn, cs, SC_64, j, false, d1, d2);
            headnorm64(ur + 512 + h * 64, p.diff_kn, cs, 1.f, j, false, d1, d2);
            headnorm64(ur + 1536 + h * 64, p.moba_qn, cs, SC_64, j, false, d1, d2);
            headnorm64(ur + 2048 + h * 64, p.moba_kn, cs, 1.f, j, true, ka1, ka2);
        }
        __syncthreads();
#pragma unroll
        for (int e = 0; e < 4; ++e) { red[(wid * 64 + lane) * 8 + e] = ka1[e]; red[(wid * 64 + lane) * 8 + 4 + e] = ka2[e]; }
        __syncthreads();
        {
            const int o = tid, hh = o >> 6, d = o & 63, jj = (d & 31) >> 2, e = (d & 3) + ((d >> 5) << 2), ln = hh * 8 + jj;
            float sum = 0.f;
#pragma unroll
            for (int w = 0; w < NW; ++w) sum += red[(w * 64 + ln) * 8 + e];
            kpart[(size_t)it * 512 + o] = sum;
        }
    }
    __syncthreads();
}

DI void phase_dil_merge(const Params& p) {
    const bfu* dil_o = (const bfu*)(p.ws + OFF_HBUF); const float* dil_lse = (const float*)(p.ws + OFF_HBUF + 48 * MiB);
    bfu* obuf = (bfu*)(p.ws + OFF_OBUF);
    for (int idx = blockIdx.x * NT + threadIdx.x; idx < T * 64; idx += gridDim.x * NT) {
        const int t = idx >> 6, r = idx & 63, h = r >> 4, jj = r & 15;
        const float l0 = dil_lse[(size_t)t * 12 + h], l1 = dil_lse[(size_t)t * 12 + 4 + h], l2 = dil_lse[(size_t)t * 12 + 8 + h];
        const float mx = fmaxf(l0, fmaxf(l1, l2));
        float w0 = exp2f(l0 - mx), w1 = exp2f(l1 - mx), w2 = exp2f(l2 - mx); const float inv = 1.f / (w0 + w1 + w2); w0 *= inv; w1 *= inv; w2 *= inv;
        const u32x2 a = *(const u32x2*)(dil_o + (size_t)t * 768 + h * 64 + 4 * jj), b = *(const u32x2*)(dil_o + (size_t)t * 768 + (4 + h) * 64 + 4 * jj),
                    c = *(const u32x2*)(dil_o + (size_t)t * 768 + (8 + h) * 64 + 4 * jj);
        const float o0 = w0 * bflo(a[0]) + w1 * bflo(b[0]) + w2 * bflo(c[0]), o1 = w0 * bfhi(a[0]) + w1 * bfhi(b[0]) + w2 * bfhi(c[0]);
        const float o2 = w0 * bflo(a[1]) + w1 * bflo(b[1]) + w2 * bflo(c[1]), o3 = w0 * bfhi(a[1]) + w1 * bfhi(b[1]) + w2 * bfhi(c[1]);
        *(u32x2*)(obuf + (size_t)t * 768 + 512 + h * 64 + 4 * jj) = (u32x2){pk2(o0, o1), pk2(o2, o3)};
    }
}

DI void phase_diff_combine(const Params& p) {
    const bfu* dbuf = (const bfu*)(p.ws + OFF_DBUF); bfu* obuf = (bfu*)(p.ws + OFF_OBUF);
    const int lane = threadIdx.x & 63, gw = blockIdx.x * NW + (threadIdx.x >> 6), nwv = gridDim.x * NW;
    float lam;
    {
        const float sa = wave_sum(p.diff_lam[lane] * p.diff_lam[64 + lane]), sb = wave_sum(p.diff_lam[128 + lane] * p.diff_lam[192 + lane]);
        lam = expf(sa) - expf(sb) + LAM_INIT;
    }
    const int h = lane >> 4, jj = lane & 15;
    const float4 sA = *(const float4*)(p.diff_subln + 8 * jj), sB = *(const float4*)(p.diff_subln + 8 * jj + 4);
    const float sw[8] = {sA.x, sA.y, sA.z, sA.w, sB.x, sB.y, sB.z, sB.w};
    for (int t = gw; t < T; t += nwv) {
        const u32x4 a = *(const u32x4*)(dbuf + (size_t)t * 1024 + (2 * h) * 128 + 8 * jj), b = *(const u32x4*)(dbuf + (size_t)t * 1024 + (2 * h + 1) * 128 + 8 * jj);
        float d[8];
#pragma unroll
        for (int e = 0; e < 4; ++e) { d[2 * e] = bflo(a[e]) - lam * bflo(b[e]); d[2 * e + 1] = bfhi(a[e]) - lam * bfhi(b[e]); }
        float ss = 0.f;
#pragma unroll
        for (int e = 0; e < 8; ++e) ss += d[e] * d[e];
        ss += __shfl_xor(ss, 1); ss += __shfl_xor(ss, 2); ss += __shfl_xor(ss, 4); ss += __shfl_xor(ss, 8);
        const float r = rsqrtf(ss * (1.f / 128.f) + EPS) * (1.f - LAM_INIT);
#pragma unroll
        for (int e = 0; e < 8; ++e) d[e] *= r * sw[e];
        *(u32x4*)(obuf + (size_t)t * 1024 + h * 128 + 8 * jj) = (u32x4){pk2(d[0], d[1]), pk2(d[2], d[3]), pk2(d[4], d[5]), pk2(d[6], d[7])};
    }
    {
        const bfu* po01 = (const bfu*)(p.ws + OFF_HBUF); const bfu* po2 = (const bfu*)(p.ws + OFF_PO2); const float* plse = (const float*)(p.ws + OFF_PLSE);
        const int hm = lane >> 3, j8 = (lane & 7) * 8;
        for (int t = gw; t < T; t += nwv) {
            const float4 ls = *(const float4*)(plse + ((size_t)t * 8 + hm) * 4);
            const float mx = fmaxf(fmaxf(ls.x, ls.y), fmaxf(ls.z, ls.w));
            float w0 = exp2f(ls.x - mx), w1 = exp2f(ls.y - mx), w2 = exp2f(ls.z - mx), w3 = exp2f(ls.w - mx);
            const float inv = 1.f / (w0 + w1 + w2 + w3); w0 *= inv; w1 *= inv; w2 *= inv; w3 *= inv;
            bfu* dst = obuf + (size_t)t * 1024 + 512 + hm * 64 + j8;
            const u32x4 z = {0u, 0u, 0u, 0u};
            const u32x4 a0 = (w0 > 0.f) ? *(const u32x4*)(po01 + (size_t)t * 512 + hm * 64 + j8) : z;
            const u32x4 a1 = (w1 > 0.f) ? *(const u32x4*)(po01 + (size_t)T * 512 + (size_t)t * 512 + hm * 64 + j8) : z;
            const u32x4 a2 = (w2 > 0.f) ? *(const u32x4*)(po2 + (size_t)t * 512 + hm * 64 + j8) : z;
            const u32x4 a3 = *(const u32x4*)dst;
            unsigned r[4];
#pragma unroll
            for (int e = 0; e < 4; ++e) {
                const float lo = w0 * bflo(a0[e]) + w1 * bflo(a1[e]) + w2 * bflo(a2[e]) + w3 * bflo(a3[e]);
                const float hi = w0 * bfhi(a0[e]) + w1 * bfhi(a1[e]) + w2 * bfhi(a2[e]) + w3 * bfhi(a3[e]);
                r[e] = pk2(lo, hi);
            }
            *(u32x4*)dst = (u32x4){r[0], r[1], r[2], r[3]};
        }
    }
}

struct Top3 { float v0, v1, v2; int i0, i1, i2; };
DI Top3 top3_ins(Top3 t, float v, int i) {
    const bool g0 = (v > t.v0) || (v == t.v0 && i < t.i0), g1 = (v > t.v1) || (v == t.v1 && i < t.i1), g2 = (v > t.v2) || (v == t.v2 && i < t.i2);
    Top3 r;
    r.v2 = g1 ? t.v1 : (g2 ? v : t.v2); r.i2 = g1 ? t.i1 : (g2 ? i : t.i2);
    r.v1 = g0 ? t.v0 : (g1 ? v : t.v1); r.i1 = g0 ? t.i0 : (g1 ? i : t.i1);
    r.v0 = g0 ? v : t.v0; r.i0 = g0 ? i : t.i0;
    return r;
}

struct MobaG {
    const int* cnt; const unsigned short* seg; int chunk, jblk, tokbase, h; bfu *po01, *po2; float* plse;
};
template <int DK, int DV, int MODE>
DI void attn_item(const bfu* __restrict__ Qp, int qp, const bfu* __restrict__ Kp, int kp, const bfu* __restrict__ Vp, int vp,
                  long rowbase, int rs, int q0, bfu* __restrict__ Op, int op, float* __restrict__ lsep, int lsest,
                  const float* __restrict__ kpart, char* smem, int jfirst = 0, const MobaG* mg = nullptr) {
    constexpr int KPT = DK + 8, KCH = DK / 8, VCH = DV / 8, NKL = (64 * KCH + NT - 1) / NT, NVL = 64 * VCH / NT, NDV = DV / 32, ND0 = DK / 16;
    constexpr int KST = 64 * KPT, VST = 64 * DV;
    bfu* Ks = (bfu*)smem; bfu* Vs = Ks + 3 * KST;
    short* tlist = (short*)(Vs + 3 * VST);
    int* misc = (int*)(tlist + 192);
    float* km = (float*)(misc + 4);
    unsigned* selm = (unsigned*)(km + 2048);
    float* cand = (float*)(selm + 256);
    const int tid = threadIdx.x, lane = tid & 63, wid = tid >> 6, l32 = lane & 31, hi = lane >> 5;
    const int qw = q0 + wid * 32, qstep = qw + l32;
    unsigned mysel = 0;
    bool g_active = true; size_t g_tok = 0; int g_slot = 0, g_total = 0;
    if (MODE == 3) {
        const int myc = (lane < 32 && lane > mg->jblk) ? mg->cnt[lane] : 0;
        int inc = myc;
#pragma unroll
        for (int d = 1; d < 32; d <<= 1) { const int t_ = __shfl_up(inc, d); if ((lane & 31) >= d) inc += t_; }
        const int exc = inc - myc;
        g_total = __builtin_amdgcn_readlane(inc, 31);
        const int pp = mg->chunk * 256 + wid * 32 + l32;
        g_active = pp < g_total;
        int n = 31, pbase = __builtin_amdgcn_readlane(exc, 31);
#pragma unroll
        for (int c = 31; c >= 1; --c) { const int pc = __builtin_amdgcn_readlane(exc, c); if (pp < pc) { n = c - 1; } }
#pragma unroll
        for (int c = 0; c < 32; ++c) { const int pc = __builtin_amdgcn_readlane(exc, c); if (c == n) pbase = pc; }
        const unsigned short e = g_active ? mg->seg[(size_t)n * 256 + (pp - pbase)] : (unsigned short)0;
        g_slot = e >> 8;
        g_tok = (size_t)mg->tokbase + (g_active ? (size_t)(n * 256 + (e & 255)) : 0);
    }
    if (MODE == 2) {
        const int nb = q0 >> 8;
        for (int idx = tid; idx < nb * 64; idx += NT) {
            const int blk = idx >> 6, d = idx & 63; const float* kq = kpart + (size_t)(blk * 4) * 512 + d;
            km[idx] = (kq[0] + kq[512] + kq[1024] + kq[1536]) * (1.f / 256.f);
        }
        if (tid == 0) misc[1] = 0;
        __syncthreads();
        {
            const int qq = tid & 255, hf = tid >> 8;
            const bfu* qr = Qp + (size_t)(rowbase + q0 + qq) * qp;
            float qv[64];
#pragma unroll
            for (int c8 = 0; c8 < 8; ++c8) {
                const u32x4 w = *(const u32x4*)(qr + c8 * 8);
#pragma unroll
                for (int e = 0; e < 4; ++e) { qv[c8 * 8 + 2 * e] = bflo(w[e]); qv[c8 * 8 + 2 * e + 1] = bfhi(w[e]); }
            }
            Top3 tp; tp.v0 = -3e38f; tp.v1 = -3e38f; tp.v2 = -3e38f; tp.i0 = 64; tp.i1 = 64; tp.i2 = 64;
            for (int blk = hf; blk < nb; blk += 2) {
                float g = 0.f;
#pragma unroll
                for (int d = 0; d < 64; ++d) g += qv[d] * km[blk * 64 + d];
                tp = top3_ins(tp, g, blk);
            }
            cand[tid * 6 + 0] = tp.v0; cand[tid * 6 + 1] = tp.v1; cand[tid * 6 + 2] = tp.v2;
            cand[tid * 6 + 3] = __int_as_float(tp.i0); cand[tid * 6 + 4] = __int_as_float(tp.i1); cand[tid * 6 + 5] = __int_as_float(tp.i2);
        }
        __syncthreads();
        if (tid < 256) {
            Top3 tp; tp.v0 = cand[tid * 6]; tp.v1 = cand[tid * 6 + 1]; tp.v2 = cand[tid * 6 + 2];
            tp.i0 = __float_as_int(cand[tid * 6 + 3]); tp.i1 = __float_as_int(cand[tid * 6 + 4]); tp.i2 = __float_as_int(cand[tid * 6 + 5]);
            const int o = (tid + 256) * 6;
#pragma unroll
            for (int e = 0; e < 3; ++e) { const int ii = __float_as_int(cand[o + 3 + e]); tp = top3_ins(tp, cand[o + e], ii); }
            unsigned mk = 0;
            if (tp.i0 < 32) mk |= 1u << tp.i0;
            if (tp.i1 < 32) mk |= 1u << tp.i1;
            if (tp.i2 < 32) mk |= 1u << tp.i2;
            selm[tid] = mk;
            atomicOr((unsigned*)&misc[1], mk);
        }
        __syncthreads();
        mysel = selm[wid * 32 + l32];
    }
    int jbase = 0, nt;
    if (MODE == 0) { jbase = jfirst; nt = (q0 >> 6) + 4 - jfirst; }
    else if (MODE == 1) { jbase = (q0 >> 6) >= 2 ? (q0 >> 6) - 2 : 0; nt = (q0 >> 6) + 4 - jbase; }
    else if (MODE == 3) { jbase = mg->jblk * 4; nt = 4; }
    else {
        if (tid == 0) {
            const unsigned om = (unsigned)misc[1]; const int nb = q0 >> 8; int n = 0;
            for (int blk = 0; blk < nb; ++blk) if ((om >> blk) & 1u) { tlist[n++] = (short)(blk * 4); tlist[n++] = (short)(blk * 4 + 1); tlist[n++] = (short)(blk * 4 + 2); tlist[n++] = (short)(blk * 4 + 3); }
            for (int jx = nb * 4; jx <= nb * 4 + 3; ++jx) tlist[n++] = (short)jx;
            misc[0] = n;
        }
        __syncthreads();
        nt = misc[0];
    }
#define ATT_TILE(I) ((MODE == 2) ? (int)tlist[(I)] : jbase + (I))
    bf16x8 qf[ND0];
    {
        const bfu* qr = Qp + ((MODE == 3) ? g_tok : (size_t)(rowbase + (long)qstep * rs)) * qp + hi * 8;
#pragma unroll
        for (int d0 = 0; d0 < ND0; ++d0) qf[d0] = *(const bf16x8*)(qr + d0 * 16);
    }
    float m = 0.f, l = 0.f; bool anym = false;
    f32x16 o[NDV];
#pragma unroll
    for (int dvb = 0; dvb < NDV; ++dvb)
#pragma unroll
        for (int r = 0; r < 16; ++r) o[dvb][r] = 0.f;
    int krow[NKL], kch[NKL], vrow[NVL], vch[NVL];
#pragma unroll
    for (int i = 0; i < NKL; ++i) { const int id = tid + NT * i; krow[i] = id / KCH; kch[i] = id % KCH; }
#pragma unroll
    for (int i = 0; i < NVL; ++i) { const int id = tid + NT * i; vrow[i] = id / VCH; vch[i] = id % VCH; }
    u32x4 rk[NKL], rv[NVL];
#define ATT_LOAD(JJ) do { const int j_ = __builtin_amdgcn_readfirstlane((int)(JJ)); \
    _Pragma("unroll") for (int i = 0; i < NKL; ++i) if (NT * (i + 1) <= 64 * KCH || tid + NT * i < 64 * KCH) rk[i] = *(const u32x4*)(Kp + (size_t)(rowbase + (long)(j_ * 64 + krow[i]) * rs) * kp + kch[i] * 8); \
    _Pragma("unroll") for (int i = 0; i < NVL; ++i) rv[i] = *(const u32x4*)(Vp + (size_t)(rowbase + (long)(j_ * 64 + vrow[i]) * rs) * vp + vch[i] * 8); } while (0)
#define ATT_STORE(ST) do { bfu* ks_ = Ks + (ST) * KST; bfu* vs_ = Vs + (ST) * VST; \
    _Pragma("unroll") for (int i = 0; i < NKL; ++i) if (NT * (i + 1) <= 64 * KCH || tid + NT * i < 64 * KCH) *(u32x4*)(ks_ + krow[i] * KPT + kch[i] * 8) = rk[i]; \
    _Pragma("unroll") for (int i = 0; i < NVL; ++i) *(u32x4*)(vs_ + (vch[i] >> 2) * 2048 + vrow[i] * 32 + (vch[i] & 3) * 8) = rv[i]; } while (0)
    ATT_LOAD(ATT_TILE(0));
    ATT_STORE(0);
    if (nt > 1) ATT_LOAD(ATT_TILE(1));
    __syncthreads();
    const lds_cptr vb0 = (lds_cptr)Vs + ((lane >> 4) & 1) * 32 + (lane & 3) * 8 + (4 * hi + ((lane & 15) >> 2)) * 64;
    const bfu* ksr0 = Ks + l32 * KPT + hi * 8;
    constexpr int NQK = 2 * ND0, NPV = 4 * NDV, OPA = 48 / NQK, EXB = 32 / NPV;
    static_assert(48 % NQK == 0 && 32 % NPV == 0, "filler split");
    f32x16 pA0, pA1;
    u32x4 pw[4];
    bool pend = false; int pstage = 0;
#define ATT_SLOW() do { if (__builtin_expect(anym || __any(ps > 1e12f), 0)) { \
        float mxp = fmaxf(pA0[0], pA1[0]); \
        _Pragma("unroll") for (int r = 1; r < 16; ++r) mxp = fmaxf(mxp, fmaxf(pA0[r], pA1[r])); \
        mxp = fmaxf(mxp, __shfl_xor(mxp, 32)); \
        const float e_ = (mxp > 0.f) ? (__builtin_amdgcn_logf(mxp) - m) : -1e30f; \
        const float delta = (e_ > 24.f) ? floorf(e_) : 0.f; \
        m += delta; \
        const float alpha = __builtin_amdgcn_exp2f(-delta), sc = __builtin_amdgcn_exp2f(-m); \
        l *= alpha; \
        _Pragma("unroll") for (int dvb = 0; dvb < NDV; ++dvb) _Pragma("unroll") for (int r = 0; r < 16; ++r) o[dvb][r] *= alpha; \
        ps = 0.f; \
        _Pragma("unroll") for (int r = 0; r < 16; ++r) { pA0[r] *= sc; pA1[r] *= sc; ps += pA0[r] + pA1[r]; } \
        _Pragma("unroll") for (int q = 0; q < 16; ++q) pw[q >> 2][q & 3] = (q < 8) ? pk2(pA0[2 * q], pA0[2 * q + 1]) : pk2(pA1[2 * q - 16], pA1[2 * q - 15]); \
        anym = anym || (__any(m != 0.f) != 0); } } while (0)
#define ATT_VFRAG(STG, G) ({ const lds_cptr vb_ = vb0 + (STG) * (VST * 2) + ((G) % NDV) * 4096 + ((G) / NDV) * 1024; \
        const s16x4 lo_ = vtr(vb_), hh_ = vtr(vb_ + 512); (bf16x8){lo_[0], lo_[1], lo_[2], lo_[3], hh_[0], hh_[1], hh_[2], hh_[3]}; })
#define ATT_FLUSH() do { float ps = 0.f; \
        _Pragma("unroll") for (int r = 0; r < 16; ++r) ps += pA0[r] + pA1[r]; \
        _Pragma("unroll") for (int q = 0; q < 16; ++q) pw[q >> 2][q & 3] = (q < 8) ? pk2(pA0[2 * q], pA0[2 * q + 1]) : pk2(pA1[2 * q - 16], pA1[2 * q - 15]); \
        ATT_SLOW(); l += ps; \
        _Pragma("unroll") for (int g = 0; g < NPV; ++g) { const bf16x8 vf_ = ATT_VFRAG(pstage, g); o[g % NDV] = MFMA(vf_, __builtin_bit_cast(bf16x8, pw[g / NDV]), o[g % NDV]); } \
        pend = false; } while (0)
    int cur = 0;
    for (int it = 0; it < nt; ++it) {
        const int nxt = (cur == 2) ? 0 : cur + 1;
        const int jc = __builtin_amdgcn_readfirstlane(ATT_TILE(it));
        if (it + 1 < nt) ATT_STORE(nxt);
        if (it + 2 < nt) ATT_LOAD(ATT_TILE(it + 2));
        __builtin_amdgcn_sched_barrier(0);
        bool need;
        if (MODE == 1) need = (jc * 64 <= qw + 31) && (jc * 64 + 63 >= qw - 128);
        else if (MODE == 3) need = (mg->chunk * 256 + wid * 32 < g_total);
        else {
            need = (jc * 64 <= qw + 31);
            if (MODE == 2) { const int blk = jc >> 2; if (blk < (q0 >> 8)) need = __any((mysel >> blk) & 1u) != 0; }
        }
        if (need) {
            const bfu* ksr = ksr0 + cur * KST;
            f32x16 s0, s1;
#pragma unroll
            for (int r = 0; r < 16; ++r) { s0[r] = 0.f; s1[r] = 0.f; }
            bf16x8 kf0[ND0], kf1[ND0];
#pragma unroll
            for (int d0 = 0; d0 < ND0; ++d0) { kf0[d0] = *(const bf16x8*)(ksr + d0 * 16); kf1[d0] = *(const bf16x8*)(ksr + 32 * KPT + d0 * 16); }
            __builtin_amdgcn_sched_barrier(0);
            if (pend) {
                float ps = 0.f;
#pragma unroll
                for (int g = 0; g < NQK; ++g) {
                    if (g & 1) s1 = MFMA(kf1[g >> 1], qf[g >> 1], s1); else s0 = MFMA(kf0[g >> 1], qf[g >> 1], s0);
#pragma unroll
                    for (int k = g * OPA; k < (g + 1) * OPA; ++k) {
                        if (k < 32) ps += (k < 16) ? pA0[k & 15] : pA1[k & 15];
                        else { const int q = k - 32; unsigned w_ = (q < 8) ? pk2(pA0[(2 * q) & 15], pA0[(2 * q + 1) & 15]) : pk2(pA1[(2 * q) & 15], pA1[(2 * q + 1) & 15]);
                               asm volatile("" : "+v"(w_)); pw[q >> 2][q & 3] = w_; }
                    }
                    asm volatile("" : "+v"(ps));
                    __builtin_amdgcn_sched_barrier(0);
                }
                ATT_SLOW();
                l += ps;
            } else {
#pragma unroll
                for (int d0 = 0; d0 < ND0; ++d0) { s0 = MFMA(kf0[d0], qf[d0], s0); s1 = MFMA(kf1[d0], qf[d0], s1); }
            }
            const int kbase = jc * 64 + 4 * hi;
            if (MODE == 1) {
#pragma unroll
                for (int r = 0; r < 16; ++r) {
                    const int dd = qstep - (kbase + (r & 3) + 8 * (r >> 2));
                    if (dd < 0 || dd > 128) s0[r] = -INFINITY;
                    if (dd - 32 < 0 || dd - 32 > 128) s1[r] = -INFINITY;
                }
            } else if (MODE != 3) {
                if (jc * 64 + 63 > qw) {
#pragma unroll
                    for (int r = 0; r < 16; ++r) {
                        const int ks = kbase + (r & 3) + 8 * (r >> 2);
                        if (ks > qstep) s0[r] = -INFINITY;
                        if (ks + 32 > qstep) s1[r] = -INFINITY;
                    }
                }
                if (MODE == 2) {
                    const int blk = jc >> 2;
                    if (blk < (q0 >> 8) && !((mysel >> blk) & 1u)) {
#pragma unroll
                        for (int r = 0; r < 16; ++r) { s0[r] = -INFINITY; s1[r] = -INFINITY; }
                    }
                }
            }
            if (pend) {
                asm volatile("" : "+v"(s0), "+v"(s1));
                __builtin_amdgcn_sched_barrier(0);
                bf16x8 vfc_ = ATT_VFRAG(pstage, 0), vfd_ = ATT_VFRAG(pstage, 1);
#pragma unroll
                for (int g = 0; g < NPV; ++g) {
                    const bf16x8 vfn_ = (g + 2 < NPV) ? ATT_VFRAG(pstage, (g + 2 < NPV ? g + 2 : g)) : vfd_;
                    o[g % NDV] = MFMA(vfc_, __builtin_bit_cast(bf16x8, pw[g / NDV]), o[g % NDV]);
                    vfc_ = vfd_; vfd_ = vfn_;
#pragma unroll
                    for (int k = g * EXB; k < (g + 1) * EXB; ++k) {
                        float t_ = __builtin_amdgcn_exp2f((k < 16) ? s0[k & 15] : s1[k & 15]);
                        asm volatile("" : "+v"(t_));
                        if (k < 16) s0[k & 15] = t_; else s1[k & 15] = t_;
                    }
                    __builtin_amdgcn_sched_barrier(0);
                }
            } else {
#pragma unroll
                for (int r = 0; r < 16; ++r) { s0[r] = __builtin_amdgcn_exp2f(s0[r]); s1[r] = __builtin_amdgcn_exp2f(s1[r]); }
            }
            pA0 = s0; pA1 = s1; pend = true; pstage = cur;
        } else if (pend) {
            ATT_FLUSH();
        }
        __syncthreads();
        cur = nxt;
    }
    if (pend) ATT_FLUSH();
#undef ATT_SLOW
#undef ATT_VFRAG
#undef ATT_FLUSH
#undef ATT_LOAD
#undef ATT_TILE
#undef ATT_STORE
    l += __shfl_xor(l, 32);
    const float inv = 1.f / l;
    const size_t tok = (MODE == 3) ? g_tok : (size_t)(rowbase + (long)qstep * rs);
    bfu* Ow = Op + tok * op;
    if (MODE == 3) Ow = (g_slot == 2 ? mg->po2 : mg->po01 + (size_t)g_slot * ((size_t)T * 512)) + tok * 512 + mg->h * 64;
    if (MODE != 3 || g_active) {
#pragma unroll
        for (int dvb = 0; dvb < NDV; ++dvb)
#pragma unroll
            for (int i = 0; i < 4; ++i) {
                const int dv = dvb * 32 + 8 * i + 4 * hi;
                *(u32x2*)(Ow + dv) = (u32x2){pk2(o[dvb][4 * i] * inv, o[dvb][4 * i + 1] * inv), pk2(o[dvb][4 * i + 2] * inv, o[dvb][4 * i + 3] * inv)};
            }
        if (MODE == 3) { if (hi == 0) mg->plse[(tok * 8 + mg->h) * 4 + g_slot] = m + __builtin_amdgcn_logf(l); }
        else if (MODE == 1 || (MODE == 0 && lsep != nullptr)) { if (hi == 0) lsep[tok * lsest] = m + __builtin_amdgcn_logf(l); }
    }
}

DI void phase_attn_even(const Params& p, char* smem, int* s_item, int rep) {
    char* ws = p.ws;
    const bfu* ubuf = (const bfu*)(ws + OFF_UBUF);
    const bfu* Qa = (const bfu*)p.out; const bfu* Ka = Qa + (size_t)T * 768; const bfu* Va = Ka + (size_t)T * 768;
    bfu* obuf = (bfu*)(ws + OFF_OBUF); bfu* dil_o = (bfu*)(ws + OFF_HBUF); float* dil_lse = (float*)(ws + OFF_HBUF + 48 * MiB);
    const int nblk = gridDim.x;
    for (int it = blockIdx.x; it < 1024; it += nblk) {
        int bh, qt;
        if (nblk == 256) { const int x = blockIdx.x & 7, li = blockIdx.x >> 3, hs = it >> 8; bh = x + 8 * hs; qt = (hs & 1) ? li : 31 - li; }
        else { bh = it & 31; qt = 31 - (it >> 5); }
        const int b = bh >> 3, h = bh & 7;
        __syncthreads();
        attn_item<96, 64, 0>(Qa + h * 96, 768, Ka + h * 96, 768, Va + h * 64, 512, (long)b * SEQ, 1, qt * 256, obuf + h * 64, 768, nullptr, 0, nullptr, smem);
    }
    for (int i2 = blockIdx.x; i2 < 1536; i2 += nblk) {
        const int g = i2 >> 9, r2 = i2 & 511, h = r2 & 3, b = (r2 >> 2) & 3, qi = r2 >> 4;
        const int rr = (g == 0) ? 1 : (g == 1 ? 4 : 16), tpc = 32 / rr, cls = qi / tpc, st = qi % tpc;
        const int gh = g * 4 + h;
        __syncthreads();
        attn_item<64, 64, 1>(ubuf + 672 + gh * 64, 3072, ubuf + 672 + 768 + gh * 64, 3072, ubuf + 672 + 1536 + gh * 64, 3072, (long)b * SEQ + cls, rr, st * 256,
                             dil_o + gh * 64, 768, dil_lse + gh, 12, nullptr, smem);
    }
}
DI void phase_moba_select(const Params& p, char* smem) {
    char* ws = p.ws;
    const bfu* ubuf = (const bfu*)(ws + OFF_UBUF); const float* kpart_all = (const float*)(ws + OFF_KPART);
    float* plse = (float*)(ws + OFF_PLSE); unsigned short* seg = (unsigned short*)(ws + OFF_SEG); int* cnt = (int*)(ws + OFF_CNT);
    float* km = (float*)smem; float* cand = km + 2048; int* sel3 = (int*)(cand + NT * 6); int* wcnt = sel3 + 768;
    const int tid = threadIdx.x, lane = tid & 63, wid = tid >> 6;
    for (int it = blockIdx.x; it < 1024; it += gridDim.x) {
        const int bh = it & 31, n = 31 - (it >> 5), b = bh >> 3, h = bh & 7;
        const float* kpart = kpart_all + (size_t)b * (32 * 4 * 512) + h * 64;
        const bfu* Qp = ubuf + 1536 + h * 64;
        __syncthreads();
        for (int idx = tid; idx < n * 64; idx += NT) {
            const int blk = idx >> 6, d = idx & 63; const float* kq = kpart + (size_t)(blk * 4) * 512 + d;
            km[idx] = (kq[0] + kq[512] + kq[1024] + kq[1536]) * (1.f / 256.f);
        }
        if (tid < 32 && tid >= n) cnt[(bh * 32 + tid) * 32 + n] = 0;
        __syncthreads();
        {
            const int qq = tid & 255, hf = tid >> 8;
            const bfu* qr = Qp + (size_t)(b * SEQ + n * 256 + qq) * 3072;
            float qv[64];
#pragma unroll
            for (int c8 = 0; c8 < 8; ++c8) {
                const u32x4 w = *(const u32x4*)(qr + c8 * 8);
#pragma unroll
                for (int e = 0; e < 4; ++e) { qv[c8 * 8 + 2 * e] = bflo(w[e]); qv[c8 * 8 + 2 * e + 1] = bfhi(w[e]); }
            }
            Top3 tp; tp.v0 = -3e38f; tp.v1 = -3e38f; tp.v2 = -3e38f; tp.i0 = 64; tp.i1 = 64; tp.i2 = 64;
            for (int blk = hf; blk < n; blk += 2) {
                float g = 0.f;
#pragma unroll
                for (int d = 0; d < 64; ++d) g += qv[d] * km[blk * 64 + d];
                tp = top3_ins(tp, g, blk);
            }
            cand[tid * 6 + 0] = tp.v0; cand[tid * 6 + 1] = tp.v1; cand[tid * 6 + 2] = tp.v2;
            cand[tid * 6 + 3] = __int_as_float(tp.i0); cand[tid * 6 + 4] = __int_as_float(tp.i1); cand[tid * 6 + 5] = __int_as_float(tp.i2);
        }
        __syncthreads();
        if (tid < 256) {
            Top3 tp; tp.v0 = cand[tid * 6]; tp.v1 = cand[tid * 6 + 1]; tp.v2 = cand[tid * 6 + 2];
            tp.i0 = __float_as_int(cand[tid * 6 + 3]); tp.i1 = __float_as_int(cand[tid * 6 + 4]); tp.i2 = __float_as_int(cand[tid * 6 + 5]);
            const int o = (tid + 256) * 6;
#pragma unroll
            for (int e = 0; e < 3; ++e) { const int ii = __float_as_int(cand[o + 3 + e]); tp = top3_ins(tp, cand[o + e], ii); }
            sel3[tid * 3 + 0] = tp.i0 < 32 ? tp.i0 : -1; sel3[tid * 3 + 1] = tp.i1 < 32 ? tp.i1 : -1; sel3[tid * 3 + 2] = tp.i2 < 32 ? tp.i2 : -1;
            float* pl = plse + ((size_t)(b * SEQ + n * 256 + tid) * 8 + h) * 4;
            if (tp.i0 >= 32) pl[0] = -INFINITY;
            if (tp.i1 >= 32) pl[1] = -INFINITY;
            if (tp.i2 >= 32) pl[2] = -INFINITY;
        }
        __syncthreads();
        int q0s = -1, q1s = -1, q2s = -1;
        if (tid < 256) { q0s = sel3[tid * 3]; q1s = sel3[tid * 3 + 1]; q2s = sel3[tid * 3 + 2]; }
        for (int j = 0; j < n; ++j) {
            const unsigned long long bal = __ballot(q0s == j || q1s == j || q2s == j);
            if (lane == 0 && wid < 4) wcnt[j * 4 + wid] = __popcll(bal);
        }
        __syncthreads();
        for (int j = 0; j < n; ++j) {
            const int sl = (q0s == j) ? 0 : (q1s == j) ? 1 : (q2s == j) ? 2 : -1;
            const unsigned long long bal = __ballot(sl >= 0);
            if (sl >= 0) {
                int off = __popcll(bal & ((1ull << lane) - 1ull));
                for (int w = 0; w < wid; ++w) off += wcnt[j * 4 + w];
                seg[((size_t)((bh * 32 + j) * 32 + n)) * 256 + off] = (unsigned short)(tid | (sl << 8));
            }
            if (tid == 0) cnt[(bh * 32 + j) * 32 + n] = wcnt[j * 4] + wcnt[j * 4 + 1] + wcnt[j * 4 + 2] + wcnt[j * 4 + 3];
        }
    }
    __syncthreads();
}

DI void phase_attn_odd(const Params& p, char* smem, int* s_item, int rep) {
    char* ws = p.ws;
    const bfu* ubuf = (const bfu*)(ws + OFF_UBUF);
    bfu* obuf = (bfu*)(ws + OFF_OBUF); bfu* dbuf = (bfu*)(ws + OFF_DBUF);
    float* plse = (float*)(ws + OFF_PLSE); const unsigned short* seg = (const unsigned short*)(ws + OFF_SEG); const int* cnt = (const int*)(ws + OFF_CNT);
    const int nblk = gridDim.x, tid = threadIdx.x;
    int* cpre = (int*)(smem + 114688);
    __syncthreads();
    for (int e = tid; e < 1024; e += NT) {
        const int j = e & 31; int sum = 0;
        for (int n = j + 1; n < 32; ++n) sum += cnt[e * 32 + n];
        cpre[e + 1] = (sum + 255) >> 8;
    }
    __syncthreads();
    if (tid == 0) { int a = 0; cpre[0] = 0; for (int e = 1; e <= 1024; ++e) { a += cpre[e]; cpre[e] = a; } }
    __syncthreads();
    const int nchunks = cpre[1024];
    for (int it = blockIdx.x; it < 2048; it += nblk) {
        int bh, qt, kind;
        if (nblk == 256) { const int x = blockIdx.x & 7, li = blockIdx.x >> 3, hs = it >> 8; kind = hs >> 2; bh = x + 8 * (hs & 3); qt = (hs & 1) ? li : 31 - li; }
        else { kind = (it >> 5) & 1; bh = it & 31; qt = 31 - (it >> 6); }
        const int b = bh >> 3, hh = bh & 7;
        __syncthreads();
        if (kind == 0) {
            attn_item<64, 128, 0>(ubuf + hh * 64, 3072, ubuf + 512 + hh * 64, 3072, ubuf + 1024 + (hh >> 1) * 128, 3072, (long)b * SEQ, 1, qt * 256,
                                  dbuf + hh * 128, 1024, nullptr, 0, nullptr, smem);
        } else {
            attn_item<64, 64, 0>(ubuf + 1536 + hh * 64, 3072, ubuf + 2048 + hh * 64, 3072, ubuf + 2560 + hh * 64, 3072, (long)b * SEQ, 1, qt * 256,
                                 obuf + 512 + hh * 64, 1024, plse + hh * 4 + 3, 32, nullptr, smem, qt * 4);
        }
    }
    for (int i = blockIdx.x; i < nchunks; i += nblk) {
        int lo = 0, hi2 = 1023;
        while (lo < hi2) { const int mid = (lo + hi2 + 1) >> 1; if (cpre[mid] <= i) lo = mid; else hi2 = mid - 1; }
        const int e = lo, bh = e >> 5, j = e & 31, b = bh >> 3, hh = bh & 7;
        MobaG mg; mg.cnt = cnt + e * 32; mg.seg = seg + (size_t)(e * 32) * 256; mg.chunk = i - cpre[e]; mg.jblk = j; mg.tokbase = b * SEQ; mg.h = hh;
        mg.po01 = (bfu*)(ws + OFF_HBUF); mg.po2 = (bfu*)(ws + OFF_PO2); mg.plse = plse;
        __syncthreads();
        attn_item<64, 64, 3>(ubuf + 1536 + hh * 64, 3072, ubuf + 2048 + hh * 64, 3072, ubuf + 2560 + hh * 64, 3072, (long)b * SEQ, 1, 0,
                             nullptr, 0, nullptr, 0, nullptr, smem, 0, &mg);
    }
}

#define XB_TMO      128
#define XB_XCNT(j)  (256  + 64 * (j))
#define XB_XSUB(j)  (1280 + 64 * (j))
#define XB_XGEN(j)  (2304 + 64 * (j))
#define XB_TOP      3328
#define XB_TOPGEN   3392
#define XCD_BAR_WORDS 3456
#define XB_SPIN_CAP (1u << 18)
#define LAS __attribute__((address_space(3)))

__device__ __forceinline__ unsigned xb_ld(unsigned* p)              { return __hip_atomic_load(p, __ATOMIC_RELAXED, __HIP_MEMORY_SCOPE_AGENT); }
__device__ __forceinline__ unsigned xb_add(unsigned* p, unsigned v) { return __hip_atomic_fetch_add(p, v, __ATOMIC_RELAXED, __HIP_MEMORY_SCOPE_AGENT); }
__device__ __forceinline__ unsigned xb_xcc_id() { return (unsigned)__builtin_amdgcn_s_getreg((3 << 11) | 20) & 0xFu; }
#define XB_SPIN(cond, bar) do { unsigned _sp = 0; while (cond) { __builtin_amdgcn_s_sleep(1); \
    if ((++_sp & 255u) == 0u) { if (xb_ld(&(bar)[XB_TMO])) break; if (_sp > XB_SPIN_CAP) { atomicAdd(&(bar)[XB_TMO], 1u); break; } } } } while (0)

struct XcdBarrier {
    unsigned* bar; unsigned x;
    volatile LAS unsigned* st;
};

__device__ __forceinline__ XcdBarrier xcd_barrier_post(unsigned* bar, volatile LAS unsigned* st) {
    XcdBarrier b; b.bar = bar; b.x = xb_xcc_id(); b.st = st;
    if (threadIdx.x == 0) (void)xb_add(&bar[XB_XCNT(b.x)], 1u);
    return b;
}
__device__ __forceinline__ void xcd_barrier_complete(unsigned* bar, unsigned x, unsigned& nloc, unsigned& nx) {
    const unsigned G = gridDim.x * gridDim.y * gridDim.z;
    unsigned sum, cnt, mine, sp = 0u;
    for (;;) {
        sum = 0u; cnt = 0u; mine = 0u;
#pragma unroll
        for (unsigned j = 0; j < 16; ++j) { const unsigned c = xb_ld(&bar[XB_XCNT(j)]); sum += c; cnt += (c > 0u) ? 1u : 0u; mine = (j == x) ? c : mine; }
        if (sum == G) break;
        __builtin_amdgcn_s_sleep(1);
        if ((++sp & 255u) == 0u) { if (xb_ld(&bar[XB_TMO])) break; if (sp > XB_SPIN_CAP) { atomicAdd(&bar[XB_TMO], 1u); break; } }
    }
    nloc = mine > 0u ? mine : 1u; nx = cnt > 0u ? cnt : 1u;
}

__device__ __forceinline__ void xcd_barrier(const XcdBarrier& b) {
    asm volatile("s_waitcnt vmcnt(0)" ::: "memory");
    __syncthreads();
    if (threadIdx.x == 0) {
        unsigned* bar = b.bar;
        __builtin_amdgcn_s_waitcnt(0);
        unsigned nloc = b.st[0], nx = b.st[1];
        if (nloc == 0u) { xcd_barrier_complete(bar, b.x, nloc, nx); b.st[0] = nloc; b.st[1] = nx; }
        const unsigned old = xb_add(&bar[XB_XSUB(b.x)], 1u);
        const unsigned gen = old / nloc;
        if (old + 1u == (gen + 1u) * nloc) {
            __builtin_amdgcn_fence(__ATOMIC_RELEASE, "agent");
            asm volatile("s_waitcnt vmcnt(0)" ::: "memory");
            const unsigned og = xb_add(&bar[XB_TOP], 1u);
            const unsigned tg = og / nx;
            if (og + 1u == (tg + 1u) * nx) xb_add(&bar[XB_TOPGEN], 1u);
            else XB_SPIN(xb_ld(&bar[XB_TOPGEN]) == tg, bar);
            __builtin_amdgcn_fence(__ATOMIC_ACQUIRE, "agent");
            xb_add(&bar[XB_XGEN(b.x)], 1u);
            asm volatile("s_waitcnt vmcnt(0)" ::: "memory");
        } else {
            XB_SPIN(xb_ld(&bar[XB_XGEN(b.x)]) == gen, bar);
            __builtin_amdgcn_fence(__ATOMIC_ACQUIRE, "agent");
            asm volatile("s_waitcnt vmcnt(0)" ::: "memory");
        }
    }
    __syncthreads();
}

#ifndef MK_REPMASK
#define MK_REPMASK 0u
#endif
#define PHASE_BEGIN(k) if (p.phase_lo <= (k) && (k) < p.phase_hi) { for (int rep_ = 0; rep_ < (((MK_REPMASK >> (k)) & 1u) ? 2 : 1); ++rep_) {
#define PHASE_MID(k) if (rep_ == 0 && ((MK_REPMASK >> (k)) & 1u)) xcd_barrier(xb); }
#define PHASE_END(k) PHASE_MID(k) if (p.coop && (k) + 1 < p.phase_hi) xcd_barrier(xb); }
__global__ void __launch_bounds__(512, 2) mega(Params p) {
    extern __shared__ __attribute__((aligned(16))) char smem[];
    __shared__ int s_item;
    __shared__ uint4 xb_words;
    char* ws = p.ws;
    if (threadIdx.x == 0) xb_words = make_uint4(0u, 0u, 0u, 0u);
    __syncthreads();
    XcdBarrier xb = xcd_barrier_post((unsigned*)(ws + OFF_CTR + 4096), (volatile LAS unsigned*)&xb_words);
    bfu* hbuf = (bfu*)(ws + OFF_HBUF); bfu* obuf = (bfu*)(ws + OFF_OBUF); bfu* ubuf = (bfu*)(ws + OFF_UBUF); bfu* hid = ubuf;
    const float* mod0 = (const float*)(ws + OFF_MOD); const float* mod1 = mod0 + 4 * 6144;
    PHASE_BEGIN(0) phase_prep(p, smem); PHASE_END(0)
    PHASE_BEGIN(1) phase_modfin(p); PHASE_END(1)
    PHASE_BEGIN(2) phase_normmod(p.x, p.norm_mix, mod0, 0, hbuf); PHASE_END(2)
    PHASE_BEGIN(3) phase_gemm8<0>(hbuf, 1024, (const bfu*)(ws + OFF_WIN0), 1024, 2976, 12, ubuf, 3072, nullptr, nullptr, nullptr, smem); PHASE_END(3)
#if MK_PROBE
    if (p.coop) { phase_gemm_probe<MK_PROBE - 1>(hbuf, (const bfu*)(ws + OFF_WIN0), (float*)(ws + OFF_DBUF), p.pad_, smem); xcd_barrier(xb); }
#endif
    PHASE_BEGIN(4)
            phase_gemm8<0>(ubuf, 3072, (const bfu*)(ws + OFF_WUQ), 384, 768, 3, hbuf, 768, nullptr, nullptr, nullptr, smem);
            phase_gemm8<0>(ubuf + 384, 3072, (const bfu*)(ws + OFF_WUKV), 256, 1024, 4, obuf, 1024, nullptr, nullptr, nullptr, smem);
    PHASE_END(4)
    PHASE_BEGIN(5) phase_post_even(p); PHASE_END(5)
    PHASE_BEGIN(6) phase_attn_even(p, smem, &s_item, rep_); PHASE_END(6)
    PHASE_BEGIN(7) phase_dil_merge(p); PHASE_END(7)
    PHASE_BEGIN(8) phase_gemm8<2>(obuf, 768, (const bfu*)(ws + OFF_WOUT0), 768, 1024, 4, nullptr, 0, p.x, p.out, mod0 + 2048, smem); PHASE_END(8)
    PHASE_BEGIN(9) phase_normmod(p.out, p.norm_mlp, mod0, 3072, hbuf); PHASE_END(9)
    PHASE_BEGIN(10) phase_gemm8<1>(hbuf, 1024, (const bfu*)(ws + OFF_W1_0), 1024, 4096, 16, hid, 4096, nullptr, nullptr, nullptr, smem); PHASE_END(10)
    PHASE_BEGIN(11) phase_gemm8<2>(hid, 4096, (const bfu*)(ws + OFF_W2_0), 4096, 1024, 4, nullptr, 0, p.out, p.out, mod0 + 5120, smem); PHASE_END(11)
    PHASE_BEGIN(12) phase_normmod(p.out, p.norm_mix + 1024, mod1, 0, hbuf); PHASE_END(12)
    PHASE_BEGIN(13) phase_gemm_heads(p, hbuf, (const bfu*)(ws + OFF_WIN1), ubuf, smem); PHASE_END(13)
    PHASE_BEGIN(15) phase_moba_select(p, smem); if (p.coop) xcd_barrier(xb); phase_attn_odd(p, smem, &s_item, rep_); PHASE_END(15)
    PHASE_BEGIN(16) phase_diff_combine(p); PHASE_END(16)
    PHASE_BEGIN(17) phase_gemm8<2>(obuf, 1024, (const bfu*)(ws + OFF_WOUT1), 1024, 1024, 4, nullptr, 0, p.out, p.out, mod1 + 2048, smem); PHASE_END(17)
    PHASE_BEGIN(18) phase_normmod(p.out, p.norm_mlp + 1024, mod1, 3072, hbuf); PHASE_END(18)
    PHASE_BEGIN(19) phase_gemm8<1>(hbuf, 1024, (const bfu*)(ws + OFF_W1_1), 1024, 4096, 16, hid, 4096, nullptr, nullptr, nullptr, smem); PHASE_END(19)
    PHASE_BEGIN(20) phase_gemm8<2>(hid, 4096, (const bfu*)(ws + OFF_W2_1), 4096, 1024, 4, nullptr, 0, p.out, p.out, mod1 + 5120, smem); PHASE_END(20)
    if (p.coop == 2) cg::this_grid().sync();
}

extern "C" void kernel_launch(void* const* d_in, const int* in_sizes, int n_in, void* d_out, int out_size, void* d_ws, size_t ws_size, hipStream_t stream) {
    static int grid_blocks = 0;
    if (!grid_blocks) {
        int dev = 0, cus = 0, per_cu = 0;
        (void)hipGetDevice(&dev);
        (void)hipDeviceGetAttribute(&cus, hipDeviceAttributeMultiprocessorCount, dev);
        (void)hipFuncSetAttribute((const void*)mega, hipFuncAttributeMaxDynamicSharedMemorySize, DYN_LDS);
        (void)hipOccupancyMaxActiveBlocksPerMultiprocessor(&per_cu, mega, NT, DYN_LDS);
        if (per_cu != 1) per_cu = 1;
        grid_blocks = cus * per_cu;
    }
    if (ws_size < WS_END) fprintf(stderr, "workspace too small: %zu < %zu\n", ws_size, (size_t)WS_END);
    Params p{};
    p.x = (const float*)d_in[0]; p.c = (const float*)d_in[1]; p.pos = (const int*)d_in[2];
    p.ada_w = (const float*)d_in[3]; p.ada_b = (const float*)d_in[4]; p.norm_mix = (const float*)d_in[5]; p.norm_mlp = (const float*)d_in[6];
    p.w1 = (const float*)d_in[7]; p.w2 = (const float*)d_in[8]; p.e_win = (const float*)d_in[9]; p.e_wout = (const float*)d_in[10];
    p.qlat = (const float*)d_in[11]; p.kvlat = (const float*)d_in[12]; p.wuq = (const float*)d_in[13]; p.wukv = (const float*)d_in[14];
    p.mla_qn = (const float*)d_in[15]; p.mla_kn = (const float*)d_in[16]; p.dil_qn = (const float*)d_in[17]; p.dil_kn = (const float*)d_in[18];
    p.o_win = (const float*)d_in[19]; p.o_wout = (const float*)d_in[20]; p.diff_qn = (const float*)d_in[21]; p.diff_kn = (const float*)d_in[22];
    p.diff_lam = (const float*)d_in[23]; p.diff_subln = (const float*)d_in[24]; p.moba_qn = (const float*)d_in[25]; p.moba_kn = (const float*)d_in[26];
    p.out = (float*)d_out; p.ws = (char*)d_ws;
    for (int i = 0; i < 32; ++i) p.invf64[i] = (float)pow(10000.0, -(double)i / 32.0);
    for (int i = 0; i < 16; ++i) p.invf32[i] = (float)pow(10000.0, -(double)i / 16.0);
    (void)hipMemsetAsync((char*)d_ws + OFF_CTR, 0, 32768, stream);
#if MK_COOP
    p.phase_lo = 0; p.phase_hi = NPH; p.coop = 1;
    void* args[] = {&p};
    hipError_t e = hipLaunchCooperativeKernel((void*)mega, dim3(grid_blocks), dim3(NT), args, DYN_LDS, stream);
    if (e != hipSuccess) fprintf(stderr, "cooperative launch failed: %s (grid %d)\n", hipGetErrorString(e), grid_blocks);
#else
    for (int ph = 0; ph < NPH; ++ph) {
        p.phase_lo = ph; p.phase_hi = ph + 1; p.coop = 0;
        hipLaunchKernelGGL(mega, dim3(grid_blocks), dim3(NT), DYN_LDS, stream, p);
    }
#endif
}
```

```cpp
#include <hip/hip_runtime.h>
#include <hip/hip_cooperative_groups.h>
#include <stdint.h>
#include <cstdio>
#include <cmath>
namespace cg = cooperative_groups;

#ifndef MK_COOP
#define MK_COOP 1
#endif

typedef unsigned short bfu;
typedef __attribute__((ext_vector_type(8))) short bf16x8;
typedef __attribute__((ext_vector_type(4))) short s16x4;
typedef short v4i16_t __attribute__((ext_vector_type(4)));
typedef __attribute__((ext_vector_type(16))) float f32x16;
typedef __attribute__((ext_vector_type(4))) float f32x4;
typedef __attribute__((ext_vector_type(2))) float f32x2;
typedef __attribute__((ext_vector_type(4))) unsigned u32x4;
typedef __attribute__((ext_vector_type(2))) unsigned u32x2;
typedef __attribute__((ext_vector_type(2))) __bf16 bf2_t;
typedef __attribute__((address_space(3))) const char* lds_cptr;

#define DI __device__ __forceinline__
#define MFMA(a, b, c) __builtin_amdgcn_mfma_f32_32x32x16_bf16((a), (b), (c), 0, 0, 0)

constexpr int T = 32768, SEQ = 8192;
constexpr float EPS = 1e-6f;
constexpr float LOG2E = 1.4426950408889634f;
constexpr float SC_MLA = 0.10206207261596577f * LOG2E;
constexpr float SC_64 = 0.125f * LOG2E;
constexpr float LAM_INIT = 0.35550906759096926f;
constexpr int NPH = 21;
constexpr int NT = 512, NW = 8;
constexpr int DYN_LDS = 2 * 512 * 72 * 2;

constexpr size_t MiB = 1048576;
constexpr size_t OFF_WIN0 = 0, OFF_WIN1 = 6 * MiB, OFF_W1_0 = 12 * MiB, OFF_W1_1 = 20 * MiB, OFF_W2_0 = 28 * MiB, OFF_W2_1 = 36 * MiB,
                 OFF_WOUT0 = 44 * MiB, OFF_WOUT1 = 46 * MiB, OFF_WUQ = 48 * MiB, OFF_WUKV = 49 * MiB, OFF_MODP = 50 * MiB, OFF_MOD = 52 * MiB,
                 OFF_ROPE64 = 53 * MiB, OFF_ROPE32 = 61 * MiB, OFF_KPART = 65 * MiB, OFF_CTR = 66 * MiB,
                 OFF_HBUF = 72 * MiB, OFF_OBUF = 136 * MiB, OFF_UBUF = 200 * MiB, OFF_DBUF = 392 * MiB,
                 OFF_PO2 = 456 * MiB, OFF_PLSE = 488 * MiB, OFF_SEG = 492 * MiB, OFF_CNT = 508 * MiB, WS_END = 509 * MiB;

struct Params {
    const float *x, *c; const int* pos;
    const float *ada_w, *ada_b, *norm_mix, *norm_mlp, *w1, *w2, *e_win, *e_wout, *qlat, *kvlat, *wuq, *wukv, *mla_qn, *mla_kn, *dil_qn, *dil_kn,
        *o_win, *o_wout, *diff_qn, *diff_kn, *diff_lam, *diff_subln, *moba_qn, *moba_kn;
    float* out; char* ws;
    float invf64[32]; float invf32[16];
    int phase_lo, phase_hi, coop, pad_;
};

DI unsigned pk2(float a, float b) { f32x2 v = {a, b}; bf2_t r = __builtin_convertvector(v, bf2_t); return __builtin_bit_cast(unsigned, r); }
DI float bflo(unsigned u) { return __uint_as_float(u << 16); }
DI float bfhi(unsigned u) { return __uint_as_float(u & 0xffff0000u); }
DI float wave_sum(float v) {
#pragma unroll
    for (int o = 32; o; o >>= 1) v += __shfl_xor(v, o);
    return v; }
DI s16x4 vtr(lds_cptr p) { return __builtin_bit_cast(s16x4, __builtin_amdgcn_ds_read_tr16_b64_v4i16((__attribute__((address_space(3))) v4i16_t*)p)); }

DI int hp_col(int n) { return (n & ~255) + 64 * ((n >> 5) & 3) + 32 * ((n >> 7) & 1) + (n & 31); }
DI void tr_tile(const float* __restrict__ src, int K, int N, bfu* __restrict__ dst, const float* __restrict__ kscale, int it, float* tl, int hperm) {
    const int nkt = K >> 6; const int kt = it % nkt, nt = it / nkt; const int tid = threadIdx.x;
#pragma unroll
    for (int rr = 0; rr < 2; ++rr) {
        const int kl = rr * 32 + (tid >> 4), k = kt * 64 + kl, nl = (tid & 15) * 4, n = nt * 64 + nl;
        float4 v = make_float4(0.f, 0.f, 0.f, 0.f);
        if (n < N) v = *(const float4*)(src + (size_t)k * N + (hperm ? hp_col(n) : n));
        if (kscale) { const float sc = kscale[k]; v.x *= sc; v.y *= sc; v.z *= sc; v.w *= sc; }
        tl[kl * 65 + nl] = v.x; tl[kl * 65 + nl + 1] = v.y; tl[kl * 65 + nl + 2] = v.z; tl[kl * 65 + nl + 3] = v.w;
    }
    __syncthreads();
    {
        const int nl = tid >> 3, kc = (tid & 7) * 8;
        unsigned w[4];
#pragma unroll
        for (int i = 0; i < 4; ++i) w[i] = pk2(tl[(kc + 2 * i) * 65 + nl], tl[(kc + 2 * i + 1) * 65 + nl]);
        bfu* d = dst + (size_t)(nt * 64 + nl) * K + kt * 64 + kc;
        *(u32x4*)d = (u32x4){w[0], w[1], w[2], w[3]};
    }
    __syncthreads();
}
DI void tr_matrix(const float* src, int K, int N, int Npad, bfu* dst, const float* kscale, float* tl, int hperm = 0) {
    const int nit = (K >> 6) * (Npad >> 6);
    for (int it = blockIdx.x; it < nit; it += gridDim.x) tr_tile(src, K, N, dst, kscale, it, tl, hperm);
}

DI void phase_prep(const Params& p, char* smem) {
    float* tl = (float*)smem;
    char* ws = p.ws;
    if (blockIdx.x == 0 && threadIdx.x < 4) ((int*)(ws + OFF_CTR))[threadIdx.x] = 0;
    tr_matrix(p.e_win, 1024, 2976, 3072, (bfu*)(ws + OFF_WIN0), nullptr, tl);
    tr_matrix(p.o_win, 1024, 3072, 3072, (bfu*)(ws + OFF_WIN1), nullptr, tl, 1);
    tr_matrix(p.w1, 1024, 4096, 4096, (bfu*)(ws + OFF_W1_0), nullptr, tl);
    tr_matrix(p.w1 + (size_t)1024 * 4096, 1024, 4096, 4096, (bfu*)(ws + OFF_W1_1), nullptr, tl);
    tr_matrix(p.w2, 4096, 1024, 1024, (bfu*)(ws + OFF_W2_0), nullptr, tl);
    tr_matrix(p.w2 + (size_t)1024 * 4096, 4096, 1024, 1024, (bfu*)(ws + OFF_W2_1), nullptr, tl);
    tr_matrix(p.e_wout, 768, 1024, 1024, (bfu*)(ws + OFF_WOUT0), nullptr, tl);
    tr_matrix(p.o_wout, 1024, 1024, 1024, (bfu*)(ws + OFF_WOUT1), nullptr, tl);
    tr_matrix(p.wuq, 384, 768, 768, (bfu*)(ws + OFF_WUQ), p.qlat, tl);
    tr_matrix(p.wukv, 256, 1024, 1024, (bfu*)(ws + OFF_WUKV), p.kvlat, tl);
    {
        float2* r64 = (float2*)(ws + OFF_ROPE64); float2* r32 = (float2*)(ws + OFF_ROPE32);
        for (int idx = blockIdx.x * NT + threadIdx.x; idx < T * 48; idx += gridDim.x * NT) {
            const int t = idx / 48, i = idx % 48;
            const float invf = (i < 32) ? p.invf64[i] : p.invf32[i - 32];
            const float a = (float)p.pos[t] * invf;
            double rev = (double)a * 0.15915494309189535; rev -= floor(rev);
            const double y = (rev > 0.5 ? rev - 1.0 : rev) * 6.283185307179586;
            const double y2 = y * y; double s = 1.0, c = 1.0;
#pragma unroll
            for (int k = 15; k >= 1; --k) { s = 1.0 - s * y2 * (1.0 / (double)((2 * k) * (2 * k + 1))); c = 1.0 - c * y2 * (1.0 / (double)((2 * k - 1) * (2 * k))); }
            s *= y;
            const float2 o = make_float2((float)c, (float)s);
            if (i < 32) r64[(size_t)t * 32 + i] = o; else r32[(size_t)t * 16 + (i - 32)] = o;
        }
    }
    {
        float* sl = (float*)smem; float* modp = (float*)(ws + OFF_MODP);
        for (int it = blockIdx.x; it < 2 * 12 * 8; it += gridDim.x) {
            const int l = it / 96, cc = (it % 96) / 8, kc = it % 8;
            __syncthreads();
            { const int i = threadIdx.x, b = i >> 7, kk = i & 127; const float cv = p.c[b * 1024 + kc * 128 + kk]; sl[i] = cv / (1.f + __expf(-cv)); }
            __syncthreads();
            const int j = cc * 512 + threadIdx.x;
            const float* w = p.ada_w + ((size_t)l * 1024 + kc * 128) * 6144 + j;
            float a0 = 0.f, a1 = 0.f, a2 = 0.f, a3 = 0.f;
#pragma unroll 8
            for (int kk = 0; kk < 128; ++kk) { const float wv = w[(size_t)kk * 6144]; a0 += sl[kk] * wv; a1 += sl[128 + kk] * wv; a2 += sl[256 + kk] * wv; a3 += sl[384 + kk] * wv; }
            float* o = modp + (size_t)((l * 8 + kc) * 4) * 6144 + j;
            o[0] = a0; o[6144] = a1; o[2 * 6144] = a2; o[3 * 6144] = a3;
        }
        __syncthreads();
    }
}

DI void phase_modfin(const Params& p) {
    const float* modp = (const float*)(p.ws + OFF_MODP); float* mod = (float*)(p.ws + OFF_MOD);
    for (int idx = blockIdx.x * NT + threadIdx.x; idx < 2 * 4 * 6144; idx += gridDim.x * NT) {
        const int l = idx / 24576, rem = idx % 24576, j = rem % 6144;
        float s = p.ada_b[l * 6144 + j];
#pragma unroll
        for (int kc = 0; kc < 8; ++kc) s += modp[(size_t)((l * 8 + kc) * 4) * 6144 + rem];
        mod[idx] = s;
    }
}

DI void phase_normmod(const float* xs, const float* __restrict__ nw, const float* __restrict__ mod, int sh_off, bfu* __restrict__ hb) {
    const int lane = threadIdx.x & 63, gw = blockIdx.x * NW + (threadIdx.x >> 6), nwv = gridDim.x * NW;
    for (int t = gw; t < T; t += nwv) {
        const int b = t >> 13; const float* xr = xs + (size_t)t * 1024;
        float4 v[4]; float ss = 0.f;
#pragma unroll
        for (int i = 0; i < 4; ++i) { v[i] = *(const float4*)(xr + (i * 64 + lane) * 4); ss += v[i].x * v[i].x + v[i].y * v[i].y + v[i].z * v[i].z + v[i].w * v[i].w; }
        ss = wave_sum(ss);
        const float rinv = rsqrtf(ss * (1.f / 1024.f) + EPS);
        const float* mb = mod + b * 6144 + sh_off;
#pragma unroll
        for (int i = 0; i < 4; ++i) {
            const int col = (i * 64 + lane) * 4;
            const float4 w = *(const float4*)(nw + col), sh = *(const float4*)(mb + col), sc = *(const float4*)(mb + 1024 + col);
            const float o0 = v[i].x * rinv * w.x * (1.f + sc.x) + sh.x, o1 = v[i].y * rinv * w.y * (1.f + sc.y) + sh.y;
            const float o2 = v[i].z * rinv * w.z * (1.f + sc.z) + sh.z, o3 = v[i].w * rinv * w.w * (1.f + sc.w) + sh.w;
            *(u32x2*)(hb + (size_t)t * 1024 + col) = (u32x2){pk2(o0, o1), pk2(o2, o3)};
        }
    }
}

template <int EPI>
DI void gemm_tile(const bfu* __restrict__ A, int lda, const bfu* __restrict__ Bt, int K, int m0, int n0, int N,
                  bfu* Cb, int ldc, const float* resid, float* outf, const float* __restrict__ gate, char* smem) {
    constexpr int STG = 512 * 72;
    bfu* S0 = (bfu*)smem;
    const int tid = threadIdx.x, lane = tid & 63, wid = tid >> 6, l32 = lane & 31, hi = lane >> 5;
    const int wm = wid & 3, wn = wid >> 2;
    f32x16 acc[4][2];
#pragma unroll
    for (int nb = 0; nb < 4; ++nb)
#pragma unroll
        for (int mb = 0; mb < 2; ++mb)
#pragma unroll
            for (int r = 0; r < 16; ++r) acc[nb][mb][r] = 0.f;
    const bfu* Ag = A + (size_t)(m0 + (tid >> 3)) * lda + (tid & 7) * 8;
    const bfu* Bg = Bt + (size_t)(n0 + (tid >> 3)) * K + (tid & 7) * 8;
    u32x4 ra[4], rb[4];
#pragma unroll
    for (int i = 0; i < 4; ++i) { ra[i] = *(const u32x4*)(Ag + (size_t)(64 * i) * lda); rb[i] = *(const u32x4*)(Bg + (size_t)(64 * i) * K); }
    const int nk = K >> 6;
    const int wofs = (tid >> 3) * 72 + (tid & 7) * 8;
    const int arofs = (wm * 64 + l32) * 72 + hi * 8, brofs = 256 * 72 + (wn * 128 + l32) * 72 + hi * 8;
    __syncthreads();
#pragma unroll
    for (int i = 0; i < 4; ++i) { *(u32x4*)(S0 + wofs + 64 * i * 72) = ra[i]; *(u32x4*)(S0 + 256 * 72 + wofs + 64 * i * 72) = rb[i]; }
    if (nk > 1) {
#pragma unroll
        for (int i = 0; i < 4; ++i) { ra[i] = *(const u32x4*)(Ag + (size_t)(64 * i) * lda + 64); rb[i] = *(const u32x4*)(Bg + (size_t)(64 * i) * K + 64); }
    }
    __syncthreads();
#pragma unroll 1
    for (int kt = 0; kt < nk; ++kt) {
        const bfu* Sc = S0 + (kt & 1) * STG; bfu* Sn = S0 + ((kt & 1) ^ 1) * STG;
        if (kt + 1 < nk) {
#pragma unroll
            for (int i = 0; i < 4; ++i) { *(u32x4*)(Sn + wofs + 64 * i * 72) = ra[i]; *(u32x4*)(Sn + 256 * 72 + wofs + 64 * i * 72) = rb[i]; }
        }
        __builtin_amdgcn_sched_barrier(0);
        if (kt + 2 < nk) {
            const int ko = (kt + 2) * 64;
#pragma unroll
            for (int i = 0; i < 4; ++i) { ra[i] = *(const u32x4*)(Ag + (size_t)(64 * i) * lda + ko); rb[i] = *(const u32x4*)(Bg + (size_t)(64 * i) * K + ko); }
        }
        __builtin_amdgcn_sched_barrier(0);
#pragma unroll
        for (int k16 = 0; k16 < 4; ++k16) {
            bf16x8 af[2], bfr[4];
#pragma unroll
            for (int mb = 0; mb < 2; ++mb) af[mb] = *(const bf16x8*)(Sc + arofs + mb * 32 * 72 + k16 * 16);
#pragma unroll
            for (int nb = 0; nb < 4; ++nb) bfr[nb] = *(const bf16x8*)(Sc + brofs + nb * 32 * 72 + k16 * 16);
#pragma unroll
            for (int nb = 0; nb < 4; ++nb)
#pragma unroll
                for (int mb = 0; mb < 2; ++mb) acc[nb][mb] = MFMA(bfr[nb], af[mb], acc[nb][mb]);
        }
        __syncthreads();
    }
    if (EPI != 2) {
        constexpr int CP = 264;
        bfu* Cs = (bfu*)smem;
#pragma unroll
        for (int nb = 0; nb < 4; ++nb)
#pragma unroll
            for (int mb = 0; mb < 2; ++mb) {
                const int row = wm * 64 + mb * 32 + l32;
#pragma unroll
                for (int i = 0; i < 4; ++i) {
                    const int col = wn * 128 + nb * 32 + 8 * i + 4 * hi;
                    float v0 = acc[nb][mb][4 * i], v1 = acc[nb][mb][4 * i + 1], v2 = acc[nb][mb][4 * i + 2], v3 = acc[nb][mb][4 * i + 3];
                    if (EPI == 1) { v0 = fmaxf(v0, 0.f); v1 = fmaxf(v1, 0.f); v2 = fmaxf(v2, 0.f); v3 = fmaxf(v3, 0.f); v0 *= v0; v1 *= v1; v2 *= v2; v3 *= v3; }
                    *(u32x2*)(Cs + row * CP + col) = (u32x2){pk2(v0, v1), pk2(v2, v3)};
                }
            }
        __syncthreads();
        const int c8 = (tid & 31) * 8, n = n0 + c8;
#pragma unroll 1
        for (int ps = 0; ps < 16; ++ps) {
            const int row = ps * 16 + (tid >> 5);
            const u32x4 v = *(const u32x4*)(Cs + row * CP + c8);
            if (n < N) *(u32x4*)(Cb + (size_t)(m0 + row) * ldc + n) = v;
        }
        __syncthreads();
    } else {
        constexpr int CPF = 132;
        float* Cs = (float*)smem;
#pragma unroll
        for (int p2 = 0; p2 < 2; ++p2) {
#pragma unroll
            for (int nbl = 0; nbl < 2; ++nbl)
#pragma unroll
                for (int mb = 0; mb < 2; ++mb) {
                    const int row = wm * 64 + mb * 32 + l32;
#pragma unroll
                    for (int i = 0; i < 4; ++i) {
                        const int col = wn * 64 + nbl * 32 + 8 * i + 4 * hi;
                        *(f32x4*)(Cs + row * CPF + col) = (f32x4){acc[2 * p2 + nbl][mb][4 * i], acc[2 * p2 + nbl][mb][4 * i + 1], acc[2 * p2 + nbl][mb][4 * i + 2], acc[2 * p2 + nbl][mb][4 * i + 3]};
                    }
                }
            __syncthreads();
            const int cl = (tid & 31) * 4;
            const int n = n0 + (cl >> 6) * 128 + (2 * p2 + ((cl >> 5) & 1)) * 32 + (cl & 31);
#pragma unroll 1
            for (int ps = 0; ps < 16; ++ps) {
                const int row = ps * 16 + (tid >> 5), m = m0 + row, b = m >> 13;
                const f32x4 v = *(const f32x4*)(Cs + row * CPF + cl);
                const float4 g = *(const float4*)(gate + b * 6144 + n);
                const float4 r = *(const float4*)(resid + (size_t)m * 1024 + n);
                float4 o; o.x = r.x + g.x * v[0]; o.y = r.y + g.y * v[1]; o.z = r.z + g.z * v[2]; o.w = r.w + g.w * v[3];
                *(float4*)(outf + (size_t)m * 1024 + n) = o;
            }
            __syncthreads();
        }
    }
}

DI bool gemm_map(int round, int nsn, int nwt, int& mt, int& nt) {
    const int x = blockIdx.x & 7, li = blockIdx.x >> 3;
    const int st = round * 8 + x;
    if (st >= 16 * nsn || (li >> 3) >= nwt) return false;
    const int sm = st / nsn, sn = st % nsn;
    mt = sm * 8 + (li & 7); nt = sn * nwt + (li >> 3);
    return true;
}
template <int EPI>
DI void phase_gemm(const bfu* A, int lda, const bfu* Bt, int K, int N, int ntn, bfu* Cb, int ldc, const float* resid, float* outf, const float* gate, char* smem) {
    const bool xcd = (gridDim.x == 256);
    const int nwt = (ntn % 4 == 0) ? 4 : ntn, nsn = ntn / nwt;
    const int rounds = xcd ? 2 * nsn : (128 * ntn + (int)gridDim.x - 1) / (int)gridDim.x;
    for (int r = 0; r < rounds; ++r) {
        int mt = 0, nt = 0; bool ok;
        if (xcd) ok = gemm_map(r, nsn, nwt, mt, nt);
        else { const int tile = r * gridDim.x + blockIdx.x; ok = tile < 128 * ntn; mt = tile / ntn; nt = tile % ntn; }
        if (ok) gemm_tile<EPI>(A, lda, Bt, K, mt * 256, nt * 256, N, Cb, ldc, resid, outf, gate, smem);
    }
}


namespace pg8 {
#define PG8_LAS __attribute__((address_space(3)))
typedef unsigned short bf16_t;
typedef short bf16x8 __attribute__((ext_vector_type(8)));
typedef float f32x4 __attribute__((ext_vector_type(4)));
typedef unsigned u32x4 __attribute__((ext_vector_type(4)));
constexpr int BM = 256, BK = 64, HALF = 128, HTB = HALF * BK * 2  , STAGE_BYTES = 8 * HTB, NXCD = 8, WGM = 8;

__host__ __device__ __forceinline__ int lds_byte(int r, int c) { const int st = (r >> 4) * 2 + (c >> 5), rr = r & 15, cc = c & 31, ob = rr * 64 + cc * 2; return st * 1024 + (ob ^ (((ob >> 9) & 1) << 5)); }
__host__ __device__ __forceinline__ void stage_rc(int b, int& R, int& C) { const int st = b / 1024, sb = b % 1024, swz = sb ^ (((sb >> 9) & 1) << 5); R = (st >> 1) * 16 + swz / 64; C = (st & 1) * 32 + (swz % 64) / 2; }
__host__ __device__ __forceinline__ int perm32(int rho) { const int n = rho >> 4, i = rho & 15; return 8 * (i >> 2) + 4 * n + (i & 3); }

struct Unit { int pm, pn; };
struct Gemm { const bf16_t* A; const bf16_t* Bt; int lda, K; };

template <class Epi, class Sched, bool STAMP = false>
__device__ __forceinline__ void gemm_phase(PG8_LAS unsigned char* lds, const Gemm g, const Sched& S, const Epi& E, unsigned long long* stamps) {
    const int tid = threadIdx.x, wid = __builtin_amdgcn_readfirstlane(tid >> 6), lane = tid & 63, wr = wid >> 2, wc = wid & 3, fr = lane & 15, fq = lane >> 4;
    const int K = g.K, nt = K / BK;
    int ts_lo = 0, ts_hi = 0, nts = 0; const unsigned long long rt_entry = STAMP ? (unsigned long long)wall_clock64() : 0ull;
#define PG8_STAMP() do { if (STAMP && wid == 0 && nts < 64) { const unsigned long long _c = (unsigned long long)clock64(); \
        ts_lo = (lane == nts) ? (int)(unsigned)_c : ts_lo; ts_hi = (lane == nts) ? (int)(unsigned)(_c >> 32) : ts_hi; ++nts; } } while (0)
    PG8_STAMP();
    unsigned voffA[2], voffB[2];
#pragma unroll
    for (int i = 0; i < 2; ++i) { int R, C; stage_rc(tid * 16 + i * 8192, R, C); const int Rb = Epi::PERM ? ((R & ~31) + perm32(R & 31)) : R;
        voffA[i] = (unsigned)(R * g.lda + C) * 2u; voffB[i] = (unsigned)(Rb * K + C) * 2u; }
    const size_t kstep = (size_t)(BK * 2);
    const size_t hstep = (size_t)HALF * K * 2, hstepA = (size_t)HALF * g.lda * 2;
    const size_t tstep = 2 * hstep, tstepA = 2 * hstepA;
    const unsigned ldsw = (unsigned)wid * 1024u;
    const int aoff = lds_byte(wr * 64 + fr, fq * 8), boff = lds_byte(wc * 32 + fr, fq * 8);
#define PG8_SA(b, h) (((b) * 2 + (h)) * HTB)
#define PG8_SB(b, h) ((4 + (b) * 2 + (h)) * HTB)
#define PG8_STAGE(bufoff, gbase, voff) do { _Pragma("unroll") for (int _i = 0; _i < 2; ++_i) \
        __builtin_amdgcn_global_load_lds((const unsigned*)((const char*)(gbase) + (voff)[_i]), (PG8_LAS unsigned*)(lds + (bufoff) + ldsw + _i * 8192), 16, 0, 0); } while (0)
#define PG8_LDA(dst, b, h) do { _Pragma("unroll") for (int m = 0; m < 4; ++m) _Pragma("unroll") for (int k = 0; k < 2; ++k) dst[m][k] = *(const PG8_LAS bf16x8*)(lds + PG8_SA(b, h) + aoff + m * 2048 + k * 1024); } while (0)
#define PG8_LDB(dst, b, h) do { _Pragma("unroll") for (int n = 0; n < 2; ++n) _Pragma("unroll") for (int k = 0; k < 2; ++k) dst[n][k] = *(const PG8_LAS bf16x8*)(lds + PG8_SB(b, h) + boff + n * 2048 + k * 1024); } while (0)
#define PG8_MMA(ai, bj, At, Bt) do { __builtin_amdgcn_s_setprio(1); _Pragma("unroll") for (int m = 0; m < 4; ++m) _Pragma("unroll") for (int n = 0; n < 2; ++n) _Pragma("unroll") for (int k = 0; k < 2; ++k) \
        acc[ai][bj][m][n] = __builtin_amdgcn_mfma_f32_16x16x32_bf16(Bt[n][k], At[m][k], acc[ai][bj][m][n], 0, 0, 0); __builtin_amdgcn_s_setprio(0); } while (0)
#define PG8_WAIT_V(n) asm volatile("s_waitcnt vmcnt(" #n ")" ::: "memory")
#define PG8_WAIT_L(n) asm volatile("s_waitcnt lgkmcnt(" #n ")" ::: "memory")
#define PG8_BAR __builtin_amdgcn_s_barrier()
#define PG8_SCHED __builtin_amdgcn_sched_barrier(0)
    Unit cur, nxt; int ui = 0;
    if (!S.next(0, cur)) return;
    f32x4 acc[2][2][4][2];
#pragma unroll
    for (int a = 0; a < 2; ++a)
#pragma unroll
        for (int b = 0; b < 2; ++b)
#pragma unroll
            for (int m = 0; m < 4; ++m)
#pragma unroll
                for (int n = 0; n < 2; ++n) acc[a][b][m][n] = (f32x4){0.f, 0.f, 0.f, 0.f};
    bf16x8 At[4][2], B0[2][2], B1[2][2];
    const char* cA = (const char*)g.A + (size_t)cur.pm * tstepA; const char* cB = (const char*)g.Bt + (size_t)cur.pn * tstep;
    S.a_ready(cur);
    PG8_STAGE(PG8_SB(0, 0), cB, voffB); PG8_STAGE(PG8_SA(0, 0), cA, voffA); PG8_STAGE(PG8_SB(0, 1), cB + hstep, voffB); PG8_STAGE(PG8_SA(0, 1), cA + hstepA, voffA);
    if (wr == 1) PG8_BAR;
    PG8_WAIT_V(4); PG8_BAR;
    PG8_STAGE(PG8_SB(1, 0), cB + kstep, voffB); PG8_STAGE(PG8_SA(1, 0), cA + kstep, voffA); PG8_STAGE(PG8_SB(1, 1), cB + hstep + kstep, voffB);
    PG8_WAIT_V(6); PG8_BAR;
    PG8_STAMP();
    for (;;) {
        const bool has_next = S.next(ui + 1, nxt);
        const char* nA = has_next ? (const char*)g.A + (size_t)nxt.pm * tstepA : cA; const char* nB = has_next ? (const char*)g.Bt + (size_t)nxt.pn * tstep : cB;
        for (int t = 0; t < nt; t += 2) {
            const bool last = (t == nt - 2);
            const char* a1 = cA + (size_t)(t + 1) * kstep;
            const char* a2 = last ? nA : cA + (size_t)(t + 2) * kstep; const char* b2 = last ? nB : cB + (size_t)(t + 2) * kstep;
            const char* a3 = a2 + kstep; const char* b3 = b2 + kstep;
            if (last && has_next) S.a_ready(nxt);
            PG8_LDB(B0, 0, 0); PG8_SCHED; PG8_LDA(At, 0, 0); PG8_STAGE(PG8_SA(1, 1), a1 + hstepA, voffA);
            PG8_WAIT_L(8); PG8_BAR; PG8_WAIT_L(0); PG8_MMA(0, 0, At, B0); PG8_BAR; PG8_SCHED;
            PG8_LDB(B1, 0, 1); PG8_STAGE(PG8_SB(0, 0), b2, voffB);
            PG8_BAR; PG8_WAIT_L(0); PG8_MMA(0, 1, At, B1); PG8_BAR;
            PG8_LDA(At, 0, 1); PG8_STAGE(PG8_SA(0, 0), a2, voffA);
            PG8_BAR; PG8_WAIT_L(0); PG8_MMA(1, 0, At, B0); PG8_BAR; PG8_SCHED;
            PG8_STAGE(PG8_SB(0, 1), b2 + hstep, voffB);
            PG8_WAIT_V(6); PG8_BAR; PG8_MMA(1, 1, At, B1); PG8_BAR;
            PG8_LDB(B0, 1, 0); PG8_SCHED; PG8_LDA(At, 1, 0); PG8_STAGE(PG8_SA(0, 1), a2 + hstepA, voffA);
            PG8_WAIT_L(8); PG8_BAR; PG8_WAIT_L(0); PG8_MMA(0, 0, At, B0); PG8_BAR; PG8_SCHED;
            PG8_LDB(B1, 1, 1); PG8_STAGE(PG8_SB(1, 0), b3, voffB);
            PG8_BAR; PG8_WAIT_L(0); PG8_MMA(0, 1, At, B1); PG8_BAR;
            PG8_LDA(At, 1, 1); PG8_STAGE(PG8_SA(1, 0), a3, voffA);
            PG8_BAR; PG8_WAIT_L(0); PG8_MMA(1, 0, At, B0); PG8_BAR; PG8_SCHED;
            PG8_STAGE(PG8_SB(1, 1), b3 + hstep, voffB);
            PG8_WAIT_V(6); PG8_BAR; PG8_MMA(1, 1, At, B1); PG8_BAR;
        }
        PG8_STAMP();
        if constexpr (!Epi::AFTER_DRAIN) { E(acc, cur, wr, wc, fr, fq); S.done(cur); }
        PG8_STAMP();
        if (!has_next) break;
#pragma unroll
        for (int a = 0; a < 2; ++a)
#pragma unroll
            for (int b = 0; b < 2; ++b)
#pragma unroll
                for (int m = 0; m < 4; ++m)
#pragma unroll
                    for (int n = 0; n < 2; ++n) acc[a][b][m][n] = (f32x4){0.f, 0.f, 0.f, 0.f};
        cur = nxt; cA = nA; cB = nB; ++ui;
    }
    PG8_WAIT_V(0);
    if (wr == 0) PG8_BAR;
    PG8_BAR;
    if constexpr (Epi::AFTER_DRAIN) { E.fused(acc, cur, wr, wc, fr, fq, lds, wid, lane); S.done(cur); }
    PG8_STAMP();
    if (STAMP && wid == 0) { stamps[lane] = lane < nts ? (((unsigned long long)(unsigned)ts_hi << 32) | (unsigned)ts_lo) : 0ull;
        if (lane == 62) stamps[62] = rt_entry; if (lane == 63) stamps[63] = (unsigned long long)wall_clock64(); }
#undef PG8_STAMP
#undef PG8_SA
#undef PG8_SB
#undef PG8_STAGE
#undef PG8_LDA
#undef PG8_LDB
#undef PG8_MMA
#undef PG8_WAIT_V
#undef PG8_WAIT_L
#undef PG8_BAR
#undef PG8_SCHED
}
}

struct XcdOrder {
    int nsn, nwt, ntn;
    DI bool next(int i, pg8::Unit& u) const {
        int mt, nt;
        if (gridDim.x == 256) { if (!gemm_map(i, nsn, nwt, mt, nt)) return false; }
        else { const int tile = i * (int)gridDim.x + (int)blockIdx.x; if (tile >= 128 * ntn) return false; mt = tile / ntn; nt = tile % ntn; }
        u.pm = mt; u.pn = nt; return true;
    }
    DI void a_ready(const pg8::Unit&) const {}
    DI void done(const pg8::Unit&) const {}
};
template <int ACT> struct EpiOutBf16 {
    static constexpr bool PERM = true, AFTER_DRAIN = false;
    bfu* O; int ldc, N;
    DI void operator()(const pg8::f32x4 (&acc)[2][2][4][2], const pg8::Unit& u, int wr, int wc, int fr, int fq) const {
        const int row0 = u.pm * 256 + wr * 64 + fr, col0 = u.pn * 256 + wc * 32 + 8 * fq;
#pragma unroll
        for (int ai = 0; ai < 2; ++ai)
#pragma unroll
            for (int m = 0; m < 4; ++m) {
                bfu* rowp = O + (size_t)(row0 + ai * 128 + m * 16) * ldc + col0;
#pragma unroll
                for (int bj = 0; bj < 2; ++bj) {
                    pg8::f32x4 v0 = acc[ai][bj][m][0], v1 = acc[ai][bj][m][1];
                    if (ACT == 1) {
#pragma unroll
                        for (int j = 0; j < 4; ++j) { const float a = fmaxf(v0[j], 0.f), b = fmaxf(v1[j], 0.f); v0[j] = a * a; v1[j] = b * b; }
                    }
                    if (col0 + bj * 128 < N) *(u32x4*)(rowp + bj * 128) = (u32x4){pk2(v0[0], v0[1]), pk2(v0[2], v0[3]), pk2(v1[0], v1[1]), pk2(v1[2], v1[3])};
                }
            }
    }
};
struct EpiResid {
    static constexpr bool PERM = false, AFTER_DRAIN = false;
    const float* resid; float* out; const float* gate;
    DI void operator()(const pg8::f32x4 (&acc)[2][2][4][2], const pg8::Unit& u, int wr, int wc, int fr, int fq) const {
        const int row0 = u.pm * 256 + wr * 64 + fr, col0 = u.pn * 256 + wc * 32 + 4 * fq;
        const float* gb = gate + ((u.pm * 256) >> 13) * 6144 + col0;
        pg8::f32x4 gv[2][2];
#pragma unroll
        for (int bj = 0; bj < 2; ++bj)
#pragma unroll
            for (int n = 0; n < 2; ++n) gv[bj][n] = *(const pg8::f32x4*)(gb + bj * 128 + n * 16);
#pragma unroll
        for (int ai = 0; ai < 2; ++ai)
#pragma unroll
            for (int m = 0; m < 4; ++m) {
                const size_t ro = (size_t)(row0 + ai * 128 + m * 16) * 1024 + col0;
#pragma unroll
                for (int bj = 0; bj < 2; ++bj)
#pragma unroll
                    for (int n = 0; n < 2; ++n) {
                        const pg8::f32x4 r = *(const pg8::f32x4*)(resid + ro + bj * 128 + n * 16);
                        *(pg8::f32x4*)(out + ro + bj * 128 + n * 16) = r + gv[bj][n] * acc[ai][bj][m][n];
                    }
            }
    }
};
template <int EPI>
DI void phase_gemm8(const bfu* A, int lda, const bfu* Bt, int K, int N, int ntn, bfu* Cb, int ldc, const float* resid, float* outf, const float* gate, char* smem) {
    pg8::Gemm g; g.A = A; g.Bt = Bt; g.lda = lda; g.K = K;
    XcdOrder S; S.ntn = ntn; S.nwt = (ntn % 4 == 0) ? 4 : ntn; S.nsn = ntn / S.nwt;
    __syncthreads();
    if (EPI == 2) { EpiResid E; E.resid = resid; E.out = outf; E.gate = gate; pg8::gemm_phase<EpiResid, XcdOrder, false>((PG8_LAS unsigned char*)smem, g, S, E, nullptr); }
    else { EpiOutBf16<EPI> E; E.O = Cb; E.ldc = ldc; E.N = N; pg8::gemm_phase<EpiOutBf16<EPI>, XcdOrder, false>((PG8_LAS unsigned char*)smem, g, S, E, nullptr); }
    __syncthreads();
}


struct EpiHeads {
    static constexpr bool PERM = true, AFTER_DRAIN = false;
    bfu* O; const float2* rope; const float *w_dq, *w_dk, *w_mq, *w_mk; float* kpart;
    DI void operator()(const pg8::f32x4 (&acc)[2][2][4][2], const pg8::Unit& u, int wr, int wc, int fr, int fq) const {
        const int pn = u.pn;
        const int kind = (pn < 2) ? 1 : (pn < 4) ? 2 : (pn < 6) ? 0 : (pn < 8) ? 3 : (pn < 10) ? 4 : 0;
        const float scale = (kind == 1 || kind == 3) ? SC_64 : 1.f;
        const int colbase = pn * 256 + wc * 64 + 8 * fq;
        float wa[8], wb[8];
#pragma unroll
        for (int e = 0; e < 8; ++e) {
            const int d = 8 * fq + e;
            const float a1 = w_dq[d], a2 = w_dk[d], a3 = w_mq[d], a4 = w_mk[d], b1 = w_dq[32 + d], b2 = w_dk[32 + d], b3 = w_mq[32 + d], b4 = w_mk[32 + d];
            wa[e] = ((kind == 1) ? a1 : (kind == 2) ? a2 : (kind == 3) ? a3 : a4) * scale;
            wb[e] = ((kind == 1) ? b1 : (kind == 2) ? b2 : (kind == 3) ? b3 : b4) * scale;
        }
#pragma unroll
        for (int ai = 0; ai < 2; ++ai) {
            float ks1[8], ks2[8];
#pragma unroll
            for (int e = 0; e < 8; ++e) { ks1[e] = 0.f; ks2[e] = 0.f; }
#pragma unroll
            for (int m = 0; m < 4; ++m) {
                const int row = u.pm * 256 + ai * 128 + wr * 64 + m * 16 + fr;
                float x1[8], x2[8];
#pragma unroll
                for (int e = 0; e < 8; ++e) { x1[e] = acc[ai][0][m][e >> 2][e & 3]; x2[e] = acc[ai][1][m][e >> 2][e & 3]; }
                if (kind) {
                    float ss = 0.f;
#pragma unroll
                    for (int e = 0; e < 8; ++e) ss += x1[e] * x1[e] + x2[e] * x2[e];
                    ss += __shfl_xor(ss, 16); ss += __shfl_xor(ss, 32);
                    const float r = rsqrtf(ss * (1.f / 64.f) + EPS);
                    const float4* cp = (const float4*)(rope + (size_t)row * 32 + 8 * fq);
#pragma unroll
                    for (int e2 = 0; e2 < 4; ++e2) {
                        const float4 cs = cp[e2];
                        {   const int e = 2 * e2; const float y1 = x1[e] * r * wa[e], y2 = x2[e] * r * wb[e];
                            x1[e] = y1 * cs.x - y2 * cs.y; x2[e] = y2 * cs.x + y1 * cs.y; }
                        {   const int e = 2 * e2 + 1; const float y1 = x1[e] * r * wa[e], y2 = x2[e] * r * wb[e];
                            x1[e] = y1 * cs.z - y2 * cs.w; x2[e] = y2 * cs.z + y1 * cs.w; }
                    }
                    if (kind == 4) {
#pragma unroll
                        for (int e = 0; e < 8; ++e) { ks1[e] += x1[e]; ks2[e] += x2[e]; }
                    }
                }
                bfu* rowp = O + (size_t)row * 3072 + colbase;
                *(u32x4*)rowp = (u32x4){pk2(x1[0], x1[1]), pk2(x1[2], x1[3]), pk2(x1[4], x1[5]), pk2(x1[6], x1[7])};
                *(u32x4*)(rowp + 32) = (u32x4){pk2(x2[0], x2[1]), pk2(x2[2], x2[3]), pk2(x2[4], x2[5]), pk2(x2[6], x2[7])};
            }
            if (kind == 4) {
#pragma unroll
                for (int e = 0; e < 8; ++e) {
                    float a = ks1[e], b = ks2[e];
                    a += __shfl_xor(a, 1); a += __shfl_xor(a, 2); a += __shfl_xor(a, 4); a += __shfl_xor(a, 8);
                    b += __shfl_xor(b, 1); b += __shfl_xor(b, 2); b += __shfl_xor(b, 4); b += __shfl_xor(b, 8);
                    ks1[e] = a; ks2[e] = b;
                }
                if (fr == 0) {
                    float* kp = kpart + (size_t)(4 * u.pm + 2 * ai + wr) * 512 + ((pn - 8) * 4 + wc) * 64 + 8 * fq;
#pragma unroll
                    for (int e = 0; e < 8; ++e) { kp[e] = ks1[e]; kp[32 + e] = ks2[e]; }
                }
            }
        }
    }
};
DI void phase_gemm_heads(const Params& p, const bfu* A, const bfu* Bt, bfu* O, char* smem) {
    pg8::Gemm g; g.A = A; g.Bt = Bt; g.lda = 1024; g.K = 1024;
    XcdOrder S; S.ntn = 12; S.nwt = 4; S.nsn = 3;
    EpiHeads E; E.O = O; E.rope = (const float2*)(p.ws + OFF_ROPE64); E.w_dq = p.diff_qn; E.w_dk = p.diff_kn; E.w_mq = p.moba_qn; E.w_mk = p.moba_kn;
    E.kpart = (float*)(p.ws + OFF_KPART);
    __syncthreads();
    pg8::gemm_phase<EpiHeads, XcdOrder, false>((PG8_LAS unsigned char*)smem, g, S, E, nullptr);
    __syncthreads();
}

#ifndef MK_PROBE
#define MK_PROBE 0
#endif
#if MK_PROBE
template <int VAR>
DI void gemm_probe(const bfu* __restrict__ A, int lda, const bfu* __restrict__ Bt, int K, int m0, int n0, float* sinkp, int sink, char* smem) {
    constexpr int STG = 512 * 72;
    bfu* S0 = (bfu*)smem;
    const int tid = threadIdx.x, lane = tid & 63, wid = tid >> 6, l32 = lane & 31, hi = lane >> 5;
    const int wm = wid & 3, wn = wid >> 2;
    f32x16 acc[4][2];
#pragma unroll
    for (int nb = 0; nb < 4; ++nb)
#pragma unroll
        for (int mb = 0; mb < 2; ++mb)
#pragma unroll
            for (int r = 0; r < 16; ++r) acc[nb][mb][r] = 0.f;
    const bfu* Ag = A + (size_t)(m0 + (tid >> 3)) * lda + (tid & 7) * 8;
    const bfu* Bg = Bt + (size_t)(n0 + (tid >> 3)) * K + (tid & 7) * 8;
    u32x4 ra[4], rb[4];
#pragma unroll
    for (int i = 0; i < 4; ++i) { ra[i] = *(const u32x4*)(Ag + (size_t)(64 * i) * lda); rb[i] = *(const u32x4*)(Bg + (size_t)(64 * i) * K); }
    const int nk = K >> 6;
    const int wofs = (tid >> 3) * 72 + (tid & 7) * 8;
    const int arofs = (wm * 64 + l32) * 72 + hi * 8, brofs = 256 * 72 + (wn * 128 + l32) * 72 + hi * 8;
    __syncthreads();
#pragma unroll
    for (int i = 0; i < 4; ++i) { *(u32x4*)(S0 + wofs + 64 * i * 72) = ra[i]; *(u32x4*)(S0 + 256 * 72 + wofs + 64 * i * 72) = rb[i]; }
    __syncthreads();
#pragma unroll 1
    for (int kt = 0; kt < nk; ++kt) {
        const bfu* Sc = S0 + (kt & 1) * STG; bfu* Sn = S0 + ((kt & 1) ^ 1) * STG;
        if (VAR != 2 && kt + 1 < nk) {
#pragma unroll
            for (int i = 0; i < 4; ++i) { *(u32x4*)(Sn + wofs + 64 * i * 72) = ra[i]; *(u32x4*)(Sn + 256 * 72 + wofs + 64 * i * 72) = rb[i]; }
        }
        __builtin_amdgcn_sched_barrier(0);
        if (VAR != 1 && VAR != 2 && kt + 2 < nk) {
            const int ko = (kt + 2) * 64;
#pragma unroll
            for (int i = 0; i < 4; ++i) { ra[i] = *(const u32x4*)(Ag + (size_t)(64 * i) * lda + ko); rb[i] = *(const u32x4*)(Bg + (size_t)(64 * i) * K + ko); }
        }
        __builtin_amdgcn_sched_barrier(0);
        if (VAR == 3) {
            bf16x8 af[2], bfr[4];
#pragma unroll
            for (int mb = 0; mb < 2; ++mb) af[mb] = *(const bf16x8*)(Sc + arofs + mb * 32 * 72);
#pragma unroll
            for (int nb = 0; nb < 4; ++nb) bfr[nb] = *(const bf16x8*)(Sc + brofs + nb * 32 * 72);
#pragma unroll
            for (int k16 = 0; k16 < 4; ++k16)
#pragma unroll
                for (int nb = 0; nb < 4; ++nb)
#pragma unroll
                    for (int mb = 0; mb < 2; ++mb) acc[nb][mb] = MFMA(bfr[nb], af[mb], acc[nb][mb]);
        } else {
#pragma unroll
            for (int k16 = 0; k16 < 4; ++k16) {
                bf16x8 af[2], bfr[4];
#pragma unroll
                for (int mb = 0; mb < 2; ++mb) af[mb] = *(const bf16x8*)(Sc + arofs + mb * 32 * 72 + k16 * 16);
#pragma unroll
                for (int nb = 0; nb < 4; ++nb) bfr[nb] = *(const bf16x8*)(Sc + brofs + nb * 32 * 72 + k16 * 16);
#pragma unroll
                for (int nb = 0; nb < 4; ++nb)
#pragma unroll
                    for (int mb = 0; mb < 2; ++mb) acc[nb][mb] = MFMA(bfr[nb], af[mb], acc[nb][mb]);
            }
        }
        __syncthreads();
    }
    if (sink) {
#pragma unroll
        for (int nb = 0; nb < 4; ++nb)
#pragma unroll
            for (int mb = 0; mb < 2; ++mb)
#pragma unroll
                for (int r = 0; r < 16; ++r) sinkp[tid * 128 + (nb * 2 + mb) * 16 + r] = acc[nb][mb][r];
    }
}
template <int VAR>
DI void phase_gemm_probe(const bfu* A, const bfu* Bt, float* sinkp, int sink, char* smem) {
    for (int r = 0; r < 6; ++r) { int mt, nt; if (gemm_map(r, 3, 4, mt, nt)) gemm_probe<VAR>(A, 1024, Bt, 1024, mt * 256, nt * 256, sinkp, sink, smem); }
}
#endif

DI void headnorm64(bfu* hp, const float* __restrict__ w, const float2* __restrict__ cs, float scale, int j, bool acc_on, f32x4& ka1, f32x4& ka2) {
    const u32x2 a = *(const u32x2*)(hp + 4 * j), b = *(const u32x2*)(hp + 32 + 4 * j);
    float x1[4] = {bflo(a[0]), bfhi(a[0]), bflo(a[1]), bfhi(a[1])}, x2[4] = {bflo(b[0]), bfhi(b[0]), bflo(b[1]), bfhi(b[1])};
    float ss = 0.f;
#pragma unroll
    for (int e = 0; e < 4; ++e) ss += x1[e] * x1[e] + x2[e] * x2[e];
    ss += __shfl_xor(ss, 1); ss += __shfl_xor(ss, 2); ss += __shfl_xor(ss, 4);
    const float r = rsqrtf(ss * (1.f / 64.f) + EPS);
    const float4 w1 = *(const float4*)(w + 4 * j), w2 = *(const float4*)(w + 32 + 4 * j);
    const float wa[4] = {w1.x, w1.y, w1.z, w1.w}, wb[4] = {w2.x, w2.y, w2.z, w2.w};
    float o1[4], o2[4];
#pragma unroll
    for (int e = 0; e < 4; ++e) {
        const float y1 = x1[e] * r * wa[e], y2 = x2[e] * r * wb[e]; const float2 c = cs[4 * j + e];
        o1[e] = y1 * c.x - y2 * c.y; o2[e] = y2 * c.x + y1 * c.y;
    }
    if (acc_on) {
#pragma unroll
        for (int e = 0; e < 4; ++e) { ka1[e] += o1[e]; ka2[e] += o2[e]; }
    }
    *(u32x2*)(hp + 4 * j) = (u32x2){pk2(o1[0] * scale, o1[1] * scale), pk2(o1[2] * scale, o1[3] * scale)};
    *(u32x2*)(hp + 32 + 4 * j) = (u32x2){pk2(o2[0] * scale, o2[1] * scale), pk2(o2[2] * scale, o2[3] * scale)};
}

DI float sq4(u32x2 a) { const float x0 = bflo(a[0]), x1 = bfhi(a[0]), x2 = bflo(a[1]), x3 = bfhi(a[1]); return x0 * x0 + x1 * x1 + x2 * x2 + x3 * x3; }

DI void mla_head(u32x4 nv, unsigned x1, unsigned x2, float rn, float rr, const float* __restrict__ wn, int j, float2 csA, float2 csB, float scale, bfu* dst) {
    float f[8] = {bflo(nv[0]) * rn, bfhi(nv[0]) * rn, bflo(nv[1]) * rn, bfhi(nv[1]) * rn, bflo(nv[2]) * rn, bfhi(nv[2]) * rn, bflo(nv[3]) * rn, bfhi(nv[3]) * rn};
    const float a0 = bflo(x1) * rr, a1 = bfhi(x1) * rr, b0 = bflo(x2) * rr, b1 = bfhi(x2) * rr;
    float ss = a0 * a0 + a1 * a1 + b0 * b0 + b1 * b1;
#pragma unroll
    for (int e = 0; e < 8; ++e) ss += f[e] * f[e];
    ss += __shfl_xor(ss, 1); ss += __shfl_xor(ss, 2); ss += __shfl_xor(ss, 4);
    const float r = rsqrtf(ss * (1.f / 96.f) + EPS) * scale;
    const float4 wA = *(const float4*)(wn + 8 * j), wB = *(const float4*)(wn + 8 * j + 4);
    const float wv[8] = {wA.x, wA.y, wA.z, wA.w, wB.x, wB.y, wB.z, wB.w};
#pragma unroll
    for (int e = 0; e < 8; ++e) f[e] *= r * wv[e];
    *(u32x4*)(dst + 8 * j) = (u32x4){pk2(f[0], f[1]), pk2(f[2], f[3]), pk2(f[4], f[5]), pk2(f[6], f[7])};
    const float y10 = a0 * r * wn[64 + 2 * j], y11 = a1 * r * wn[65 + 2 * j], y20 = b0 * r * wn[80 + 2 * j], y21 = b1 * r * wn[81 + 2 * j];
    *(unsigned*)(dst + 64 + 2 * j) = pk2(y10 * csA.x - y20 * csA.y, y11 * csB.x - y21 * csB.y);
    *(unsigned*)(dst + 80 + 2 * j) = pk2(y20 * csA.x + y10 * csA.y, y21 * csB.x + y11 * csB.y);
}

DI void phase_post_even(const Params& p) {
    char* ws = p.ws;
    bfu* ubuf = (bfu*)(ws + OFF_UBUF); const bfu* qraw = (const bfu*)(ws + OFF_HBUF); const bfu* kvraw = (const bfu*)(ws + OFF_OBUF);
    bfu* Qa = (bfu*)p.out; bfu* Ka = Qa + (size_t)T * 768; bfu* Va = Ka + (size_t)T * 768;
    const float2* r64 = (const float2*)(ws + OFF_ROPE64); const float2* r32 = (const float2*)(ws + OFF_ROPE32);
    const int lane = threadIdx.x & 63, gw = blockIdx.x * NW + (threadIdx.x >> 6), nwv = gridDim.x * NW;
    const int h = lane >> 3, j = lane & 7;
    for (int t = gw; t < T; t += nwv) {
        bfu* ur = ubuf + (size_t)t * 3072;
        float ssq = sq4(*(const u32x2*)(ur + lane * 4));
        if (lane < 32) ssq += sq4(*(const u32x2*)(ur + 256 + lane * 4));
        float sskv = sq4(*(const u32x2*)(ur + 384 + lane * 4));
        ssq = wave_sum(ssq); sskv = wave_sum(sskv);
        const float rq = rsqrtf(ssq * (1.f / 384.f) + EPS), rkv = rsqrtf(sskv * (1.f / 256.f) + EPS);
        const float2 csA = r32[(size_t)t * 16 + 2 * j], csB = r32[(size_t)t * 16 + 2 * j + 1];
        {
            const bfu* qr = qraw + (size_t)t * 768 + h * 96;
            mla_head(*(const u32x4*)(qr + 8 * j), *(const unsigned*)(qr + 64 + 2 * j), *(const unsigned*)(qr + 80 + 2 * j), rq, rq, p.mla_qn, j, csA, csB, SC_MLA, Qa + (size_t)t * 768 + h * 96);
        }
        {
            const bfu* kr = kvraw + (size_t)t * 1024 + h * 128;
            mla_head(*(const u32x4*)(kr + 8 * j), *(const unsigned*)(ur + 640 + 2 * j), *(const unsigned*)(ur + 656 + 2 * j), rkv, 1.f, p.mla_kn, j, csA, csB, 1.f, Ka + (size_t)t * 768 + h * 96);
            const u32x4 vv = *(const u32x4*)(kr + 64 + 8 * j);
            *(u32x4*)(Va + (size_t)t * 512 + h * 64 + 8 * j) = (u32x4){pk2(bflo(vv[0]) * rkv, bfhi(vv[0]) * rkv), pk2(bflo(vv[1]) * rkv, bfhi(vv[1]) * rkv),
                                                                      pk2(bflo(vv[2]) * rkv, bfhi(vv[2]) * rkv), pk2(bflo(vv[3]) * rkv, bfhi(vv[3]) * rkv)};
        }
        f32x4 d1, d2;
#pragma unroll
        for (int rd = 0; rd < 3; ++rd) {
            const int hh = rd * 8 + h, which = hh / 12, gh = hh % 12;
            headnorm64(ur + 672 + which * 768 + gh * 64, which ? p.dil_kn : p.dil_qn, r64 + (size_t)t * 32, which ? 1.f : SC_64, j, false, d1, d2);
        }
    }
}

DI void phase_post_odd(const Params& p, char* smem) {
    char* ws = p.ws;
    bfu* ubuf = (bfu*)(ws + OFF_UBUF); const float2* r64 = (const float2*)(ws + OFF_ROPE64); float* kpart = (float*)(ws + OFF_KPART);
    const int tid = threadIdx.x, lane = tid & 63, wid = tid >> 6, h = lane >> 3, j = lane & 7;
    float* red = (float*)smem;
    for (int it = blockIdx.x; it < T / 64; it += gridDim.x) {
        f32x4 ka1 = {0.f, 0.f, 0.f, 0.f}, ka2 = {0.f, 0.f, 0.f, 0.f}, d1, d2;
        for (int tt = 0; tt < 8; ++tt) {
            const int t = it * 64 + wid * 8 + tt;
            bfu* ur = ubuf + (size_t)t * 3072; const float2* cs = r64 + (size_t)t * 32;
            headnorm64(ur + h * 64, p.diff_qn, cs, SC_64, j, false, d1, d2);
            headnorm64(ur + 512 + h * 64, p.diff_kn, cs, 1.f, j, false, d1, d2);
            headnorm64(ur + 1536 + h * 64, p.moba_qn, cs, SC_64, j, false, d1, d2);
            headnorm64(ur + 2048 + h * 64, p.moba_kn, cs, 1.f, j, true, ka1, ka2);
        }
        __syncthreads();
#pragma unroll
        for (int e = 0; e < 4; ++e) { red[(wid * 64 + lane) * 8 + e] = ka1[e]; red[(wid * 64 + lane) * 8 + 4 + e] = ka2[e]; }
        __syncthreads();
        {
            const int o = tid, hh = o >> 6, d = o & 63, jj = (d & 31) >> 2, e = (d & 3) + ((d >> 5) << 2), ln = hh * 8 + jj;
            float sum = 0.f;
#pragma unroll
            for (int w = 0; w < NW; ++w) sum += red[(w * 64 + ln) * 8 + e];
            kpart[(size_t)it * 512 + o] = sum;
        }
    }
    __syncthreads();
}

DI void phase_dil_merge(const Params& p) {
    const bfu* dil_o = (const bfu*)(p.ws + OFF_HBUF); const float* dil_lse = (const float*)(p.ws + OFF_HBUF + 48 * MiB);
    bfu* obuf = (bfu*)(p.ws + OFF_OBUF);
    for (int idx = blockIdx.x * NT + threadIdx.x; idx < T * 64; idx += gridDim.x * NT) {
        const int t = idx >> 6, r = idx & 63, h = r >> 4, jj = r & 15;
        const float l0 = dil_lse[(size_t)t * 12 + h], l1 = dil_lse[(size_t)t * 12 + 4 + h], l2 = dil_lse[(size_t)t * 12 + 8 + h];
        const float mx = fmaxf(l0, fmaxf(l1, l2));
        float w0 = exp2f(l0 - mx), w1 = exp2f(l1 - mx), w2 = exp2f(l2 - mx); const float inv = 1.f / (w0 + w1 + w2); w0 *= inv; w1 *= inv; w2 *= inv;
        const u32x2 a = *(const u32x2*)(dil_o + (size_t)t * 768 + h * 64 + 4 * jj), b = *(const u32x2*)(dil_o + (size_t)t * 768 + (4 + h) * 64 + 4 * jj),
                    c = *(const u32x2*)(dil_o + (size_t)t * 768 + (8 + h) * 64 + 4 * jj);
        const float o0 = w0 * bflo(a[0]) + w1 * bflo(b[0]) + w2 * bflo(c[0]), o1 = w0 * bfhi(a[0]) + w1 * bfhi(b[0]) + w2 * bfhi(c[0]);
        const float o2 = w0 * bflo(a[1]) + w1 * bflo(b[1]) + w2 * bflo(c[1]), o3 = w0 * bfhi(a[1]) + w1 * bfhi(b[1]) + w2 * bfhi(c[1]);
        *(u32x2*)(obuf + (size_t)t * 768 + 512 + h * 64 + 4 * jj) = (u32x2){pk2(o0, o1), pk2(o2, o3)};
    }
}

DI void phase_diff_combine(const Params& p) {
    const bfu* dbuf = (const bfu*)(p.ws + OFF_DBUF); bfu* obuf = (bfu*)(p.ws + OFF_OBUF);
    const int lane = threadIdx.x & 63, gw = blockIdx.x * NW + (threadIdx.x >> 6), nwv = gridDim.x * NW;
    float lam;
    {
        const float sa = wave_sum(p.diff_lam[lane] * p.diff_lam[64 + lane]), sb = wave_sum(p.diff_lam[128 + lane] * p.diff_lam[192 + lane]);
        lam = expf(sa) - expf(sb) + LAM_INIT;
    }
    const int h = lane >> 4, jj = lane & 15;
    const float4 sA = *(const float4*)(p.diff_subln + 8 * jj), sB = *(const float4*)(p.diff_subln + 8 * jj + 4);
    const float sw[8] = {sA.x, sA.y, sA.z, sA.w, sB.x, sB.y, sB.z, sB.w};
    for (int t = gw; t < T; t += nwv) {
        const u32x4 a = *(const u32x4*)(dbuf + (size_t)t * 1024 + (2 * h) * 128 + 8 * jj), b = *(const u32x4*)(dbuf + (size_t)t * 1024 + (2 * h + 1) * 128 + 8 * jj);
        float d[8];
#pragma unroll
        for (int e = 0; e < 4; ++e) { d[2 * e] = bflo(a[e]) - lam * bflo(b[e]); d[2 * e + 1] = bfhi(a[e]) - lam * bfhi(b[e]); }
        float ss = 0.f;
#pragma unroll
        for (int e = 0; e < 8; ++e) ss += d[e] * d[e];
        ss += __shfl_xor(ss, 1); ss += __shfl_xor(ss, 2); ss += __shfl_xor(ss, 4); ss += __shfl_xor(ss, 8);
        const float r = rsqrtf(ss * (1.f / 128.f) + EPS) * (1.f - LAM_INIT);
#pragma unroll
        for (int e = 0; e < 8; ++e) d[e] *= r * sw[e];
        *(u32x4*)(obuf + (size_t)t * 1024 + h * 128 + 8 * jj) = (u32x4){pk2(d[0], d[1]), pk2(d[2], d[3]), pk2(d[4], d[5]), pk2(d[6], d[7])};
    }
    {
        const bfu* po01 = (const bfu*)(p.ws + OFF_HBUF); const bfu* po2 = (const bfu*)(p.ws + OFF_PO2); const float* plse = (const float*)(p.ws + OFF_PLSE);
        const int hm = lane >> 3, j8 = (lane & 7) * 8;
        for (int t = gw; t < T; t += nwv) {
            const float4 ls = *(const float4*)(plse + ((size_t)t * 8 + hm) * 4);
            const float mx = fmaxf(fmaxf(ls.x, ls.y), fmaxf(ls.z, ls.w));
            float w0 = exp2f(ls.x - mx), w1 = exp2f(ls.y - mx), w2 = exp2f(ls.z - mx), w3 = exp2f(ls.w - mx);
            const float inv = 1.f / (w0 + w1 + w2 + w3); w0 *= inv; w1 *= inv; w2 *= inv; w3 *= inv;
            bfu* dst = obuf + (size_t)t * 1024 + 512 + hm * 64 + j8;
            const u32x4 z = {0u, 0u, 0u, 0u};
            const u32x4 a0 = (w0 > 0.f) ? *(const u32x4*)(po01 + (size_t)t * 512 + hm * 64 + j8) : z;
            const u32x4 a1 = (w1 > 0.f) ? *(const u32x4*)(po01 + (size_t)T * 512 + (size_t)t * 512 + hm * 64 + j8) : z;
            const u32x4 a2 = (w2 > 0.f) ? *(const u32x4*)(po2 + (size_t)t * 512 + hm * 64 + j8) : z;
            const u32x4 a3 = *(const u32x4*)dst;
            unsigned r[4];
#pragma unroll
            for (int e = 0; e < 4; ++e) {
                const float lo = w0 * bflo(a0[e]) + w1 * bflo(a1[e]) + w2 * bflo(a2[e]) + w3 * bflo(a3[e]);
                const float hi = w0 * bfhi(a0[e]) + w1 * bfhi(a1[e]) + w2 * bfhi(a2[e]) + w3 * bfhi(a3[e]);
                r[e] = pk2(lo, hi);
            }
            *(u32x4*)dst = (u32x4){r[0], r[1], r[2], r[3]};
        }
    }
}

struct Top3 { float v0, v1, v2; int i0, i1, i2; };
DI Top3 top3_ins(Top3 t, float v, int i) {
    const bool g0 = (v > t.v0) || (v == t.v0 && i < t.i0), g1 = (v > t.v1) || (v == t.v1 && i < t.i1), g2 = (v > t.v2) || (v == t.v2 && i < t.i2);
    Top3 r;
    r.v2 = g1 ? t.v1 : (g2 ? v : t.v2); r.i2 = g1 ? t.i1 : (g2 ? i : t.i2);
    r.v1 = g0 ? t.v0 : (g1 ? v : t.v1); r.i1 = g0 ? t.i0 : (g1 ? i : t.i1);
    r.v0 = g0 ? v : t.v0; r.i0 = g0 ? i : t.i0;
    return r;
}

struct MobaG {
    const int* cnt; const unsigned short* seg; int chunk, jblk, tokbase, h; bfu *po01, *po2; float* plse;
};
template <int DK, int DV, int MODE>
DI void attn_item(const bfu* __restrict__ Qp, int qp, const bfu* __restrict__ Kp, int kp, const bfu* __restrict__ Vp, int vp,
                  long rowbase, int rs, int q0, bfu* __restrict__ Op, int op, float* __restrict__ lsep, int lsest,
                  const float* __restrict__ kpart, char* smem, int jfirst = 0, const MobaG* mg = nullptr) {
    constexpr int KPT = DK + 8, KCH = DK / 8, VCH = DV / 8, NKL = (64 * KCH + NT - 1) / NT, NVL = 64 * VCH / NT, NDV = DV / 32, ND0 = DK / 16;
    constexpr int KST = 64 * KPT, VST = 64 * DV;
    bfu* Ks = (bfu*)smem; bfu* Vs = Ks + 3 * KST;
    short* tlist = (short*)(Vs + 3 * VST);
    int* misc = (int*)(tlist + 192);
    float* km = (float*)(misc + 4);
    unsigned* selm = (unsigned*)(km + 2048);
    float* cand = (float*)(selm + 256);
    const int tid = threadIdx.x, lane = tid & 63, wid = tid >> 6, l32 = lane & 31, hi = lane >> 5;
    const int qw = q0 + wid * 32, qstep = qw + l32;
    unsigned mysel = 0;
    bool g_active = true; size_t g_tok = 0; int g_slot = 0, g_total = 0;
    if (MODE == 3) {
        const int myc = (lane < 32 && lane > mg->jblk) ? mg->cnt[lane] : 0;
        int inc = myc;
#pragma unroll
        for (int d = 1; d < 32; d <<= 1) { const int t_ = __shfl_up(inc, d); if ((lane & 31) >= d) inc += t_; }
        const int exc = inc - myc;
        g_total = __builtin_amdgcn_readlane(inc, 31);
        const int pp = mg->chunk * 256 + wid * 32 + l32;
        g_active = pp < g_total;
        int n = 31, pbase = __builtin_amdgcn_readlane(exc, 31);
#pragma unroll
        for (int c = 31; c >= 1; --c) { const int pc = __builtin_amdgcn_readlane(exc, c); if (pp < pc) { n = c - 1; } }
#pragma unroll
        for (int c = 0; c < 32; ++c) { const int pc = __builtin_amdgcn_readlane(exc, c); if (c == n) pbase = pc; }
        const unsigned short e = g_active ? mg->seg[(size_t)n * 256 + (pp - pbase)] : (unsigned short)0;
        g_slot = e >> 8;
        g_tok = (size_t)mg->tokbase + (g_active ? (size_t)(n * 256 + (e & 255)) : 0);
    }
    if (MODE == 2) {
        const int nb = q0 >> 8;
        for (int idx = tid; idx < nb * 64; idx += NT) {
            const int blk = idx >> 6, d = idx & 63; const float* kq = kpart + (size_t)(blk * 4) * 512 + d;
            km[idx] = (kq[0] + kq[512] + kq[1024] + kq[1536]) * (1.f / 256.f);
        }
        if (tid == 0) misc[1] = 0;
        __syncthreads();
        {
            const int qq = tid & 255, hf = tid >> 8;
            const bfu* qr = Qp + (size_t)(rowbase + q0 + qq) * qp;
            float qv[64];
#pragma unroll
            for (int c8 = 0; c8 < 8; ++c8) {
                const u32x4 w = *(const u32x4*)(qr + c8 * 8);
#pragma unroll
                for (int e = 0; e < 4; ++e) { qv[c8 * 8 + 2 * e] = bflo(w[e]); qv[c8 * 8 + 2 * e + 1] = bfhi(w[e]); }
            }
            Top3 tp; tp.v0 = -3e38f; tp.v1 = -3e38f; tp.v2 = -3e38f; tp.i0 = 64; tp.i1 = 64; tp.i2 = 64;
            for (int blk = hf; blk < nb; blk += 2) {
                float g = 0.f;
#pragma unroll
                for (int d = 0; d < 64; ++d) g += qv[d] * km[blk * 64 + d];
                tp = top3_ins(tp, g, blk);
            }
            cand[tid * 6 + 0] = tp.v0; cand[tid * 6 + 1] = tp.v1; cand[tid * 6 + 2] = tp.v2;
            cand[tid * 6 + 3] = __int_as_float(tp.i0); cand[tid * 6 + 4] = __int_as_float(tp.i1); cand[tid * 6 + 5] = __int_as_float(tp.i2);
        }
        __syncthreads();
        if (tid < 256) {
            Top3 tp; tp.v0 = cand[tid * 6]; tp.v1 = cand[tid * 6 + 1]; tp.v2 = cand[tid * 6 + 2];
            tp.i0 = __float_as_int(cand[tid * 6 + 3]); tp.i1 = __float_as_int(cand[tid * 6 + 4]); tp.i2 = __float_as_int(cand[tid * 6 + 5]);
            const int o = (tid + 256) * 6;
#pragma unroll
            for (int e = 0; e < 3; ++e) { const int ii = __float_as_int(cand[o + 3 + e]); tp = top3_ins(tp, cand[o + e], ii); }
            unsigned mk = 0;
            if (tp.i0 < 32) mk |= 1u << tp.i0;
            if (tp.i1 < 32) mk |= 1u << tp.i1;
            if (tp.i2 < 32) mk |= 1u << tp.i2;
            selm[tid] = mk;
            atomicOr((unsigned*)&misc[1], mk);
        }
        __syncthreads();
        mysel = selm[wid * 32 + l32];
    }
    int jbase = 0, nt;
    if (MODE == 0) { jbase = jfirst; nt = (q0 >> 6) + 4 - jfirst; }
    else if (MODE == 1) { jbase = (q0 >> 6) >= 2 ? (q0 >> 6) - 2 : 0; nt = (q0 >> 6) + 4 - jbase; }
    else if (MODE == 3) { jbase = mg->jblk * 4; nt = 4; }
    else {
        if (tid == 0) {
            const unsigned om = (unsigned)misc[1]; const int nb = q0 >> 8; int n = 0;
            for (int blk = 0; blk < nb; ++blk) if ((om >> blk) & 1u) { tlist[n++] = (short)(blk * 4); tlist[n++] = (short)(blk * 4 + 1); tlist[n++] = (short)(blk * 4 + 2); tlist[n++] = (short)(blk * 4 + 3); }
            for (int jx = nb * 4; jx <= nb * 4 + 3; ++jx) tlist[n++] = (short)jx;
            misc[0] = n;
        }
        __syncthreads();
        nt = misc[0];
    }
#define ATT_TILE(I) ((MODE == 2) ? (int)tlist[(I)] : jbase + (I))
    bf16x8 qf[ND0];
    {
        const bfu* qr = Qp + ((MODE == 3) ? g_tok : (size_t)(rowbase + (long)qstep * rs)) * qp + hi * 8;
#pragma unroll
        for (int d0 = 0; d0 < ND0; ++d0) qf[d0] = *(const bf16x8*)(qr + d0 * 16);
    }
    float m = 0.f, l = 0.f; bool anym = false;
    f32x16 o[NDV];
#pragma unroll
    for (int dvb = 0; dvb < NDV; ++dvb)
#pragma unroll
        for (int r = 0; r < 16; ++r) o[dvb][r] = 0.f;
    int krow[NKL], kch[NKL], vrow[NVL], vch[NVL];
#pragma unroll
    for (int i = 0; i < NKL; ++i) { const int id = tid + NT * i; krow[i] = id / KCH; kch[i] = id % KCH; }
#pragma unroll
    for (int i = 0; i < NVL; ++i) { const int id = tid + NT * i; vrow[i] = id / VCH; vch[i] = id % VCH; }
    u32x4 rk[NKL], rv[NVL];
    const int rs1 = (MODE == 1) ? rs : 1;
    const bfu* Kb = Kp + (size_t)rowbase * kp; const bfu* Vb = Vp + (size_t)rowbase * vp;
    unsigned kofs[NKL], vofs[NVL];
#pragma unroll
    for (int i = 0; i < NKL; ++i) kofs[i] = (unsigned)(krow[i] * rs1) * (unsigned)kp + (unsigned)(kch[i] * 8);
#pragma unroll
    for (int i = 0; i < NVL; ++i) vofs[i] = (unsigned)(vrow[i] * rs1) * (unsigned)vp + (unsigned)(vch[i] * 8);
#define ATT_LOAD(JJ) do { const int j_ = __builtin_amdgcn_readfirstlane((int)(JJ)); \
    const bfu* kt_ = Kb + (size_t)((unsigned)(j_ * 64 * rs1) * (unsigned)kp); const bfu* vt_ = Vb + (size_t)((unsigned)(j_ * 64 * rs1) * (unsigned)vp); \
    _Pragma("unroll") for (int i = 0; i < NKL; ++i) if (NT * (i + 1) <= 64 * KCH || tid + NT * i < 64 * KCH) rk[i] = *(const u32x4*)(kt_ + kofs[i]); \
    _Pragma("unroll") for (int i = 0; i < NVL; ++i) rv[i] = *(const u32x4*)(vt_ + vofs[i]); } while (0)
#define ATT_STORE(ST) do { bfu* ks_ = Ks + (ST) * KST; bfu* vs_ = Vs + (ST) * VST; \
    _Pragma("unroll") for (int i = 0; i < NKL; ++i) if (NT * (i + 1) <= 64 * KCH || tid + NT * i < 64 * KCH) *(u32x4*)(ks_ + krow[i] * KPT + kch[i] * 8) = rk[i]; \
    _Pragma("unroll") for (int i = 0; i < NVL; ++i) *(u32x4*)(vs_ + (vch[i] >> 2) * 2048 + vrow[i] * 32 + (vch[i] & 3) * 8) = rv[i]; } while (0)
    ATT_LOAD(ATT_TILE(0));
    ATT_STORE(0);
    if (nt > 1) ATT_LOAD(ATT_TILE(1));
    __syncthreads();
    const lds_cptr vb0 = (lds_cptr)Vs + ((lane >> 4) & 1) * 32 + (lane & 3) * 8 + (4 * hi + ((lane & 15) >> 2)) * 64;
    const bfu* ksr0 = Ks + l32 * KPT + hi * 8;
    constexpr int NQK = 2 * ND0, NPV = 4 * NDV, OPA = 48 / NQK, EXB = 32 / NPV;
    static_assert(48 % NQK == 0 && 32 % NPV == 0, "filler split");
    f32x16 pA0, pA1;
    u32x4 pw[4];
    bool pend = false; int pstage = 0;
#define ATT_SLOW() do { if (__builtin_expect(anym || __any(ps > 1e12f), 0)) { \
        float mxp = fmaxf(pA0[0], pA1[0]); \
        _Pragma("unroll") for (int r = 1; r < 16; ++r) mxp = fmaxf(mxp, fmaxf(pA0[r], pA1[r])); \
        mxp = fmaxf(mxp, __shfl_xor(mxp, 32)); \
        const float e_ = (mxp > 0.f) ? (__builtin_amdgcn_logf(mxp) - m) : -1e30f; \
        const float delta = (e_ > 24.f) ? floorf(e_) : 0.f; \
        m += delta; \
        const float alpha = __builtin_amdgcn_exp2f(-delta), sc = __builtin_amdgcn_exp2f(-m); \
        l *= alpha; \
        _Pragma("unroll") for (int dvb = 0; dvb < NDV; ++dvb) _Pragma("unroll") for (int r = 0; r < 16; ++r) o[dvb][r] *= alpha; \
        ps = 0.f; \
        _Pragma("unroll") for (int r = 0; r < 16; ++r) { pA0[r] *= sc; pA1[r] *= sc; ps += pA0[r] + pA1[r]; } \
        _Pragma("unroll") for (int q = 0; q < 16; ++q) pw[q >> 2][q & 3] = (q < 8) ? pk2(pA0[2 * q], pA0[2 * q + 1]) : pk2(pA1[2 * q - 16], pA1[2 * q - 15]); \
        anym = anym || (__any(m != 0.f) != 0); } } while (0)
#define ATT_VFRAG(STG, G) ({ const lds_cptr vb_ = vb0 + (STG) * (VST * 2) + ((G) % NDV) * 4096 + ((G) / NDV) * 1024; \
        const s16x4 lo_ = vtr(vb_), hh_ = vtr(vb_ + 512); (bf16x8){lo_[0], lo_[1], lo_[2], lo_[3], hh_[0], hh_[1], hh_[2], hh_[3]}; })
#define ATT_FLUSH() do { float ps = 0.f; \
        _Pragma("unroll") for (int r = 0; r < 16; ++r) ps += pA0[r] + pA1[r]; \
        _Pragma("unroll") for (int q = 0; q < 16; ++q) pw[q >> 2][q & 3] = (q < 8) ? pk2(pA0[2 * q], pA0[2 * q + 1]) : pk2(pA1[2 * q - 16], pA1[2 * q - 15]); \
        ATT_SLOW(); l += ps; \
        _Pragma("unroll") for (int g = 0; g < NPV; ++g) { const bf16x8 vf_ = ATT_VFRAG(pstage, g); o[g % NDV] = MFMA(vf_, __builtin_bit_cast(bf16x8, pw[g / NDV]), o[g % NDV]); } \
        pend = false; } while (0)
    int cur = 0;
    for (int it = 0; it < nt; ++it) {
        const int nxt = (cur == 2) ? 0 : cur + 1;
        const int jc = __builtin_amdgcn_readfirstlane(ATT_TILE(it));
        if (it + 1 < nt) ATT_STORE(nxt);
        if (it + 2 < nt) ATT_LOAD(ATT_TILE(it + 2));
        __builtin_amdgcn_sched_barrier(0);
        bool need;
        if (MODE == 1) need = (jc * 64 <= qw + 31) && (jc * 64 + 63 >= qw - 128);
        else if (MODE == 3) need = (mg->chunk * 256 + wid * 32 < g_total);
        else {
            need = (jc * 64 <= qw + 31);
            if (MODE == 2) { const int blk = jc >> 2; if (blk < (q0 >> 8)) need = __any((mysel >> blk) & 1u) != 0; }
        }
        if (need) {
            const bfu* ksr = ksr0 + cur * KST;
            f32x16 s0, s1;
#pragma unroll
            for (int r = 0; r < 16; ++r) { s0[r] = 0.f; s1[r] = 0.f; }
            bf16x8 kf0[ND0], kf1[ND0];
#pragma unroll
            for (int d0 = 0; d0 < ND0; ++d0) { kf0[d0] = *(const bf16x8*)(ksr + d0 * 16); kf1[d0] = *(const bf16x8*)(ksr + 32 * KPT + d0 * 16); }
            __builtin_amdgcn_sched_barrier(0);
            if (pend) {
                float ps = 0.f;
#pragma unroll
                for (int g = 0; g < NQK; ++g) {
                    if (g & 1) s1 = MFMA(kf1[g >> 1], qf[g >> 1], s1); else s0 = MFMA(kf0[g >> 1], qf[g >> 1], s0);
#pragma unroll
                    for (int k = g * OPA; k < (g + 1) * OPA; ++k) {
                        if (k < 32) ps += (k < 16) ? pA0[k & 15] : pA1[k & 15];
                        else { const int q = k - 32; unsigned w_ = (q < 8) ? pk2(pA0[(2 * q) & 15], pA0[(2 * q + 1) & 15]) : pk2(pA1[(2 * q) & 15], pA1[(2 * q + 1) & 15]);
                               asm volatile("" : "+v"(w_)); pw[q >> 2][q & 3] = w_; }
                    }
                    asm volatile("" : "+v"(ps));
                    __builtin_amdgcn_sched_barrier(0);
                }
                ATT_SLOW();
                l += ps;
            } else {
#pragma unroll
                for (int d0 = 0; d0 < ND0; ++d0) { s0 = MFMA(kf0[d0], qf[d0], s0); s1 = MFMA(kf1[d0], qf[d0], s1); }
            }
            const int kbase = jc * 64 + 4 * hi;
            if (MODE == 1) {
#pragma unroll
                for (int r = 0; r < 16; ++r) {
                    const int dd = qstep - (kbase + (r & 3) + 8 * (r >> 2));
                    if (dd < 0 || dd > 128) s0[r] = -INFINITY;
                    if (dd - 32 < 0 || dd - 32 > 128) s1[r] = -INFINITY;
                }
            } else if (MODE != 3) {
                if (jc * 64 + 63 > qw) {
#pragma unroll
                    for (int r = 0; r < 16; ++r) {
                        const int ks = kbase + (r & 3) + 8 * (r >> 2);
                        if (ks > qstep) s0[r] = -INFINITY;
                        if (ks + 32 > qstep) s1[r] = -INFINITY;
                    }
                }
                if (MODE == 2) {
                    const int blk = jc >> 2;
                    if (blk < (q0 >> 8) && !((mysel >> blk) & 1u)) {
#pragma unroll
                        for (int r = 0; r < 16; ++r) { s0[r] = -INFINITY; s1[r] = -INFINITY; }
                    }
                }
            }
            if (pend) {
                asm volatile("" : "+v"(s0), "+v"(s1));
                __builtin_amdgcn_sched_barrier(0);
                bf16x8 vfc_ = ATT_VFRAG(pstage, 0), vfd_ = ATT_VFRAG(pstage, 1);
#pragma unroll
                for (int g = 0; g < NPV; ++g) {
                    const bf16x8 vfn_ = (g + 2 < NPV) ? ATT_VFRAG(pstage, (g + 2 < NPV ? g + 2 : g)) : vfd_;
                    o[g % NDV] = MFMA(vfc_, __builtin_bit_cast(bf16x8, pw[g / NDV]), o[g % NDV]);
                    vfc_ = vfd_; vfd_ = vfn_;
#pragma unroll
                    for (int k = g * EXB; k < (g + 1) * EXB; ++k) {
                        float t_ = __builtin_amdgcn_exp2f((k < 16) ? s0[k & 15] : s1[k & 15]);
                        asm volatile("" : "+v"(t_));
                        if (k < 16) s0[k & 15] = t_; else s1[k & 15] = t_;
                    }
                    __builtin_amdgcn_sched_barrier(0);
                }
            } else {
#pragma unroll
                for (int r = 0; r < 16; ++r) { s0[r] = __builtin_amdgcn_exp2f(s0[r]); s1[r] = __builtin_amdgcn_exp2f(s1[r]); }
            }
            pA0 = s0; pA1 = s1; pend = true; pstage = cur;
        } else if (pend) {
            ATT_FLUSH();
        }
        __syncthreads();
        cur = nxt;
    }
    if (pend) ATT_FLUSH();
#undef ATT_SLOW
#undef ATT_VFRAG
#undef ATT_FLUSH
#undef ATT_LOAD
#undef ATT_TILE
#undef ATT_STORE
    l += __shfl_xor(l, 32);
    const float inv = 1.f / l;
    const size_t tok = (MODE == 3) ? g_tok : (size_t)(rowbase + (long)qstep * rs);
    bfu* Ow = Op + tok * op;
    if (MODE == 3) Ow = (g_slot == 2 ? mg->po2 : mg->po01 + (size_t)g_slot * ((size_t)T * 512)) + tok * 512 + mg->h * 64;
    if (MODE != 3 || g_active) {
#pragma unroll
        for (int dvb = 0; dvb < NDV; ++dvb)
#pragma unroll
            for (int i = 0; i < 4; ++i) {
                const int dv = dvb * 32 + 8 * i + 4 * hi;
                *(u32x2*)(Ow + dv) = (u32x2){pk2(o[dvb][4 * i] * inv, o[dvb][4 * i + 1] * inv), pk2(o[dvb][4 * i + 2] * inv, o[dvb][4 * i + 3] * inv)};
            }
        if (MODE == 3) { if (hi == 0) mg->plse[(tok * 8 + mg->h) * 4 + g_slot] = m + __builtin_amdgcn_logf(l); }
        else if (MODE == 1 || (MODE == 0 && lsep != nullptr)) { if (hi == 0) lsep[tok * lsest] = m + __builtin_amdgcn_logf(l); }
    }
}

DI void phase_attn_even(const Params& p, char* smem, int* s_item, int rep) {
    char* ws = p.ws;
    const bfu* ubuf = (const bfu*)(ws + OFF_UBUF);
    const bfu* Qa = (const bfu*)p.out; const bfu* Ka = Qa + (size_t)T * 768; const bfu* Va = Ka + (size_t)T * 768;
    bfu* obuf = (bfu*)(ws + OFF_OBUF); bfu* dil_o = (bfu*)(ws + OFF_HBUF); float* dil_lse = (float*)(ws + OFF_HBUF + 48 * MiB);
    const int nblk = gridDim.x;
    for (int it = blockIdx.x; it < 1024; it += nblk) {
        int bh, qt;
        if (nblk == 256) { const int x = blockIdx.x & 7, li = blockIdx.x >> 3, hs = it >> 8; bh = x + 8 * hs; qt = (hs & 1) ? li : 31 - li; }
        else { bh = it & 31; qt = 31 - (it >> 5); }
        const int b = bh >> 3, h = bh & 7;
        __syncthreads();
        attn_item<96, 64, 0>(Qa + h * 96, 768, Ka + h * 96, 768, Va + h * 64, 512, (long)b * SEQ, 1, qt * 256, obuf + h * 64, 768, nullptr, 0, nullptr, smem);
    }
    for (int i2 = blockIdx.x; i2 < 1536; i2 += nblk) {
        const int g = i2 >> 9, r2 = i2 & 511, h = r2 & 3, b = (r2 >> 2) & 3, qi = r2 >> 4;
        const int rr = (g == 0) ? 1 : (g == 1 ? 4 : 16), tpc = 32 / rr, cls = qi / tpc, st = qi % tpc;
        const int gh = g * 4 + h;
        __syncthreads();
        attn_item<64, 64, 1>(ubuf + 672 + gh * 64, 3072, ubuf + 672 + 768 + gh * 64, 3072, ubuf + 672 + 1536 + gh * 64, 3072, (long)b * SEQ + cls, rr, st * 256,
                             dil_o + gh * 64, 768, dil_lse + gh, 12, nullptr, smem);
    }
}
DI void phase_moba_select(const Params& p, char* smem) {
    char* ws = p.ws;
    const bfu* ubuf = (const bfu*)(ws + OFF_UBUF); const float* kpart_all = (const float*)(ws + OFF_KPART);
    float* plse = (float*)(ws + OFF_PLSE); unsigned short* seg = (unsigned short*)(ws + OFF_SEG); int* cnt = (int*)(ws + OFF_CNT);
    float* km = (float*)smem; float* cand = km + 2048; int* sel3 = (int*)(cand + NT * 6); int* wcnt = sel3 + 768;
    const int tid = threadIdx.x, lane = tid & 63, wid = tid >> 6;
    for (int it = blockIdx.x; it < 1024; it += gridDim.x) {
        const int bh = it & 31, n = 31 - (it >> 5), b = bh >> 3, h = bh & 7;
        const float* kpart = kpart_all + (size_t)b * (32 * 4 * 512) + h * 64;
        const bfu* Qp = ubuf + 1536 + h * 64;
        __syncthreads();
        for (int idx = tid; idx < n * 64; idx += NT) {
            const int blk = idx >> 6, d = idx & 63; const float* kq = kpart + (size_t)(blk * 4) * 512 + d;
            km[idx] = (kq[0] + kq[512] + kq[1024] + kq[1536]) * (1.f / 256.f);
        }
        if (tid < 32 && tid >= n) cnt[(bh * 32 + tid) * 32 + n] = 0;
        __syncthreads();
        {
            const int qq = tid & 255, hf = tid >> 8;
            const bfu* qr = Qp + (size_t)(b * SEQ + n * 256 + qq) * 3072;
            float qv[64];
#pragma unroll
            for (int c8 = 0; c8 < 8; ++c8) {
                const u32x4 w = *(const u32x4*)(qr + c8 * 8);
#pragma unroll
                for (int e = 0; e < 4; ++e) { qv[c8 * 8 + 2 * e] = bflo(w[e]); qv[c8 * 8 + 2 * e + 1] = bfhi(w[e]); }
            }
            Top3 tp; tp.v0 = -3e38f; tp.v1 = -3e38f; tp.v2 = -3e38f; tp.i0 = 64; tp.i1 = 64; tp.i2 = 64;
            for (int blk = hf; blk < n; blk += 2) {
                float g = 0.f;
#pragma unroll
                for (int d = 0; d < 64; ++d) g += qv[d] * km[blk * 64 + d];
                tp = top3_ins(tp, g, blk);
            }
            cand[tid * 6 + 0] = tp.v0; cand[tid * 6 + 1] = tp.v1; cand[tid * 6 + 2] = tp.v2;
            cand[tid * 6 + 3] = __int_as_float(tp.i0); cand[tid * 6 + 4] = __int_as_float(tp.i1); cand[tid * 6 + 5] = __int_as_float(tp.i2);
        }
        __syncthreads();
        if (tid < 256) {
            Top3 tp; tp.v0 = cand[tid * 6]; tp.v1 = cand[tid * 6 + 1]; tp.v2 = cand[tid * 6 + 2];
            tp.i0 = __float_as_int(cand[tid * 6 + 3]); tp.i1 = __float_as_int(cand[tid * 6 + 4]); tp.i2 = __float_as_int(cand[tid * 6 + 5]);
            const int o = (tid + 256) * 6;
#pragma unroll
            for (int e = 0; e < 3; ++e) { const int ii = __float_as_int(cand[o + 3 + e]); tp = top3_ins(tp, cand[o + e], ii); }
            sel3[tid * 3 + 0] = tp.i0 < 32 ? tp.i0 : -1; sel3[tid * 3 + 1] = tp.i1 < 32 ? tp.i1 : -1; sel3[tid * 3 + 2] = tp.i2 < 32 ? tp.i2 : -1;
            float* pl = plse + ((size_t)(b * SEQ + n * 256 + tid) * 8 + h) * 4;
            if (tp.i0 >= 32) pl[0] = -INFINITY;
            if (tp.i1 >= 32) pl[1] = -INFINITY;
            if (tp.i2 >= 32) pl[2] = -INFINITY;
        }
        __syncthreads();
        int q0s = -1, q1s = -1, q2s = -1;
        if (tid < 256) { q0s = sel3[tid * 3]; q1s = sel3[tid * 3 + 1]; q2s = sel3[tid * 3 + 2]; }
        for (int j = 0; j < n; ++j) {
            const unsigned long long bal = __ballot(q0s == j || q1s == j || q2s == j);
            if (lane == 0 && wid < 4) wcnt[j * 4 + wid] = __popcll(bal);
        }
        __syncthreads();
        for (int j = 0; j < n; ++j) {
            const int sl = (q0s == j) ? 0 : (q1s == j) ? 1 : (q2s == j) ? 2 : -1;
            const unsigned long long bal = __ballot(sl >= 0);
            if (sl >= 0) {
                int off = __popcll(bal & ((1ull << lane) - 1ull));
                for (int w = 0; w < wid; ++w) off += wcnt[j * 4 + w];
                seg[((size_t)((bh * 32 + j) * 32 + n)) * 256 + off] = (unsigned short)(tid | (sl << 8));
            }
            if (tid == 0) cnt[(bh * 32 + j) * 32 + n] = wcnt[j * 4] + wcnt[j * 4 + 1] + wcnt[j * 4 + 2] + wcnt[j * 4 + 3];
        }
    }
    __syncthreads();
}

DI void phase_attn_odd(const Params& p, char* smem, int* s_item, int rep) {
    char* ws = p.ws;
    const bfu* ubuf = (const bfu*)(ws + OFF_UBUF);
    bfu* obuf = (bfu*)(ws + OFF_OBUF); bfu* dbuf = (bfu*)(ws + OFF_DBUF);
    float* plse = (float*)(ws + OFF_PLSE); const unsigned short* seg = (const unsigned short*)(ws + OFF_SEG); const int* cnt = (const int*)(ws + OFF_CNT);
    const int nblk = gridDim.x, tid = threadIdx.x;
    int* cpre = (int*)(smem + 114688);
    __syncthreads();
    for (int e = tid; e < 1024; e += NT) {
        const int j = e & 31; int sum = 0;
        for (int n = j + 1; n < 32; ++n) sum += cnt[e * 32 + n];
        cpre[e + 1] = (sum + 255) >> 8;
    }
    __syncthreads();
    if (tid == 0) { int a = 0; cpre[0] = 0; for (int e = 1; e <= 1024; ++e) { a += cpre[e]; cpre[e] = a; } }
    __syncthreads();
    const int nchunks = cpre[1024];
    for (int it = blockIdx.x; it < 2048; it += nblk) {
        int bh, qt, kind;
        if (nblk == 256) { const int x = blockIdx.x & 7, li = blockIdx.x >> 3, hs = it >> 8; kind = hs >> 2; bh = x + 8 * (hs & 3); qt = (hs & 1) ? li : 31 - li; }
        else { kind = (it >> 5) & 1; bh = it & 31; qt = 31 - (it >> 6); }
        const int b = bh >> 3, hh = bh & 7;
        __syncthreads();
        if (kind == 0) {
            attn_item<64, 128, 0>(ubuf + hh * 64, 3072, ubuf + 512 + hh * 64, 3072, ubuf + 1024 + (hh >> 1) * 128, 3072, (long)b * SEQ, 1, qt * 256,
                                  dbuf + hh * 128, 1024, nullptr, 0, nullptr, smem);
        } else {
            attn_item<64, 64, 0>(ubuf + 1536 + hh * 64, 3072, ubuf + 2048 + hh * 64, 3072, ubuf + 2560 + hh * 64, 3072, (long)b * SEQ, 1, qt * 256,
                                 obuf + 512 + hh * 64, 1024, plse + hh * 4 + 3, 32, nullptr, smem, qt * 4);
        }
    }
    for (int i = blockIdx.x; i < nchunks; i += nblk) {
        int lo = 0, hi2 = 1023;
        while (lo < hi2) { const int mid = (lo + hi2 + 1) >> 1; if (cpre[mid] <= i) lo = mid; else hi2 = mid - 1; }
        const int e = lo, bh = e >> 5, j = e & 31, b = bh >> 3, hh = bh & 7;
        MobaG mg; mg.cnt = cnt + e * 32; mg.seg = seg + (size_t)(e * 32) * 256; mg.chunk = i - cpre[e]; mg.jblk = j; mg.tokbase = b * SEQ; mg.h = hh;
        mg.po01 = (bfu*)(ws + OFF_HBUF); mg.po2 = (bfu*)(ws + OFF_PO2); mg.plse = plse;
        __syncthreads();
        attn_item<64, 64, 3>(ubuf + 1536 + hh * 64, 3072, ubuf + 2048 + hh * 64, 3072, ubuf + 2560 + hh * 64, 3072, (long)b * SEQ, 1, 0,
                             nullptr, 0, nullptr, 0, nullptr, smem, 0, &mg);
    }
}

#define XB_TMO      128
#define XB_XCNT(j)  (256  + 64 * (j))
#define XB_XSUB(j)  (1280 + 64 * (j))
#define XB_XGEN(j)  (2304 + 64 * (j))
#define XB_TOP      3328
#define XB_TOPGEN   3392
#define XCD_BAR_WORDS 3456
#define XB_SPIN_CAP (1u << 18)
#define LAS __attribute__((address_space(3)))

__device__ __forceinline__ unsigned xb_ld(unsigned* p)              { return __hip_atomic_load(p, __ATOMIC_RELAXED, __HIP_MEMORY_SCOPE_AGENT); }
__device__ __forceinline__ unsigned xb_add(unsigned* p, unsigned v) { return __hip_atomic_fetch_add(p, v, __ATOMIC_RELAXED, __HIP_MEMORY_SCOPE_AGENT); }
__device__ __forceinline__ unsigned xb_xcc_id() { return (unsigned)__builtin_amdgcn_s_getreg((3 << 11) | 20) & 0xFu; }
#define XB_SPIN(cond, bar) do { unsigned _sp = 0; while (cond) { __builtin_amdgcn_s_sleep(1); \
    if ((++_sp & 255u) == 0u) { if (xb_ld(&(bar)[XB_TMO])) break; if (_sp > XB_SPIN_CAP) { atomicAdd(&(bar)[XB_TMO], 1u); break; } } } } while (0)

struct XcdBarrier {
    unsigned* bar; unsigned x;
    volatile LAS unsigned* st;
};

__device__ __forceinline__ XcdBarrier xcd_barrier_post(unsigned* bar, volatile LAS unsigned* st) {
    XcdBarrier b; b.bar = bar; b.x = xb_xcc_id(); b.st = st;
    if (threadIdx.x == 0) (void)xb_add(&bar[XB_XCNT(b.x)], 1u);
    return b;
}
__device__ __forceinline__ void xcd_barrier_complete(unsigned* bar, unsigned x, unsigned& nloc, unsigned& nx) {
    const unsigned G = gridDim.x * gridDim.y * gridDim.z;
    unsigned sum, cnt, mine, sp = 0u;
    for (;;) {
        sum = 0u; cnt = 0u; mine = 0u;
#pragma unroll
        for (unsigned j = 0; j < 16; ++j) { const unsigned c = xb_ld(&bar[XB_XCNT(j)]); sum += c; cnt += (c > 0u) ? 1u : 0u; mine = (j == x) ? c : mine; }
        if (sum == G) break;
        __builtin_amdgcn_s_sleep(1);
        if ((++sp & 255u) == 0u) { if (xb_ld(&bar[XB_TMO])) break; if (sp > XB_SPIN_CAP) { atomicAdd(&bar[XB_TMO], 1u); break; } }
    }
    nloc = mine > 0u ? mine : 1u; nx = cnt > 0u ? cnt : 1u;
}

__device__ __forceinline__ void xcd_barrier(const XcdBarrier& b) {
    asm volatile("s_waitcnt vmcnt(0)" ::: "memory");
    __syncthreads();
    if (threadIdx.x == 0) {
        unsigned* bar = b.bar;
        __builtin_amdgcn_s_waitcnt(0);
        unsigned nloc = b.st[0], nx = b.st[1];
        if (nloc == 0u) { xcd_barrier_complete(bar, b.x, nloc, nx); b.st[0] = nloc; b.st[1] = nx; }
        const unsigned old = xb_add(&bar[XB_XSUB(b.x)], 1u);
        const unsigned gen = old / nloc;
        if (old + 1u == (gen + 1u) * nloc) {
            __builtin_amdgcn_fence(__ATOMIC_RELEASE, "agent");
            asm volatile("s_waitcnt vmcnt(0)" ::: "memory");
            const unsigned og = xb_add(&bar[XB_TOP], 1u);
            const unsigned tg = og / nx;
            if (og + 1u == (tg + 1u) * nx) xb_add(&bar[XB_TOPGEN], 1u);
            else XB_SPIN(xb_ld(&bar[XB_TOPGEN]) == tg, bar);
            __builtin_amdgcn_fence(__ATOMIC_ACQUIRE, "agent");
            xb_add(&bar[XB_XGEN(b.x)], 1u);
            asm volatile("s_waitcnt vmcnt(0)" ::: "memory");
        } else {
            XB_SPIN(xb_ld(&bar[XB_XGEN(b.x)]) == gen, bar);
            __builtin_amdgcn_fence(__ATOMIC_ACQUIRE, "agent");
            asm volatile("s_waitcnt vmcnt(0)" ::: "memory");
        }
    }
    __syncthreads();
}

#ifndef MK_REPMASK
#define MK_REPMASK 0u
#endif
#define PHASE_BEGIN(k) if (p.phase_lo <= (k) && (k) < p.phase_hi) { for (int rep_ = 0; rep_ < (((MK_REPMASK >> (k)) & 1u) ? 2 : 1); ++rep_) {
#define PHASE_MID(k) if (rep_ == 0 && ((MK_REPMASK >> (k)) & 1u)) xcd_barrier(xb); }
#define PHASE_END(k) PHASE_MID(k) if (p.coop && (k) + 1 < p.phase_hi) xcd_barrier(xb); }
__global__ void __launch_bounds__(512, 2) mega(Params p) {
    extern __shared__ __attribute__((aligned(16))) char smem[];
    __shared__ int s_item;
    __shared__ uint4 xb_words;
    char* ws = p.ws;
    if (threadIdx.x == 0) xb_words = make_uint4(0u, 0u, 0u, 0u);
    __syncthreads();
    XcdBarrier xb = xcd_barrier_post((unsigned*)(ws + OFF_CTR + 4096), (volatile LAS unsigned*)&xb_words);
    bfu* hbuf = (bfu*)(ws + OFF_HBUF); bfu* obuf = (bfu*)(ws + OFF_OBUF); bfu* ubuf = (bfu*)(ws + OFF_UBUF); bfu* hid = ubuf;
    const float* mod0 = (const float*)(ws + OFF_MOD); const float* mod1 = mod0 + 4 * 6144;
    PHASE_BEGIN(0) phase_prep(p, smem); PHASE_END(0)
    PHASE_BEGIN(1) phase_modfin(p); PHASE_END(1)
    PHASE_BEGIN(2) phase_normmod(p.x, p.norm_mix, mod0, 0, hbuf); PHASE_END(2)
    PHASE_BEGIN(3) phase_gemm8<0>(hbuf, 1024, (const bfu*)(ws + OFF_WIN0), 1024, 2976, 12, ubuf, 3072, nullptr, nullptr, nullptr, smem); PHASE_END(3)
#if MK_PROBE
    if (p.coop) { phase_gemm_probe<MK_PROBE - 1>(hbuf, (const bfu*)(ws + OFF_WIN0), (float*)(ws + OFF_DBUF), p.pad_, smem); xcd_barrier(xb); }
#endif
    PHASE_BEGIN(4)
            phase_gemm8<0>(ubuf, 3072, (const bfu*)(ws + OFF_WUQ), 384, 768, 3, hbuf, 768, nullptr, nullptr, nullptr, smem);
            phase_gemm8<0>(ubuf + 384, 3072, (const bfu*)(ws + OFF_WUKV), 256, 1024, 4, obuf, 1024, nullptr, nullptr, nullptr, smem);
    PHASE_END(4)
    PHASE_BEGIN(5) phase_post_even(p); PHASE_END(5)
    PHASE_BEGIN(6) phase_attn_even(p, smem, &s_item, rep_); PHASE_END(6)
    PHASE_BEGIN(7) phase_dil_merge(p); PHASE_END(7)
    PHASE_BEGIN(8) phase_gemm8<2>(obuf, 768, (const bfu*)(ws + OFF_WOUT0), 768, 1024, 4, nullptr, 0, p.x, p.out, mod0 + 2048, smem); PHASE_END(8)
    PHASE_BEGIN(9) phase_normmod(p.out, p.norm_mlp, mod0, 3072, hbuf); PHASE_END(9)
    PHASE_BEGIN(10) phase_gemm8<1>(hbuf, 1024, (const bfu*)(ws + OFF_W1_0), 1024, 4096, 16, hid, 4096, nullptr, nullptr, nullptr, smem); PHASE_END(10)
    PHASE_BEGIN(11) phase_gemm8<2>(hid, 4096, (const bfu*)(ws + OFF_W2_0), 4096, 1024, 4, nullptr, 0, p.out, p.out, mod0 + 5120, smem); PHASE_END(11)
    PHASE_BEGIN(12) phase_normmod(p.out, p.norm_mix + 1024, mod1, 0, hbuf); PHASE_END(12)
    PHASE_BEGIN(13) phase_gemm_heads(p, hbuf, (const bfu*)(ws + OFF_WIN1), ubuf, smem); PHASE_END(13)
    PHASE_BEGIN(15) phase_moba_select(p, smem); if (p.coop) xcd_barrier(xb); phase_attn_odd(p, smem, &s_item, rep_); PHASE_END(15)
    PHASE_BEGIN(16) phase_diff_combine(p); PHASE_END(16)
    PHASE_BEGIN(17) phase_gemm8<2>(obuf, 1024, (const bfu*)(ws + OFF_WOUT1), 1024, 1024, 4, nullptr, 0, p.out, p.out, mod1 + 2048, smem); PHASE_END(17)
    PHASE_BEGIN(18) phase_normmod(p.out, p.norm_mlp + 1024, mod1, 3072, hbuf); PHASE_END(18)
    PHASE_BEGIN(19) phase_gemm8<1>(hbuf, 1024, (const bfu*)(ws + OFF_W1_1), 1024, 4096, 16, hid, 4096, nullptr, nullptr, nullptr, smem); PHASE_END(19)
    PHASE_BEGIN(20) phase_gemm8<2>(hid, 4096, (const bfu*)(ws + OFF_W2_1), 4096, 1024, 4, nullptr, 0, p.out, p.out, mod1 + 5120, smem); PHASE_END(20)
    if (p.coop == 2) cg::this_grid().sync();
}

extern "C" void kernel_launch(void* const* d_in, const int* in_sizes, int n_in, void* d_out, int out_size, void* d_ws, size_t ws_size, hipStream_t stream) {
    static int grid_blocks = 0;
    if (!grid_blocks) {
        int dev = 0, cus = 0, per_cu = 0;
        (void)hipGetDevice(&dev);
        (void)hipDeviceGetAttribute(&cus, hipDeviceAttributeMultiprocessorCount, dev);
        (void)hipFuncSetAttribute((const void*)mega, hipFuncAttributeMaxDynamicSharedMemorySize, DYN_LDS);
        (void)hipOccupancyMaxActiveBlocksPerMultiprocessor(&per_cu, mega, NT, DYN_LDS);
        if (per_cu != 1) per_cu = 1;
        grid_blocks = cus * per_cu;
    }
    if (ws_size < WS_END) fprintf(stderr, "workspace too small: %zu < %zu\n", ws_size, (size_t)WS_END);
    Params p{};
    p.x = (const float*)d_in[0]; p.c = (const float*)d_in[1]; p.pos = (const int*)d_in[2];
    p.ada_w = (const float*)d_in[3]; p.ada_b = (const float*)d_in[4]; p.norm_mix = (const float*)d_in[5]; p.norm_mlp = (const float*)d_in[6];
    p.w1 = (const float*)d_in[7]; p.w2 = (const float*)d_in[8]; p.e_win = (const float*)d_in[9]; p.e_wout = (const float*)d_in[10];
    p.qlat = (const float*)d_in[11]; p.kvlat = (const float*)d_in[12]; p.wuq = (const float*)d_in[13]; p.wukv = (const float*)d_in[14];
    p.mla_qn = (const float*)d_in[15]; p.mla_kn = (const float*)d_in[16]; p.dil_qn = (const float*)d_in[17]; p.dil_kn = (const float*)d_in[18];
    p.o_win = (const float*)d_in[19]; p.o_wout = (const float*)d_in[20]; p.diff_qn = (const float*)d_in[21]; p.diff_kn = (const float*)d_in[22];
    p.diff_lam = (const float*)d_in[23]; p.diff_subln = (const float*)d_in[24]; p.moba_qn = (const float*)d_in[25]; p.moba_kn = (const float*)d_in[26];
    p.out = (float*)d_out; p.ws = (char*)d_ws;
    for (int i = 0; i < 32; ++i) p.invf64[i] = (float)pow(10000.0, -(double)i / 32.0);
    for (int i = 0; i < 16; ++i) p.invf32[i] = (float)pow(10000.0, -(double)i / 16.0);
    (void)hipMemsetAsync((char*)d_ws + OFF_CTR, 0, 32768, stream);
#if MK_COOP
    p.phase_lo = 0; p.phase_hi = NPH; p.coop = 1;
    void* args[] = {&p};
    hipError_t e = hipLaunchCooperativeKernel((void*)mega, dim3(grid_blocks), dim3(NT), args, DYN_LDS, stream);
    if (e != hipSuccess) fprintf(stderr, "cooperative launch failed: %s (grid %d)\n", hipGetErrorString(e), grid_blocks);
#else
    for (int ph = 0; ph < NPH; ++ph) {
        p.phase_lo = ph; p.phase_hi = ph + 1; p.coop = 0;
        hipLaunchKernelGGL(mega, dim3(grid_blocks), dim3(NT), DYN_LDS, stream, p);
    }
#endif
}
```
